# Optimizing an MI355X kernel written in HIP

```python
import math, functools
import jax, jax.numpy as jnp
from jax import lax
import numpy as np

D_MODEL = 1024
BATCH = 4
SEQ = 8192
DEPTH = 4

CTX_LEN = 256
GRID_W = 64

HEAD_DIM = 64
CHUNK = 64
GDN_HEADS = 4
GDN_WIDTH = GDN_HEADS * HEAD_DIM
SHORT_CONV = 3
S5_WIDTH = 256
S5_GROUP = 16
S5_GROUPS = S5_WIDTH // S5_GROUP
S5_STATE = 64
HGRN_HEADS = 4
HGRN_WIDTH = HGRN_HEADS * HEAD_DIM
RET_HEADS = 4
RET_WIDTH = RET_HEADS * HEAD_DIM
ROPE_BASE = 10000.0
D_MIX = GDN_WIDTH + S5_WIDTH + HGRN_WIDTH + RET_WIDTH

PROJ_SIZES = (
    3 * GDN_WIDTH,
    GDN_WIDTH,
    2 * GDN_HEADS,
    2 * GDN_HEADS,
    S5_WIDTH,
    HGRN_WIDTH,
    2 * HGRN_WIDTH,
    HGRN_WIDTH,
    HGRN_WIDTH,
    3 * RET_WIDTH,
    RET_WIDTH,
)
D_PROJ = sum(PROJ_SIZES)

FF_DENSE = 2816
N_EXPERTS = 8
TOP_K = 2
FF_EXPERT = 3584
MOE_BLOCK = 128
N_DENSE_LAYERS = (DEPTH + 1) // 2
N_MOE_LAYERS = DEPTH // 2

DEEPNORM_ALPHA = (2.0 * DEPTH) ** 0.25
DEEPNORM_BETA = (8.0 * DEPTH) ** -0.25
LN_EPS = 1e-5
RMS_EPS = 1e-6

kernel_name = "hybrid_parallel_mixer_diffusion_trunk"


def _f32(t):
    return t.astype(jnp.float32)


def _layer_norm(x, g, b):
    xf = _f32(x)
    mu = jnp.mean(xf, -1, keepdims=True)
    var = jnp.mean(jnp.square(xf - mu), -1, keepdims=True)
    return ((xf - mu) * lax.rsqrt(var + LN_EPS) * _f32(g) + _f32(b)).astype(x.dtype)


def _rms_norm(x, w=None):
    y = x * lax.rsqrt(jnp.mean(jnp.square(x), -1, keepdims=True) + RMS_EPS)
    return y if w is None else y * w


def _l2norm(t):
    return t * lax.rsqrt(jnp.sum(t * t, -1, keepdims=True) + RMS_EPS)


def _heads(t, n_heads):
    b, l, _ = t.shape
    return t.reshape(b, l, n_heads, -1).transpose(0, 2, 1, 3)


def _merge(t):
    b, h, l, d = t.shape
    return t.transpose(0, 2, 1, 3).reshape(b, l, h * d)


def _chunk(t):
    return t.reshape(t.shape[:2] + (t.shape[2] // CHUNK, CHUNK) + t.shape[3:])


def _scan_chunks(step, s0, xs):
    s, o = lax.scan(step, s0, tuple(jnp.moveaxis(t, 2, 0) for t in xs))
    o = jnp.moveaxis(o, 0, 2)
    return o.reshape(o.shape[:2] + (-1,) + o.shape[4:]), s


def _short_conv(x, w):
    pad = SHORT_CONV // 2
    return lax.conv_general_dilated(x, w[:, None, :], window_strides=(1,), padding=((pad, pad),),
                                    dimension_numbers=('NWC', 'WIO', 'NWC'),
                                    feature_group_count=x.shape[-1])


def _axial_rotary(t, rows, cols):
    half = t.shape[-1] // 2
    quarter = half // 2
    inv_freq = ROPE_BASE ** (-jnp.arange(quarter, dtype=jnp.float32) / quarter)
    ang = jnp.concatenate([rows[:, None] * inv_freq, cols[:, None] * inv_freq], axis=-1)
    cos, sin = jnp.cos(ang), jnp.sin(ang)
    t1, t2 = t[..., :half], t[..., half:]
    return jnp.concatenate([t1 * cos - t2 * sin, t1 * sin + t2 * cos], axis=-1)


def _bidirectional(run_f, run_b, ctx_f, ctx_b, lat_f, lat_b, axis, need_ctx):
    flip = lambda xs: tuple(jnp.flip(t, axis) for t in xs)
    o_cf, s_cf = run_f(*ctx_f, None)
    o_cb, s_cb = run_b(*flip(ctx_b), None)
    o_lf, _ = run_f(*lat_f, s_cf)
    o_lb, _ = run_b(*flip(lat_b), s_cb)
    o_lat = o_lf + jnp.flip(o_lb, axis)
    o_ctx = (o_cf + jnp.flip(o_cb, axis)) if need_ctx else None
    return o_ctx, o_lat


def _gdn_direction(q, k, v, g, beta, s0):
    bsz, nh, _, dk = q.shape
    dv = v.shape[-1]
    q, k, v, g, beta = (_chunk(t) for t in (q, k, v, g, beta))
    gc = jnp.cumsum(g, axis=-1)
    tri = jnp.tril(jnp.ones((CHUNK, CHUNK), bool))
    decay = jnp.exp(jnp.where(tri, gc[..., :, None] - gc[..., None, :], -jnp.inf))
    kb = k * beta[..., None]
    a = jnp.einsum('bhnik,bhnjk->bhnij', kb, k) * decay
    eye = jnp.broadcast_to(jnp.eye(CHUNK, dtype=a.dtype), a.shape)
    t_inv = lax.linalg.triangular_solve(a, eye, left_side=True, lower=True, unit_diagonal=True)
    u = jnp.einsum('bhnij,bhnjv->bhniv', t_inv, v * beta[..., None])
    w = jnp.einsum('bhnij,bhnjk->bhnik', t_inv, kb * jnp.exp(gc)[..., None])
    qk = jnp.einsum('bhnik,bhnjk->bhnij', q, k) * decay
    if s0 is None:
        s0 = jnp.zeros((bsz, nh, dk, dv), q.dtype)

    def step(s, inp):
        q_c, k_c, u_c, w_c, qk_c, g_c = inp
        v_new = u_c - jnp.einsum('bhck,bhkv->bhcv', w_c, s)
        o = (jnp.einsum('bhck,bhkv->bhcv', q_c * jnp.exp(g_c)[..., None], s)
             + jnp.einsum('bhij,bhjv->bhiv', qk_c, v_new))
        g_last = g_c[..., -1:]
        s = (s * jnp.exp(g_last)[..., None]
             + jnp.einsum('bhck,bhcv->bhkv', k_c * jnp.exp(g_last - g_c)[..., None], v_new))
        return s, o

    return _scan_chunks(step, s0, (q, k, u, w, qk, gc))


def _gdn_mixer(ctx_parts, lat_parts, conv_w, a_log, dt_bias, norm_w, need_ctx):
    def per_dir(t):
        return t.reshape(t.shape[0], t.shape[1], 2, GDN_HEADS).transpose(2, 0, 3, 1)

    def prep(qkv, a, b):
        qkv = jax.nn.silu(_short_conv(qkv, conv_w))
        q, k, v = (_heads(t, GDN_HEADS) for t in jnp.split(qkv, 3, axis=-1))
        q = _l2norm(q) * HEAD_DIM ** -0.5
        k = _l2norm(k)
        g = -jnp.exp(a_log)[:, None, :, None] * jax.nn.softplus(per_dir(a) + dt_bias[:, None, :, None])
        beta = jax.nn.sigmoid(per_dir(b))
        return (q, k, v, g[0], beta[0]), (q, k, v, g[1], beta[1])

    c_qkv, c_z, c_a, c_b = ctx_parts
    l_qkv, l_z, l_a, l_b = lat_parts
    cf, cb = prep(c_qkv, c_a, c_b)
    lf, lb = prep(l_qkv, l_a, l_b)
    o_ctx, o_lat = _bidirectional(_gdn_direction, _gdn_direction, cf, cb, lf, lb, 2, need_ctx)

    def readout(o, z):
        return _merge(_rms_norm(o, norm_w) * jax.nn.silu(_heads(z, GDN_HEADS)))

    return (readout(o_ctx, c_z) if need_ctx else None), readout(o_lat, l_z)


def _s5_direction(lam_bar, b_bar, c_mat, u, h0):
    bu = jnp.einsum('blgh,gph->blgp', u.astype(jnp.complex64), b_bar)
    if h0 is not None:
        bu = bu.at[:, 0].add(lam_bar * h0)
    a = jnp.broadcast_to(lam_bar, bu.shape)

    def combine(e1, e2):
        return e1[0] * e2[0], e2[0] * e1[1] + e2[1]

    _, states = lax.associative_scan(combine, (a, bu), axis=1)
    y = jnp.real(jnp.einsum('blgp,ghp->blgh', states, c_mat))
    return y, states[:, -1]


def _s5_mixer(u_ctx, u_lat, a_re, a_im, log_step, b_re, b_im, c_re, c_im, d_skip, glu_w, glu_b,
              need_ctx):
    lam = lax.complex(a_re, a_im)
    lam_bar = jnp.exp(lam * jnp.exp(log_step)[..., None])
    b_bar = ((lam_bar - 1.0) / lam)[..., None] * lax.complex(b_re, b_im)
    c_mat = lax.complex(c_re, c_im)
    run_f = functools.partial(_s5_direction, lam_bar[0], b_bar[0], c_mat[0])
    run_b = functools.partial(_s5_direction, lam_bar[1], b_bar[1], c_mat[1])
    grp = lambda t: t.reshape(t.shape[:2] + (S5_GROUPS, S5_GROUP))
    uc, ul = grp(u_ctx), grp(u_lat)
    y_ctx, y_lat = _bidirectional(run_f, run_b, (uc,), (uc,), (ul,), (ul,), 1, need_ctx)

    def readout(y, u):
        y = jax.nn.gelu(y.reshape(u.shape) + d_skip * u)
        return y * jax.nn.sigmoid(y @ glu_w + glu_b)

    return (readout(y_ctx, u_ctx) if need_ctx else None), readout(y_lat, u_lat)


def _hgrn2_direction(q, k, v, logf, s0):
    bsz, nh, _, dk = q.shape
    dv = v.shape[-1]
    q, k, v, logf = (_chunk(t) for t in (q, k, v, logf))
    gc = jnp.cumsum(logf, axis=3)
    tri = jnp.tril(jnp.ones((CHUNK, CHUNK), bool))[:, :, None]
    if s0 is None:
        s0 = jnp.zeros((bsz, nh, dk, dv), q.dtype)

    def step(s, inp):
        q_c, k_c, v_c, g_c = inp
        rel = jnp.exp(jnp.where(tri, g_c[:, :, :, None, :] - g_c[:, :, None, :, :], -jnp.inf))
        att = jnp.einsum('bhik,bhjk,bhijk->bhij', q_c, k_c, rel)
        o = (jnp.einsum('bhck,bhkv->bhcv', q_c * jnp.exp(g_c), s)
             + jnp.einsum('bhij,bhjv->bhiv', att, v_c))
        g_last = g_c[:, :, -1:, :]
        s = (s * jnp.exp(g_last[:, :, 0, :])[..., None]
             + jnp.einsum('bhck,bhcv->bhkv', k_c * jnp.exp(g_last - g_c), v_c))
        return s, o

    return _scan_chunks(step, s0, (q, k, v, gc))


def _hgrn2_mixer(ctx_parts, lat_parts, lower_bound, norm_w, need_ctx):
    lb = lower_bound.reshape(HGRN_HEADS, 1, -1)

    def prep(q, f, i):
        q = jax.nn.silu(_heads(q, HGRN_HEADS))
        i = _heads(i, HGRN_HEADS)
        dirs = []
        for fz in jnp.split(f, 2, axis=-1):
            logf = jnp.logaddexp(jnp.log(lb), jnp.log1p(-lb) + jax.nn.log_sigmoid(_heads(fz, HGRN_HEADS)))
            dirs.append((q, -jnp.expm1(logf), i, logf))
        return dirs

    c_q, c_f, c_i, c_g = ctx_parts
    l_q, l_f, l_i, l_g = lat_parts
    cf, cb = prep(c_q, c_f, c_i)
    lf, lb_ = prep(l_q, l_f, l_i)
    o_ctx, o_lat = _bidirectional(_hgrn2_direction, _hgrn2_direction, cf, cb, lf, lb_, 2, need_ctx)

    def readout(o, g):
        return _merge(_rms_norm(o, norm_w) * jax.nn.silu(_heads(g, HGRN_HEADS)))

    return (readout(o_ctx, c_g) if need_ctx else None), readout(o_lat, l_g)


def _retention_direction(log_gamma, q, k, v, s0):
    bsz, nh, _, dk = q.shape
    dv = v.shape[-1]
    q, k, v = (_chunk(t) for t in (q, k, v))
    idx = jnp.arange(CHUNK, dtype=jnp.float32)
    tri = jnp.tril(jnp.ones((CHUNK, CHUNK), bool))
    decay = jnp.exp(jnp.where(tri, (idx[:, None] - idx[None, :]) * log_gamma[:, None, None], -jnp.inf))
    intra = jnp.einsum('bhnij,bhnjv->bhniv',
                       jnp.einsum('bhnik,bhnjk->bhnij', q, k) * decay[None, :, None], v)
    q_dec = jnp.exp((idx + 1.0) * log_gamma[:, None])
    k_dec = jnp.exp((CHUNK - 1.0 - idx) * log_gamma[:, None])
    c_dec = jnp.exp(CHUNK * log_gamma)
    if s0 is None:
        s0 = jnp.zeros((bsz, nh, dk, dv), q.dtype)

    def step(s, inp):
        q_c, k_c, v_c = inp
        o = jnp.einsum('bhck,bhkv->bhcv', q_c * q_dec[None, :, :, None], s)
        s = s * c_dec[None, :, None, None] + jnp.einsum('bhck,bhcv->bhkv', k_c * k_dec[None, :, :, None], v_c)
        return s, o

    inter, s = _scan_chunks(step, s0, (q, k, v))
    return intra.reshape(inter.shape) + inter, s


def _retention_mixer(ctx_parts, lat_parts, rows, cols, decay_param, need_ctx):
    log_gamma = -jnp.exp(decay_param)

    def prep(qkv, rotate):
        q, k, v = (_heads(t, RET_HEADS) for t in jnp.split(qkv, 3, axis=-1))
        if rotate:
            q, k = _axial_rotary(q, rows, cols), _axial_rotary(k, rows, cols)
        return (q, k * HEAD_DIM ** -0.5, v)

    c_qkv, c_g = ctx_parts
    l_qkv, l_g = lat_parts
    cin, lin = prep(c_qkv, False), prep(l_qkv, True)
    run_f = functools.partial(_retention_direction, log_gamma[0])
    run_b = functools.partial(_retention_direction, log_gamma[1])
    o_ctx, o_lat = _bidirectional(run_f, run_b, cin, cin, lin, lin, 2, need_ctx)

    def readout(o, g):
        return _merge(_rms_norm(o) * jax.nn.silu(_heads(g, RET_HEADS)))

    return (readout(o_ctx, c_g) if need_ctx else None), readout(o_lat, l_g)


def _swiglu(h, w1, w3, w2):
    return (jax.nn.silu(h @ w1) * (h @ w3)) @ w2


def _moe_swiglu(h, router, w1, w3, w2):
    shape = h.shape
    tok = h.reshape(-1, shape[-1])
    n_tok = tok.shape[0]
    n_asg = n_tok * TOP_K
    logits = _f32(tok @ router)
    top_val, top_idx = lax.top_k(logits, TOP_K)
    gates = jax.nn.softmax(top_val, axis=-1)
    flat_e = top_idx.reshape(-1)
    order = jnp.argsort(flat_e)
    sorted_e = flat_e[order]
    counts = jnp.bincount(flat_e, length=N_EXPERTS)
    padded = (counts + MOE_BLOCK - 1) // MOE_BLOCK * MOE_BLOCK
    start = jnp.cumsum(counts) - counts
    pad_end = jnp.cumsum(padded)
    pad_start = pad_end - padded
    dest = pad_start[sorted_e] + jnp.arange(n_asg) - start[sorted_e]
    n_blocks = -(-n_asg // MOE_BLOCK) + N_EXPERTS
    n_rows = n_blocks * MOE_BLOCK
    row_tok = jnp.full((n_rows,), n_tok, jnp.int32).at[dest].set((order // TOP_K).astype(jnp.int32))
    row_gate = jnp.zeros((n_rows,), jnp.float32).at[dest].set(gates.reshape(-1)[order])
    block_expert = jnp.minimum(
        jnp.sum(jnp.arange(n_blocks)[:, None] * MOE_BLOCK >= pad_end[None, :], axis=1), N_EXPERTS - 1)
    tok_pad = jnp.concatenate([tok, jnp.zeros((1, tok.shape[1]), tok.dtype)], axis=0)
    xb = tok_pad[row_tok].reshape(n_blocks, MOE_BLOCK, -1)

    def expert_block(args):
        xblk, e = args
        return (jax.nn.silu(xblk @ w1[e]) * (xblk @ w3[e])) @ w2[e]

    yb = lax.map(expert_block, (xb, block_expert)).reshape(n_rows, -1)
    out = jnp.zeros_like(tok_pad).at[row_tok].add(yb * row_gate[:, None].astype(yb.dtype))
    return out[:n_tok].reshape(shape)


def _split_proj(p):
    return jnp.split(p, np.cumsum(PROJ_SIZES)[:-1].tolist(), axis=-1)


def setup_inputs(seed: int = 0) -> dict:
    key = jax.random.key(seed)
    ks = iter(jax.random.split(key, 48))
    nrm = lambda shape, scale: jax.random.normal(next(ks), shape, jnp.float32) * scale
    unif = lambda shape, lo, hi: jax.random.uniform(next(ks), shape, jnp.float32, lo, hi)
    D, L = D_MODEL, DEPTH
    dt_init = jnp.exp(unif((L, 2, GDN_HEADS), math.log(1e-3), math.log(1e-1)))
    ret_init = jnp.log(-jnp.log1p(-(2.0 ** (-5.0 - jnp.arange(RET_HEADS, dtype=jnp.float32)))))
    return {
        "x": nrm((BATCH, SEQ, D), 1.0),
        "c": nrm((BATCH, D), 1.0),
        "ctx": nrm((BATCH, CTX_LEN, D), 1.0),
        "c_ctx": nrm((D,), 1.0),
        "ada_w": nrm((L, D, 6 * D), 0.5 * D ** -0.5),
        "ada_b": nrm((L, 6 * D), 0.01),
        "w_in": nrm((L, D, D_PROJ), D ** -0.5),
        "w_out": nrm((L, D_MIX, D), DEEPNORM_BETA * D_MIX ** -0.5),
        "ln_g": 1.0 + nrm((L, 2, D), 0.01),
        "ln_b": nrm((L, 2, D), 0.01),
        "gdn_conv_w": nrm((L, SHORT_CONV, 3 * GDN_WIDTH), SHORT_CONV ** -0.5),
        "gdn_a_log": jnp.log(unif((L, 2, GDN_HEADS), 1.0, 16.0)),
        "gdn_dt_bias": dt_init + jnp.log(-jnp.expm1(-dt_init)),
        "gdn_norm_w": 1.0 + nrm((L, HEAD_DIM), 0.01),
        "s5_a_re": -0.5 + nrm((L, 2, S5_GROUPS, S5_STATE), 0.01),
        "s5_a_im": jnp.pi * jnp.arange(S5_STATE, dtype=jnp.float32) + nrm((L, 2, S5_GROUPS, S5_STATE), 0.01),
        "s5_log_step": jnp.log(unif((L, 2, S5_GROUPS), 1e-3, 1e-1)),
        "s5_b_re": nrm((L, 2, S5_GROUPS, S5_STATE, S5_GROUP), (2.0 * S5_GROUP) ** -0.5),
        "s5_b_im": nrm((L, 2, S5_GROUPS, S5_STATE, S5_GROUP), (2.0 * S5_GROUP) ** -0.5),
        "s5_c_re": nrm((L, 2, S5_GROUPS, S5_GROUP, S5_STATE), (2.0 * S5_STATE) ** -0.5),
        "s5_c_im": nrm((L, 2, S5_GROUPS, S5_GROUP, S5_STATE), (2.0 * S5_STATE) ** -0.5),
        "s5_d": nrm((L, S5_WIDTH), 1.0),
        "s5_glu_w": nrm((L, S5_WIDTH, S5_WIDTH), S5_WIDTH ** -0.5),
        "s5_glu_b": nrm((L, S5_WIDTH), 0.01),
        "hgrn_lower_bounds": nrm((L, HGRN_WIDTH), 0.1),
        "hgrn_norm_w": 1.0 + nrm((L, HEAD_DIM), 0.01),
        "ret_decay": ret_init + nrm((L, 2, RET_HEADS), 0.05),
        "ffn_w1": nrm((N_DENSE_LAYERS, D, FF_DENSE), D ** -0.5),
        "ffn_w3": nrm((N_DENSE_LAYERS, D, FF_DENSE), D ** -0.5),
        "ffn_w2": nrm((N_DENSE_LAYERS, FF_DENSE, D), DEEPNORM_BETA * FF_DENSE ** -0.5),
        "moe_router": nrm((N_MOE_LAYERS, D, N_EXPERTS), D ** -0.5),
        "moe_w1": nrm((N_MOE_LAYERS, N_EXPERTS, D, FF_EXPERT), D ** -0.5),
        "moe_w3": nrm((N_MOE_LAYERS, N_EXPERTS, D, FF_EXPERT), D ** -0.5),
        "moe_w2": nrm((N_MOE_LAYERS, N_EXPERTS, FF_EXPERT, D), DEEPNORM_BETA * FF_EXPERT ** -0.5),
    }


def reference(x, c, ctx, c_ctx, ada_w, ada_b, w_in, w_out, ln_g, ln_b,
              gdn_conv_w, gdn_a_log, gdn_dt_bias, gdn_norm_w,
              s5_a_re, s5_a_im, s5_log_step, s5_b_re, s5_b_im, s5_c_re, s5_c_im,
              s5_d, s5_glu_w, s5_glu_b,
              hgrn_lower_bounds, hgrn_norm_w, ret_decay,
              ffn_w1, ffn_w3, ffn_w2, moe_router, moe_w1, moe_w3, moe_w2):
    dt = x.dtype
    n_lat = x.shape[1]
    ROWS = n_lat // GRID_W
    rows = jnp.repeat(jnp.arange(ROWS, dtype=jnp.float32), GRID_W)
    cols = jnp.tile(jnp.arange(GRID_W, dtype=jnp.float32), ROWS)
    lb_all = jnp.cumsum(jax.nn.softmax(_f32(hgrn_lower_bounds), axis=0), axis=0)
    lb_all = lb_all - lb_all[0]

    for layer in range(DEPTH):
        need_ctx = layer < DEPTH - 1
        mod_lat = jax.nn.silu(c) @ ada_w[layer] + ada_b[layer]
        mod_ctx = jax.nn.silu(c_ctx) @ ada_w[layer] + ada_b[layer]
        sh1, sc1, gt1, sh2, sc2, gt2 = jnp.split(mod_lat[:, None, :], 6, axis=-1)
        csh1, csc1, cgt1, csh2, csc2, cgt2 = jnp.split(mod_ctx, 6, axis=-1)

        p_lat = _split_proj(_f32((x * (1.0 + sc1) + sh1) @ w_in[layer]))
        p_ctx = _split_proj(_f32((ctx * (1.0 + csc1) + csh1) @ w_in[layer]))
        gdn_c, gdn_l = _gdn_mixer(p_ctx[0:4], p_lat[0:4], _f32(gdn_conv_w[layer]), _f32(gdn_a_log[layer]),
                                  _f32(gdn_dt_bias[layer]), _f32(gdn_norm_w[layer]), need_ctx)
        s5_c, s5_l = _s5_mixer(p_ctx[4], p_lat[4], _f32(s5_a_re[layer]), _f32(s5_a_im[layer]),
                               _f32(s5_log_step[layer]), _f32(s5_b_re[layer]), _f32(s5_b_im[layer]),
                               _f32(s5_c_re[layer]), _f32(s5_c_im[layer]), _f32(s5_d[layer]),
                               _f32(s5_glu_w[layer]), _f32(s5_glu_b[layer]), need_ctx)
        hg_c, hg_l = _hgrn2_mixer(p_ctx[5:9], p_lat[5:9], lb_all[layer], _f32(hgrn_norm_w[layer]), need_ctx)
        rt_c, rt_l = _retention_mixer(p_ctx[9:11], p_lat[9:11], rows, cols, _f32(ret_decay[layer]), need_ctx)

        mix_lat = jnp.concatenate([gdn_l, s5_l, hg_l, rt_l], axis=-1).astype(dt)
        x = _layer_norm(DEEPNORM_ALPHA * x + gt1 * (mix_lat @ w_out[layer]), ln_g[layer, 0], ln_b[layer, 0])
        if need_ctx:
            mix_ctx = jnp.concatenate([gdn_c, s5_c, hg_c, rt_c], axis=-1).astype(dt)
            ctx = _layer_norm(DEEPNORM_ALPHA * ctx + cgt1 * (mix_ctx @ w_out[layer]),
                              ln_g[layer, 0], ln_b[layer, 0])

        j = layer // 2
        if layer % 2 == 0:
            ffn = functools.partial(_swiglu, w1=ffn_w1[j], w3=ffn_w3[j], w2=ffn_w2[j])
        else:
            ffn = functools.partial(_moe_swiglu, router=moe_router[j], w1=moe_w1[j], w3=moe_w3[j], w2=moe_w2[j])
        x = _layer_norm(DEEPNORM_ALPHA * x + gt2 * ffn(x * (1.0 + sc2) + sh2), ln_g[layer, 1], ln_b[layer, 1])
        if need_ctx:
            ctx = _layer_norm(DEEPNORM_ALPHA * ctx + cgt2 * ffn(ctx * (1.0 + csc2) + csh2),
                              ln_g[layer, 1], ln_b[layer, 1])
    return x
```

```cpp
#include <hip/hip_runtime.h>
#include <cstdio>
#include <cstdint>

#ifndef MK_ONE_LAUNCH
#define MK_ONE_LAUNCH 0
#endif

#define GAS __attribute__((address_space(1)))
#define LAS __attribute__((address_space(3)))
typedef unsigned short bf16;
typedef unsigned v4u __attribute__((ext_vector_type(4)));
typedef unsigned v2u __attribute__((ext_vector_type(2)));
typedef float f32x4 __attribute__((ext_vector_type(4)));
typedef float f32x2 __attribute__((ext_vector_type(2)));
typedef short bf16x8 __attribute__((ext_vector_type(8)));

constexpr int D = 1024, BATCH = 4, SEQ = 8192, CTXL = 256, DEPTH = 4;
constexpr int NLAT = BATCH * SEQ, NCTX = BATCH * CTXL, R = NLAT + NCTX;
constexpr int DPROJ = 3600, DPP = 3840;
constexpr int FFD = 2816, FFE = 3584, NEXP = 8;
constexpr int MOE_ROWS = 2 * R + NEXP * 256;
constexpr float ALPHA = 1.681792830507429f;
constexpr float LN_EPS = 1e-5f, RMS_EPS = 1e-6f;
constexpr int PC_GQKV = 0, PC_GZ = 768, PC_GA = 1024, PC_GB = 1032, PC_S5U = 1040, PC_HQ = 1296, PC_HF = 1552, PC_HI = 2064, PC_HG = 2320, PC_RQKV = 2576, PC_RG = 3344;
constexpr int NSEQ = CTXL + SEQ;
constexpr int TCH = 32, NCHUNK = NSEQ / TCH;

constexpr size_t MiB = 1u << 20;
constexpr size_t WS_CTL = 0, CTL_ZERO_BYTES = 1 * MiB;
constexpr size_t WS_MOD = 1 * MiB;
constexpr size_t WS_LB = WS_MOD + 512 * 1024;
constexpr size_t WS_ROT = WS_LB + 4096;
constexpr size_t WS_S5LAM = WS_ROT + 32768;
constexpr size_t WS_S5B = 2 * MiB;
constexpr size_t WS_TOPE = 3 * MiB;
constexpr size_t WS_TOPG = WS_TOPE + 256 * 1024;
constexpr size_t WS_TOKPOS = WS_TOPG + 512 * 1024;
constexpr size_t WS_ROWG = 4 * MiB + 256 * 1024;
constexpr size_t WS_WGCNT = 4 * MiB + 768 * 1024;
constexpr size_t WS_MOEINFO = WS_WGCNT + 16384;
constexpr size_t WS_GSC = 5 * MiB;
constexpr size_t WS_WIN = 8 * MiB;
constexpr size_t WS_WOUT = 38 * MiB;
constexpr size_t WS_WF13 = 46 * MiB;
constexpr size_t WS_WF2 = 68 * MiB;
constexpr size_t WS_WGLU = 79 * MiB;
constexpr size_t WS_WM13 = 80 * MiB;
constexpr size_t WS_WM2 = 192 * MiB;
constexpr size_t WS_XC = 248 * MiB;
constexpr size_t WS_A = 252 * MiB;
constexpr size_t WS_U = 318 * MiB;
constexpr size_t WS_P = WS_U;
constexpr size_t WS_Y = WS_U;
constexpr size_t WS_MIX = 566 * MiB;
constexpr size_t WS_GQ = 632 * MiB, WS_GK = WS_GQ + 17 * MiB, WS_GV = WS_GK + 17 * MiB;
constexpr size_t WS_O = 684 * MiB;
constexpr size_t WS_HID = 566 * MiB;
constexpr size_t WS_XG = WS_U;
constexpr size_t WS_MHID = 454 * MiB;
constexpr size_t WS_END = 1040 * MiB;
static_assert(WS_O + (size_t)8 * R * 256 * 4 <= WS_END && WS_MHID + (size_t)MOE_ROWS * FFE * 2 <= WS_END && WS_XG + (size_t)MOE_ROWS * D * 2 <= WS_MHID, "ws map");
static_assert(WS_P + (size_t)R * DPP * 2 <= WS_MIX && WS_HID + (size_t)R * FFD * 2 <= WS_END && WS_Y + (size_t)R * D * 4 <= WS_MIX, "ws map 2");

constexpr int RING_BYTES = 131072, LDSCTL_OFF = RING_BYTES, LDS_BYTES = 147456;

__device__ __forceinline__ unsigned f2bf(float f) { unsigned u = __builtin_bit_cast(unsigned, f); return (u + 0x7fffu + ((u >> 16) & 1u)) >> 16; }
__device__ __forceinline__ unsigned pk2(float lo, float hi) { return f2bf(lo) | (f2bf(hi) << 16); }
__device__ __forceinline__ float bflo(unsigned w) { return __builtin_bit_cast(float, w << 16); }
__device__ __forceinline__ float bfhi(unsigned w) { return __builtin_bit_cast(float, w & 0xffff0000u); }
__device__ __forceinline__ float bf2f(bf16 h) { return __builtin_bit_cast(float, (unsigned)h << 16); }
__device__ __forceinline__ float wave_sum(float v) {
#pragma unroll
    for (int o = 1; o < 64; o <<= 1) v += __shfl_xor(v, o);
    return v;
}
__device__ __forceinline__ float sum16(float v) { v += __shfl_xor(v, 1); v += __shfl_xor(v, 2); v += __shfl_xor(v, 4); v += __shfl_xor(v, 8); return v; }
__device__ __forceinline__ float sigmoidf_(float x) { return 1.f / (1.f + __expf(-x)); }
__device__ __forceinline__ float siluf_(float x) { return x / (1.f + __expf(-x)); }
__device__ __forceinline__ float gelu_tanh(float x) { const float u = 0.7978845608028654f * (x + 0.044715f * x * x * x); const float t = 1.f - 2.f / (__expf(2.f * u) + 1.f); return 0.5f * x * (1.f + t); }
#define LDS_WAIT() asm volatile("s_waitcnt lgkmcnt(0)" ::: "memory")

#define XB_TMO      128
#define XB_XCNT(j)  (256  + 64 * (j))
#define XB_XSUB(j)  (1280 + 64 * (j))
#define XB_XGEN(j)  (2304 + 64 * (j))
#define XB_TOP      3328
#define XB_TOPGEN   3392
#define XCD_BAR_WORDS 3456
#define XB_SPIN_CAP (1u << 18)
__device__ __forceinline__ unsigned xb_ld(unsigned* p)              { return __hip_atomic_load(p, __ATOMIC_RELAXED, __HIP_MEMORY_SCOPE_AGENT); }
__device__ __forceinline__ unsigned xb_add(unsigned* p, unsigned v) { return __hip_atomic_fetch_add(p, v, __ATOMIC_RELAXED, __HIP_MEMORY_SCOPE_AGENT); }
__device__ __forceinline__ unsigned xb_xcc_id() { return (unsigned)__builtin_amdgcn_s_getreg((3 << 11) | 20) & 0xFu; }
#define XB_SPIN(cond, bar) do { unsigned _sp = 0; while (cond) { __builtin_amdgcn_s_sleep(1); \
    if ((++_sp & 255u) == 0u) { if (xb_ld(&(bar)[XB_TMO])) break; if (_sp > XB_SPIN_CAP) { atomicAdd(&(bar)[XB_TMO], 1u); break; } } } } while (0)
struct XcdBarrier { unsigned* bar; unsigned x; volatile LAS unsigned* st; };
__device__ __forceinline__ bool xb_thread0(int wave_id) { return wave_id == 0 && __builtin_amdgcn_mbcnt_hi(~0u, __builtin_amdgcn_mbcnt_lo(~0u, 0u)) == 0u; }
__device__ __forceinline__ XcdBarrier xcd_barrier_post(unsigned* bar, volatile LAS unsigned* st, int wave_id) {
    XcdBarrier b; b.bar = bar; b.x = xb_xcc_id(); b.st = st;
    if (xb_thread0(wave_id)) (void)xb_add(&bar[XB_XCNT(b.x)], 1u);
    return b;
}
__device__ __forceinline__ void xcd_barrier_complete(unsigned* bar, unsigned x, unsigned& nloc, unsigned& nx) {
    const unsigned G = gridDim.x * gridDim.y * gridDim.z;
    unsigned sum, cnt, mine, sp = 0u;
    for (;;) {
        sum = 0u; cnt = 0u; mine = 0u;
#pragma unroll
        for (unsigned j = 0; j < 16; ++j) { const unsigned c = xb_ld(&bar[XB_XCNT(j)]); sum += c; cnt += (c > 0u) ? 1u : 0u; mine = (j == x) ? c : mine; }
        if (sum == G) break;
        __builtin_amdgcn_s_sleep(1);
        if ((++sp & 255u) == 0u) { if (xb_ld(&bar[XB_TMO])) break; if (sp > XB_SPIN_CAP) { atomicAdd(&bar[XB_TMO], 1u); break; } }
    }
    nloc = mine > 0u ? mine : 1u; nx = cnt > 0u ? cnt : 1u;
}
__device__ __forceinline__ void xcd_barrier(const XcdBarrier& b, int wave_id) {
    asm volatile("s_waitcnt vmcnt(0)" ::: "memory");
    __syncthreads();
    if (xb_thread0(wave_id)) {
        unsigned* bar = b.bar; asm volatile("" : "+s"(bar));
        __builtin_amdgcn_s_waitcnt(0);
        unsigned nloc = b.st[0], nx = b.st[1];
        if (nloc == 0u) { xcd_barrier_complete(bar, b.x, nloc, nx); b.st[0] = nloc; b.st[1] = nx; }
        const unsigned old = xb_add(&bar[XB_XSUB(b.x)], 1u);
        const unsigned gen = old / nloc;
        if (old + 1u == (gen + 1u) * nloc) {
            __builtin_amdgcn_fence(__ATOMIC_RELEASE, "agent");
            asm volatile("s_waitcnt vmcnt(0)" ::: "memory");
            const unsigned og = xb_add(&bar[XB_TOP], 1u);
            const unsigned tg = og / nx;
            if (og + 1u == (tg + 1u) * nx) xb_add(&bar[XB_TOPGEN], 1u);
            else XB_SPIN(xb_ld(&bar[XB_TOPGEN]) == tg, bar);
            __builtin_amdgcn_fence(__ATOMIC_ACQUIRE, "agent");
            xb_add(&bar[XB_XGEN(b.x)], 1u);
            asm volatile("s_waitcnt vmcnt(0)" ::: "memory");
        } else {
            XB_SPIN(xb_ld(&bar[XB_XGEN(b.x)]) == gen, bar);
            __builtin_amdgcn_fence(__ATOMIC_ACQUIRE, "agent");
            asm volatile("s_waitcnt vmcnt(0)" ::: "memory");
        }
    }
    __syncthreads();
}

namespace pg8 {
constexpr int BM = 256, BK = 64, HALF = 128, HTB = HALF * BK * 2, STAGE_BYTES = 8 * HTB, NXCD = 8, WGM = 8;
__host__ __device__ __forceinline__ int lds_byte(int r, int c) { const int st = (r >> 4) * 2 + (c >> 5), rr = r & 15, cc = c & 31, ob = rr * 64 + cc * 2; return st * 1024 + (ob ^ (((ob >> 9) & 1) << 5)); }
__host__ __device__ __forceinline__ void stage_rc(int b, int& Rr, int& C) { const int st = b / 1024, sb = b % 1024, swz = sb ^ (((sb >> 9) & 1) << 5); Rr = (st >> 1) * 16 + swz / 64; C = (st & 1) * 32 + (swz % 64) / 2; }
__host__ __device__ __forceinline__ int perm32(int rho) { const int n = rho >> 4, i = rho & 15; return 8 * (i >> 2) + 4 * n + (i & 3); }
struct Unit { int pm, pn; size_t boff; };
struct Gemm { const bf16* A; const bf16* Bt; int K; };

struct StaticOrder {
    int nM, nN, nwg, G, c, K;
    __device__ void init(int nM_, int nN_, int K_, int G_, int c_) { nM = nM_; nN = nN_; nwg = nM * nN; G = G_; c = c_; K = K_; }
    __device__ bool map(int i, int& pm, int& pn) const {
        const long L = (long)i * G + c; if (L >= nwg) return false;
        int wgid = (int)L; { const int q = nwg / NXCD, r = nwg % NXCD, xcd = wgid % NXCD, off = wgid / NXCD; wgid = (xcd < r ? xcd * (q + 1) : r * (q + 1) + (xcd - r) * q) + off; }
        const int nig = WGM * nN, gid = wgid / nig, fm = gid * WGM, gsz = (nM - fm) < WGM ? (nM - fm) : WGM;
        pm = fm + ((wgid % nig) % gsz); pn = (wgid % nig) / gsz; return true;
    }
    __device__ bool next(int i, Unit& u) const { if (!map(i, u.pm, u.pn)) return false; u.boff = (size_t)u.pn * 256 * K * 2; return true; }
};
struct MoeOrder : StaticOrder {
    const int* texp; size_t estride;
    __device__ bool next(int i, Unit& u) const {
        if (!map(i, u.pm, u.pn)) return false;
        const int e = __builtin_amdgcn_readfirstlane(texp[u.pm]);
        u.boff = (size_t)e * estride + (size_t)u.pn * 256 * K * 2; return true;
    }
};
__device__ __forceinline__ unsigned cvt_pk_bf16(float lo, float hi) { unsigned r; asm volatile("v_cvt_pk_bf16_f32 %0, %1, %2" : "=v"(r) : "v"(lo), "v"(hi)); return r; }

template <class Epi, class Sched, bool ALIGN_EPI, bool SP2>
__device__ __forceinline__ void gemm_phase(LAS unsigned char* lds, const int wave_id, const Gemm g, const Sched& S, const Epi& E) {
    int lane = (int)__builtin_amdgcn_mbcnt_hi(~0u, __builtin_amdgcn_mbcnt_lo(~0u, 0u)); asm volatile("" : "+v"(lane));
    const int wid = wave_id, tid = wid * 64 + lane, wr = wid >> 2, wc = wid & 3, fr = lane & 15, fq = lane >> 4;
    const int K = g.K, nt = K / BK;
    unsigned voffA, voffB;
    { int Rr, C; stage_rc(tid * 16, Rr, C); const int Rb = Epi::PERM ? ((Rr & ~31) + perm32(Rr & 31)) : Rr;
        voffA = (unsigned)(Rr * K + C) * 2u; voffB = (unsigned)(Rb * K + C) * 2u; }
    const size_t qstep = (size_t)64 * K * 2;
    const size_t kstep = (size_t)(BK * 2);
    const size_t hstep = (size_t)HALF * K * 2;
    const size_t tstep = 2 * hstep;
    const unsigned ldsw = (unsigned)wid * 1024u;
    const int aoff = lds_byte(wr * 64 + fr, fq * 8), boff = lds_byte(wc * 32 + fr, fq * 8);
#define PG8_SA(b, h) (((b) * 2 + (h)) * HTB)
#define PG8_SB(b, h) ((4 + (b) * 2 + (h)) * HTB)
#define PG8_STAGE(bufoff, gbase, voff) do { _Pragma("unroll") for (int _i = 0; _i < 2; ++_i) \
        __builtin_amdgcn_global_load_lds((const unsigned*)((const char*)(gbase) + _i * qstep + (voff)), (LAS unsigned*)(lds + (bufoff) + ldsw + _i * 8192), 16, 0, 0); } while (0)
#define PG8_LDA(dst, b, h) do { _Pragma("unroll") for (int m = 0; m < 4; ++m) _Pragma("unroll") for (int k = 0; k < 2; ++k) dst[m][k] = *(const LAS bf16x8*)(lds + PG8_SA(b, h) + aoff + m * 2048 + k * 1024); } while (0)
#define PG8_LDB(dst, b, h) do { _Pragma("unroll") for (int n = 0; n < 2; ++n) _Pragma("unroll") for (int k = 0; k < 2; ++k) dst[n][k] = *(const LAS bf16x8*)(lds + PG8_SB(b, h) + boff + n * 2048 + k * 1024); } while (0)
#define PG8_MMA(ai, bj, At, Bt) do { __builtin_amdgcn_s_setprio(1); _Pragma("unroll") for (int m = 0; m < 4; ++m) _Pragma("unroll") for (int n = 0; n < 2; ++n) _Pragma("unroll") for (int k = 0; k < 2; ++k) \
        acc[ai][bj][m][n] = __builtin_amdgcn_mfma_f32_16x16x32_bf16(Bt[n][k], At[m][k], acc[ai][bj][m][n], 0, 0, 0); __builtin_amdgcn_s_setprio(0); } while (0)
#define PG8_WAIT_V(n) asm volatile("s_waitcnt vmcnt(" #n ")" ::: "memory")
#define PG8_WAIT_L(n) asm volatile("s_waitcnt lgkmcnt(" #n ")" ::: "memory")
#define PG8_BAR __builtin_amdgcn_s_barrier()
#define PG8_SCHED __builtin_amdgcn_sched_barrier(0)
    Unit cur, nxt; int ui = 0;
    if (!S.next(0, cur)) return;
    f32x4 acc[2][2][4][2];
#pragma unroll
    for (int a = 0; a < 2; ++a)
#pragma unroll
        for (int b = 0; b < 2; ++b)
#pragma unroll
            for (int m = 0; m < 4; ++m)
#pragma unroll
                for (int n = 0; n < 2; ++n) acc[a][b][m][n] = (f32x4){0.f, 0.f, 0.f, 0.f};
    bf16x8 At[4][2], B0[2][2], B1[2][2];
    const char* cA = (const char*)g.A + (size_t)cur.pm * tstep; const char* cB = (const char*)g.Bt + cur.boff;
    if constexpr (SP2) {
        PG8_STAGE(PG8_SB(0, 0), cB, voffB); PG8_STAGE(PG8_SB(0, 1), cB + hstep, voffB); PG8_STAGE(PG8_SA(0, 0), cA, voffA); PG8_STAGE(PG8_SA(0, 1), cA + hstep, voffA);
        if (wr == 1) PG8_BAR;
        PG8_WAIT_V(2); PG8_BAR;
        PG8_STAGE(PG8_SB(1, 0), cB + kstep, voffB); PG8_STAGE(PG8_SA(1, 0), cA + kstep, voffA); PG8_STAGE(PG8_SB(1, 1), cB + hstep + kstep, voffB);
        PG8_WAIT_V(6); PG8_BAR;
    } else {
        PG8_STAGE(PG8_SB(0, 0), cB, voffB); PG8_STAGE(PG8_SA(0, 0), cA, voffA); PG8_STAGE(PG8_SB(0, 1), cB + hstep, voffB); PG8_STAGE(PG8_SA(0, 1), cA + hstep, voffA);
        if (wr == 1) PG8_BAR;
        PG8_WAIT_V(4); PG8_BAR;
        PG8_STAGE(PG8_SB(1, 0), cB + kstep, voffB); PG8_STAGE(PG8_SA(1, 0), cA + kstep, voffA); PG8_STAGE(PG8_SB(1, 1), cB + hstep + kstep, voffB);
        PG8_WAIT_V(6); PG8_BAR;
    }
    for (;;) {
        const bool has_next = S.next(ui + 1, nxt);
        const char* nA = has_next ? (const char*)g.A + (size_t)nxt.pm * tstep : cA; const char* nB = has_next ? (const char*)g.Bt + nxt.boff : cB;
        for (int t = 0; t < nt; t += 2) {
            const bool last = (t == nt - 2);
            const char* a1 = cA + (size_t)(t + 1) * kstep;
            const char* a2 = last ? nA : cA + (size_t)(t + 2) * kstep; const char* b2 = last ? nB : cB + (size_t)(t + 2) * kstep;
            const char* a3 = a2 + kstep; const char* b3 = b2 + kstep;
            if constexpr (SP2) {
            PG8_LDB(B0, 0, 0); PG8_LDB(B1, 0, 1); PG8_SCHED; PG8_LDA(At, 0, 0); PG8_STAGE(PG8_SA(1, 1), a1 + hstep, voffA);
            PG8_WAIT_V(8); PG8_WAIT_L(0); PG8_BAR; PG8_MMA(0, 0, At, B0); PG8_MMA(0, 1, At, B1); PG8_BAR; PG8_SCHED;
            PG8_LDA(At, 0, 1); PG8_STAGE(PG8_SB(0, 0), b2, voffB); PG8_STAGE(PG8_SB(0, 1), b2 + hstep, voffB); PG8_STAGE(PG8_SA(0, 0), a2, voffA);
            PG8_WAIT_V(8); PG8_WAIT_L(0); PG8_BAR; PG8_MMA(1, 0, At, B0); PG8_MMA(1, 1, At, B1); PG8_BAR; PG8_SCHED;
            PG8_LDB(B0, 1, 0); PG8_LDB(B1, 1, 1); PG8_SCHED; PG8_LDA(At, 1, 0); PG8_STAGE(PG8_SA(0, 1), a2 + hstep, voffA);
            PG8_WAIT_V(8); PG8_WAIT_L(0); PG8_BAR; PG8_MMA(0, 0, At, B0); PG8_MMA(0, 1, At, B1); PG8_BAR; PG8_SCHED;
            PG8_LDA(At, 1, 1); PG8_STAGE(PG8_SB(1, 0), b3, voffB); PG8_STAGE(PG8_SB(1, 1), b3 + hstep, voffB); PG8_STAGE(PG8_SA(1, 0), a3, voffA);
            PG8_WAIT_V(8); PG8_WAIT_L(0); PG8_BAR; PG8_MMA(1, 0, At, B0); PG8_MMA(1, 1, At, B1); PG8_BAR; PG8_SCHED;
            } else {
            PG8_LDB(B0, 0, 0); PG8_SCHED; PG8_LDA(At, 0, 0); PG8_STAGE(PG8_SA(1, 1), a1 + hstep, voffA);
            PG8_WAIT_L(8); PG8_BAR; PG8_WAIT_L(0); PG8_MMA(0, 0, At, B0); PG8_BAR; PG8_SCHED;
            PG8_LDB(B1, 0, 1); PG8_STAGE(PG8_SB(0, 0), b2, voffB);
            PG8_BAR; PG8_WAIT_L(0); PG8_MMA(0, 1, At, B1); PG8_BAR;
            PG8_LDA(At, 0, 1); PG8_STAGE(PG8_SA(0, 0), a2, voffA);
            PG8_BAR; PG8_WAIT_L(0); PG8_MMA(1, 0, At, B0); PG8_BAR; PG8_SCHED;
            PG8_STAGE(PG8_SB(0, 1), b2 + hstep, voffB);
            PG8_WAIT_V(6); PG8_BAR; PG8_MMA(1, 1, At, B1); PG8_BAR;
            PG8_LDB(B0, 1, 0); PG8_SCHED; PG8_LDA(At, 1, 0); PG8_STAGE(PG8_SA(0, 1), a2 + hstep, voffA);
            PG8_WAIT_L(8); PG8_BAR; PG8_WAIT_L(0); PG8_MMA(0, 0, At, B0); PG8_BAR; PG8_SCHED;
            PG8_LDB(B1, 1, 1); PG8_STAGE(PG8_SB(1, 0), b3, voffB);
            PG8_BAR; PG8_WAIT_L(0); PG8_MMA(0, 1, At, B1); PG8_BAR;
            PG8_LDA(At, 1, 1); PG8_STAGE(PG8_SA(1, 0), a3, voffA);
            PG8_BAR; PG8_WAIT_L(0); PG8_MMA(1, 0, At, B0); PG8_BAR; PG8_SCHED;
            PG8_STAGE(PG8_SB(1, 1), b3 + hstep, voffB);
            PG8_WAIT_V(6); PG8_BAR; PG8_MMA(1, 1, At, B1); PG8_BAR;
            }
        }
        if constexpr (ALIGN_EPI) { if (wr == 0) PG8_BAR; }
        E(acc, cur, wr, wc, fr, fq);
        if (!has_next) break;
#pragma unroll
        for (int a = 0; a < 2; ++a)
#pragma unroll
            for (int b = 0; b < 2; ++b)
#pragma unroll
                for (int m = 0; m < 4; ++m)
#pragma unroll
                    for (int n = 0; n < 2; ++n) acc[a][b][m][n] = (f32x4){0.f, 0.f, 0.f, 0.f};
        cur = nxt; cA = nA; cB = nB; ++ui;
        if constexpr (ALIGN_EPI) { if (wr == 1) PG8_BAR; }
    }
    PG8_WAIT_V(0);
    if constexpr (!ALIGN_EPI) { if (wr == 0) PG8_BAR; }
    PG8_BAR;
#undef PG8_SA
#undef PG8_SB
#undef PG8_STAGE
#undef PG8_LDA
#undef PG8_LDB
#undef PG8_MMA
#undef PG8_WAIT_V
#undef PG8_WAIT_L
#undef PG8_BAR
#undef PG8_SCHED
}

struct EpiBf16 {
    static constexpr bool PERM = true;
    bf16* O; int ldc;
    __device__ __forceinline__ void operator()(const f32x4 (&acc)[2][2][4][2], const Unit& u, int wr, int wc, int fr, int fq) const {
        const int row0 = u.pm * BM + wr * 64 + fr, col0 = u.pn * BM + wc * 32 + 8 * fq;
#pragma unroll
        for (int ai = 0; ai < 2; ++ai)
#pragma unroll
            for (int m = 0; m < 4; ++m) { bf16* rowp = O + (size_t)(row0 + ai * HALF + m * 16) * ldc + col0; asm volatile("" ::: "memory");
#pragma unroll
                for (int bj = 0; bj < 2; ++bj) { const f32x4 v0 = acc[ai][bj][m][0], v1 = acc[ai][bj][m][1];
                    v4u w; w.x = cvt_pk_bf16(v0[0], v0[1]); w.y = cvt_pk_bf16(v0[2], v0[3]); w.z = cvt_pk_bf16(v1[0], v1[1]); w.w = cvt_pk_bf16(v1[2], v1[3]);
                    *(v4u*)(rowp + bj * HALF) = w; } }
    }
};
struct EpiSwiGlu {
    static constexpr bool PERM = true;
    bf16* O; int ldc;
    __device__ __forceinline__ void operator()(const f32x4 (&acc)[2][2][4][2], const Unit& u, int wr, int wc, int fr, int fq) const {
        const int row0 = u.pm * BM + wr * 64 + fr, col0 = u.pn * HALF + wc * 32 + 8 * fq;
#pragma unroll
        for (int ai = 0; ai < 2; ++ai)
#pragma unroll
            for (int m = 0; m < 4; ++m) { bf16* rowp = O + (size_t)(row0 + ai * HALF + m * 16) * ldc + col0; asm volatile("" ::: "memory");
                float h[8];
#pragma unroll
                for (int n = 0; n < 2; ++n)
#pragma unroll
                    for (int i = 0; i < 4; ++i) { const float a = acc[ai][0][m][n][i], b = acc[ai][1][m][n][i]; h[n * 4 + i] = a * b / (1.f + __expf(-a)); }
                v4u w; w.x = cvt_pk_bf16(h[0], h[1]); w.y = cvt_pk_bf16(h[2], h[3]); w.z = cvt_pk_bf16(h[4], h[5]); w.w = cvt_pk_bf16(h[6], h[7]);
                *(v4u*)rowp = w; }
    }
};
struct EpiRes {
    static constexpr bool PERM = false;
    float* Y; const float* xl; const float* xc; const float* mod; int goff;
    __device__ __forceinline__ void operator()(const f32x4 (&acc)[2][2][4][2], const Unit& u, int wr, int wc, int fr, int fq) const {
        const int row0 = u.pm * BM + wr * 64 + fr, col0 = u.pn * BM + wc * 32 + 4 * fq;
        const int s = u.pm < 128 ? (u.pm >> 5) : 4;
        const float* xb = u.pm < 128 ? xl : xc - (size_t)NLAT * D;
        const float* gp = mod + s * 6144 + goff + col0;
        f32x4 gv[2][2];
#pragma unroll
        for (int bj = 0; bj < 2; ++bj)
#pragma unroll
            for (int n = 0; n < 2; ++n) gv[bj][n] = *(const f32x4*)(gp + bj * HALF + n * 16);
#pragma unroll
        for (int ai = 0; ai < 2; ++ai)
#pragma unroll
            for (int m = 0; m < 4; ++m) { const size_t ro = (size_t)(row0 + ai * HALF + m * 16) * D + col0; asm volatile("" ::: "memory");
#pragma unroll
                for (int bj = 0; bj < 2; ++bj)
#pragma unroll
                    for (int n = 0; n < 2; ++n) { const f32x4 xv = *(const f32x4*)(xb + ro + bj * HALF + n * 16);
                        *(f32x4*)(Y + ro + bj * HALF + n * 16) = xv * ALPHA + gv[bj][n] * acc[ai][bj][m][n]; } }
    }
};
struct EpiGlu {
    static constexpr bool PERM = true;
    bf16* MIX; const float* ya; const float* gb;
    __device__ __forceinline__ void operator()(const f32x4 (&acc)[2][2][4][2], const Unit& u, int wr, int wc, int fr, int fq) const {
        const int row0 = u.pm * BM + wr * 64 + fr, col0 = wc * 32 + 8 * fq;
#pragma unroll
        for (int ai = 0; ai < 2; ++ai)
#pragma unroll
            for (int m = 0; m < 4; ++m) { const int row = row0 + ai * HALF + m * 16; asm volatile("" ::: "memory");
#pragma unroll
                for (int bj = 0; bj < 2; ++bj) { const int c = col0 + bj * HALF;
                    const f32x4 y0 = *(const f32x4*)(ya + (size_t)row * 256 + c), y1 = *(const f32x4*)(ya + (size_t)row * 256 + c + 4);
                    const f32x4 b0 = *(const f32x4*)(gb + c), b1 = *(const f32x4*)(gb + c + 4);
                    float o[8];
#pragma unroll
                    for (int i = 0; i < 4; ++i) { o[i] = y0[i] * sigmoidf_(acc[ai][bj][m][0][i] + b0[i]); o[4 + i] = y1[i] * sigmoidf_(acc[ai][bj][m][1][i] + b1[i]); }
                    v4u w; w.x = cvt_pk_bf16(o[0], o[1]); w.y = cvt_pk_bf16(o[2], o[3]); w.z = cvt_pk_bf16(o[4], o[5]); w.w = cvt_pk_bf16(o[6], o[7]);
                    *(v4u*)(MIX + (size_t)row * D + 256 + c) = w; } }
    }
};
struct EpiMoeDown {
    static constexpr bool PERM = true;
    bf16* O; const float* rowg;
    __device__ __forceinline__ void operator()(const f32x4 (&acc)[2][2][4][2], const Unit& u, int wr, int wc, int fr, int fq) const {
        const int row0 = u.pm * BM + wr * 64 + fr, col0 = u.pn * BM + wc * 32 + 8 * fq;
#pragma unroll
        for (int ai = 0; ai < 2; ++ai)
#pragma unroll
            for (int m = 0; m < 4; ++m) { asm volatile("" ::: "memory"); const int row = row0 + ai * HALF + m * 16; const float gte = rowg[row]; bf16* rowp = O + (size_t)row * D + col0;
#pragma unroll
                for (int bj = 0; bj < 2; ++bj) { const f32x4 v0 = acc[ai][bj][m][0] * gte, v1 = acc[ai][bj][m][1] * gte;
                    v4u w; w.x = cvt_pk_bf16(v0[0], v0[1]); w.y = cvt_pk_bf16(v0[2], v0[3]); w.z = cvt_pk_bf16(v1[0], v1[1]); w.w = cvt_pk_bf16(v1[2], v1[3]);
                    *(v4u*)(rowp + bj * HALF) = w; } }
    }
};
}

struct Args { const float* in[34]; float* out; unsigned char* ws; int ph_lo, ph_hi; };
struct Frame {
    LAS unsigned char* lds;
    int tid, lane, wave, G, bid;
};
typedef const __attribute__((address_space(4))) unsigned long long* kaptr_t;
__device__ __forceinline__ unsigned long long karg(int i) { kaptr_t ka = (kaptr_t)__builtin_amdgcn_kernarg_segment_ptr(); asm volatile("" : "+s"(ka)); return ka[i]; }
__device__ __forceinline__ const float* inp(int i) { return (const float*)karg(i); }
__device__ __forceinline__ float* outp() { return (float*)karg(34); }
__device__ __forceinline__ unsigned char* wsp() { return (unsigned char*)karg(35); }
enum { I_X = 0, I_C, I_CTX, I_CCTX, I_ADAW, I_ADAB, I_WIN, I_WOUT, I_LNG, I_LNB, I_GCONV, I_GALOG, I_GDTB, I_GNW, I_S5ARE, I_S5AIM, I_S5LS, I_S5BRE, I_S5BIM, I_S5CRE, I_S5CIM,
       I_S5D, I_S5GLUW, I_S5GLUB, I_HLB, I_HNW, I_RDEC, I_FW1, I_FW3, I_FW2, I_MROUTER, I_MW1, I_MW3, I_MW2 };

__device__ __forceinline__ void frame_refresh(Frame& F) { int ln = (int)__builtin_amdgcn_mbcnt_hi(~0u, __builtin_amdgcn_mbcnt_lo(~0u, 0u)); asm volatile("" : "+v"(ln)); F.lane = ln; F.tid = F.wave * 64 + ln; }
__device__ __forceinline__ int row_slot(int row) { return row < NLAT ? (row >> 13) : 4; }

__device__ __forceinline__ void transpose_item(const float* W, int K, int N, bf16* WT, int mode, LAS float* scr, int item, int lane) {
    const int nblk = (N + 31) / 32, kb = item / nblk, nb = item % nblk, k0 = 64 * kb, n0 = 32 * nb;
    const int nn = n0 + (lane & 31);
#pragma unroll 8
    for (int i = 0; i < 32; ++i) { const int kk = 2 * i + (lane >> 5); scr[kk * 33 + (lane & 31)] = (nn < N) ? W[(size_t)(k0 + kk) * N + nn] : 0.f; }
    LDS_WAIT(); asm volatile("" ::: "memory");
    const int c = lane & 7;
#pragma unroll
    for (int j = 0; j < 4; ++j) { const int nl = (lane >> 3) + 8 * j; const int n = n0 + nl; const LAS float* s = scr + (8 * c) * 33 + nl;
        v4u o; o.x = pk2(s[0 * 33], s[1 * 33]); o.y = pk2(s[2 * 33], s[3 * 33]); o.z = pk2(s[4 * 33], s[5 * 33]); o.w = pk2(s[6 * 33], s[7 * 33]);
        const int nr = mode == 0 ? n : ((n >> 7) * 256 + (n & 127) + (mode == 2 ? 128 : 0));
        if (n < N) *(v4u*)(WT + (size_t)nr * K + k0 + 8 * c) = o; }
    LDS_WAIT(); asm volatile("" ::: "memory");
}

__device__ __forceinline__ void phase_prologue(Frame& F) {
    frame_refresh(F); unsigned char* const ws = wsp();
    LAS float* scv = (LAS float*)F.lds;
    LAS float* part = (LAS float*)(F.lds + 20480);
    for (int i = F.tid; i < 5 * 1024; i += 512) { const int s = i >> 10, k = i & 1023; const float c = s < 4 ? inp(I_C)[s * 1024 + k] : inp(I_CCTX)[k]; scv[i] = siluf_(c); }
    __syncthreads();
    float* MOD = (float*)(ws + WS_MOD);
    for (int it = F.bid; it < 4 * 96; it += F.G) {
        const int l = it / 96, n0 = (it % 96) * 64;
        const float* w = inp(I_ADAW) + (size_t)l * 1024 * 6144 + n0 + F.lane;
        float a0 = 0.f, a1 = 0.f, a2 = 0.f, a3 = 0.f, a4 = 0.f;
        const int kb = F.wave * 128;
#pragma unroll 8
        for (int k = 0; k < 128; ++k) { const float wv = w[(size_t)(kb + k) * 6144];
            a0 += scv[kb + k] * wv; a1 += scv[1024 + kb + k] * wv; a2 += scv[2048 + kb + k] * wv; a3 += scv[3072 + kb + k] * wv; a4 += scv[4096 + kb + k] * wv; }
        part[(F.wave * 5 + 0) * 64 + F.lane] = a0; part[(F.wave * 5 + 1) * 64 + F.lane] = a1; part[(F.wave * 5 + 2) * 64 + F.lane] = a2; part[(F.wave * 5 + 3) * 64 + F.lane] = a3; part[(F.wave * 5 + 4) * 64 + F.lane] = a4;
        __syncthreads();
        if (F.tid < 320) { const int s = F.tid >> 6, n = F.tid & 63; float v = inp(I_ADAB)[l * 6144 + n0 + n];
#pragma unroll
            for (int w8 = 0; w8 < 8; ++w8) v += part[(w8 * 5 + s) * 64 + n];
            MOD[(size_t)(l * 5 + s) * 6144 + n0 + n] = v; }
        __syncthreads();
    }
    const int gt = F.bid * 512 + F.tid, NT = F.G * 512;
    float* LB = (float*)(ws + WS_LB);
    for (int i = gt; i < 256; i += NT) {
        float v[4], mx = -1e30f; for (int l = 0; l < 4; ++l) { v[l] = inp(I_HLB)[l * 256 + i]; mx = fmaxf(mx, v[l]); }
        float s = 0.f; for (int l = 0; l < 4; ++l) { v[l] = expf(v[l] - mx); s += v[l]; }
        float cum = 0.f, first = 0.f; for (int l = 0; l < 4; ++l) { cum += v[l] / s; if (l == 0) first = cum; LB[l * 256 + i] = cum - first; }
    }
    float* ROT = (float*)(ws + WS_ROT);
    for (int i = gt; i < 192 * 16; i += NT) { const int pos = i >> 4, q = i & 15; const float p = (float)(pos < 128 ? pos : pos - 128);
        const float invf = expf(-(float)q * (9.210340371976184f / 16.f)); const float ang = p * invf; ROT[i * 2] = cosf(ang); ROT[i * 2 + 1] = sinf(ang); }
    float* LAM = (float*)(ws + WS_S5LAM); float* BB = (float*)(ws + WS_S5B);
    for (int i = gt; i < 4 * 2 * 16 * 64; i += NT) {
        const int ldg = i >> 6;
        const float are = inp(I_S5ARE)[i], aim = inp(I_S5AIM)[i], st = expf(inp(I_S5LS)[ldg]);
        const float x = are * st, y = aim * st, ex = expf(x), cy = cosf(y), sy = sinf(y), sh = sinf(0.5f * y);
        LAM[i * 2] = ex * cy; LAM[i * 2 + 1] = ex * sy;
        const float er = expm1f(x) * cy - 2.f * sh * sh, ei = ex * sy;
        const float den = are * are + aim * aim; const float qr = (er * are + ei * aim) / den, qi = (ei * are - er * aim) / den;
        for (int c = 0; c < 16; ++c) { const float br = inp(I_S5BRE)[(size_t)i * 16 + c], bi = inp(I_S5BIM)[(size_t)i * 16 + c];
            BB[((size_t)i * 16 + c) * 2] = qr * br - qi * bi; BB[((size_t)i * 16 + c) * 2 + 1] = qr * bi + qi * br; }
    }
    LAS float* scr = (LAS float*)(F.lds + 32768 + F.wave * 8704);
    __syncthreads();
    const int gw = F.bid * 8 + F.wave, NGW = F.G * 8;
    constexpr int I_IN = 16 * 113, I_OUT = 16 * 32, I_GLU = 4 * 8, I_F1 = 16 * 88, I_F2 = 44 * 32;
    constexpr int PER_L = I_IN + I_OUT + I_GLU, TOT = 4 * PER_L + 2 * (2 * I_F1 + I_F2);
    for (int it = gw; it < TOT; it += NGW) {
        int r = it;
        if (r < 4 * PER_L) { const int l = r / PER_L; r -= l * PER_L;
            if (r < I_IN) { transpose_item(inp(I_WIN) + (size_t)l * D * DPROJ, D, DPROJ, (bf16*)(ws + WS_WIN) + (size_t)l * DPP * D, 0, scr, r, F.lane); continue; } r -= I_IN;
            if (r < I_OUT) { transpose_item(inp(I_WOUT) + (size_t)l * D * D, D, D, (bf16*)(ws + WS_WOUT) + (size_t)l * D * D, 0, scr, r, F.lane); continue; } r -= I_OUT;
            transpose_item(inp(I_S5GLUW) + (size_t)l * 65536, 256, 256, (bf16*)(ws + WS_WGLU) + (size_t)l * 65536, 0, scr, r, F.lane); continue; }
        r -= 4 * PER_L;
        const int j = r / (2 * I_F1 + I_F2); r -= j * (2 * I_F1 + I_F2);
        if (r < I_F1) { transpose_item(inp(I_FW1) + (size_t)j * D * FFD, D, FFD, (bf16*)(ws + WS_WF13) + (size_t)j * 2 * FFD * D, 1, scr, r, F.lane); continue; } r -= I_F1;
        if (r < I_F1) { transpose_item(inp(I_FW3) + (size_t)j * D * FFD, D, FFD, (bf16*)(ws + WS_WF13) + (size_t)j * 2 * FFD * D, 2, scr, r, F.lane); continue; } r -= I_F1;
        transpose_item(inp(I_FW2) + (size_t)j * FFD * D, FFD, D, (bf16*)(ws + WS_WF2) + (size_t)j * D * FFD, 0, scr, r, F.lane);
    }
}
__device__ __forceinline__ void phase_moe_convert(Frame& F, int j) {
    frame_refresh(F); unsigned char* const ws = wsp();
    LAS float* scr = (LAS float*)(F.lds + F.wave * 8704);
    const int gw = F.bid * 8 + F.wave, NGW = F.G * 8;
    constexpr int I_1 = 16 * 112, I_2 = 56 * 32, PER_E = 2 * I_1 + I_2;
    for (int it = gw; it < 8 * PER_E; it += NGW) {
        const int e = it / PER_E; int r = it - e * PER_E;
        const size_t wo = ((size_t)j * 8 + e) * D * FFE;
        if (r < I_1) { transpose_item(inp(I_MW1) + wo, D, FFE, (bf16*)(ws + WS_WM13) + (size_t)e * 2 * FFE * D, 1, scr, r, F.lane); continue; } r -= I_1;
        if (r < I_1) { transpose_item(inp(I_MW3) + wo, D, FFE, (bf16*)(ws + WS_WM13) + (size_t)e * 2 * FFE * D, 2, scr, r, F.lane); continue; } r -= I_1;
        transpose_item(inp(I_MW2) + wo, FFE, D, (bf16*)(ws + WS_WM2) + (size_t)e * D * FFE, 0, scr, r, F.lane);
    }
}

__device__ __forceinline__ const float* xrow_src(const float* xl, const float* xc, int row) { return row < NLAT ? xl + (size_t)row * D : xc + (size_t)(row - NLAT) * D; }
__device__ __forceinline__ float* xrow_dst(float* xl, float* xc, int row) { return row < NLAT ? xl + (size_t)row * D : xc + (size_t)(row - NLAT) * D; }

__device__ __forceinline__ void store_A_row(bf16* Ab, int lane_, int row, const f32x4 (&v)[4], const float* modrow, int shoff, int scoff) {
    bf16* ar = Ab + (size_t)row * D;
#pragma unroll
    for (int j = 0; j < 4; ++j) { const int c = 4 * lane_ + 256 * j; const f32x4 sh = *(const f32x4*)(modrow + shoff + c), sc = *(const f32x4*)(modrow + scoff + c);
        const f32x4 h = v[j] * (sc + 1.f) + sh; v2u w; w.x = pk2(h[0], h[1]); w.y = pk2(h[2], h[3]); *(v2u*)(ar + c) = w; }
}
__device__ __forceinline__ void ln_row(f32x4 (&v)[4], const float* g, const float* b, int lane) {
    float s = 0.f;
#pragma unroll
    for (int j = 0; j < 4; ++j) s += (v[j][0] + v[j][1]) + (v[j][2] + v[j][3]);
    const float mean = wave_sum(s) * (1.f / D); float s2 = 0.f;
#pragma unroll
    for (int j = 0; j < 4; ++j) { v[j] = v[j] - mean; s2 += (v[j][0] * v[j][0] + v[j][1] * v[j][1]) + (v[j][2] * v[j][2] + v[j][3] * v[j][3]); }
    const float rstd = 1.f / sqrtf(wave_sum(s2) * (1.f / D) + LN_EPS);
#pragma unroll
    for (int j = 0; j < 4; ++j) { const int c = 4 * lane + 256 * j; const f32x4 gg = *(const f32x4*)(g + c), bb = *(const f32x4*)(b + c); v[j] = v[j] * rstd * gg + bb; }
}

__device__ __forceinline__ void phase_a0(Frame& F) {
    frame_refresh(F); unsigned char* const ws = wsp();
    const float* MOD = (const float*)(ws + WS_MOD);
    const int gw = F.bid * 8 + F.wave, NGW = F.G * 8;
    const float* xl = inp(I_X); const float* xc = inp(I_CTX); bf16* Ab = (bf16*)(ws + WS_A);
    for (int row = gw; row < R; row += NGW) {
        const float* xr = xrow_src(xl, xc, row); f32x4 v[4];
#pragma unroll
        for (int j = 0; j < 4; ++j) v[j] = *(const f32x4*)(xr + 4 * F.lane + 256 * j);
        store_A_row(Ab, F.lane, row, v, MOD + (size_t)(0 * 5 + row_slot(row)) * 6144, 0, 1024);
    }
}

__device__ __forceinline__ void phase_gdn_prep(Frame& F, int l) {
    frame_refresh(F); unsigned char* const ws = wsp();
    const bf16* P = (const bf16*)(ws + WS_P);
    bf16* GQ = (bf16*)(ws + WS_GQ); bf16* GK = (bf16*)(ws + WS_GK); bf16* GV = (bf16*)(ws + WS_GV);
    float* GSC = (float*)(ws + WS_GSC);
    const float* cw = inp(I_GCONV) + (size_t)l * 3 * 768;
    const int gw = F.bid * 8 + F.wave, NGW = F.G * 8, lane = F.lane;
    f32x4 w[3][3];
#pragma unroll
    for (int kk = 0; kk < 3; ++kk)
#pragma unroll
        for (int j = 0; j < 3; ++j) w[kk][j] = *(const f32x4*)(cw + kk * 768 + j * 256 + 4 * lane);
    float galog = 0.f, gdtb = 0.f;
    if (lane < 8) { galog = -__expf(inp(I_GALOG)[l * 8 + lane]); gdtb = inp(I_GDTB)[l * 8 + lane]; }
    for (int row = gw; row < R; row += NGW) {
        int t, L; if (row < NLAT) { t = row & (SEQ - 1); L = SEQ; } else { t = (row - NLAT) & (CTXL - 1); L = CTXL; }
        const bf16* pr = P + (size_t)row * DPP;
        f32x4 c[3];
#pragma unroll
        for (int j = 0; j < 3; ++j) {
            const v2u x1 = *(const v2u*)(pr + j * 256 + 4 * lane);
            v2u x0 = (v2u){0u, 0u}, x2 = (v2u){0u, 0u};
            if (t > 0) x0 = *(const v2u*)(pr - DPP + j * 256 + 4 * lane);
            if (t < L - 1) x2 = *(const v2u*)(pr + DPP + j * 256 + 4 * lane);
            f32x4 a;
            a[0] = w[0][j][0] * bflo(x0.x) + w[1][j][0] * bflo(x1.x) + w[2][j][0] * bflo(x2.x);
            a[1] = w[0][j][1] * bfhi(x0.x) + w[1][j][1] * bfhi(x1.x) + w[2][j][1] * bfhi(x2.x);
            a[2] = w[0][j][2] * bflo(x0.y) + w[1][j][2] * bflo(x1.y) + w[2][j][2] * bflo(x2.y);
            a[3] = w[0][j][3] * bfhi(x0.y) + w[1][j][3] * bfhi(x1.y) + w[2][j][3] * bfhi(x2.y);
#pragma unroll
            for (int i = 0; i < 4; ++i) a[i] = siluf_(a[i]);
            c[j] = a;
        }
        const float sq = sum16(c[0][0] * c[0][0] + c[0][1] * c[0][1] + c[0][2] * c[0][2] + c[0][3] * c[0][3]);
        const float sk = sum16(c[1][0] * c[1][0] + c[1][1] * c[1][1] + c[1][2] * c[1][2] + c[1][3] * c[1][3]);
        const float rq = 0.125f / sqrtf(sq + RMS_EPS), rk = 1.f / sqrtf(sk + RMS_EPS);
        v2u o;
        o.x = pk2(c[0][0] * rq, c[0][1] * rq); o.y = pk2(c[0][2] * rq, c[0][3] * rq); *(v2u*)(GQ + (size_t)row * 256 + 4 * lane) = o;
        o.x = pk2(c[1][0] * rk, c[1][1] * rk); o.y = pk2(c[1][2] * rk, c[1][3] * rk); *(v2u*)(GK + (size_t)row * 256 + 4 * lane) = o;
        o.x = pk2(c[2][0], c[2][1]); o.y = pk2(c[2][2], c[2][3]); *(v2u*)(GV + (size_t)row * 256 + 4 * lane) = o;
        if (lane < 16) {
            const float a = bf2f(pr[PC_GA + lane]);
            float val;
            if (lane < 8) { const float z = a + gdtb; const float e = __expf(z); const float sp = z > 20.f ? z : (e < 0.01f ? e * (1.f - e * (0.5f - e * 0.33333333f)) : __logf(1.f + e)); val = galog * sp; }
            else val = sigmoidf_(a);
            GSC[(size_t)row * 16 + lane] = val;
        }
    }
}

__device__ __forceinline__ void chunk_rows(int b, int dir, int c, int& r0, int& step, int& t0) {
    const int s0 = c * TCH;
    if (s0 < CTXL) { t0 = -1; if (dir == 0) { r0 = NLAT + b * CTXL + s0; step = 1; } else { r0 = NLAT + b * CTXL + (CTXL - 1 - s0); step = -1; } }
    else { const int u = s0 - CTXL; if (dir == 0) { r0 = b * SEQ + u; step = 1; t0 = u; } else { r0 = b * SEQ + (SEQ - 1 - u); step = -1; t0 = SEQ - 1 - u; } }
}
struct MatStage { v4u q[4], k[4], k2[4], q2[4], v; float sc0, sc1; };

template <int MODE>
__device__ __forceinline__ void scan_mat(Frame& F, int l, int sub, LAS unsigned char* lds) {
    unsigned char* const ws = wsp();
    const int lane = F.lane, j = lane & 15, rg = lane >> 4;
    const int cg = sub & 3, dir = (sub >> 2) & 1, h = (sub >> 3) & 3, b = sub >> 5;
    const bf16* P = (const bf16*)(ws + WS_P);
    const bf16* GQ = (const bf16*)(ws + WS_GQ); const bf16* GK = (const bf16*)(ws + WS_GK); const bf16* GV = (const bf16*)(ws + WS_GV);
    const float* GSC = (const float*)(ws + WS_GSC);
    const float* ROT = (const float*)(ws + WS_ROT);
    float* O = (float*)(ws + WS_O) + (size_t)(MODE * 2 + dir) * R * 256;
    constexpr int BUFB = 8192 + 8192 + 2048 + 256;
    LAS float* OS = (LAS float*)(lds + 2 * BUFB);
    float S[16];
#pragma unroll
    for (int i = 0; i < 16; ++i) S[i] = 0.f;
    float gam = 0.f;
    if (MODE == 2) gam = __expf(-__expf(inp(I_RDEC)[l * 8 + dir * 4 + h]));
    const int c8 = lane & 7;
    float lb[8];
#pragma unroll
    for (int i = 0; i < 8; ++i) lb[i] = (MODE == 1) ? ((const float*)(ws + WS_LB))[l * 256 + h * 64 + c8 * 8 + i] : 0.f;

    MatStage st;
    auto load = [&](int c) {
        int r0, step, t0; chunk_rows(b, dir, c, r0, step, t0);
#pragma unroll
        for (int i = 0; i < 4; ++i) { const int idx = i * 64 + lane, tt = idx >> 3; const int row = r0 + step * tt;
            if (MODE == 0) { st.q[i] = *(const v4u*)(GQ + (size_t)row * 256 + h * 64 + c8 * 8); st.k[i] = *(const v4u*)(GK + (size_t)row * 256 + h * 64 + c8 * 8); }
            if (MODE == 1) { st.q[i] = *(const v4u*)(P + (size_t)row * DPP + PC_HQ + h * 64 + c8 * 8); st.k[i] = *(const v4u*)(P + (size_t)row * DPP + PC_HF + dir * 256 + h * 64 + c8 * 8); }
            if (MODE == 2) { st.q[i] = *(const v4u*)(P + (size_t)row * DPP + PC_RQKV + h * 64 + c8 * 8); st.k[i] = *(const v4u*)(P + (size_t)row * DPP + PC_RQKV + 256 + h * 64 + c8 * 8);
                             st.q2[i] = *(const v4u*)(P + (size_t)row * DPP + PC_RQKV + h * 64 + (c8 ^ 4) * 8); st.k2[i] = *(const v4u*)(P + (size_t)row * DPP + PC_RQKV + 256 + h * 64 + (c8 ^ 4) * 8); } }
        { const int tt = lane >> 1, half = lane & 1; const int row = r0 + step * tt;
            if (MODE == 0) st.v = *(const v4u*)(GV + (size_t)row * 256 + h * 64 + cg * 16 + half * 8);
            if (MODE == 1) st.v = *(const v4u*)(P + (size_t)row * DPP + PC_HI + h * 64 + cg * 16 + half * 8);
            if (MODE == 2) st.v = *(const v4u*)(P + (size_t)row * DPP + PC_RQKV + 512 + h * 64 + cg * 16 + half * 8); }
        st.sc0 = 0.f; st.sc1 = 0.f;
        if (MODE == 0 && lane < TCH) { const int row = r0 + step * lane; st.sc0 = GSC[(size_t)row * 16 + dir * 4 + h]; st.sc1 = GSC[(size_t)row * 16 + 8 + dir * 4 + h]; }
    };
    auto stage = [&](int c, int buf) {
        LAS float* Qs = (LAS float*)(lds + buf * BUFB); LAS float* Ks = Qs + 2048; LAS float* Vs = Ks + 2048; LAS float* SC = Vs + 512;
        int r0, step, t0; chunk_rows(b, dir, c, r0, step, t0);
#pragma unroll
        for (int i = 0; i < 4; ++i) { const int idx = i * 64 + lane, tt = idx >> 3;
            float q[8], k[8];
            const unsigned qw[4] = {st.q[i].x, st.q[i].y, st.q[i].z, st.q[i].w}, kw[4] = {st.k[i].x, st.k[i].y, st.k[i].z, st.k[i].w};
#pragma unroll
            for (int e = 0; e < 4; ++e) { q[2 * e] = bflo(qw[e]); q[2 * e + 1] = bfhi(qw[e]); k[2 * e] = bflo(kw[e]); k[2 * e + 1] = bfhi(kw[e]); }
            if (MODE == 1) {
#pragma unroll
                for (int e = 0; e < 8; ++e) { q[e] = siluf_(q[e]); k[e] = lb[e] + (1.f - lb[e]) * sigmoidf_(k[e]); }
            }
            if (MODE == 2) {
                if (t0 >= 0) {
                    const int t = t0 + step * tt;
                    const unsigned q2w[4] = {st.q2[i].x, st.q2[i].y, st.q2[i].z, st.q2[i].w}, k2w[4] = {st.k2[i].x, st.k2[i].y, st.k2[i].z, st.k2[i].w};
                    const int ci = c8 & 3;
                    const float* tab = ROT + (size_t)((ci < 2 ? (t >> 6) : 128 + (t & 63)) * 16 + (ci & 1) * 8) * 2;
                    const float sgn = (c8 < 4) ? -1.f : 1.f;
#pragma unroll
                    for (int e = 0; e < 8; ++e) { const float cs = tab[2 * e], sn = tab[2 * e + 1] * sgn;
                        const float qo = (e & 1) ? bfhi(q2w[e >> 1]) : bflo(q2w[e >> 1]), ko = (e & 1) ? bfhi(k2w[e >> 1]) : bflo(k2w[e >> 1]);
                        q[e] = q[e] * cs + qo * sn; k[e] = k[e] * cs + ko * sn; }
                }
#pragma unroll
                for (int e = 0; e < 8; ++e) k[e] *= 0.125f;
            }
            *(LAS f32x4*)(Qs + tt * 64 + c8 * 8) = (f32x4){q[0], q[1], q[2], q[3]}; *(LAS f32x4*)(Qs + tt * 64 + c8 * 8 + 4) = (f32x4){q[4], q[5], q[6], q[7]};
            *(LAS f32x4*)(Ks + tt * 64 + c8 * 8) = (f32x4){k[0], k[1], k[2], k[3]}; *(LAS f32x4*)(Ks + tt * 64 + c8 * 8 + 4) = (f32x4){k[4], k[5], k[6], k[7]};
        }
        { const int tt = lane >> 1, half = lane & 1; const unsigned vw[4] = {st.v.x, st.v.y, st.v.z, st.v.w};
            *(LAS f32x4*)(Vs + tt * 16 + half * 8) = (f32x4){bflo(vw[0]), bfhi(vw[0]), bflo(vw[1]), bfhi(vw[1])};
            *(LAS f32x4*)(Vs + tt * 16 + half * 8 + 4) = (f32x4){bflo(vw[2]), bfhi(vw[2]), bflo(vw[3]), bfhi(vw[3])}; }
        if (MODE == 0 && lane < TCH) { SC[lane * 2] = __expf(st.sc0); SC[lane * 2 + 1] = st.sc1; }
    };
    load(0); stage(0, 0);
    for (int c = 0; c < NCHUNK; ++c) {
        const int buf = c & 1;
        if (c + 1 < NCHUNK) load(c + 1);
        LAS float* Qs = (LAS float*)(lds + buf * BUFB); LAS float* Ks = Qs + 2048; LAS float* Vs = Ks + 2048; LAS float* SC = Vs + 512;
        LDS_WAIT();
        for (int tt = 0; tt < TCH; ++tt) {
            f32x4 qv[4], kv[4];
#pragma unroll
            for (int i = 0; i < 4; ++i) { qv[i] = *(const LAS f32x4*)(Qs + tt * 64 + rg * 16 + 4 * i); kv[i] = *(const LAS f32x4*)(Ks + tt * 64 + rg * 16 + 4 * i); }
            const float vj = Vs[tt * 16 + j];
            float o = 0.f;
            if (MODE == 0) {
                const float eg = SC[tt * 2], beta = SC[tt * 2 + 1];
                float ks = 0.f;
#pragma unroll
                for (int i = 0; i < 16; ++i) ks += kv[i >> 2][i & 3] * S[i];
                ks += __shfl_xor(ks, 16); ks += __shfl_xor(ks, 32);
                const float d = beta * (vj - eg * ks);
#pragma unroll
                for (int i = 0; i < 16; ++i) { S[i] = eg * S[i] + kv[i >> 2][i & 3] * d; o += qv[i >> 2][i & 3] * S[i]; }
            } else if (MODE == 1) {
#pragma unroll
                for (int i = 0; i < 16; ++i) { const float f = kv[i >> 2][i & 3]; S[i] = f * S[i] + (1.f - f) * vj; o += qv[i >> 2][i & 3] * S[i]; }
            } else {
#pragma unroll
                for (int i = 0; i < 16; ++i) { S[i] = gam * S[i] + kv[i >> 2][i & 3] * vj; o += qv[i >> 2][i & 3] * S[i]; }
            }
            o += __shfl_xor(o, 16); o += __shfl_xor(o, 32);
            if (rg == 0) OS[tt * 16 + j] = o;
        }
        LDS_WAIT();
        { int r0, step, t0; chunk_rows(b, dir, c, r0, step, t0); const int tt = lane >> 1, half = lane & 1; const int row = r0 + step * tt;
            float* op = O + (size_t)row * 256 + h * 64 + cg * 16 + half * 8;
            *(f32x4*)op = *(const LAS f32x4*)(OS + tt * 16 + half * 8); *(f32x4*)(op + 4) = *(const LAS f32x4*)(OS + tt * 16 + half * 8 + 4); }
        if (c + 1 < NCHUNK) stage(c + 1, buf ^ 1);
    }
}

__device__ __forceinline__ void scan_s5(Frame& F, int l, int sub, LAS unsigned char* lds) {
    unsigned char* const ws = wsp();
    const int lane = F.lane, g = sub & 15, dir = (sub >> 4) & 1, b = sub >> 5;
    const bf16* P = (const bf16*)(ws + WS_P);
    float* O = (float*)(ws + WS_O) + (size_t)(3 * 2 + dir) * R * 256;
    const int ldg = (l * 2 + dir) * 16 + g;
    const float* LAM = (const float*)(ws + WS_S5LAM) + (size_t)(ldg * 64 + lane) * 2;
    const float* BB = (const float*)(ws + WS_S5B) + (size_t)(ldg * 64 + lane) * 32;
    const float lr = LAM[0], li = LAM[1];
    float br[16], bi[16];
#pragma unroll
    for (int c = 0; c < 16; ++c) { br[c] = BB[2 * c]; bi[c] = BB[2 * c + 1]; }
    LAS float* US = (LAS float*)lds; LAS float* HS = US + 1024; LAS float* CS = HS + 32 * 130; LAS float* YS = CS + 2048;
    { const float* cre = inp(I_S5CRE) + (size_t)ldg * 16 * 64; const float* cim = inp(I_S5CIM) + (size_t)ldg * 16 * 64;
        for (int i = lane; i < 1024; i += 64) { CS[i * 2] = cre[i]; CS[i * 2 + 1] = cim[i]; } }
    float hr = 0.f, hi = 0.f;
    v4u ust;
    auto load = [&](int c) { int r0, step, t0; chunk_rows(b, dir, c, r0, step, t0); const int tt = lane >> 1, half = lane & 1; const int row = r0 + step * tt;
        ust = *(const v4u*)(P + (size_t)row * DPP + PC_S5U + g * 16 + half * 8); };
    auto stage = [&](int buf) { const int tt = lane >> 1, half = lane & 1; LAS float* u = US + buf * 512 + tt * 16 + half * 8; const unsigned w[4] = {ust.x, ust.y, ust.z, ust.w};
        *(LAS f32x4*)u = (f32x4){bflo(w[0]), bfhi(w[0]), bflo(w[1]), bfhi(w[1])}; *(LAS f32x4*)(u + 4) = (f32x4){bflo(w[2]), bfhi(w[2]), bflo(w[3]), bfhi(w[3])}; };
    load(0); stage(0);
    for (int c = 0; c < NCHUNK; ++c) {
        const int buf = c & 1;
        if (c + 1 < NCHUNK) load(c + 1);
        LDS_WAIT();
        const LAS float* U = US + buf * 512;
        for (int tt = 0; tt < TCH; ++tt) {
            f32x4 u[4];
#pragma unroll
            for (int i = 0; i < 4; ++i) u[i] = *(const LAS f32x4*)(U + tt * 16 + 4 * i);
            float ar = 0.f, ai = 0.f;
#pragma unroll
            for (int cc = 0; cc < 16; ++cc) { ar += br[cc] * u[cc >> 2][cc & 3]; ai += bi[cc] * u[cc >> 2][cc & 3]; }
            const float nr = lr * hr - li * hi + ar, ni = lr * hi + li * hr + ai;
            hr = nr; hi = ni;
            *(LAS f32x2*)(HS + tt * 130 + lane * 2) = (f32x2){hr, hi};
        }
        LDS_WAIT();
        { const int cc = lane & 15, tq = lane >> 4;
            float acc[8];
#pragma unroll
            for (int k = 0; k < 8; ++k) acc[k] = 0.f;
            for (int p = 0; p < 64; ++p) {
                const f32x2 cv = *(const LAS f32x2*)(CS + (cc * 64 + p) * 2);
#pragma unroll
                for (int k = 0; k < 8; ++k) { const f32x2 hv = *(const LAS f32x2*)(HS + (tq * 8 + k) * 130 + p * 2); acc[k] += cv[0] * hv[0] - cv[1] * hv[1]; }
            }
#pragma unroll
            for (int k = 0; k < 8; ++k) YS[(tq * 8 + k) * 16 + cc] = acc[k];
        }
        LDS_WAIT();
        { int r0, step, t0; chunk_rows(b, dir, c, r0, step, t0); const int tt = lane >> 1, half = lane & 1; const int row = r0 + step * tt;
            float* op = O + (size_t)row * 256 + g * 16 + half * 8;
            *(f32x4*)op = *(const LAS f32x4*)(YS + tt * 16 + half * 8); *(f32x4*)(op + 4) = *(const LAS f32x4*)(YS + tt * 16 + half * 8 + 4); }
        if (c + 1 < NCHUNK) stage(buf ^ 1);
    }
}
__device__ __forceinline__ void phase_scans(Frame& F, int l) {
    frame_refresh(F); unsigned char* const ws = wsp();
    if (F.wave < 2) {
        LAS unsigned char* lds = F.lds + F.wave * 65536;
        for (int it = F.wave * F.G + F.bid; it < 512; it += 2 * F.G) {
            const int kind = it >> 7, sub = it & 127;
            if (kind == 0) scan_mat<0>(F, l, sub, lds);
            else if (kind == 1) scan_s5(F, l, sub, lds);
            else if (kind == 2) scan_mat<1>(F, l, sub, lds);
            else scan_mat<2>(F, l, sub, lds);
        }
    }
}

__device__ __forceinline__ void phase_readout(Frame& F, int l) {
    frame_refresh(F); unsigned char* const ws = wsp();
    const bf16* P = (const bf16*)(ws + WS_P);
    bf16* MIX = (bf16*)(ws + WS_MIX); bf16* YA = (bf16*)(ws + WS_GQ);
    float* O = (float*)(ws + WS_O);
    const int gw = F.bid * 8 + F.wave, NGW = F.G * 8, lane = F.lane;
    const int dch = (4 * lane) & 63;
    const f32x4 gnw = *(const f32x4*)(inp(I_GNW) + l * 64 + dch), hnw = *(const f32x4*)(inp(I_HNW) + l * 64 + dch);
    const f32x4 dsk = *(const f32x4*)(inp(I_S5D) + l * 256 + 4 * lane);
    const size_t OB = (size_t)R * 256;
    for (int row = gw; row < R; row += NGW) {
        const bf16* pr = P + (size_t)row * DPP;
        const size_t ro = (size_t)row * 256 + 4 * lane;
#pragma unroll
        for (int m = 0; m < 3; ++m) {
            const f32x4 o = *(const f32x4*)(O + (size_t)(m * 2) * OB + ro) + *(const f32x4*)(O + (size_t)(m * 2 + 1) * OB + ro);
            const float ss = sum16(o[0] * o[0] + o[1] * o[1] + o[2] * o[2] + o[3] * o[3]);
            const float r = 1.f / sqrtf(ss * (1.f / 64.f) + RMS_EPS);
            const int gc = (m == 0 ? PC_GZ : (m == 1 ? PC_HG : PC_RG)) + 4 * lane;
            const v2u gw2 = *(const v2u*)(pr + gc);
            const float gt[4] = {bflo(gw2.x), bfhi(gw2.x), bflo(gw2.y), bfhi(gw2.y)};
            float y[4];
#pragma unroll
            for (int i = 0; i < 4; ++i) { const float nw = m == 0 ? gnw[i] : (m == 1 ? hnw[i] : 1.f); y[i] = o[i] * r * nw * siluf_(gt[i]); }
            v2u w; w.x = pk2(y[0], y[1]); w.y = pk2(y[2], y[3]);
            *(v2u*)(MIX + (size_t)row * D + (m == 0 ? 0 : (m == 1 ? 512 : 768)) + 4 * lane) = w;
        }
        { const f32x4 o = *(const f32x4*)(O + (size_t)6 * OB + ro) + *(const f32x4*)(O + (size_t)7 * OB + ro);
            const v2u uw = *(const v2u*)(pr + PC_S5U + 4 * lane);
            const float u[4] = {bflo(uw.x), bfhi(uw.x), bflo(uw.y), bfhi(uw.y)};
            f32x4 ya;
#pragma unroll
            for (int i = 0; i < 4; ++i) ya[i] = gelu_tanh(o[i] + dsk[i] * u[i]);
            *(f32x4*)(O + (size_t)6 * OB + ro) = ya;
            v2u w; w.x = pk2(ya[0], ya[1]); w.y = pk2(ya[2], ya[3]); *(v2u*)(YA + ro) = w; }
    }
}

template <bool ROUTE>
__device__ __forceinline__ void phase_ln(Frame& F, int l, int which) {
    frame_refresh(F); unsigned char* const ws = wsp();
    const float* Y = (const float*)(ws + WS_Y);
    const float* MOD = (const float*)(ws + WS_MOD);
    const float* lg = inp(I_LNG) + (size_t)(l * 2 + which) * D; const float* lb = inp(I_LNB) + (size_t)(l * 2 + which) * D;
    const bool last = (l == DEPTH - 1 && which == 1);
    const int nl = which == 0 ? l : l + 1, shoff = which == 0 ? 3072 : 0, scoff = which == 0 ? 4096 : 1024;
    const int lane = F.lane;
    float* xl = outp(); float* xc = (float*)(ws + WS_XC); bf16* Ab = (bf16*)(ws + WS_A);
    if constexpr (!ROUTE) {
        const int gw = F.bid * 8 + F.wave, NGW = F.G * 8;
        const int nrows = last ? NLAT : R;
        for (int row = gw; row < nrows; row += NGW) {
            f32x4 v[4];
#pragma unroll
            for (int j = 0; j < 4; ++j) v[j] = *(const f32x4*)(Y + (size_t)row * D + 4 * lane + 256 * j);
            ln_row(v, lg, lb, lane);
            float* xd = xrow_dst(xl, xc, row);
#pragma unroll
            for (int j = 0; j < 4; ++j) *(f32x4*)(xd + 4 * lane + 256 * j) = v[j];
            if (!last) store_A_row(Ab, lane, row, v, MOD + (size_t)(nl * 5 + row_slot(row)) * 6144, shoff, scoff);
        }
    } else {
        LAS int* cnt = (LAS int*)F.lds;
        if (F.tid < 8) cnt[F.tid] = 0;
        __syncthreads();
        const float* rw = inp(I_MROUTER) + (size_t)(l >> 1) * D * NEXP;
        f32x4 rwa[4][4][2];
#pragma unroll
        for (int j = 0; j < 4; ++j)
#pragma unroll
            for (int i = 0; i < 4; ++i) { const float* p = rw + (size_t)(4 * lane + 256 * j + i) * 8; rwa[j][i][0] = *(const f32x4*)p; rwa[j][i][1] = *(const f32x4*)(p + 4); }
        int* TOPE = (int*)(ws + WS_TOPE); float* TOPG = (float*)(ws + WS_TOPG);
        const int RPW = (R + F.G - 1) / F.G, rbeg = F.bid * RPW, rend = min(R, rbeg + RPW);
        for (int row = rbeg + F.wave; row < rend; row += 8) {
            f32x4 v[4];
#pragma unroll
            for (int j = 0; j < 4; ++j) v[j] = *(const f32x4*)(Y + (size_t)row * D + 4 * lane + 256 * j);
            ln_row(v, lg, lb, lane);
            float* xd = xrow_dst(xl, xc, row);
#pragma unroll
            for (int j = 0; j < 4; ++j) *(f32x4*)(xd + 4 * lane + 256 * j) = v[j];
            const float* modrow = MOD + (size_t)(nl * 5 + row_slot(row)) * 6144;
            store_A_row(Ab, lane, row, v, modrow, shoff, scoff);
            float lgt[8];
#pragma unroll
            for (int e = 0; e < 8; ++e) lgt[e] = 0.f;
#pragma unroll
            for (int j = 0; j < 4; ++j) { const int c = 4 * lane + 256 * j; const f32x4 sh = *(const f32x4*)(modrow + shoff + c), sc = *(const f32x4*)(modrow + scoff + c);
                const f32x4 hv = v[j] * (sc + 1.f) + sh;
#pragma unroll
                for (int i = 0; i < 4; ++i)
#pragma unroll
                    for (int e = 0; e < 8; ++e) lgt[e] += hv[i] * rwa[j][i][e >> 2][e & 3]; }
#pragma unroll
            for (int e = 0; e < 8; ++e) lgt[e] = wave_sum(lgt[e]);
            int e0 = 0; float v0 = lgt[0];
#pragma unroll
            for (int e = 1; e < 8; ++e) if (lgt[e] > v0) { v0 = lgt[e]; e0 = e; }
            int e1 = -1; float v1 = -3.0e38f;
#pragma unroll
            for (int e = 0; e < 8; ++e) if (e != e0 && lgt[e] > v1) { v1 = lgt[e]; e1 = e; }
            if (lane == 0) { const float ex = __expf(v1 - v0); const float g0 = 1.f / (1.f + ex); TOPE[row] = e0 | (e1 << 8); TOPG[row * 2] = g0; TOPG[row * 2 + 1] = ex * g0;
                __hip_atomic_fetch_add(&cnt[e0], 1, __ATOMIC_RELAXED, __HIP_MEMORY_SCOPE_WORKGROUP); __hip_atomic_fetch_add(&cnt[e1], 1, __ATOMIC_RELAXED, __HIP_MEMORY_SCOPE_WORKGROUP); }
        }
        __syncthreads();
        if (F.tid < 8) ((int*)(ws + WS_WGCNT))[F.bid * 8 + F.tid] = cnt[F.tid];
    }
}

__device__ __forceinline__ void phase_moe_assign(Frame& F) {
    frame_refresh(F); unsigned char* const ws = wsp();
    LAS int* sm = (LAS int*)F.lds;
    const int* WGCNT = (const int*)(ws + WS_WGCNT);
    if (F.tid < 8) { int tot = 0, pre = 0; for (int w = 0; w < F.G; ++w) { const int c = WGCNT[w * 8 + F.tid]; tot += c; if (w < F.bid) pre += c; } sm[16 + F.tid] = tot; sm[24 + F.tid] = pre; sm[8 + F.tid] = 0; }
    __syncthreads();
    if (F.tid == 0) { int ps = 0; int* info = (int*)(ws + WS_MOEINFO);
        for (int e = 0; e < 8; ++e) { sm[e] = ps + sm[24 + e]; if (F.bid == 0) info[e] = ps >> 8; ps += (sm[16 + e] + 255) & ~255; }
        if (F.bid == 0) { info[8] = ps >> 8; } }
    __syncthreads();
    if (F.bid == 0 && F.tid < 272) { int* info = (int*)(ws + WS_MOEINFO); int ps = 0, e = 0;
        for (int q = 0; q < 8; ++q) { ps += (sm[16 + q] + 255) >> 8; if (F.tid >= ps) e = q + 1; }
        info[16 + F.tid] = e < 8 ? e : 7; }
    __syncthreads();
    const int* TOPE = (const int*)(ws + WS_TOPE); const float* TOPG = (const float*)(ws + WS_TOPG);
    int* TOKPOS = (int*)(ws + WS_TOKPOS); float* ROWG = (float*)(ws + WS_ROWG);
    const bf16* A = (const bf16*)(ws + WS_A); bf16* XG = (bf16*)(ws + WS_XG);
    const int RPW = (R + F.G - 1) / F.G, rbeg = F.bid * RPW, rend = min(R, rbeg + RPW);
    for (int row = rbeg + F.wave; row < rend; row += 8) {
        int p0 = 0, p1 = 0;
        if (F.lane == 0) { const int te = TOPE[row]; const int e0 = te & 255, e1 = te >> 8;
            p0 = sm[e0] + __hip_atomic_fetch_add(&sm[8 + e0], 1, __ATOMIC_RELAXED, __HIP_MEMORY_SCOPE_WORKGROUP); p1 = sm[e1] + __hip_atomic_fetch_add(&sm[8 + e1], 1, __ATOMIC_RELAXED, __HIP_MEMORY_SCOPE_WORKGROUP);
            TOKPOS[row * 2] = p0; TOKPOS[row * 2 + 1] = p1; ROWG[p0] = TOPG[row * 2]; ROWG[p1] = TOPG[row * 2 + 1]; }
        p0 = __shfl(p0, 0); p1 = __shfl(p1, 0);
        const v4u a0 = *(const v4u*)(A + (size_t)row * D + 8 * F.lane), a1 = *(const v4u*)(A + (size_t)row * D + 512 + 8 * F.lane);
        *(v4u*)(XG + (size_t)p0 * D + 8 * F.lane) = a0; *(v4u*)(XG + (size_t)p0 * D + 512 + 8 * F.lane) = a1;
        *(v4u*)(XG + (size_t)p1 * D + 8 * F.lane) = a0; *(v4u*)(XG + (size_t)p1 * D + 512 + 8 * F.lane) = a1;
    }
}
__device__ __forceinline__ void phase_moe_combine(Frame& F, int l) {
    frame_refresh(F); unsigned char* const ws = wsp();
    const float* MOD = (const float*)(ws + WS_MOD);
    const float* lg = inp(I_LNG) + (size_t)(l * 2 + 1) * D; const float* lb = inp(I_LNB) + (size_t)(l * 2 + 1) * D;
    const bool last = (l == DEPTH - 1);
    const int* TOKPOS = (const int*)(ws + WS_TOKPOS); const bf16* YB = (const bf16*)(ws + WS_XG);
    const int gw = F.bid * 8 + F.wave, NGW = F.G * 8, lane = F.lane;
    const int nrows = last ? NLAT : R;
    float* xl = outp(); float* xc = (float*)(ws + WS_XC); bf16* Ab = (bf16*)(ws + WS_A);
    for (int row = gw; row < nrows; row += NGW) {
        const int p0 = TOKPOS[row * 2], p1 = TOKPOS[row * 2 + 1];
        const float* xs = xrow_src(xl, xc, row);
        const float* gp = MOD + (size_t)(l * 5 + row_slot(row)) * 6144 + 5120;
        f32x4 v[4];
#pragma unroll
        for (int j = 0; j < 4; ++j) { const int c = 4 * lane + 256 * j;
            const v2u y0 = *(const v2u*)(YB + (size_t)p0 * D + c), y1 = *(const v2u*)(YB + (size_t)p1 * D + c);
            const f32x4 f = (f32x4){bflo(y0.x) + bflo(y1.x), bfhi(y0.x) + bfhi(y1.x), bflo(y0.y) + bflo(y1.y), bfhi(y0.y) + bfhi(y1.y)};
            v[j] = *(const f32x4*)(xs + c) * ALPHA + *(const f32x4*)(gp + c) * f; }
        ln_row(v, lg, lb, lane);
        float* xd = xrow_dst(xl, xc, row);
#pragma unroll
        for (int j = 0; j < 4; ++j) *(f32x4*)(xd + 4 * lane + 256 * j) = v[j];
        if (!last) store_A_row(Ab, lane, row, v, MOD + (size_t)((l + 1) * 5 + row_slot(row)) * 6144, 0, 1024);
    }
}

#ifndef PHMASK
#define PHMASK 0xFFFFFFFFu
#endif
#define PK(k) ((PHMASK >> (k)) & 1u)
constexpr int PPL = 12, NPHASE = 2 + DEPTH * PPL;
__global__ void __launch_bounds__(512, 2) fwd(Args args) {
    extern __shared__ __attribute__((aligned(16))) unsigned char lds_raw[];
    Frame F;
    F.lds = (LAS unsigned char*)lds_raw;
    F.tid = threadIdx.x; F.lane = F.tid & 63; F.wave = __builtin_amdgcn_readfirstlane(F.tid >> 6); F.G = gridDim.x; F.bid = blockIdx.x;
    volatile LAS unsigned* MISC = (volatile LAS unsigned*)(F.lds + LDSCTL_OFF);
    if (F.tid < 64) MISC[F.tid] = 0u;
    __syncthreads();
    const int lo = args.ph_lo, hi = args.ph_hi;
    XcdBarrier bar; bar.bar = (unsigned*)(args.ws + WS_CTL) + 4096; bar.x = 0; bar.st = nullptr;
    if (hi - lo > 1) bar = xcd_barrier_post((unsigned*)(args.ws + WS_CTL) + 4096, MISC + 8, F.wave);
#define IN(k) (lo <= (k) && (k) < hi)
#define SEAM(k) do { if (IN((k) + 1)) xcd_barrier(bar, F.wave); } while (0)
    LAS unsigned char* ring = F.lds;

    if (IN(0)) { if (PK(0)) phase_prologue(F); SEAM(0); }
    if (IN(1)) { if (PK(1)) phase_a0(F); SEAM(1); }
    for (int l = 0; l < DEPTH; ++l) {
        const int pb = 2 + l * PPL;
        const bool moe = (l & 1) != 0;
        if (IN(pb + 0)) { if (PK(2) && moe) phase_moe_convert(F, l >> 1); SEAM(pb + 0); }
        if (PK(3) && IN(pb + 1)) {
            unsigned char* const ws = wsp(); const float* modl = (const float*)(ws + WS_MOD) + (size_t)l * 5 * 6144; (void)modl;
            pg8::Gemm g{(const bf16*)(ws + WS_A), (const bf16*)(ws + WS_WIN) + (size_t)l * DPP * D, D};
            pg8::StaticOrder S; S.init(R / 256, DPP / 256, D, F.G, F.bid);
            pg8::EpiBf16 E{(bf16*)(ws + WS_P), DPP};
            pg8::gemm_phase<pg8::EpiBf16, pg8::StaticOrder, true, true>(ring, F.wave, g, S, E);
            SEAM(pb + 1);
        }
        if (IN(pb + 2)) { if (PK(4)) phase_gdn_prep(F, l); SEAM(pb + 2); }
        if (IN(pb + 3)) { if (PK(5)) phase_scans(F, l); SEAM(pb + 3); }
        if (IN(pb + 4)) { if (PK(6)) phase_readout(F, l); SEAM(pb + 4); }
        if (PK(7) && IN(pb + 5)) {
            unsigned char* const ws = wsp(); const float* modl = (const float*)(ws + WS_MOD) + (size_t)l * 5 * 6144; (void)modl;
            pg8::Gemm g{(const bf16*)(ws + WS_GQ), (const bf16*)(ws + WS_WGLU) + (size_t)l * 65536, 256};
            pg8::StaticOrder S; S.init(R / 256, 1, 256, F.G, F.bid);
            pg8::EpiGlu E{(bf16*)(ws + WS_MIX), (const float*)(ws + WS_O) + (size_t)6 * R * 256, inp(I_S5GLUB) + l * 256};
            pg8::gemm_phase<pg8::EpiGlu, pg8::StaticOrder, true, true>(ring, F.wave, g, S, E);
            SEAM(pb + 5);
        }
        if (PK(8) && IN(pb + 6)) {
            unsigned char* const ws = wsp(); const float* modl = (const float*)(ws + WS_MOD) + (size_t)l * 5 * 6144; (void)modl;
            pg8::Gemm g{(const bf16*)(ws + WS_MIX), (const bf16*)(ws + WS_WOUT) + (size_t)l * D * D, D};
            pg8::StaticOrder S; S.init(R / 256, D / 256, D, F.G, F.bid);
            pg8::EpiRes E{(float*)(ws + WS_Y), l == 0 ? inp(I_X) : (const float*)outp(), l == 0 ? inp(I_CTX) : (const float*)(ws + WS_XC), modl, 2048};
            pg8::gemm_phase<pg8::EpiRes, pg8::StaticOrder, true, true>(ring, F.wave, g, S, E);
            SEAM(pb + 6);
        }
        if (IN(pb + 7)) { if (moe) { if (PK(9)) phase_ln<true>(F, l, 0); } else { if (PK(10)) phase_ln<false>(F, l, 0); } SEAM(pb + 7); }
        if (!moe) {
            if (PK(11) && IN(pb + 8)) {
            unsigned char* const ws = wsp(); const float* modl = (const float*)(ws + WS_MOD) + (size_t)l * 5 * 6144; (void)modl;
                pg8::Gemm g{(const bf16*)(ws + WS_A), (const bf16*)(ws + WS_WF13) + (size_t)(l >> 1) * 2 * FFD * D, D};
                pg8::StaticOrder S; S.init(R / 256, 2 * FFD / 256, D, F.G, F.bid);
                pg8::EpiSwiGlu E{(bf16*)(ws + WS_HID), FFD};
                pg8::gemm_phase<pg8::EpiSwiGlu, pg8::StaticOrder, true, true>(ring, F.wave, g, S, E);
                SEAM(pb + 8);
            }
            if (PK(12) && IN(pb + 9)) {
            unsigned char* const ws = wsp(); const float* modl = (const float*)(ws + WS_MOD) + (size_t)l * 5 * 6144; (void)modl;
                pg8::Gemm g{(const bf16*)(ws + WS_HID), (const bf16*)(ws + WS_WF2) + (size_t)(l >> 1) * D * FFD, FFD};
                pg8::StaticOrder S; S.init(R / 256, D / 256, FFD, F.G, F.bid);
                pg8::EpiRes E{(float*)(ws + WS_Y), (const float*)outp(), (const float*)(ws + WS_XC), modl, 5120};
                pg8::gemm_phase<pg8::EpiRes, pg8::StaticOrder, true, true>(ring, F.wave, g, S, E);
                SEAM(pb + 9);
            }
            if (IN(pb + 10)) { if (PK(13)) phase_ln<false>(F, l, 1); SEAM(pb + 10); }
            if (IN(pb + 11)) { SEAM(pb + 11); }
        } else {
            if (IN(pb + 8)) { if (PK(14)) phase_moe_assign(F); SEAM(pb + 8); }
            if (PK(15) && IN(pb + 9)) {
            unsigned char* const ws = wsp(); const float* modl = (const float*)(ws + WS_MOD) + (size_t)l * 5 * 6144; (void)modl;
                const int* info = (const int*)(ws + WS_MOEINFO);
                pg8::Gemm g{(const bf16*)(ws + WS_XG), (const bf16*)(ws + WS_WM13), D};
                pg8::MoeOrder S; S.init(info[8], 2 * FFE / 256, D, F.G, F.bid);
                S.texp = info + 16; S.estride = (size_t)2 * FFE * D * 2;
                pg8::EpiSwiGlu E{(bf16*)(ws + WS_MHID), FFE};
                pg8::gemm_phase<pg8::EpiSwiGlu, pg8::MoeOrder, true, true>(ring, F.wave, g, S, E);
                SEAM(pb + 9);
            }
            if (PK(16) && IN(pb + 10)) {
            unsigned char* const ws = wsp(); const float* modl = (const float*)(ws + WS_MOD) + (size_t)l * 5 * 6144; (void)modl;
                const int* info = (const int*)(ws + WS_MOEINFO);
                pg8::Gemm g{(const bf16*)(ws + WS_MHID), (const bf16*)(ws + WS_WM2), FFE};
                pg8::MoeOrder S; S.init(info[8], D / 256, FFE, F.G, F.bid);
                S.texp = info + 16; S.estride = (size_t)D * FFE * 2;
                pg8::EpiMoeDown E{(bf16*)(ws + WS_XG), (const float*)(ws + WS_ROWG)};
                pg8::gemm_phase<pg8::EpiMoeDown, pg8::MoeOrder, true, true>(ring, F.wave, g, S, E);
                SEAM(pb + 10);
            }
            if (IN(pb + 11)) { if (PK(17)) phase_moe_combine(F, l); SEAM(pb + 11); }
        }
    }
#undef IN
#undef SEAM
}

extern "C" void kernel_launch(void* const* d_in, const int* in_sizes, int n_in, void* d_out, int out_size, void* d_ws, size_t ws_size, hipStream_t stream) {
    static int grid = 0;
    if (grid == 0) {
        if (n_in != 34 || out_size != NLAT * D || ws_size < WS_END) { fprintf(stderr, "kernel_launch: unexpected shapes (n_in %d out %d ws %zu need %zu)\n", n_in, out_size, ws_size, (size_t)WS_END); grid = -1; return; }
        int dev = 0, cus = 0, per_cu = 0;
        if (hipGetDevice(&dev) != hipSuccess || hipDeviceGetAttribute(&cus, hipDeviceAttributeMultiprocessorCount, dev) != hipSuccess) { grid = -1; return; }
        if (hipFuncSetAttribute((const void*)fwd, hipFuncAttributeMaxDynamicSharedMemorySize, LDS_BYTES) != hipSuccess) { fprintf(stderr, "kernel_launch: hipFuncSetAttribute failed\n"); grid = -1; return; }
        if (hipOccupancyMaxActiveBlocksPerMultiprocessor(&per_cu, (const void*)fwd, 512, LDS_BYTES) != hipSuccess || per_cu < 1) fprintf(stderr, "kernel_launch: occupancy query reports %d\n", per_cu);
        (void)hipGetLastError();
        grid = cus;
    }
    if (grid < 0) return;
    (void)hipMemsetAsync((char*)d_ws + WS_CTL, 0, CTL_ZERO_BYTES, stream);
    Args a{};
    for (int i = 0; i < 34; ++i) a.in[i] = (const float*)d_in[i];
    a.out = (float*)d_out; a.ws = (unsigned char*)d_ws;
#if MK_ONE_LAUNCH
    a.ph_lo = 0; a.ph_hi = NPHASE;
    hipLaunchKernelGGL(fwd, dim3(grid), dim3(512), LDS_BYTES, stream, a);
#else
    for (int p = 0; p < NPHASE; ++p) {
        if (p >= 2) { const int l = (p - 2) / PPL, k = (p - 2) % PPL; const bool moe = (l & 1) != 0; if (k == 0 && !moe) continue; if (k == 11 && !moe) continue; }
        a.ph_lo = p; a.ph_hi = p + 1;
        hipLaunchKernelGGL(fwd, dim3(grid), dim3(512), LDS_BYTES, stream, a);
    }
#endif
}
```

```cpp
#include <hip/hip_runtime.h>
#include <cstdio>
#include <cstdint>

#ifndef MK_ONE_LAUNCH
#define MK_ONE_LAUNCH 1
#endif

#define GAS __attribute__((address_space(1)))
#define LAS __attribute__((address_space(3)))
typedef unsigned short bf16;
typedef unsigned v4u __attribute__((ext_vector_type(4)));
typedef unsigned v2u __attribute__((ext_vector_type(2)));
typedef float f32x4 __attribute__((ext_vector_type(4)));
typedef float f32x2 __attribute__((ext_vector_type(2)));
typedef short bf16x8 __attribute__((ext_vector_type(8)));

constexpr int D = 1024, BATCH = 4, SEQ = 8192, CTXL = 256, DEPTH = 4;
constexpr int NLAT = BATCH * SEQ, NCTX = BATCH * CTXL, R = NLAT + NCTX;
constexpr int DPROJ = 3600, DPP = 3840;
constexpr int FFD = 2816, FFE = 3584, NEXP = 8;
constexpr int MOE_ROWS = 2 * R + NEXP * 256;
constexpr float ALPHA = 1.681792830507429f;
constexpr float LN_EPS = 1e-5f, RMS_EPS = 1e-6f;
constexpr int PC_GQKV = 0, PC_GZ = 768, PC_GA = 1024, PC_GB = 1032, PC_S5U = 1040, PC_HQ = 1296, PC_HF = 1552, PC_HI = 2064, PC_HG = 2320, PC_RQKV = 2576, PC_RG = 3344;
constexpr int NSEQ = CTXL + SEQ;
constexpr int TCH = 32, NCHUNK = NSEQ / TCH;

constexpr size_t MiB = 1u << 20;
constexpr size_t WS_CTL = 0, CTL_ZERO_BYTES = 1 * MiB;
constexpr size_t WS_MOD = 1 * MiB;
constexpr size_t WS_LB = WS_MOD + 512 * 1024;
constexpr size_t WS_ROT = WS_LB + 4096;
constexpr size_t WS_S5LAM = WS_ROT + 32768;
constexpr size_t WS_S5B = 2 * MiB;
constexpr size_t WS_TOPE = 3 * MiB;
constexpr size_t WS_TOPG = WS_TOPE + 256 * 1024;
constexpr size_t WS_TOKPOS = WS_TOPG + 512 * 1024;
constexpr size_t WS_ROWG = 4 * MiB + 256 * 1024;
constexpr size_t WS_WGCNT = 4 * MiB + 768 * 1024;
constexpr size_t WS_MOEINFO = WS_WGCNT + 16384;
constexpr size_t WS_GSC = 5 * MiB;
constexpr size_t WS_WIN = 8 * MiB;
constexpr size_t WS_WOUT = 38 * MiB;
constexpr size_t WS_WF13 = 46 * MiB;
constexpr size_t WS_WF2 = 68 * MiB;
constexpr size_t WS_WGLU = 79 * MiB;
constexpr size_t WS_WM13 = 80 * MiB;
constexpr size_t WS_WM2 = 192 * MiB;
constexpr size_t WS_XC = 248 * MiB;
constexpr size_t WS_A = 252 * MiB;
constexpr size_t WS_U = 318 * MiB;
constexpr size_t WS_P = WS_U;
constexpr size_t WS_Y = WS_U;
constexpr size_t WS_MIX = 566 * MiB;
constexpr size_t WS_GQ = 632 * MiB, WS_GK = WS_GQ + 17 * MiB, WS_GV = WS_GK + 17 * MiB;
constexpr size_t WS_O = 684 * MiB;
constexpr size_t WS_HID = 566 * MiB;
constexpr size_t WS_XG = WS_U;
constexpr size_t WS_MHID = 454 * MiB;
constexpr size_t WS_END = 1040 * MiB;
static_assert(WS_O + (size_t)8 * R * 256 * 4 <= WS_END && WS_MHID + (size_t)MOE_ROWS * FFE * 2 <= WS_END && WS_XG + (size_t)MOE_ROWS * D * 2 <= WS_MHID, "ws map");
static_assert(WS_P + (size_t)R * DPP * 2 <= WS_MIX && WS_HID + (size_t)R * FFD * 2 <= WS_END && WS_Y + (size_t)R * D * 4 <= WS_MIX, "ws map 2");

constexpr int RING_BYTES = 131072, LDSCTL_OFF = RING_BYTES, LDS_BYTES = 147456;

__device__ __forceinline__ unsigned f2bf(float f) { unsigned u = __builtin_bit_cast(unsigned, f); return (u + 0x7fffu + ((u >> 16) & 1u)) >> 16; }
__device__ __forceinline__ unsigned pk2(float lo, float hi) { return f2bf(lo) | (f2bf(hi) << 16); }
__device__ __forceinline__ float bflo(unsigned w) { return __builtin_bit_cast(float, w << 16); }
__device__ __forceinline__ float bfhi(unsigned w) { return __builtin_bit_cast(float, w & 0xffff0000u); }
__device__ __forceinline__ float bf2f(bf16 h) { return __builtin_bit_cast(float, (unsigned)h << 16); }
__device__ __forceinline__ float wave_sum(float v) {
#pragma unroll
    for (int o = 1; o < 64; o <<= 1) v += __shfl_xor(v, o);
    return v;
}
__device__ __forceinline__ float sum16(float v) { v += __shfl_xor(v, 1); v += __shfl_xor(v, 2); v += __shfl_xor(v, 4); v += __shfl_xor(v, 8); return v; }
__device__ __forceinline__ float sigmoidf_(float x) { return 1.f / (1.f + __expf(-x)); }
__device__ __forceinline__ float siluf_(float x) { return x / (1.f + __expf(-x)); }
__device__ __forceinline__ float gelu_tanh(float x) { const float u = 0.7978845608028654f * (x + 0.044715f * x * x * x); const float t = 1.f - 2.f / (__expf(2.f * u) + 1.f); return 0.5f * x * (1.f + t); }
#define LDS_WAIT() asm volatile("s_waitcnt lgkmcnt(0)" ::: "memory")

#define XB_TMO      128
#define XB_XCNT(j)  (256  + 64 * (j))
#define XB_XSUB(j)  (1280 + 64 * (j))
#define XB_XGEN(j)  (2304 + 64 * (j))
#define XB_TOP      3328
#define XB_TOPGEN   3392
#define XCD_BAR_WORDS 3456
#define XB_SPIN_CAP (1u << 18)
__device__ __forceinline__ unsigned xb_ld(unsigned* p)              { return __hip_atomic_load(p, __ATOMIC_RELAXED, __HIP_MEMORY_SCOPE_AGENT); }
__device__ __forceinline__ unsigned xb_add(unsigned* p, unsigned v) { return __hip_atomic_fetch_add(p, v, __ATOMIC_RELAXED, __HIP_MEMORY_SCOPE_AGENT); }
__device__ __forceinline__ unsigned xb_xcc_id() { return (unsigned)__builtin_amdgcn_s_getreg((3 << 11) | 20) & 0xFu; }
#define XB_SPIN(cond, bar) do { unsigned _sp = 0; while (cond) { __builtin_amdgcn_s_sleep(1); \
    if ((++_sp & 255u) == 0u) { if (xb_ld(&(bar)[XB_TMO])) break; if (_sp > XB_SPIN_CAP) { atomicAdd(&(bar)[XB_TMO], 1u); break; } } } } while (0)
struct XcdBarrier { unsigned* bar; unsigned x; volatile LAS unsigned* st; };
__device__ __forceinline__ bool xb_thread0(int wave_id) { return wave_id == 0 && __builtin_amdgcn_mbcnt_hi(~0u, __builtin_amdgcn_mbcnt_lo(~0u, 0u)) == 0u; }
__device__ __forceinline__ XcdBarrier xcd_barrier_post(unsigned* bar, volatile LAS unsigned* st, int wave_id) {
    XcdBarrier b; b.bar = bar; b.x = xb_xcc_id(); b.st = st;
    if (xb_thread0(wave_id)) (void)xb_add(&bar[XB_XCNT(b.x)], 1u);
    return b;
}
__device__ __forceinline__ void xcd_barrier_complete(unsigned* bar, unsigned x, unsigned& nloc, unsigned& nx) {
    const unsigned G = gridDim.x * gridDim.y * gridDim.z;
    unsigned sum, cnt, mine, sp = 0u;
    for (;;) {
        sum = 0u; cnt = 0u; mine = 0u;
#pragma unroll
        for (unsigned j = 0; j < 16; ++j) { const unsigned c = xb_ld(&bar[XB_XCNT(j)]); sum += c; cnt += (c > 0u) ? 1u : 0u; mine = (j == x) ? c : mine; }
        if (sum == G) break;
        __builtin_amdgcn_s_sleep(1);
        if ((++sp & 255u) == 0u) { if (xb_ld(&bar[XB_TMO])) break; if (sp > XB_SPIN_CAP) { atomicAdd(&bar[XB_TMO], 1u); break; } }
    }
    nloc = mine > 0u ? mine : 1u; nx = cnt > 0u ? cnt : 1u;
}
__device__ __forceinline__ void xcd_barrier(const XcdBarrier& b, int wave_id) {
    asm volatile("s_waitcnt vmcnt(0)" ::: "memory");
    __syncthreads();
    if (xb_thread0(wave_id)) {
        unsigned* bar = b.bar; asm volatile("" : "+s"(bar));
        __builtin_amdgcn_s_waitcnt(0);
        unsigned nloc = b.st[0], nx = b.st[1];
        if (nloc == 0u) { xcd_barrier_complete(bar, b.x, nloc, nx); b.st[0] = nloc; b.st[1] = nx; }
        const unsigned old = xb_add(&bar[XB_XSUB(b.x)], 1u);
        const unsigned gen = old / nloc;
        if (old + 1u == (gen + 1u) * nloc) {
            __builtin_amdgcn_fence(__ATOMIC_RELEASE, "agent");
            asm volatile("s_waitcnt vmcnt(0)" ::: "memory");
            const unsigned og = xb_add(&bar[XB_TOP], 1u);
            const unsigned tg = og / nx;
            if (og + 1u == (tg + 1u) * nx) xb_add(&bar[XB_TOPGEN], 1u);
            else XB_SPIN(xb_ld(&bar[XB_TOPGEN]) == tg, bar);
            __builtin_amdgcn_fence(__ATOMIC_ACQUIRE, "agent");
            xb_add(&bar[XB_XGEN(b.x)], 1u);
            asm volatile("s_waitcnt vmcnt(0)" ::: "memory");
        } else {
            XB_SPIN(xb_ld(&bar[XB_XGEN(b.x)]) == gen, bar);
            __builtin_amdgcn_fence(__ATOMIC_ACQUIRE, "agent");
            asm volatile("s_waitcnt vmcnt(0)" ::: "memory");
        }
    }
    __syncthreads();
}

namespace pg8 {
constexpr int BM = 256, BK = 64, HALF = 128, HTB = HALF * BK * 2, STAGE_BYTES = 8 * HTB, NXCD = 8, WGM = 8;
__host__ __device__ __forceinline__ int lds_byte(int r, int c) { const int st = (r >> 4) * 2 + (c >> 5), rr = r & 15, cc = c & 31, ob = rr * 64 + cc * 2; return st * 1024 + (ob ^ (((ob >> 9) & 1) << 5)); }
__host__ __device__ __forceinline__ void stage_rc(int b, int& Rr, int& C) { const int st = b / 1024, sb = b % 1024, swz = sb ^ (((sb >> 9) & 1) << 5); Rr = (st >> 1) * 16 + swz / 64; C = (st & 1) * 32 + (swz % 64) / 2; }
__host__ __device__ __forceinline__ int perm32(int rho) { const int n = rho >> 4, i = rho & 15; return 8 * (i >> 2) + 4 * n + (i & 3); }
struct Unit { int pm, pn; size_t boff; };
struct Gemm { const bf16* A; const bf16* Bt; int K; };

struct StaticOrder {
    int nM, nN, nwg, G, c, K;
    __device__ void init(int nM_, int nN_, int K_, int G_, int c_) { nM = nM_; nN = nN_; nwg = nM * nN; G = G_; c = c_; K = K_; }
    __device__ bool map(int i, int& pm, int& pn) const {
        const long L = (long)i * G + c; if (L >= nwg) return false;
        int wgid = (int)L; { const int q = nwg / NXCD, r = nwg % NXCD, xcd = wgid % NXCD, off = wgid / NXCD; wgid = (xcd < r ? xcd * (q + 1) : r * (q + 1) + (xcd - r) * q) + off; }
        const int nig = WGM * nN, gid = wgid / nig, fm = gid * WGM, gsz = (nM - fm) < WGM ? (nM - fm) : WGM;
        pm = fm + ((wgid % nig) % gsz); pn = (wgid % nig) / gsz; return true;
    }
    __device__ bool next(int i, Unit& u) const { if (!map(i, u.pm, u.pn)) return false; u.boff = (size_t)u.pn * 256 * K * 2; return true; }
};
struct MoeOrder : StaticOrder {
    const int* texp; size_t estride;
    __device__ bool next(int i, Unit& u) const {
        if (!map(i, u.pm, u.pn)) return false;
        const int e = __builtin_amdgcn_readfirstlane(texp[u.pm]);
        u.boff = (size_t)e * estride + (size_t)u.pn * 256 * K * 2; return true;
    }
};
__device__ __forceinline__ unsigned cvt_pk_bf16(float lo, float hi) { unsigned r; asm volatile("v_cvt_pk_bf16_f32 %0, %1, %2" : "=v"(r) : "v"(lo), "v"(hi)); return r; }

template <class Epi, class Sched, bool ALIGN_EPI, bool SP2>
__device__ __forceinline__ void gemm_phase(LAS unsigned char* lds, const int wave_id, const Gemm g, const Sched& S, const Epi& E) {
    int lane = (int)__builtin_amdgcn_mbcnt_hi(~0u, __builtin_amdgcn_mbcnt_lo(~0u, 0u)); asm volatile("" : "+v"(lane));
    const int wid = wave_id, tid = wid * 64 + lane, wr = wid >> 2, wc = wid & 3, fr = lane & 15, fq = lane >> 4;
    const int K = g.K, nt = K / BK;
    unsigned voffA, voffB;
    { int Rr, C; stage_rc(tid * 16, Rr, C); const int Rb = Epi::PERM ? ((Rr & ~31) + perm32(Rr & 31)) : Rr;
        voffA = (unsigned)(Rr * K + C) * 2u; voffB = (unsigned)(Rb * K + C) * 2u; }
    const size_t qstep = (size_t)64 * K * 2;
    const size_t kstep = (size_t)(BK * 2);
    const size_t hstep = (size_t)HALF * K * 2;
    const size_t tstep = 2 * hstep;
    const unsigned ldsw = (unsigned)wid * 1024u;
    const int aoff = lds_byte(wr * 64 + fr, fq * 8), boff = lds_byte(wc * 32 + fr, fq * 8);
#define PG8_SA(b, h) (((b) * 2 + (h)) * HTB)
#define PG8_SB(b, h) ((4 + (b) * 2 + (h)) * HTB)
#define PG8_STAGE(bufoff, gbase, voff) do { _Pragma("unroll") for (int _i = 0; _i < 2; ++_i) \
        __builtin_amdgcn_global_load_lds((const unsigned*)((const char*)(gbase) + _i * qstep + (voff)), (LAS unsigned*)(lds + (bufoff) + ldsw + _i * 8192), 16, 0, 0); } while (0)
#define PG8_LDA(dst, b, h) do { _Pragma("unroll") for (int m = 0; m < 4; ++m) _Pragma("unroll") for (int k = 0; k < 2; ++k) dst[m][k] = *(const LAS bf16x8*)(lds + PG8_SA(b, h) + aoff + m * 2048 + k * 1024); } while (0)
#define PG8_LDB(dst, b, h) do { _Pragma("unroll") for (int n = 0; n < 2; ++n) _Pragma("unroll") for (int k = 0; k < 2; ++k) dst[n][k] = *(const LAS bf16x8*)(lds + PG8_SB(b, h) + boff + n * 2048 + k * 1024); } while (0)
#define PG8_MMA(ai, bj, At, Bt) do { __builtin_amdgcn_s_setprio(1); _Pragma("unroll") for (int m = 0; m < 4; ++m) _Pragma("unroll") for (int n = 0; n < 2; ++n) _Pragma("unroll") for (int k = 0; k < 2; ++k) \
        acc[ai][bj][m][n] = __builtin_amdgcn_mfma_f32_16x16x32_bf16(Bt[n][k], At[m][k], acc[ai][bj][m][n], 0, 0, 0); __builtin_amdgcn_s_setprio(0); } while (0)
#define PG8_WAIT_V(n) asm volatile("s_waitcnt vmcnt(" #n ")" ::: "memory")
#define PG8_WAIT_L(n) asm volatile("s_waitcnt lgkmcnt(" #n ")" ::: "memory")
#define PG8_BAR __builtin_amdgcn_s_barrier()
#define PG8_SCHED __builtin_amdgcn_sched_barrier(0)
    Unit cur, nxt; int ui = 0;
    if (!S.next(0, cur)) return;
    f32x4 acc[2][2][4][2];
#pragma unroll
    for (int a = 0; a < 2; ++a)
#pragma unroll
        for (int b = 0; b < 2; ++b)
#pragma unroll
            for (int m = 0; m < 4; ++m)
#pragma unroll
                for (int n = 0; n < 2; ++n) acc[a][b][m][n] = (f32x4){0.f, 0.f, 0.f, 0.f};
    bf16x8 At[4][2], B0[2][2], B1[2][2];
    const char* cA = (const char*)g.A + (size_t)cur.pm * tstep; const char* cB = (const char*)g.Bt + cur.boff;
    if constexpr (SP2) {
        PG8_STAGE(PG8_SB(0, 0), cB, voffB); PG8_STAGE(PG8_SB(0, 1), cB + hstep, voffB); PG8_STAGE(PG8_SA(0, 0), cA, voffA); PG8_STAGE(PG8_SA(0, 1), cA + hstep, voffA);
        if (wr == 1) PG8_BAR;
        PG8_WAIT_V(2); PG8_BAR;
        PG8_STAGE(PG8_SB(1, 0), cB + kstep, voffB); PG8_STAGE(PG8_SA(1, 0), cA + kstep, voffA); PG8_STAGE(PG8_SB(1, 1), cB + hstep + kstep, voffB);
        PG8_WAIT_V(6); PG8_BAR;
    } else {
        PG8_STAGE(PG8_SB(0, 0), cB, voffB); PG8_STAGE(PG8_SA(0, 0), cA, voffA); PG8_STAGE(PG8_SB(0, 1), cB + hstep, voffB); PG8_STAGE(PG8_SA(0, 1), cA + hstep, voffA);
        if (wr == 1) PG8_BAR;
        PG8_WAIT_V(4); PG8_BAR;
        PG8_STAGE(PG8_SB(1, 0), cB + kstep, voffB); PG8_STAGE(PG8_SA(1, 0), cA + kstep, voffA); PG8_STAGE(PG8_SB(1, 1), cB + hstep + kstep, voffB);
        PG8_WAIT_V(6); PG8_BAR;
    }
    for (;;) {
        const bool has_next = S.next(ui + 1, nxt);
        const char* nA = has_next ? (const char*)g.A + (size_t)nxt.pm * tstep : cA; const char* nB = has_next ? (const char*)g.Bt + nxt.boff : cB;
        for (int t = 0; t < nt; t += 2) {
            const bool last = (t == nt - 2);
            const char* a1 = cA + (size_t)(t + 1) * kstep;
            const char* a2 = last ? nA : cA + (size_t)(t + 2) * kstep; const char* b2 = last ? nB : cB + (size_t)(t + 2) * kstep;
            const char* a3 = a2 + kstep; const char* b3 = b2 + kstep;
            if constexpr (SP2) {
            PG8_LDB(B0, 0, 0); PG8_LDB(B1, 0, 1); PG8_SCHED; PG8_LDA(At, 0, 0); PG8_STAGE(PG8_SA(1, 1), a1 + hstep, voffA);
            PG8_WAIT_V(8); PG8_WAIT_L(0); PG8_BAR; PG8_MMA(0, 0, At, B0); PG8_MMA(0, 1, At, B1); PG8_BAR; PG8_SCHED;
            PG8_LDA(At, 0, 1); PG8_STAGE(PG8_SB(0, 0), b2, voffB); PG8_STAGE(PG8_SB(0, 1), b2 + hstep, voffB); PG8_STAGE(PG8_SA(0, 0), a2, voffA);
            PG8_WAIT_V(8); PG8_WAIT_L(0); PG8_BAR; PG8_MMA(1, 0, At, B0); PG8_MMA(1, 1, At, B1); PG8_BAR; PG8_SCHED;
            PG8_LDB(B0, 1, 0); PG8_LDB(B1, 1, 1); PG8_SCHED; PG8_LDA(At, 1, 0); PG8_STAGE(PG8_SA(0, 1), a2 + hstep, voffA);
            PG8_WAIT_V(8); PG8_WAIT_L(0); PG8_BAR; PG8_MMA(0, 0, At, B0); PG8_MMA(0, 1, At, B1); PG8_BAR; PG8_SCHED;
            PG8_LDA(At, 1, 1); PG8_STAGE(PG8_SB(1, 0), b3, voffB); PG8_STAGE(PG8_SB(1, 1), b3 + hstep, voffB); PG8_STAGE(PG8_SA(1, 0), a3, voffA);
            PG8_WAIT_V(8); PG8_WAIT_L(0); PG8_BAR; PG8_MMA(1, 0, At, B0); PG8_MMA(1, 1, At, B1); PG8_BAR; PG8_SCHED;
            } else {
            PG8_LDB(B0, 0, 0); PG8_SCHED; PG8_LDA(At, 0, 0); PG8_STAGE(PG8_SA(1, 1), a1 + hstep, voffA);
            PG8_WAIT_L(8); PG8_BAR; PG8_WAIT_L(0); PG8_MMA(0, 0, At, B0); PG8_BAR; PG8_SCHED;
            PG8_LDB(B1, 0, 1); PG8_STAGE(PG8_SB(0, 0), b2, voffB);
            PG8_BAR; PG8_WAIT_L(0); PG8_MMA(0, 1, At, B1); PG8_BAR;
            PG8_LDA(At, 0, 1); PG8_STAGE(PG8_SA(0, 0), a2, voffA);
            PG8_BAR; PG8_WAIT_L(0); PG8_MMA(1, 0, At, B0); PG8_BAR; PG8_SCHED;
            PG8_STAGE(PG8_SB(0, 1), b2 + hstep, voffB);
            PG8_WAIT_V(6); PG8_BAR; PG8_MMA(1, 1, At, B1); PG8_BAR;
            PG8_LDB(B0, 1, 0); PG8_SCHED; PG8_LDA(At, 1, 0); PG8_STAGE(PG8_SA(0, 1), a2 + hstep, voffA);
            PG8_WAIT_L(8); PG8_BAR; PG8_WAIT_L(0); PG8_MMA(0, 0, At, B0); PG8_BAR; PG8_SCHED;
            PG8_LDB(B1, 1, 1); PG8_STAGE(PG8_SB(1, 0), b3, voffB);
            PG8_BAR; PG8_WAIT_L(0); PG8_MMA(0, 1, At, B1); PG8_BAR;
            PG8_LDA(At, 1, 1); PG8_STAGE(PG8_SA(1, 0), a3, voffA);
            PG8_BAR; PG8_WAIT_L(0); PG8_MMA(1, 0, At, B0); PG8_BAR; PG8_SCHED;
            PG8_STAGE(PG8_SB(1, 1), b3 + hstep, voffB);
            PG8_WAIT_V(6); PG8_BAR; PG8_MMA(1, 1, At, B1); PG8_BAR;
            }
        }
        if constexpr (ALIGN_EPI) { if (wr == 0) PG8_BAR; }
        E(acc, cur, wr, wc, fr, fq);
        if (!has_next) break;
#pragma unroll
        for (int a = 0; a < 2; ++a)
#pragma unroll
            for (int b = 0; b < 2; ++b)
#pragma unroll
                for (int m = 0; m < 4; ++m)
#pragma unroll
                    for (int n = 0; n < 2; ++n) acc[a][b][m][n] = (f32x4){0.f, 0.f, 0.f, 0.f};
        cur = nxt; cA = nA; cB = nB; ++ui;
        if constexpr (ALIGN_EPI) { if (wr == 1) PG8_BAR; }
    }
    PG8_WAIT_V(0);
    if constexpr (!ALIGN_EPI) { if (wr == 0) PG8_BAR; }
    PG8_BAR;
#undef PG8_SA
#undef PG8_SB
#undef PG8_STAGE
#undef PG8_LDA
#undef PG8_LDB
#undef PG8_MMA
#undef PG8_WAIT_V
#undef PG8_WAIT_L
#undef PG8_BAR
#undef PG8_SCHED
}

struct EpiBf16 {
    static constexpr bool PERM = true;
    bf16* O; int ldc;
    __device__ __forceinline__ void operator()(const f32x4 (&acc)[2][2][4][2], const Unit& u, int wr, int wc, int fr, int fq) const {
        const int row0 = u.pm * BM + wr * 64 + fr, col0 = u.pn * BM + wc * 32 + 8 * fq;
#pragma unroll
        for (int ai = 0; ai < 2; ++ai)
#pragma unroll
            for (int m = 0; m < 4; ++m) { bf16* rowp = O + (size_t)(row0 + ai * HALF + m * 16) * ldc + col0; asm volatile("" ::: "memory");
#pragma unroll
                for (int bj = 0; bj < 2; ++bj) { const f32x4 v0 = acc[ai][bj][m][0], v1 = acc[ai][bj][m][1];
                    v4u w; w.x = cvt_pk_bf16(v0[0], v0[1]); w.y = cvt_pk_bf16(v0[2], v0[3]); w.z = cvt_pk_bf16(v1[0], v1[1]); w.w = cvt_pk_bf16(v1[2], v1[3]);
                    *(v4u*)(rowp + bj * HALF) = w; } }
    }
};
struct EpiSwiGlu {
    static constexpr bool PERM = true;
    bf16* O; int ldc;
    __device__ __forceinline__ void operator()(const f32x4 (&acc)[2][2][4][2], const Unit& u, int wr, int wc, int fr, int fq) const {
        const int row0 = u.pm * BM + wr * 64 + fr, col0 = u.pn * HALF + wc * 32 + 8 * fq;
#pragma unroll
        for (int ai = 0; ai < 2; ++ai)
#pragma unroll
            for (int m = 0; m < 4; ++m) { bf16* rowp = O + (size_t)(row0 + ai * HALF + m * 16) * ldc + col0; asm volatile("" ::: "memory");
                float h[8];
#pragma unroll
                for (int n = 0; n < 2; ++n)
#pragma unroll
                    for (int i = 0; i < 4; ++i) { const float a = acc[ai][0][m][n][i], b = acc[ai][1][m][n][i]; h[n * 4 + i] = a * b / (1.f + __expf(-a)); }
                v4u w; w.x = cvt_pk_bf16(h[0], h[1]); w.y = cvt_pk_bf16(h[2], h[3]); w.z = cvt_pk_bf16(h[4], h[5]); w.w = cvt_pk_bf16(h[6], h[7]);
                *(v4u*)rowp = w; }
    }
};
struct EpiRes {
    static constexpr bool PERM = false;
    float* Y; const float* xl; const float* xc; const float* mod; int goff;
    __device__ __forceinline__ void operator()(const f32x4 (&acc)[2][2][4][2], const Unit& u, int wr, int wc, int fr, int fq) const {
        const int row0 = u.pm * BM + wr * 64 + fr, col0 = u.pn * BM + wc * 32 + 4 * fq;
        const int s = u.pm < 128 ? (u.pm >> 5) : 4;
        const float* xb = u.pm < 128 ? xl : xc - (size_t)NLAT * D;
        const float* gp = mod + s * 6144 + goff + col0;
        f32x4 gv[2][2];
#pragma unroll
        for (int bj = 0; bj < 2; ++bj)
#pragma unroll
            for (int n = 0; n < 2; ++n) gv[bj][n] = *(const f32x4*)(gp + bj * HALF + n * 16);
#pragma unroll
        for (int ai = 0; ai < 2; ++ai)
#pragma unroll
            for (int m = 0; m < 4; ++m) { const size_t ro = (size_t)(row0 + ai * HALF + m * 16) * D + col0; asm volatile("" ::: "memory");
#pragma unroll
                for (int bj = 0; bj < 2; ++bj)
#pragma unroll
                    for (int n = 0; n < 2; ++n) { const f32x4 xv = *(const f32x4*)(xb + ro + bj * HALF + n * 16);
                        *(f32x4*)(Y + ro + bj * HALF + n * 16) = xv * ALPHA + gv[bj][n] * acc[ai][bj][m][n]; } }
    }
};
struct EpiGlu {
    static constexpr bool PERM = true;
    bf16* MIX; const float* ya; const float* gb;
    __device__ __forceinline__ void operator()(const f32x4 (&acc)[2][2][4][2], const Unit& u, int wr, int wc, int fr, int fq) const {
        const int row0 = u.pm * BM + wr * 64 + fr, col0 = wc * 32 + 8 * fq;
#pragma unroll
        for (int ai = 0; ai < 2; ++ai)
#pragma unroll
            for (int m = 0; m < 4; ++m) { const int row = row0 + ai * HALF + m * 16; asm volatile("" ::: "memory");
#pragma unroll
                for (int bj = 0; bj < 2; ++bj) { const int c = col0 + bj * HALF;
                    const f32x4 y0 = *(const f32x4*)(ya + (size_t)row * 256 + c), y1 = *(const f32x4*)(ya + (size_t)row * 256 + c + 4);
                    const f32x4 b0 = *(const f32x4*)(gb + c), b1 = *(const f32x4*)(gb + c + 4);
                    float o[8];
#pragma unroll
                    for (int i = 0; i < 4; ++i) { o[i] = y0[i] * sigmoidf_(acc[ai][bj][m][0][i] + b0[i]); o[4 + i] = y1[i] * sigmoidf_(acc[ai][bj][m][1][i] + b1[i]); }
                    v4u w; w.x = cvt_pk_bf16(o[0], o[1]); w.y = cvt_pk_bf16(o[2], o[3]); w.z = cvt_pk_bf16(o[4], o[5]); w.w = cvt_pk_bf16(o[6], o[7]);
                    *(v4u*)(MIX + (size_t)row * D + 256 + c) = w; } }
    }
};
struct EpiMoeDown {
    static constexpr bool PERM = true;
    bf16* O; const float* rowg;
    __device__ __forceinline__ void operator()(const f32x4 (&acc)[2][2][4][2], const Unit& u, int wr, int wc, int fr, int fq) const {
        const int row0 = u.pm * BM + wr * 64 + fr, col0 = u.pn * BM + wc * 32 + 8 * fq;
#pragma unroll
        for (int ai = 0; ai < 2; ++ai)
#pragma unroll
            for (int m = 0; m < 4; ++m) { asm volatile("" ::: "memory"); const int row = row0 + ai * HALF + m * 16; const float gte = rowg[row]; bf16* rowp = O + (size_t)row * D + col0;
#pragma unroll
                for (int bj = 0; bj < 2; ++bj) { const f32x4 v0 = acc[ai][bj][m][0] * gte, v1 = acc[ai][bj][m][1] * gte;
                    v4u w; w.x = cvt_pk_bf16(v0[0], v0[1]); w.y = cvt_pk_bf16(v0[2], v0[3]); w.z = cvt_pk_bf16(v1[0], v1[1]); w.w = cvt_pk_bf16(v1[2], v1[3]);
                    *(v4u*)(rowp + bj * HALF) = w; } }
    }
};
}

struct Args { const float* in[34]; float* out; unsigned char* ws; int ph_lo, ph_hi; };
struct Frame {
    LAS unsigned char* lds;
    int tid, lane, wave, G, bid;
};
typedef const __attribute__((address_space(4))) unsigned long long* kaptr_t;
__device__ __forceinline__ unsigned long long karg(int i) { kaptr_t ka = (kaptr_t)__builtin_amdgcn_kernarg_segment_ptr(); asm volatile("" : "+s"(ka)); return ka[i]; }
__device__ __forceinline__ const float* inp(int i) { return (const float*)karg(i); }
__device__ __forceinline__ float* outp() { return (float*)karg(34); }
__device__ __forceinline__ unsigned char* wsp() { return (unsigned char*)karg(35); }
enum { I_X = 0, I_C, I_CTX, I_CCTX, I_ADAW, I_ADAB, I_WIN, I_WOUT, I_LNG, I_LNB, I_GCONV, I_GALOG, I_GDTB, I_GNW, I_S5ARE, I_S5AIM, I_S5LS, I_S5BRE, I_S5BIM, I_S5CRE, I_S5CIM,
       I_S5D, I_S5GLUW, I_S5GLUB, I_HLB, I_HNW, I_RDEC, I_FW1, I_FW3, I_FW2, I_MROUTER, I_MW1, I_MW3, I_MW2 };

__device__ __forceinline__ void frame_refresh(Frame& F) { int ln = (int)__builtin_amdgcn_mbcnt_hi(~0u, __builtin_amdgcn_mbcnt_lo(~0u, 0u)); asm volatile("" : "+v"(ln)); F.lane = ln; F.tid = F.wave * 64 + ln; }
__device__ __forceinline__ int row_slot(int row) { return row < NLAT ? (row >> 13) : 4; }

__device__ __forceinline__ void transpose_item(const float* W, int K, int N, bf16* WT, int mode, LAS float* scr, int item, int lane) {
    const int nblk = (N + 31) / 32, kb = item / nblk, nb = item % nblk, k0 = 64 * kb, n0 = 32 * nb;
    const int nn = n0 + (lane & 31);
#pragma unroll 8
    for (int i = 0; i < 32; ++i) { const int kk = 2 * i + (lane >> 5); scr[kk * 33 + (lane & 31)] = (nn < N) ? W[(size_t)(k0 + kk) * N + nn] : 0.f; }
    LDS_WAIT(); asm volatile("" ::: "memory");
    const int c = lane & 7;
#pragma unroll
    for (int j = 0; j < 4; ++j) { const int nl = (lane >> 3) + 8 * j; const int n = n0 + nl; const LAS float* s = scr + (8 * c) * 33 + nl;
        v4u o; o.x = pk2(s[0 * 33], s[1 * 33]); o.y = pk2(s[2 * 33], s[3 * 33]); o.z = pk2(s[4 * 33], s[5 * 33]); o.w = pk2(s[6 * 33], s[7 * 33]);
        const int nr = mode == 0 ? n : ((n >> 7) * 256 + (n & 127) + (mode == 2 ? 128 : 0));
        if (n < N) *(v4u*)(WT + (size_t)nr * K + k0 + 8 * c) = o; }
    LDS_WAIT(); asm volatile("" ::: "memory");
}

__device__ __forceinline__ void phase_prologue(Frame& F) {
    frame_refresh(F); unsigned char* const ws = wsp();
    LAS float* scv = (LAS float*)F.lds;
    LAS float* part = (LAS float*)(F.lds + 20480);
    for (int i = F.tid; i < 5 * 1024; i += 512) { const int s = i >> 10, k = i & 1023; const float c = s < 4 ? inp(I_C)[s * 1024 + k] : inp(I_CCTX)[k]; scv[i] = siluf_(c); }
    __syncthreads();
    float* MOD = (float*)(ws + WS_MOD);
    for (int it = F.bid; it < 4 * 96; it += F.G) {
        const int l = it / 96, n0 = (it % 96) * 64;
        const float* w = inp(I_ADAW) + (size_t)l * 1024 * 6144 + n0 + F.lane;
        float a0 = 0.f, a1 = 0.f, a2 = 0.f, a3 = 0.f, a4 = 0.f;
        const int kb = F.wave * 128;
#pragma unroll 8
        for (int k = 0; k < 128; ++k) { const float wv = w[(size_t)(kb + k) * 6144];
            a0 += scv[kb + k] * wv; a1 += scv[1024 + kb + k] * wv; a2 += scv[2048 + kb + k] * wv; a3 += scv[3072 + kb + k] * wv; a4 += scv[4096 + kb + k] * wv; }
        part[(F.wave * 5 + 0) * 64 + F.lane] = a0; part[(F.wave * 5 + 1) * 64 + F.lane] = a1; part[(F.wave * 5 + 2) * 64 + F.lane] = a2; part[(F.wave * 5 + 3) * 64 + F.lane] = a3; part[(F.wave * 5 + 4) * 64 + F.lane] = a4;
        __syncthreads();
        if (F.tid < 320) { const int s = F.tid >> 6, n = F.tid & 63; float v = inp(I_ADAB)[l * 6144 + n0 + n];
#pragma unroll
            for (int w8 = 0; w8 < 8; ++w8) v += part[(w8 * 5 + s) * 64 + n];
            MOD[(size_t)(l * 5 + s) * 6144 + n0 + n] = v; }
        __syncthreads();
    }
    const int gt = F.bid * 512 + F.tid, NT = F.G * 512;
    float* LB = (float*)(ws + WS_LB);
    for (int i = gt; i < 256; i += NT) {
        float v[4], mx = -1e30f; for (int l = 0; l < 4; ++l) { v[l] = inp(I_HLB)[l * 256 + i]; mx = fmaxf(mx, v[l]); }
        float s = 0.f; for (int l = 0; l < 4; ++l) { v[l] = expf(v[l] - mx); s += v[l]; }
        float cum = 0.f, first = 0.f; for (int l = 0; l < 4; ++l) { cum += v[l] / s; if (l == 0) first = cum; LB[l * 256 + i] = cum - first; }
    }
    float* ROT = (float*)(ws + WS_ROT);
    for (int i = gt; i < 192 * 16; i += NT) { const int pos = i >> 4, q = i & 15; const float p = (float)(pos < 128 ? pos : pos - 128);
        const float invf = expf(-(float)q * (9.210340371976184f / 16.f)); const float ang = p * invf; ROT[i * 2] = cosf(ang); ROT[i * 2 + 1] = sinf(ang); }
    float* LAM = (float*)(ws + WS_S5LAM); float* BB = (float*)(ws + WS_S5B);
    for (int i = gt; i < 4 * 2 * 16 * 64; i += NT) {
        const int ldg = i >> 6;
        const float are = inp(I_S5ARE)[i], aim = inp(I_S5AIM)[i], st = expf(inp(I_S5LS)[ldg]);
        const float x = are * st, y = aim * st, ex = expf(x), cy = cosf(y), sy = sinf(y), sh = sinf(0.5f * y);
        LAM[i * 2] = ex * cy; LAM[i * 2 + 1] = ex * sy;
        const float er = expm1f(x) * cy - 2.f * sh * sh, ei = ex * sy;
        const float den = are * are + aim * aim; const float qr = (er * are + ei * aim) / den, qi = (ei * are - er * aim) / den;
        for (int c = 0; c < 16; ++c) { const float br = inp(I_S5BRE)[(size_t)i * 16 + c], bi = inp(I_S5BIM)[(size_t)i * 16 + c];
            BB[((size_t)i * 16 + c) * 2] = qr * br - qi * bi; BB[((size_t)i * 16 + c) * 2 + 1] = qr * bi + qi * br; }
    }
    LAS float* scr = (LAS float*)(F.lds + 32768 + F.wave * 8704);
    __syncthreads();
    const int gw = F.bid * 8 + F.wave, NGW = F.G * 8;
    constexpr int I_IN = 16 * 113, I_OUT = 16 * 32, I_GLU = 4 * 8, I_F1 = 16 * 88, I_F2 = 44 * 32;
    constexpr int PER_L = I_IN + I_OUT + I_GLU, TOT = 4 * PER_L + 2 * (2 * I_F1 + I_F2);
    for (int it = gw; it < TOT; it += NGW) {
        int r = it;
        if (r < 4 * PER_L) { const int l = r / PER_L; r -= l * PER_L;
            if (r < I_IN) { transpose_item(inp(I_WIN) + (size_t)l * D * DPROJ, D, DPROJ, (bf16*)(ws + WS_WIN) + (size_t)l * DPP * D, 0, scr, r, F.lane); continue; } r -= I_IN;
            if (r < I_OUT) { transpose_item(inp(I_WOUT) + (size_t)l * D * D, D, D, (bf16*)(ws + WS_WOUT) + (size_t)l * D * D, 0, scr, r, F.lane); continue; } r -= I_OUT;
            transpose_item(inp(I_S5GLUW) + (size_t)l * 65536, 256, 256, (bf16*)(ws + WS_WGLU) + (size_t)l * 65536, 0, scr, r, F.lane); continue; }
        r -= 4 * PER_L;
        const int j = r / (2 * I_F1 + I_F2); r -= j * (2 * I_F1 + I_F2);
        if (r < I_F1) { transpose_item(inp(I_FW1) + (size_t)j * D * FFD, D, FFD, (bf16*)(ws + WS_WF13) + (size_t)j * 2 * FFD * D, 1, scr, r, F.lane); continue; } r -= I_F1;
        if (r < I_F1) { transpose_item(inp(I_FW3) + (size_t)j * D * FFD, D, FFD, (bf16*)(ws + WS_WF13) + (size_t)j * 2 * FFD * D, 2, scr, r, F.lane); continue; } r -= I_F1;
        transpose_item(inp(I_FW2) + (size_t)j * FFD * D, FFD, D, (bf16*)(ws + WS_WF2) + (size_t)j * D * FFD, 0, scr, r, F.lane);
    }
}
__device__ __forceinline__ void phase_moe_convert(Frame& F, int j) {
    frame_refresh(F); unsigned char* const ws = wsp();
    LAS float* scr = (LAS float*)(F.lds + F.wave * 8704);
    const int gw = F.bid * 8 + F.wave, NGW = F.G * 8;
    constexpr int I_1 = 16 * 112, I_2 = 56 * 32, PER_E = 2 * I_1 + I_2;
    for (int it = gw; it < 8 * PER_E; it += NGW) {
        const int e = it / PER_E; int r = it - e * PER_E;
        const size_t wo = ((size_t)j * 8 + e) * D * FFE;
        if (r < I_1) { transpose_item(inp(I_MW1) + wo, D, FFE, (bf16*)(ws + WS_WM13) + (size_t)e * 2 * FFE * D, 1, scr, r, F.lane); continue; } r -= I_1;
        if (r < I_1) { transpose_item(inp(I_MW3) + wo, D, FFE, (bf16*)(ws + WS_WM13) + (size_t)e * 2 * FFE * D, 2, scr, r, F.lane); continue; } r -= I_1;
        transpose_item(inp(I_MW2) + wo, FFE, D, (bf16*)(ws + WS_WM2) + (size_t)e * D * FFE, 0, scr, r, F.lane);
    }
}

__device__ __forceinline__ const float* xrow_src(const float* xl, const float* xc, int row) { return row < NLAT ? xl + (size_t)row * D : xc + (size_t)(row - NLAT) * D; }
__device__ __forceinline__ float* xrow_dst(float* xl, float* xc, int row) { return row < NLAT ? xl + (size_t)row * D : xc + (size_t)(row - NLAT) * D; }

__device__ __forceinline__ void store_A_row(bf16* Ab, int lane_, int row, const f32x4 (&v)[4], const float* modrow, int shoff, int scoff) {
    bf16* ar = Ab + (size_t)row * D;
#pragma unroll
    for (int j = 0; j < 4; ++j) { const int c = 4 * lane_ + 256 * j; const f32x4 sh = *(const f32x4*)(modrow + shoff + c), sc = *(const f32x4*)(modrow + scoff + c);
        const f32x4 h = v[j] * (sc + 1.f) + sh; v2u w; w.x = pk2(h[0], h[1]); w.y = pk2(h[2], h[3]); *(v2u*)(ar + c) = w; }
}
__device__ __forceinline__ void ln_row(f32x4 (&v)[4], const float* g, const float* b, int lane) {
    float s = 0.f;
#pragma unroll
    for (int j = 0; j < 4; ++j) s += (v[j][0] + v[j][1]) + (v[j][2] + v[j][3]);
    const float mean = wave_sum(s) * (1.f / D); float s2 = 0.f;
#pragma unroll
    for (int j = 0; j < 4; ++j) { v[j] = v[j] - mean; s2 += (v[j][0] * v[j][0] + v[j][1] * v[j][1]) + (v[j][2] * v[j][2] + v[j][3] * v[j][3]); }
    const float rstd = 1.f / sqrtf(wave_sum(s2) * (1.f / D) + LN_EPS);
#pragma unroll
    for (int j = 0; j < 4; ++j) { const int c = 4 * lane + 256 * j; const f32x4 gg = *(const f32x4*)(g + c), bb = *(const f32x4*)(b + c); v[j] = v[j] * rstd * gg + bb; }
}

__device__ __forceinline__ void phase_a0(Frame& F) {
    frame_refresh(F); unsigned char* const ws = wsp();
    const float* MOD = (const float*)(ws + WS_MOD);
    const int gw = F.bid * 8 + F.wave, NGW = F.G * 8;
    const float* xl = inp(I_X); const float* xc = inp(I_CTX); bf16* Ab = (bf16*)(ws + WS_A);
    for (int row = gw; row < R; row += NGW) {
        const float* xr = xrow_src(xl, xc, row); f32x4 v[4];
#pragma unroll
        for (int j = 0; j < 4; ++j) v[j] = *(const f32x4*)(xr + 4 * F.lane + 256 * j);
        store_A_row(Ab, F.lane, row, v, MOD + (size_t)(0 * 5 + row_slot(row)) * 6144, 0, 1024);
    }
}

__device__ __forceinline__ void phase_gdn_prep(Frame& F, int l) {
    frame_refresh(F); unsigned char* const ws = wsp();
    const bf16* P = (const bf16*)(ws + WS_P);
    bf16* GQ = (bf16*)(ws + WS_GQ); bf16* GK = (bf16*)(ws + WS_GK); bf16* GV = (bf16*)(ws + WS_GV);
    float* GSC = (float*)(ws + WS_GSC);
    const float* cw = inp(I_GCONV) + (size_t)l * 3 * 768;
    const int gw = F.bid * 8 + F.wave, NGW = F.G * 8, lane = F.lane;
    f32x4 w[3][3];
#pragma unroll
    for (int kk = 0; kk < 3; ++kk)
#pragma unroll
        for (int j = 0; j < 3; ++j) w[kk][j] = *(const f32x4*)(cw + kk * 768 + j * 256 + 4 * lane);
    float galog = 0.f, gdtb = 0.f;
    if (lane < 8) { galog = -__expf(inp(I_GALOG)[l * 8 + lane]); gdtb = inp(I_GDTB)[l * 8 + lane]; }
    for (int row = gw; row < R; row += NGW) {
        int t, L; if (row < NLAT) { t = row & (SEQ - 1); L = SEQ; } else { t = (row - NLAT) & (CTXL - 1); L = CTXL; }
        const bf16* pr = P + (size_t)row * DPP;
        f32x4 c[3];
#pragma unroll
        for (int j = 0; j < 3; ++j) {
            const v2u x1 = *(const v2u*)(pr + j * 256 + 4 * lane);
            v2u x0 = (v2u){0u, 0u}, x2 = (v2u){0u, 0u};
            if (t > 0) x0 = *(const v2u*)(pr - DPP + j * 256 + 4 * lane);
            if (t < L - 1) x2 = *(const v2u*)(pr + DPP + j * 256 + 4 * lane);
            f32x4 a;
            a[0] = w[0][j][0] * bflo(x0.x) + w[1][j][0] * bflo(x1.x) + w[2][j][0] * bflo(x2.x);
            a[1] = w[0][j][1] * bfhi(x0.x) + w[1][j][1] * bfhi(x1.x) + w[2][j][1] * bfhi(x2.x);
            a[2] = w[0][j][2] * bflo(x0.y) + w[1][j][2] * bflo(x1.y) + w[2][j][2] * bflo(x2.y);
            a[3] = w[0][j][3] * bfhi(x0.y) + w[1][j][3] * bfhi(x1.y) + w[2][j][3] * bfhi(x2.y);
#pragma unroll
            for (int i = 0; i < 4; ++i) a[i] = siluf_(a[i]);
            c[j] = a;
        }
        const float sq = sum16(c[0][0] * c[0][0] + c[0][1] * c[0][1] + c[0][2] * c[0][2] + c[0][3] * c[0][3]);
        const float sk = sum16(c[1][0] * c[1][0] + c[1][1] * c[1][1] + c[1][2] * c[1][2] + c[1][3] * c[1][3]);
        const float rq = 0.125f / sqrtf(sq + RMS_EPS), rk = 1.f / sqrtf(sk + RMS_EPS);
        v2u o;
        o.x = pk2(c[0][0] * rq, c[0][1] * rq); o.y = pk2(c[0][2] * rq, c[0][3] * rq); *(v2u*)(GQ + (size_t)row * 256 + 4 * lane) = o;
        o.x = pk2(c[1][0] * rk, c[1][1] * rk); o.y = pk2(c[1][2] * rk, c[1][3] * rk); *(v2u*)(GK + (size_t)row * 256 + 4 * lane) = o;
        o.x = pk2(c[2][0], c[2][1]); o.y = pk2(c[2][2], c[2][3]); *(v2u*)(GV + (size_t)row * 256 + 4 * lane) = o;
        if (lane < 16) {
            const float a = bf2f(pr[PC_GA + lane]);
            float val;
            if (lane < 8) { const float z = a + gdtb; const float e = __expf(z); const float sp = z > 20.f ? z : (e < 0.01f ? e * (1.f - e * (0.5f - e * 0.33333333f)) : __logf(1.f + e)); val = galog * sp; }
            else val = sigmoidf_(a);
            GSC[(size_t)row * 16 + lane] = val;
        }
    }
}

__device__ __forceinline__ void chunk_rows(int b, int dir, int c, int& r0, int& step, int& t0) {
    const int s0 = c * TCH;
    if (s0 < CTXL) { t0 = -1; if (dir == 0) { r0 = NLAT + b * CTXL + s0; step = 1; } else { r0 = NLAT + b * CTXL + (CTXL - 1 - s0); step = -1; } }
    else { const int u = s0 - CTXL; if (dir == 0) { r0 = b * SEQ + u; step = 1; t0 = u; } else { r0 = b * SEQ + (SEQ - 1 - u); step = -1; t0 = SEQ - 1 - u; } }
}
struct MatStage { v4u q[4], k[4], k2[4], q2[4], v; float sc0, sc1; };

template <int MODE>
__device__ __forceinline__ void scan_mat(Frame& F, int l, int sub, LAS unsigned char* lds) {
    unsigned char* const ws = wsp();
    const int lane = F.lane, j = lane & 15, rg = lane >> 4;
    const int cg = sub & 3, dir = (sub >> 2) & 1, h = (sub >> 3) & 3, b = sub >> 5;
    const bf16* P = (const bf16*)(ws + WS_P);
    const bf16* GQ = (const bf16*)(ws + WS_GQ); const bf16* GK = (const bf16*)(ws + WS_GK); const bf16* GV = (const bf16*)(ws + WS_GV);
    const float* GSC = (const float*)(ws + WS_GSC);
    const float* ROT = (const float*)(ws + WS_ROT);
    float* O = (float*)(ws + WS_O) + (size_t)(MODE * 2 + dir) * R * 256;
    constexpr int BUFB = 8192 + 8192 + 2048 + 256;
    LAS float* OS = (LAS float*)(lds + 2 * BUFB);
    float S[16];
#pragma unroll
    for (int i = 0; i < 16; ++i) S[i] = 0.f;
    float gam = 0.f;
    if (MODE == 2) gam = __expf(-__expf(inp(I_RDEC)[l * 8 + dir * 4 + h]));
    const int c8 = lane & 7;
    float lb[8];
#pragma unroll
    for (int i = 0; i < 8; ++i) lb[i] = (MODE == 1) ? ((const float*)(ws + WS_LB))[l * 256 + h * 64 + c8 * 8 + i] : 0.f;

    MatStage st;
    auto load = [&](int c) {
        int r0, step, t0; chunk_rows(b, dir, c, r0, step, t0);
#pragma unroll
        for (int i = 0; i < 4; ++i) { const int idx = i * 64 + lane, tt = idx >> 3; const int row = r0 + step * tt;
            if (MODE == 0) { st.q[i] = *(const v4u*)(GQ + (size_t)row * 256 + h * 64 + c8 * 8); st.k[i] = *(const v4u*)(GK + (size_t)row * 256 + h * 64 + c8 * 8); }
            if (MODE == 1) { st.q[i] = *(const v4u*)(P + (size_t)row * DPP + PC_HQ + h * 64 + c8 * 8); st.k[i] = *(const v4u*)(P + (size_t)row * DPP + PC_HF + dir * 256 + h * 64 + c8 * 8); }
            if (MODE == 2) { st.q[i] = *(const v4u*)(P + (size_t)row * DPP + PC_RQKV + h * 64 + c8 * 8); st.k[i] = *(const v4u*)(P + (size_t)row * DPP + PC_RQKV + 256 + h * 64 + c8 * 8);
                             st.q2[i] = *(const v4u*)(P + (size_t)row * DPP + PC_RQKV + h * 64 + (c8 ^ 4) * 8); st.k2[i] = *(const v4u*)(P + (size_t)row * DPP + PC_RQKV + 256 + h * 64 + (c8 ^ 4) * 8); } }
        { const int tt = lane >> 1, half = lane & 1; const int row = r0 + step * tt;
            if (MODE == 0) st.v = *(const v4u*)(GV + (size_t)row * 256 + h * 64 + cg * 16 + half * 8);
            if (MODE == 1) st.v = *(const v4u*)(P + (size_t)row * DPP + PC_HI + h * 64 + cg * 16 + half * 8);
            if (MODE == 2) st.v = *(const v4u*)(P + (size_t)row * DPP + PC_RQKV + 512 + h * 64 + cg * 16 + half * 8); }
        st.sc0 = 0.f; st.sc1 = 0.f;
        if (MODE == 0 && lane < TCH) { const int row = r0 + step * lane; st.sc0 = GSC[(size_t)row * 16 + dir * 4 + h]; st.sc1 = GSC[(size_t)row * 16 + 8 + dir * 4 + h]; }
    };
    auto stage = [&](int c, int buf) {
        LAS float* Qs = (LAS float*)(lds + buf * BUFB); LAS float* Ks = Qs + 2048; LAS float* Vs = Ks + 2048; LAS float* SC = Vs + 512;
        int r0, step, t0; chunk_rows(b, dir, c, r0, step, t0);
#pragma unroll
        for (int i = 0; i < 4; ++i) { const int idx = i * 64 + lane, tt = idx >> 3;
            float q[8], k[8];
            const unsigned qw[4] = {st.q[i].x, st.q[i].y, st.q[i].z, st.q[i].w}, kw[4] = {st.k[i].x, st.k[i].y, st.k[i].z, st.k[i].w};
#pragma unroll
            for (int e = 0; e < 4; ++e) { q[2 * e] = bflo(qw[e]); q[2 * e + 1] = bfhi(qw[e]); k[2 * e] = bflo(kw[e]); k[2 * e + 1] = bfhi(kw[e]); }
            if (MODE == 1) {
#pragma unroll
                for (int e = 0; e < 8; ++e) { q[e] = siluf_(q[e]); k[e] = lb[e] + (1.f - lb[e]) * sigmoidf_(k[e]); }
            }
            if (MODE == 2) {
                if (t0 >= 0) {
                    const int t = t0 + step * tt;
                    const unsigned q2w[4] = {st.q2[i].x, st.q2[i].y, st.q2[i].z, st.q2[i].w}, k2w[4] = {st.k2[i].x, st.k2[i].y, st.k2[i].z, st.k2[i].w};
                    const int ci = c8 & 3;
                    const float* tab = ROT + (size_t)((ci < 2 ? (t >> 6) : 128 + (t & 63)) * 16 + (ci & 1) * 8) * 2;
                    const float sgn = (c8 < 4) ? -1.f : 1.f;
#pragma unroll
                    for (int e = 0; e < 8; ++e) { const float cs = tab[2 * e], sn = tab[2 * e + 1] * sgn;
                        const float qo = (e & 1) ? bfhi(q2w[e >> 1]) : bflo(q2w[e >> 1]), ko = (e & 1) ? bfhi(k2w[e >> 1]) : bflo(k2w[e >> 1]);
                        q[e] = q[e] * cs + qo * sn; k[e] = k[e] * cs + ko * sn; }
                }
#pragma unroll
                for (int e = 0; e < 8; ++e) k[e] *= 0.125f;
            }
            *(LAS f32x4*)(Qs + tt * 64 + c8 * 8) = (f32x4){q[0], q[1], q[2], q[3]}; *(LAS f32x4*)(Qs + tt * 64 + c8 * 8 + 4) = (f32x4){q[4], q[5], q[6], q[7]};
            *(LAS f32x4*)(Ks + tt * 64 + c8 * 8) = (f32x4){k[0], k[1], k[2], k[3]}; *(LAS f32x4*)(Ks + tt * 64 + c8 * 8 + 4) = (f32x4){k[4], k[5], k[6], k[7]};
        }
        { const int tt = lane >> 1, half = lane & 1; const unsigned vw[4] = {st.v.x, st.v.y, st.v.z, st.v.w};
            *(LAS f32x4*)(Vs + tt * 16 + half * 8) = (f32x4){bflo(vw[0]), bfhi(vw[0]), bflo(vw[1]), bfhi(vw[1])};
            *(LAS f32x4*)(Vs + tt * 16 + half * 8 + 4) = (f32x4){bflo(vw[2]), bfhi(vw[2]), bflo(vw[3]), bfhi(vw[3])}; }
        if (MODE == 0 && lane < TCH) { SC[lane * 2] = __expf(st.sc0); SC[lane * 2 + 1] = st.sc1; }
    };
    load(0); stage(0, 0);
    for (int c = 0; c < NCHUNK; ++c) {
        const int buf = c & 1;
        if (c + 1 < NCHUNK) load(c + 1);
        LAS float* Qs = (LAS float*)(lds + buf * BUFB); LAS float* Ks = Qs + 2048; LAS float* Vs = Ks + 2048; LAS float* SC = Vs + 512;
        LDS_WAIT();
        for (int tt = 0; tt < TCH; ++tt) {
            f32x4 qv[4], kv[4];
#pragma unroll
            for (int i = 0; i < 4; ++i) { qv[i] = *(const LAS f32x4*)(Qs + tt * 64 + rg * 16 + 4 * i); kv[i] = *(const LAS f32x4*)(Ks + tt * 64 + rg * 16 + 4 * i); }
            const float vj = Vs[tt * 16 + j];
            float o = 0.f;
            if (MODE == 0) {
                const float eg = SC[tt * 2], beta = SC[tt * 2 + 1];
                float ks = 0.f;
#pragma unroll
                for (int i = 0; i < 16; ++i) ks += kv[i >> 2][i & 3] * S[i];
                ks += __shfl_xor(ks, 16); ks += __shfl_xor(ks, 32);
                const float d = beta * (vj - eg * ks);
#pragma unroll
                for (int i = 0; i < 16; ++i) { S[i] = eg * S[i] + kv[i >> 2][i & 3] * d; o += qv[i >> 2][i & 3] * S[i]; }
            } else if (MODE == 1) {
#pragma unroll
                for (int i = 0; i < 16; ++i) { const float f = kv[i >> 2][i & 3]; S[i] = f * S[i] + (1.f - f) * vj; o += qv[i >> 2][i & 3] * S[i]; }
            } else {
#pragma unroll
                for (int i = 0; i < 16; ++i) { S[i] = gam * S[i] + kv[i >> 2][i & 3] * vj; o += qv[i >> 2][i & 3] * S[i]; }
            }
            o += __shfl_xor(o, 16); o += __shfl_xor(o, 32);
            if (rg == 0) OS[tt * 16 + j] = o;
        }
        LDS_WAIT();
        { int r0, step, t0; chunk_rows(b, dir, c, r0, step, t0); const int tt = lane >> 1, half = lane & 1; const int row = r0 + step * tt;
            float* op = O + (size_t)row * 256 + h * 64 + cg * 16 + half * 8;
            *(f32x4*)op = *(const LAS f32x4*)(OS + tt * 16 + half * 8); *(f32x4*)(op + 4) = *(const LAS f32x4*)(OS + tt * 16 + half * 8 + 4); }
        if (c + 1 < NCHUNK) stage(c + 1, buf ^ 1);
    }
}

__device__ __forceinline__ void scan_s5(Frame& F, int l, int sub, LAS unsigned char* lds) {
    unsigned char* const ws = wsp();
    const int lane = F.lane, g = sub & 15, dir = (sub >> 4) & 1, b = sub >> 5;
    const bf16* P = (const bf16*)(ws + WS_P);
    float* O = (float*)(ws + WS_O) + (size_t)(3 * 2 + dir) * R * 256;
    const int ldg = (l * 2 + dir) * 16 + g;
    const float* LAM = (const float*)(ws + WS_S5LAM) + (size_t)(ldg * 64 + lane) * 2;
    const float* BB = (const float*)(ws + WS_S5B) + (size_t)(ldg * 64 + lane) * 32;
    const float lr = LAM[0], li = LAM[1];
    float br[16], bi[16];
#pragma unroll
    for (int c = 0; c < 16; ++c) { br[c] = BB[2 * c]; bi[c] = BB[2 * c + 1]; }
    LAS float* US = (LAS float*)lds; LAS float* HS = US + 1024; LAS float* CS = HS + 32 * 130; LAS float* YS = CS + 2048;
    { const float* cre = inp(I_S5CRE) + (size_t)ldg * 16 * 64; const float* cim = inp(I_S5CIM) + (size_t)ldg * 16 * 64;
        for (int i = lane; i < 1024; i += 64) { CS[i * 2] = cre[i]; CS[i * 2 + 1] = cim[i]; } }
    float hr = 0.f, hi = 0.f;
    v4u ust;
    auto load = [&](int c) { int r0, step, t0; chunk_rows(b, dir, c, r0, step, t0); const int tt = lane >> 1, half = lane & 1; const int row = r0 + step * tt;
        ust = *(const v4u*)(P + (size_t)row * DPP + PC_S5U + g * 16 + half * 8); };
    auto stage = [&](int buf) { const int tt = lane >> 1, half = lane & 1; LAS float* u = US + buf * 512 + tt * 16 + half * 8; const unsigned w[4] = {ust.x, ust.y, ust.z, ust.w};
        *(LAS f32x4*)u = (f32x4){bflo(w[0]), bfhi(w[0]), bflo(w[1]), bfhi(w[1])}; *(LAS f32x4*)(u + 4) = (f32x4){bflo(w[2]), bfhi(w[2]), bflo(w[3]), bfhi(w[3])}; };
    load(0); stage(0);
    for (int c = 0; c < NCHUNK; ++c) {
        const int buf = c & 1;
        if (c + 1 < NCHUNK) load(c + 1);
        LDS_WAIT();
        const LAS float* U = US + buf * 512;
        for (int tt = 0; tt < TCH; ++tt) {
            f32x4 u[4];
#pragma unroll
            for (int i = 0; i < 4; ++i) u[i] = *(const LAS f32x4*)(U + tt * 16 + 4 * i);
            float ar = 0.f, ai = 0.f;
#pragma unroll
            for (int cc = 0; cc < 16; ++cc) { ar += br[cc] * u[cc >> 2][cc & 3]; ai += bi[cc] * u[cc >> 2][cc & 3]; }
            const float nr = lr * hr - li * hi + ar, ni = lr * hi + li * hr + ai;
            hr = nr; hi = ni;
            *(LAS f32x2*)(HS + tt * 130 + lane * 2) = (f32x2){hr, hi};
        }
        LDS_WAIT();
        { const int cc = lane & 15, tq = lane >> 4;
            float acc[8];
#pragma unroll
            for (int k = 0; k < 8; ++k) acc[k] = 0.f;
            for (int p = 0; p < 64; ++p) {
                const f32x2 cv = *(const LAS f32x2*)(CS + (cc * 64 + p) * 2);
#pragma unroll
                for (int k = 0; k < 8; ++k) { const f32x2 hv = *(const LAS f32x2*)(HS + (tq * 8 + k) * 130 + p * 2); acc[k] += cv[0] * hv[0] - cv[1] * hv[1]; }
            }
#pragma unroll
            for (int k = 0; k < 8; ++k) YS[(tq * 8 + k) * 16 + cc] = acc[k];
        }
        LDS_WAIT();
        { int r0, step, t0; chunk_rows(b, dir, c, r0, step, t0); const int tt = lane >> 1, half = lane & 1; const int row = r0 + step * tt;
            float* op = O + (size_t)row * 256 + g * 16 + half * 8;
            *(f32x4*)op = *(const LAS f32x4*)(YS + tt * 16 + half * 8); *(f32x4*)(op + 4) = *(const LAS f32x4*)(YS + tt * 16 + half * 8 + 4); }
        if (c + 1 < NCHUNK) stage(buf ^ 1);
    }
}
__device__ __forceinline__ void phase_scans(Frame& F, int l) {
    frame_refresh(F); unsigned char* const ws = wsp();
    if (F.wave < 2) {
        LAS unsigned char* lds = F.lds + F.wave * 65536;
        for (int it = F.wave * F.G + F.bid; it < 512; it += 2 * F.G) {
            const int kind = it >> 7, sub = it & 127;
            if (kind == 0) scan_mat<0>(F, l, sub, lds);
            else if (kind == 1) scan_s5(F, l, sub, lds);
            else if (kind == 2) scan_mat<1>(F, l, sub, lds);
            else scan_mat<2>(F, l, sub, lds);
        }
    }
}

__device__ __forceinline__ void phase_readout(Frame& F, int l) {
    frame_refresh(F); unsigned char* const ws = wsp();
    const bf16* P = (const bf16*)(ws + WS_P);
    bf16* MIX = (bf16*)(ws + WS_MIX); bf16* YA = (bf16*)(ws + WS_GQ);
    float* O = (float*)(ws + WS_O);
    const int gw = F.bid * 8 + F.wave, NGW = F.G * 8, lane = F.lane;
    const int dch = (4 * lane) & 63;
    const f32x4 gnw = *(const f32x4*)(inp(I_GNW) + l * 64 + dch), hnw = *(const f32x4*)(inp(I_HNW) + l * 64 + dch);
    const f32x4 dsk = *(const f32x4*)(inp(I_S5D) + l * 256 + 4 * lane);
    const size_t OB = (size_t)R * 256;
    for (int row = gw; row < R; row += NGW) {
        const bf16* pr = P + (size_t)row * DPP;
        const size_t ro = (size_t)row * 256 + 4 * lane;
#pragma unroll
        for (int m = 0; m < 3; ++m) {
            const f32x4 o = *(const f32x4*)(O + (size_t)(m * 2) * OB + ro) + *(const f32x4*)(O + (size_t)(m * 2 + 1) * OB + ro);
            const float ss = sum16(o[0] * o[0] + o[1] * o[1] + o[2] * o[2] + o[3] * o[3]);
            const float r = 1.f / sqrtf(ss * (1.f / 64.f) + RMS_EPS);
            const int gc = (m == 0 ? PC_GZ : (m == 1 ? PC_HG : PC_RG)) + 4 * lane;
            const v2u gw2 = *(const v2u*)(pr + gc);
            const float gt[4] = {bflo(gw2.x), bfhi(gw2.x), bflo(gw2.y), bfhi(gw2.y)};
            float y[4];
#pragma unroll
            for (int i = 0; i < 4; ++i) { const float nw = m == 0 ? gnw[i] : (m == 1 ? hnw[i] : 1.f); y[i] = o[i] * r * nw * siluf_(gt[i]); }
            v2u w; w.x = pk2(y[0], y[1]); w.y = pk2(y[2], y[3]);
            *(v2u*)(MIX + (size_t)row * D + (m == 0 ? 0 : (m == 1 ? 512 : 768)) + 4 * lane) = w;
        }
        { const f32x4 o = *(const f32x4*)(O + (size_t)6 * OB + ro) + *(const f32x4*)(O + (size_t)7 * OB + ro);
            const v2u uw = *(const v2u*)(pr + PC_S5U + 4 * lane);
            const float u[4] = {bflo(uw.x), bfhi(uw.x), bflo(uw.y), bfhi(uw.y)};
            f32x4 ya;
#pragma unroll
            for (int i = 0; i < 4; ++i) ya[i] = gelu_tanh(o[i] + dsk[i] * u[i]);
            *(f32x4*)(O + (size_t)6 * OB + ro) = ya;
            v2u w; w.x = pk2(ya[0], ya[1]); w.y = pk2(ya[2], ya[3]); *(v2u*)(YA + ro) = w; }
    }
}

template <bool ROUTE>
__device__ __forceinline__ void phase_ln(Frame& F, int l, int which) {
    frame_refresh(F); unsigned char* const ws = wsp();
    const float* Y = (const float*)(ws + WS_Y);
    const float* MOD = (const float*)(ws + WS_MOD);
    const float* lg = inp(I_LNG) + (size_t)(l * 2 + which) * D; const float* lb = inp(I_LNB) + (size_t)(l * 2 + which) * D;
    const bool last = (l == DEPTH - 1 && which == 1);
    const int nl = which == 0 ? l : l + 1, shoff = which == 0 ? 3072 : 0, scoff = which == 0 ? 4096 : 1024;
    const int lane = F.lane;
    float* xl = outp(); float* xc = (float*)(ws + WS_XC); bf16* Ab = (bf16*)(ws + WS_A);
    if constexpr (!ROUTE) {
        const int gw = F.bid * 8 + F.wave, NGW = F.G * 8;
        const int nrows = last ? NLAT : R;
        for (int row = gw; row < nrows; row += NGW) {
            f32x4 v[4];
#pragma unroll
            for (int j = 0; j < 4; ++j) v[j] = *(const f32x4*)(Y + (size_t)row * D + 4 * lane + 256 * j);
            ln_row(v, lg, lb, lane);
            float* xd = xrow_dst(xl, xc, row);
#pragma unroll
            for (int j = 0; j < 4; ++j) *(f32x4*)(xd + 4 * lane + 256 * j) = v[j];
            if (!last) store_A_row(Ab, lane, row, v, MOD + (size_t)(nl * 5 + row_slot(row)) * 6144, shoff, scoff);
        }
    } else {
        LAS int* cnt = (LAS int*)F.lds;
        if (F.tid < 8) cnt[F.tid] = 0;
        __syncthreads();
        const float* rw = inp(I_MROUTER) + (size_t)(l >> 1) * D * NEXP;
        f32x4 rwa[4][4][2];
#pragma unroll
        for (int j = 0; j < 4; ++j)
#pragma unroll
            for (int i = 0; i < 4; ++i) { const float* p = rw + (size_t)(4 * lane + 256 * j + i) * 8; rwa[j][i][0] = *(const f32x4*)p; rwa[j][i][1] = *(const f32x4*)(p + 4); }
        int* TOPE = (int*)(ws + WS_TOPE); float* TOPG = (float*)(ws + WS_TOPG);
        const int RPW = (R + F.G - 1) / F.G, rbeg = F.bid * RPW, rend = min(R, rbeg + RPW);
        for (int row = rbeg + F.wave; row < rend; row += 8) {
            f32x4 v[4];
#pragma unroll
            for (int j = 0; j < 4; ++j) v[j] = *(const f32x4*)(Y + (size_t)row * D + 4 * lane + 256 * j);
            ln_row(v, lg, lb, lane);
            float* xd = xrow_dst(xl, xc, row);
#pragma unroll
            for (int j = 0; j < 4; ++j) *(f32x4*)(xd + 4 * lane + 256 * j) = v[j];
            const float* modrow = MOD + (size_t)(nl * 5 + row_slot(row)) * 6144;
            store_A_row(Ab, lane, row, v, modrow, shoff, scoff);
            float lgt[8];
#pragma unroll
            for (int e = 0; e < 8; ++e) lgt[e] = 0.f;
#pragma unroll
            for (int j = 0; j < 4; ++j) { const int c = 4 * lane + 256 * j; const f32x4 sh = *(const f32x4*)(modrow + shoff + c), sc = *(const f32x4*)(modrow + scoff + c);
                const f32x4 hv = v[j] * (sc + 1.f) + sh;
#pragma unroll
                for (int i = 0; i < 4; ++i)
#pragma unroll
                    for (int e = 0; e < 8; ++e) lgt[e] += hv[i] * rwa[j][i][e >> 2][e & 3]; }
#pragma unroll
            for (int e = 0; e < 8; ++e) lgt[e] = wave_sum(lgt[e]);
            int e0 = 0; float v0 = lgt[0];
#pragma unroll
            for (int e = 1; e < 8; ++e) if (lgt[e] > v0) { v0 = lgt[e]; e0 = e; }
            int e1 = -1; float v1 = -3.0e38f;
#pragma unroll
            for (int e = 0; e < 8; ++e) if (e != e0 && lgt[e] > v1) { v1 = lgt[e]; e1 = e; }
            if (lane == 0) { const float ex = __expf(v1 - v0); const float g0 = 1.f / (1.f + ex); TOPE[row] = e0 | (e1 << 8); TOPG[row * 2] = g0; TOPG[row * 2 + 1] = ex * g0;
                __hip_atomic_fetch_add(&cnt[e0], 1, __ATOMIC_RELAXED, __HIP_MEMORY_SCOPE_WORKGROUP); __hip_atomic_fetch_add(&cnt[e1], 1, __ATOMIC_RELAXED, __HIP_MEMORY_SCOPE_WORKGROUP); }
        }
        __syncthreads();
        if (F.tid < 8) ((int*)(ws + WS_WGCNT))[F.bid * 8 + F.tid] = cnt[F.tid];
    }
}

__device__ __forceinline__ void phase_moe_assign(Frame& F) {
    frame_refresh(F); unsigned char* const ws = wsp();
    LAS int* sm = (LAS int*)F.lds;
    const int* WGCNT = (const int*)(ws + WS_WGCNT);
    if (F.tid < 8) { int tot = 0, pre = 0; for (int w = 0; w < F.G; ++w) { const int c = WGCNT[w * 8 + F.tid]; tot += c; if (w < F.bid) pre += c; } sm[16 + F.tid] = tot; sm[24 + F.tid] = pre; sm[8 + F.tid] = 0; }
    __syncthreads();
    if (F.tid == 0) { int ps = 0; int* info = (int*)(ws + WS_MOEINFO);
        for (int e = 0; e < 8; ++e) { sm[e] = ps + sm[24 + e]; if (F.bid == 0) info[e] = ps >> 8; ps += (sm[16 + e] + 255) & ~255; }
        if (F.bid == 0) { info[8] = ps >> 8; } }
    __syncthreads();
    if (F.bid == 0 && F.tid < 272) { int* info = (int*)(ws + WS_MOEINFO); int ps = 0, e = 0;
        for (int q = 0; q < 8; ++q) { ps += (sm[16 + q] + 255) >> 8; if (F.tid >= ps) e = q + 1; }
        info[16 + F.tid] = e < 8 ? e : 7; }
    __syncthreads();
    const int* TOPE = (const int*)(ws + WS_TOPE); const float* TOPG = (const float*)(ws + WS_TOPG);
    int* TOKPOS = (int*)(ws + WS_TOKPOS); float* ROWG = (float*)(ws + WS_ROWG);
    const bf16* A = (const bf16*)(ws + WS_A); bf16* XG = (bf16*)(ws + WS_XG);
    const int RPW = (R + F.G - 1) / F.G, rbeg = F.bid * RPW, rend = min(R, rbeg + RPW);
    for (int row = rbeg + F.wave; row < rend; row += 8) {
        int p0 = 0, p1 = 0;
        if (F.lane == 0) { const int te = TOPE[row]; const int e0 = te & 255, e1 = te >> 8;
            p0 = sm[e0] + __hip_atomic_fetch_add(&sm[8 + e0], 1, __ATOMIC_RELAXED, __HIP_MEMORY_SCOPE_WORKGROUP); p1 = sm[e1] + __hip_atomic_fetch_add(&sm[8 + e1], 1, __ATOMIC_RELAXED, __HIP_MEMORY_SCOPE_WORKGROUP);
            TOKPOS[row * 2] = p0; TOKPOS[row * 2 + 1] = p1; ROWG[p0] = TOPG[row * 2]; ROWG[p1] = TOPG[row * 2 + 1]; }
        p0 = __shfl(p0, 0); p1 = __shfl(p1, 0);
        const v4u a0 = *(const v4u*)(A + (size_t)row * D + 8 * F.lane), a1 = *(const v4u*)(A + (size_t)row * D + 512 + 8 * F.lane);
        *(v4u*)(XG + (size_t)p0 * D + 8 * F.lane) = a0; *(v4u*)(XG + (size_t)p0 * D + 512 + 8 * F.lane) = a1;
        *(v4u*)(XG + (size_t)p1 * D + 8 * F.lane) = a0; *(v4u*)(XG + (size_t)p1 * D + 512 + 8 * F.lane) = a1;
    }
}
__device__ __forceinline__ void phase_moe_combine(Frame& F, int l) {
    frame_refresh(F); unsigned char* const ws = wsp();
    const float* MOD = (const float*)(ws + WS_MOD);
    const float* lg = inp(I_LNG) + (size_t)(l * 2 + 1) * D; const float* lb = inp(I_LNB) + (size_t)(l * 2 + 1) * D;
    const bool last = (l == DEPTH - 1);
    const int* TOKPOS = (const int*)(ws + WS_TOKPOS); const bf16* YB = (const bf16*)(ws + WS_XG);
    const int gw = F.bid * 8 + F.wave, NGW = F.G * 8, lane = F.lane;
    const int nrows = last ? NLAT : R;
    float* xl = outp(); float* xc = (float*)(ws + WS_XC); bf16* Ab = (bf16*)(ws + WS_A);
    for (int row = gw; row < nrows; row += NGW) {
        const int p0 = TOKPOS[row * 2], p1 = TOKPOS[row * 2 + 1];
        const float* xs = xrow_src(xl, xc, row);
        const float* gp = MOD + (size_t)(l * 5 + row_slot(row)) * 6144 + 5120;
        f32x4 v[4];
#pragma unroll
        for (int j = 0; j < 4; ++j) { const int c = 4 * lane + 256 * j;
            const v2u y0 = *(const v2u*)(YB + (size_t)p0 * D + c), y1 = *(const v2u*)(YB + (size_t)p1 * D + c);
            const f32x4 f = (f32x4){bflo(y0.x) + bflo(y1.x), bfhi(y0.x) + bfhi(y1.x), bflo(y0.y) + bflo(y1.y), bfhi(y0.y) + bfhi(y1.y)};
            v[j] = *(const f32x4*)(xs + c) * ALPHA + *(const f32x4*)(gp + c) * f; }
        ln_row(v, lg, lb, lane);
        float* xd = xrow_dst(xl, xc, row);
#pragma unroll
        for (int j = 0; j < 4; ++j) *(f32x4*)(xd + 4 * lane + 256 * j) = v[j];
        if (!last) store_A_row(Ab, lane, row, v, MOD + (size_t)((l + 1) * 5 + row_slot(row)) * 6144, 0, 1024);
    }
}

#ifndef PHMASK
#define PHMASK 0xFFFFFFFFu
#endif
#define PK(k) ((PHMASK >> (k)) & 1u)
constexpr int PPL = 12, NPHASE = 2 + DEPTH * PPL;
__global__ void __launch_bounds__(512, 2) fwd(Args args) {
    extern __shared__ __attribute__((aligned(16))) unsigned char lds_raw[];
    Frame F;
    F.lds = (LAS unsigned char*)lds_raw;
    F.tid = threadIdx.x; F.lane = F.tid & 63; F.wave = __builtin_amdgcn_readfirstlane(F.tid >> 6); F.G = gridDim.x; F.bid = blockIdx.x;
    volatile LAS unsigned* MISC = (volatile LAS unsigned*)(F.lds + LDSCTL_OFF);
    if (F.tid < 64) MISC[F.tid] = 0u;
    __syncthreads();
    const int lo = args.ph_lo, hi = args.ph_hi;
    XcdBarrier bar; bar.bar = (unsigned*)(args.ws + WS_CTL) + 4096; bar.x = 0; bar.st = nullptr;
    if (hi - lo > 1) bar = xcd_barrier_post((unsigned*)(args.ws + WS_CTL) + 4096, MISC + 8, F.wave);
#define IN(k) (lo <= (k) && (k) < hi)
#define SEAM(k) do { if (IN((k) + 1)) xcd_barrier(bar, F.wave); } while (0)
    LAS unsigned char* ring = F.lds;

    if (IN(0)) { if (PK(0)) phase_prologue(F); SEAM(0); }
    if (IN(1)) { if (PK(1)) phase_a0(F); SEAM(1); }
    for (int l = 0; l < DEPTH; ++l) {
        const int pb = 2 + l * PPL;
        const bool moe = (l & 1) != 0;
        if (IN(pb + 0)) { if (PK(2) && moe) phase_moe_convert(F, l >> 1); SEAM(pb + 0); }
        if (PK(3) && IN(pb + 1)) {
            unsigned char* const ws = wsp(); const float* modl = (const float*)(ws + WS_MOD) + (size_t)l * 5 * 6144; (void)modl;
            pg8::Gemm g{(const bf16*)(ws + WS_A), (const bf16*)(ws + WS_WIN) + (size_t)l * DPP * D, D};
            pg8::StaticOrder S; S.init(R / 256, DPP / 256, D, F.G, F.bid);
            pg8::EpiBf16 E{(bf16*)(ws + WS_P), DPP};
            pg8::gemm_phase<pg8::EpiBf16, pg8::StaticOrder, true, true>(ring, F.wave, g, S, E);
            SEAM(pb + 1);
        }
        if (IN(pb + 2)) { if (PK(4)) phase_gdn_prep(F, l); SEAM(pb + 2); }
        if (IN(pb + 3)) { if (PK(5)) phase_scans(F, l); SEAM(pb + 3); }
        if (IN(pb + 4)) { if (PK(6)) phase_readout(F, l); SEAM(pb + 4); }
        if (PK(7) && IN(pb + 5)) {
            unsigned char* const ws = wsp(); const float* modl = (const float*)(ws + WS_MOD) + (size_t)l * 5 * 6144; (void)modl;
            pg8::Gemm g{(const bf16*)(ws + WS_GQ), (const bf16*)(ws + WS_WGLU) + (size_t)l * 65536, 256};
            pg8::StaticOrder S; S.init(R / 256, 1, 256, F.G, F.bid);
            pg8::EpiGlu E{(bf16*)(ws + WS_MIX), (const float*)(ws + WS_O) + (size_t)6 * R * 256, inp(I_S5GLUB) + l * 256};
            pg8::gemm_phase<pg8::EpiGlu, pg8::StaticOrder, true, true>(ring, F.wave, g, S, E);
            SEAM(pb + 5);
        }
        if (PK(8) && IN(pb + 6)) {
            unsigned char* const ws = wsp(); const float* modl = (const float*)(ws + WS_MOD) + (size_t)l * 5 * 6144; (void)modl;
            pg8::Gemm g{(const bf16*)(ws + WS_MIX), (const bf16*)(ws + WS_WOUT) + (size_t)l * D * D, D};
            pg8::StaticOrder S; S.init(R / 256, D / 256, D, F.G, F.bid);
            pg8::EpiRes E{(float*)(ws + WS_Y), l == 0 ? inp(I_X) : (const float*)outp(), l == 0 ? inp(I_CTX) : (const float*)(ws + WS_XC), modl, 2048};
            pg8::gemm_phase<pg8::EpiRes, pg8::StaticOrder, true, true>(ring, F.wave, g, S, E);
            SEAM(pb + 6);
        }
        if (IN(pb + 7)) { if (moe) { if (PK(9)) phase_ln<true>(F, l, 0); } else { if (PK(10)) phase_ln<false>(F, l, 0); } SEAM(pb + 7); }
        if (!moe) {
            if (PK(11) && IN(pb + 8)) {
            unsigned char* const ws = wsp(); const float* modl = (const float*)(ws + WS_MOD) + (size_t)l * 5 * 6144; (void)modl;
                pg8::Gemm g{(const bf16*)(ws + WS_A), (const bf16*)(ws + WS_WF13) + (size_t)(l >> 1) * 2 * FFD * D, D};
                pg8::StaticOrder S; S.init(R / 256, 2 * FFD / 256, D, F.G, F.bid);
                pg8::EpiSwiGlu E{(bf16*)(ws + WS_HID), FFD};
                pg8::gemm_phase<pg8::EpiSwiGlu, pg8::StaticOrder, true, true>(ring, F.wave, g, S, E);
                SEAM(pb + 8);
            }
            if (PK(12) && IN(pb + 9)) {
            unsigned char* const ws = wsp(); const float* modl = (const float*)(ws + WS_MOD) + (size_t)l * 5 * 6144; (void)modl;
                pg8::Gemm g{(const bf16*)(ws + WS_HID), (const bf16*)(ws + WS_WF2) + (size_t)(l >> 1) * D * FFD, FFD};
                pg8::StaticOrder S; S.init(R / 256, D / 256, FFD, F.G, F.bid);
                pg8::EpiRes E{(float*)(ws + WS_Y), (const float*)outp(), (const float*)(ws + WS_XC), modl, 5120};
                pg8::gemm_phase<pg8::EpiRes, pg8::StaticOrder, true, true>(ring, F.wave, g, S, E);
                SEAM(pb + 9);
            }
            if (IN(pb + 10)) { if (PK(13)) phase_ln<false>(F, l, 1); SEAM(pb + 10); }
            if (IN(pb + 11)) { SEAM(pb + 11); }
        } else {
            if (IN(pb + 8)) { if (PK(14)) phase_moe_assign(F); SEAM(pb + 8); }
            if (PK(15) && IN(pb + 9)) {
            unsigned char* const ws = wsp(); const float* modl = (const float*)(ws + WS_MOD) + (size_t)l * 5 * 6144; (void)modl;
                const int* info = (const int*)(ws + WS_MOEINFO);
                pg8::Gemm g{(const bf16*)(ws + WS_XG), (const bf16*)(ws + WS_WM13), D};
                pg8::MoeOrder S; S.init(info[8], 2 * FFE / 256, D, F.G, F.bid);
                S.texp = info + 16; S.estride = (size_t)2 * FFE * D * 2;
                pg8::EpiSwiGlu E{(bf16*)(ws + WS_MHID), FFE};
                pg8::gemm_phase<pg8::EpiSwiGlu, pg8::MoeOrder, true, true>(ring, F.wave, g, S, E);
                SEAM(pb + 9);
            }
            if (PK(16) && IN(pb + 10)) {
            unsigned char* const ws = wsp(); const float* modl = (const float*)(ws + WS_MOD) + (size_t)l * 5 * 6144; (void)modl;
                const int* info = (const int*)(ws + WS_MOEINFO);
                pg8::Gemm g{(const bf16*)(ws + WS_MHID), (const bf16*)(ws + WS_WM2), FFE};
                pg8::MoeOrder S; S.init(info[8], D / 256, FFE, F.G, F.bid);
                S.texp = info + 16; S.estride = (size_t)D * FFE * 2;
                pg8::EpiMoeDown E{(bf16*)(ws + WS_XG), (const float*)(ws + WS_ROWG)};
                pg8::gemm_phase<pg8::EpiMoeDown, pg8::MoeOrder, true, true>(ring, F.wave, g, S, E);
                SEAM(pb + 10);
            }
            if (IN(pb + 11)) { if (PK(17)) phase_moe_combine(F, l); SEAM(pb + 11); }
        }
    }
#undef IN
#undef SEAM
}

extern "C" void kernel_launch(void* const* d_in, const int* in_sizes, int n_in, void* d_out, int out_size, void* d_ws, size_t ws_size, hipStream_t stream) {
    static int grid = 0;
    if (grid == 0) {
        if (n_in != 34 || out_size != NLAT * D || ws_size < WS_END) { fprintf(stderr, "kernel_launch: unexpected shapes (n_in %d out %d ws %zu need %zu)\n", n_in, out_size, ws_size, (size_t)WS_END); grid = -1; return; }
        int dev = 0, cus = 0, per_cu = 0;
        if (hipGetDevice(&dev) != hipSuccess || hipDeviceGetAttribute(&cus, hipDeviceAttributeMultiprocessorCount, dev) != hipSuccess) { grid = -1; return; }
        if (hipFuncSetAttribute((const void*)fwd, hipFuncAttributeMaxDynamicSharedMemorySize, LDS_BYTES) != hipSuccess) { fprintf(stderr, "kernel_launch: hipFuncSetAttribute failed\n"); grid = -1; return; }
        if (hipOccupancyMaxActiveBlocksPerMultiprocessor(&per_cu, (const void*)fwd, 512, LDS_BYTES) != hipSuccess || per_cu < 1) fprintf(stderr, "kernel_launch: occupancy query reports %d\n", per_cu);
        (void)hipGetLastError();
        grid = cus;
    }
    if (grid < 0) return;
    (void)hipMemsetAsync((char*)d_ws + WS_CTL, 0, CTL_ZERO_BYTES, stream);
    Args a{};
    for (int i = 0; i < 34; ++i) a.in[i] = (const float*)d_in[i];
    a.out = (float*)d_out; a.ws = (unsigned char*)d_ws;
#if MK_ONE_LAUNCH
    a.ph_lo = 0; a.ph_hi = NPHASE;
    hipLaunchKernelGGL(fwd, dim3(grid), dim3(512), LDS_BYTES, stream, a);
#else
    for (int p = 0; p < NPHASE; ++p) {
        if (p >= 2) { const int l = (p - 2) / PPL, k = (p - 2) % PPL; const bool moe = (l & 1) != 0; if (k == 0 && !moe) continue; if (k == 11 && !moe) continue; }
        a.ph_lo = p; a.ph_hi = p + 1;
        hipLaunchKernelGGL(fwd, dim3(grid), dim3(512), LDS_BYTES, stream, a);
    }
#endif
}
```

```cpp
#include <hip/hip_runtime.h>
#include <cstdio>
#include <cstdint>

#ifndef MK_ONE_LAUNCH
#define MK_ONE_LAUNCH 1
#endif

#define GAS __attribute__((address_space(1)))
#define LAS __attribute__((address_space(3)))
typedef unsigned short bf16;
typedef unsigned v4u __attribute__((ext_vector_type(4)));
typedef unsigned v2u __attribute__((ext_vector_type(2)));
typedef float f32x4 __attribute__((ext_vector_type(4)));
typedef float f32x2 __attribute__((ext_vector_type(2)));
typedef short bf16x8 __attribute__((ext_vector_type(8)));

constexpr int D = 1024, BATCH = 4, SEQ = 8192, CTXL = 256, DEPTH = 4;
constexpr int NLAT = BATCH * SEQ, NCTX = BATCH * CTXL, R = NLAT + NCTX;
constexpr int DPROJ = 3600, DPP = 3600, DPW = 3840;
constexpr int FFD = 2816, FFE = 3584, NEXP = 8;
constexpr int MOE_ROWS = 2 * R + NEXP * 256;
constexpr float ALPHA = 1.681792830507429f;
constexpr float LN_EPS = 1e-5f, RMS_EPS = 1e-6f;
constexpr int PC_GQKV = 0, PC_GZ = 768, PC_GA = 1024, PC_GB = 1032, PC_S5U = 1040, PC_HQ = 1296, PC_HF = 1552, PC_HI = 2064, PC_HG = 2320, PC_RQKV = 2576, PC_RG = 3344;
constexpr int NSEQ = CTXL + SEQ;
constexpr int TCH = 32, NCHUNK = NSEQ / TCH;

constexpr size_t MiB = 1u << 20;
constexpr size_t WS_CTL = 0, CTL_ZERO_BYTES = 1 * MiB;
constexpr size_t WS_MOD = 1 * MiB;
constexpr size_t WS_LB = WS_MOD + 512 * 1024;
constexpr size_t WS_ROT = WS_LB + 4096;
constexpr size_t WS_S5LAM = WS_ROT + 32768;
constexpr size_t WS_S5B = 2 * MiB;
constexpr size_t WS_TOPE = 3 * MiB;
constexpr size_t WS_TOPG = WS_TOPE + 256 * 1024;
constexpr size_t WS_TOKPOS = WS_TOPG + 512 * 1024;
constexpr size_t WS_ROWG = 4 * MiB + 256 * 1024;
constexpr size_t WS_WGCNT = 4 * MiB + 768 * 1024;
constexpr size_t WS_MOEINFO = WS_WGCNT + 16384;
constexpr size_t WS_GSC = 5 * MiB;
constexpr size_t WS_WIN = 8 * MiB;
constexpr size_t WS_WOUT = 38 * MiB;
constexpr size_t WS_WF13 = 46 * MiB;
constexpr size_t WS_WF2 = 68 * MiB;
constexpr size_t WS_WGLU = 79 * MiB;
constexpr size_t WS_WM13 = 80 * MiB;
constexpr size_t WS_WM2 = 192 * MiB;
constexpr size_t WS_XC = 248 * MiB;
constexpr size_t WS_A = 252 * MiB;
constexpr size_t WS_MIX = WS_A;
constexpr size_t WS_TG = 80 * MiB;
constexpr size_t WS_U = 318 * MiB;
constexpr size_t WS_P = WS_U;
constexpr size_t WS_Y = WS_U;
constexpr size_t WS_OB = 551 * MiB;
constexpr size_t WS_O5 = 650 * MiB;
constexpr size_t WS_GQ = 716 * MiB, WS_GK = WS_GQ + 17 * MiB, WS_GV = WS_GK + 17 * MiB;
constexpr size_t WS_TH = 767 * MiB;
constexpr size_t WS_TR = 899 * MiB;
constexpr size_t WS_DEC = 1031 * MiB;
constexpr size_t WS_HID = 566 * MiB;
constexpr size_t WS_XG = WS_U;
constexpr size_t WS_MHID = 454 * MiB;
constexpr size_t WS_END = 1040 * MiB;
static_assert(WS_MHID + (size_t)MOE_ROWS * FFE * 2 <= WS_END && WS_XG + (size_t)MOE_ROWS * D * 2 <= WS_MHID, "ws map");
static_assert(WS_P + (size_t)R * 3600 * 2 <= WS_OB && WS_OB + (size_t)6 * R * 256 * 2 <= WS_O5 && WS_O5 + (size_t)2 * R * 256 * 4 <= WS_GQ && WS_GV + (size_t)R * 256 * 2 <= WS_TH, "ws map 2");
static_assert(WS_TH + (size_t)4224 * 4 * 8192 <= WS_TR && WS_TR + (size_t)4224 * 4 * 8192 <= WS_DEC && WS_DEC + (size_t)3 * 4224 * 256 <= WS_END && WS_TG + (size_t)4224 * 5 * 8192 <= 248 * MiB, "ws map 3");
static_assert(WS_HID + (size_t)R * FFD * 2 <= WS_END && WS_Y + (size_t)R * D * 4 <= WS_OB, "ws map 4");

constexpr int RING_BYTES = 131072, LDSCTL_OFF = RING_BYTES, LDS_BYTES = 147456;

__device__ __forceinline__ unsigned f2bf(float f) { unsigned u = __builtin_bit_cast(unsigned, f); return (u + 0x7fffu + ((u >> 16) & 1u)) >> 16; }
__device__ __forceinline__ unsigned pk2(float lo, float hi) { return f2bf(lo) | (f2bf(hi) << 16); }
__device__ __forceinline__ float bflo(unsigned w) { return __builtin_bit_cast(float, w << 16); }
__device__ __forceinline__ float bfhi(unsigned w) { return __builtin_bit_cast(float, w & 0xffff0000u); }
__device__ __forceinline__ float bf2f(bf16 h) { return __builtin_bit_cast(float, (unsigned)h << 16); }
__device__ __forceinline__ float wave_sum(float v) {
#pragma unroll
    for (int o = 1; o < 64; o <<= 1) v += __shfl_xor(v, o);
    return v;
}
__device__ __forceinline__ float sum16(float v) { v += __shfl_xor(v, 1); v += __shfl_xor(v, 2); v += __shfl_xor(v, 4); v += __shfl_xor(v, 8); return v; }
__device__ __forceinline__ float sigmoidf_(float x) { return 1.f / (1.f + __expf(-x)); }
__device__ __forceinline__ float siluf_(float x) { return x / (1.f + __expf(-x)); }
__device__ __forceinline__ float gelu_tanh(float x) { const float u = 0.7978845608028654f * (x + 0.044715f * x * x * x); const float t = 1.f - 2.f / (__expf(2.f * u) + 1.f); return 0.5f * x * (1.f + t); }
#define LDS_WAIT() asm volatile("s_waitcnt lgkmcnt(0)" ::: "memory")

__device__ __forceinline__ int lane_id_opaque() { unsigned z; asm volatile("v_mov_b32 %0, 0" : "=v"(z)); return (int)__builtin_amdgcn_mbcnt_hi(~0u, __builtin_amdgcn_mbcnt_lo(~0u, z)); }
#define XB_TMO      128
#define XB_XCNT(j)  (256  + 64 * (j))
#define XB_XSUB(j)  (1280 + 64 * (j))
#define XB_XGEN(j)  (2304 + 64 * (j))
#define XB_TOP      3328
#define XB_TOPGEN   3392
#define XCD_BAR_WORDS 3456
#define XB_SPIN_CAP (1u << 18)
__device__ __forceinline__ unsigned xb_ld(GAS unsigned* p)              { return __hip_atomic_load(p, __ATOMIC_RELAXED, __HIP_MEMORY_SCOPE_AGENT); }
__device__ __forceinline__ unsigned xb_add(GAS unsigned* p, unsigned v) { return __hip_atomic_fetch_add(p, v, __ATOMIC_RELAXED, __HIP_MEMORY_SCOPE_AGENT); }
__device__ __forceinline__ unsigned xb_xcc_id() { return (unsigned)__builtin_amdgcn_s_getreg((3 << 11) | 20) & 0xFu; }
#define XB_SPIN(cond, bar) do { unsigned _sp = 0; while (cond) { __builtin_amdgcn_s_sleep(1); \
    if ((++_sp & 255u) == 0u) { if (xb_ld(&(bar)[XB_TMO])) break; if (_sp > XB_SPIN_CAP) { (void)xb_add(&(bar)[XB_TMO], 1u); break; } } } } while (0)
struct XcdBarrier { GAS unsigned* bar; unsigned x; volatile LAS unsigned* st; };
__device__ __forceinline__ bool xb_thread0(int wave_id) { return wave_id == 0 && lane_id_opaque() == 0; }
__device__ __forceinline__ XcdBarrier xcd_barrier_post(GAS unsigned* bar, volatile LAS unsigned* st, int wave_id) {
    XcdBarrier b; b.bar = bar; b.x = xb_xcc_id(); b.st = st;
    if (xb_thread0(wave_id)) (void)xb_add(&bar[XB_XCNT(b.x)], 1u);
    return b;
}
__device__ __forceinline__ void xcd_barrier_complete(GAS unsigned* bar, unsigned x, unsigned& nloc, unsigned& nx) {
    const unsigned G = gridDim.x * gridDim.y * gridDim.z;
    unsigned sum, cnt, mine, sp = 0u;
    for (;;) {
        sum = 0u; cnt = 0u; mine = 0u;
#pragma unroll
        for (unsigned j = 0; j < 16; ++j) { const unsigned c = xb_ld(&bar[XB_XCNT(j)]); sum += c; cnt += (c > 0u) ? 1u : 0u; mine = (j == x) ? c : mine; }
        if (sum == G) break;
        __builtin_amdgcn_s_sleep(1);
        if ((++sp & 255u) == 0u) { if (xb_ld(&bar[XB_TMO])) break; if (sp > XB_SPIN_CAP) { (void)xb_add(&bar[XB_TMO], 1u); break; } }
    }
    nloc = mine > 0u ? mine : 1u; nx = cnt > 0u ? cnt : 1u;
}
__device__ __forceinline__ void xcd_barrier(const XcdBarrier& b, int wave_id) {
    asm volatile("s_waitcnt vmcnt(0)" ::: "memory");
    __syncthreads();
    if (xb_thread0(wave_id)) {
        GAS unsigned* bar = b.bar; asm volatile("" : "+s"(bar));
        __builtin_amdgcn_s_waitcnt(0);
        unsigned nloc = b.st[0], nx = b.st[1];
        if (nloc == 0u) { xcd_barrier_complete(bar, b.x, nloc, nx); b.st[0] = nloc; b.st[1] = nx; }
        const unsigned old = xb_add(&bar[XB_XSUB(b.x)], 1u);
        const unsigned gen = old / nloc;
        if (old + 1u == (gen + 1u) * nloc) {
            __builtin_amdgcn_fence(__ATOMIC_RELEASE, "agent");
            asm volatile("s_waitcnt vmcnt(0)" ::: "memory");
            const unsigned og = xb_add(&bar[XB_TOP], 1u);
            const unsigned tg = og / nx;
            if (og + 1u == (tg + 1u) * nx) xb_add(&bar[XB_TOPGEN], 1u);
            else XB_SPIN(xb_ld(&bar[XB_TOPGEN]) == tg, bar);
            __builtin_amdgcn_fence(__ATOMIC_ACQUIRE, "agent");
            xb_add(&bar[XB_XGEN(b.x)], 1u);
            asm volatile("s_waitcnt vmcnt(0)" ::: "memory");
        } else {
            XB_SPIN(xb_ld(&bar[XB_XGEN(b.x)]) == gen, bar);
            __builtin_amdgcn_fence(__ATOMIC_ACQUIRE, "agent");
            asm volatile("s_waitcnt vmcnt(0)" ::: "memory");
        }
    }
    __syncthreads();
}

namespace pg8 {
constexpr int BM = 256, BK = 64, HALF = 128, HTB = HALF * BK * 2, STAGE_BYTES = 8 * HTB, NXCD = 8, WGM = 8;
__host__ __device__ __forceinline__ int lds_byte(int r, int c) { const int st = (r >> 4) * 2 + (c >> 5), rr = r & 15, cc = c & 31, ob = rr * 64 + cc * 2; return st * 1024 + (ob ^ (((ob >> 9) & 1) << 5)); }
__host__ __device__ __forceinline__ void stage_rc(int b, int& Rr, int& C) { const int st = b / 1024, sb = b % 1024, swz = sb ^ (((sb >> 9) & 1) << 5); Rr = (st >> 1) * 16 + swz / 64; C = (st & 1) * 32 + (swz % 64) / 2; }
__host__ __device__ __forceinline__ int perm32(int rho) { const int n = rho >> 4, i = rho & 15; return 8 * (i >> 2) + 4 * n + (i & 3); }
struct Unit { int pm, pn; size_t boff; };
struct Gemm { const GAS bf16* A; const GAS bf16* Bt; int K; };

struct StaticOrder {
    int nM, nN, nwg, G, c, K;
    __device__ void init(int nM_, int nN_, int K_, int G_, int c_) { nM = nM_; nN = nN_; nwg = nM * nN; G = G_; K = K_; int cc = c_; asm volatile("" : "+s"(cc)); c = cc; }
    __device__ bool map(int i, int& pm, int& pn) const {
        const long L = (long)i * G + c; if (L >= nwg) return false;
        int wgid = (int)L; { const int q = nwg / NXCD, r = nwg % NXCD, xcd = wgid % NXCD, off = wgid / NXCD; wgid = (xcd < r ? xcd * (q + 1) : r * (q + 1) + (xcd - r) * q) + off; }
        const int nig = WGM * nN, gid = wgid / nig, fm = gid * WGM, gsz = (nM - fm) < WGM ? (nM - fm) : WGM;
        pm = fm + ((wgid % nig) % gsz); pn = (wgid % nig) / gsz; return true;
    }
    __device__ bool next(int i, Unit& u) const { if (!map(i, u.pm, u.pn)) return false; u.boff = (size_t)u.pn * 256 * K * 2; return true; }
};
struct MoeOrder : StaticOrder {
    const GAS int* texp; size_t estride;
    __device__ bool next(int i, Unit& u) const {
        if (!map(i, u.pm, u.pn)) return false;
        const int e = __builtin_amdgcn_readfirstlane(texp[u.pm]);
        u.boff = (size_t)e * estride + (size_t)u.pn * 256 * K * 2; return true;
    }
};
__device__ __forceinline__ unsigned cvt_pk_bf16(float lo, float hi) { unsigned r; asm volatile("v_cvt_pk_bf16_f32 %0, %1, %2" : "=v"(r) : "v"(lo), "v"(hi)); return r; }

template <class Epi, class Sched, bool ALIGN_EPI, bool SP2>
__device__ __forceinline__ void gemm_phase(LAS unsigned char* lds, const int wave_id, const Gemm g, const Sched& S, const Epi& E) {
    const int lane = lane_id_opaque();
    const int wid = wave_id, tid = wid * 64 + lane, wr = wid >> 2, wc = wid & 3, fr = lane & 15, fq = lane >> 4;
    int K_ = g.K; asm volatile("" : "+s"(K_));
    const int K = K_, nt = K / BK;
    unsigned voffA, voffB;
    { int Rr, C; stage_rc(tid * 16, Rr, C); const int Rb = Epi::PERM ? ((Rr & ~31) + perm32(Rr & 31)) : Rr;
        voffA = (unsigned)(Rr * K + C) * 2u; voffB = (unsigned)(Rb * K + C) * 2u; }
    const size_t qstep = (size_t)64 * K * 2;
    const size_t kstep = (size_t)(BK * 2);
    const size_t hstep = (size_t)HALF * K * 2;
    const size_t tstep = 2 * hstep;
    const unsigned ldsw = (unsigned)wid * 1024u;
    const int aoff = lds_byte(wr * 64 + fr, fq * 8), boff = lds_byte(wc * 32 + fr, fq * 8);
#define PG8_SA(b, h) (((b) * 2 + (h)) * HTB)
#define PG8_SB(b, h) ((4 + (b) * 2 + (h)) * HTB)
#define PG8_STAGE(bufoff, gbase, voff) do { _Pragma("unroll") for (int _i = 0; _i < 2; ++_i) \
        __builtin_amdgcn_global_load_lds((const GAS unsigned*)((const char*)(gbase) + _i * qstep + (voff)), (LAS unsigned*)(lds + (bufoff) + ldsw + _i * 8192), 16, 0, 0); } while (0)
#define PG8_LDA(dst, b, h) do { _Pragma("unroll") for (int m = 0; m < 4; ++m) _Pragma("unroll") for (int k = 0; k < 2; ++k) dst[m][k] = *(const LAS bf16x8*)(lds + PG8_SA(b, h) + aoff + m * 2048 + k * 1024); } while (0)
#define PG8_LDB(dst, b, h) do { _Pragma("unroll") for (int n = 0; n < 2; ++n) _Pragma("unroll") for (int k = 0; k < 2; ++k) dst[n][k] = *(const LAS bf16x8*)(lds + PG8_SB(b, h) + boff + n * 2048 + k * 1024); } while (0)
#define PG8_MMA(ai, bj, At, Bt) do { __builtin_amdgcn_s_setprio(1); _Pragma("unroll") for (int m = 0; m < 4; ++m) _Pragma("unroll") for (int n = 0; n < 2; ++n) _Pragma("unroll") for (int k = 0; k < 2; ++k) \
        acc[ai][bj][m][n] = __builtin_amdgcn_mfma_f32_16x16x32_bf16(Bt[n][k], At[m][k], acc[ai][bj][m][n], 0, 0, 0); __builtin_amdgcn_s_setprio(0); } while (0)
#define PG8_WAIT_V(n) asm volatile("s_waitcnt vmcnt(" #n ")" ::: "memory")
#define PG8_WAIT_L(n) asm volatile("s_waitcnt lgkmcnt(" #n ")" ::: "memory")
#define PG8_BAR __builtin_amdgcn_s_barrier()
#define PG8_SCHED __builtin_amdgcn_sched_barrier(0)
    Unit cur, nxt; int ui = 0;
    if (!S.next(0, cur)) return;
    f32x4 acc[2][2][4][2];
#pragma unroll
    for (int a = 0; a < 2; ++a)
#pragma unroll
        for (int b = 0; b < 2; ++b)
#pragma unroll
            for (int m = 0; m < 4; ++m)
#pragma unroll
                for (int n = 0; n < 2; ++n) acc[a][b][m][n] = (f32x4){0.f, 0.f, 0.f, 0.f};
    bf16x8 At[4][2], B0[2][2], B1[2][2];
    const char* cA = (const char*)g.A + (size_t)cur.pm * tstep; const char* cB = (const char*)g.Bt + cur.boff;
    if constexpr (SP2) {
        PG8_STAGE(PG8_SB(0, 0), cB, voffB); PG8_STAGE(PG8_SB(0, 1), cB + hstep, voffB); PG8_STAGE(PG8_SA(0, 0), cA, voffA); PG8_STAGE(PG8_SA(0, 1), cA + hstep, voffA);
        if (wr == 1) PG8_BAR;
        PG8_WAIT_V(2); PG8_BAR;
        PG8_STAGE(PG8_SB(1, 0), cB + kstep, voffB); PG8_STAGE(PG8_SA(1, 0), cA + kstep, voffA); PG8_STAGE(PG8_SB(1, 1), cB + hstep + kstep, voffB);
        PG8_WAIT_V(6); PG8_BAR;
    } else {
        PG8_STAGE(PG8_SB(0, 0), cB, voffB); PG8_STAGE(PG8_SA(0, 0), cA, voffA); PG8_STAGE(PG8_SB(0, 1), cB + hstep, voffB); PG8_STAGE(PG8_SA(0, 1), cA + hstep, voffA);
        if (wr == 1) PG8_BAR;
        PG8_WAIT_V(4); PG8_BAR;
        PG8_STAGE(PG8_SB(1, 0), cB + kstep, voffB); PG8_STAGE(PG8_SA(1, 0), cA + kstep, voffA); PG8_STAGE(PG8_SB(1, 1), cB + hstep + kstep, voffB);
        PG8_WAIT_V(6); PG8_BAR;
    }
    for (;;) {
        const bool has_next = S.next(ui + 1, nxt);
        const char* nA = has_next ? (const char*)g.A + (size_t)nxt.pm * tstep : cA; const char* nB = has_next ? (const char*)g.Bt + nxt.boff : cB;
        for (int t = 0; t < nt; t += 2) {
            const bool last = (t == nt - 2);
            const char* a1 = cA + (size_t)(t + 1) * kstep;
            const char* a2 = last ? nA : cA + (size_t)(t + 2) * kstep; const char* b2 = last ? nB : cB + (size_t)(t + 2) * kstep;
            const char* a3 = a2 + kstep; const char* b3 = b2 + kstep;
            if constexpr (SP2) {
            PG8_LDB(B0, 0, 0); PG8_LDB(B1, 0, 1); PG8_SCHED; PG8_LDA(At, 0, 0); PG8_STAGE(PG8_SA(1, 1), a1 + hstep, voffA);
            PG8_WAIT_V(8); PG8_WAIT_L(0); PG8_BAR; PG8_MMA(0, 0, At, B0); PG8_MMA(0, 1, At, B1); PG8_BAR; PG8_SCHED;
            PG8_LDA(At, 0, 1); PG8_STAGE(PG8_SB(0, 0), b2, voffB); PG8_STAGE(PG8_SB(0, 1), b2 + hstep, voffB); PG8_STAGE(PG8_SA(0, 0), a2, voffA);
            PG8_WAIT_V(8); PG8_WAIT_L(0); PG8_BAR; PG8_MMA(1, 0, At, B0); PG8_MMA(1, 1, At, B1); PG8_BAR; PG8_SCHED;
            PG8_LDB(B0, 1, 0); PG8_LDB(B1, 1, 1); PG8_SCHED; PG8_LDA(At, 1, 0); PG8_STAGE(PG8_SA(0, 1), a2 + hstep, voffA);
            PG8_WAIT_V(8); PG8_WAIT_L(0); PG8_BAR; PG8_MMA(0, 0, At, B0); PG8_MMA(0, 1, At, B1); PG8_BAR; PG8_SCHED;
            PG8_LDA(At, 1, 1); PG8_STAGE(PG8_SB(1, 0), b3, voffB); PG8_STAGE(PG8_SB(1, 1), b3 + hstep, voffB); PG8_STAGE(PG8_SA(1, 0), a3, voffA);
            PG8_WAIT_V(8); PG8_WAIT_L(0); PG8_BAR; PG8_MMA(1, 0, At, B0); PG8_MMA(1, 1, At, B1); PG8_BAR; PG8_SCHED;
            } else {
            PG8_LDB(B0, 0, 0); PG8_SCHED; PG8_LDA(At, 0, 0); PG8_STAGE(PG8_SA(1, 1), a1 + hstep, voffA);
            PG8_WAIT_L(8); PG8_BAR; PG8_WAIT_L(0); PG8_MMA(0, 0, At, B0); PG8_BAR; PG8_SCHED;
            PG8_LDB(B1, 0, 1); PG8_STAGE(PG8_SB(0, 0), b2, voffB);
            PG8_BAR; PG8_WAIT_L(0); PG8_MMA(0, 1, At, B1); PG8_BAR;
            PG8_LDA(At, 0, 1); PG8_STAGE(PG8_SA(0, 0), a2, voffA);
            PG8_BAR; PG8_WAIT_L(0); PG8_MMA(1, 0, At, B0); PG8_BAR; PG8_SCHED;
            PG8_STAGE(PG8_SB(0, 1), b2 + hstep, voffB);
            PG8_WAIT_V(6); PG8_BAR; PG8_MMA(1, 1, At, B1); PG8_BAR;
            PG8_LDB(B0, 1, 0); PG8_SCHED; PG8_LDA(At, 1, 0); PG8_STAGE(PG8_SA(0, 1), a2 + hstep, voffA);
            PG8_WAIT_L(8); PG8_BAR; PG8_WAIT_L(0); PG8_MMA(0, 0, At, B0); PG8_BAR; PG8_SCHED;
            PG8_LDB(B1, 1, 1); PG8_STAGE(PG8_SB(1, 0), b3, voffB);
            PG8_BAR; PG8_WAIT_L(0); PG8_MMA(0, 1, At, B1); PG8_BAR;
            PG8_LDA(At, 1, 1); PG8_STAGE(PG8_SA(1, 0), a3, voffA);
            PG8_BAR; PG8_WAIT_L(0); PG8_MMA(1, 0, At, B0); PG8_BAR; PG8_SCHED;
            PG8_STAGE(PG8_SB(1, 1), b3 + hstep, voffB);
            PG8_WAIT_V(6); PG8_BAR; PG8_MMA(1, 1, At, B1); PG8_BAR;
            }
        }
        if constexpr (ALIGN_EPI) { if (wr == 0) PG8_BAR; }
        { const int l2 = lane_id_opaque(); E(acc, cur, wr, wc, l2 & 15, l2 >> 4); }
        if (!has_next) break;
#pragma unroll
        for (int a = 0; a < 2; ++a)
#pragma unroll
            for (int b = 0; b < 2; ++b)
#pragma unroll
                for (int m = 0; m < 4; ++m)
#pragma unroll
                    for (int n = 0; n < 2; ++n) acc[a][b][m][n] = (f32x4){0.f, 0.f, 0.f, 0.f};
        cur = nxt; cA = nA; cB = nB; ++ui;
        if constexpr (ALIGN_EPI) { if (wr == 1) PG8_BAR; }
    }
    PG8_WAIT_V(0);
    if constexpr (!ALIGN_EPI) { if (wr == 0) PG8_BAR; }
    PG8_BAR;
#undef PG8_SA
#undef PG8_SB
#undef PG8_STAGE
#undef PG8_LDA
#undef PG8_LDB
#undef PG8_MMA
#undef PG8_WAIT_V
#undef PG8_WAIT_L
#undef PG8_BAR
#undef PG8_SCHED
}

struct EpiBf16 {
    static constexpr bool PERM = true;
    GAS bf16* O; int ldc, ncols;
    __device__ __forceinline__ void operator()(const f32x4 (&acc)[2][2][4][2], const Unit& u, int wr, int wc, int fr, int fq) const {
        const int row0 = u.pm * BM + wr * 64 + fr, col0 = u.pn * BM + wc * 32 + 8 * fq;
#pragma unroll
        for (int ai = 0; ai < 2; ++ai)
#pragma unroll
            for (int m = 0; m < 4; ++m) { GAS bf16* rowp = O + (size_t)(row0 + ai * HALF + m * 16) * ldc + col0; asm volatile("" ::: "memory");
#pragma unroll
                for (int bj = 0; bj < 2; ++bj) { const f32x4 v0 = acc[ai][bj][m][0], v1 = acc[ai][bj][m][1];
                    v4u w; w.x = cvt_pk_bf16(v0[0], v0[1]); w.y = cvt_pk_bf16(v0[2], v0[3]); w.z = cvt_pk_bf16(v1[0], v1[1]); w.w = cvt_pk_bf16(v1[2], v1[3]);
                    if (col0 + bj * HALF < ncols) *(GAS v4u*)(rowp + bj * HALF) = w; } }
    }
};
struct EpiSwiGlu {
    static constexpr bool PERM = true;
    GAS bf16* O; int ldc;
    __device__ __forceinline__ void operator()(const f32x4 (&acc)[2][2][4][2], const Unit& u, int wr, int wc, int fr, int fq) const {
        const int row0 = u.pm * BM + wr * 64 + fr, col0 = u.pn * HALF + wc * 32 + 8 * fq;
#pragma unroll
        for (int ai = 0; ai < 2; ++ai)
#pragma unroll
            for (int m = 0; m < 4; ++m) { GAS bf16* rowp = O + (size_t)(row0 + ai * HALF + m * 16) * ldc + col0; asm volatile("" ::: "memory");
                float h[8];
#pragma unroll
                for (int n = 0; n < 2; ++n)
#pragma unroll
                    for (int i = 0; i < 4; ++i) { const float a = acc[ai][0][m][n][i], b = acc[ai][1][m][n][i]; h[n * 4 + i] = a * b / (1.f + __expf(-a)); }
                v4u w; w.x = cvt_pk_bf16(h[0], h[1]); w.y = cvt_pk_bf16(h[2], h[3]); w.z = cvt_pk_bf16(h[4], h[5]); w.w = cvt_pk_bf16(h[6], h[7]);
                *(GAS v4u*)rowp = w; }
    }
};
struct EpiRes {
    static constexpr bool PERM = false;
    GAS float* Y; const GAS float* xl; const GAS float* xc; const GAS float* mod; int goff;
    __device__ __forceinline__ void operator()(const f32x4 (&acc)[2][2][4][2], const Unit& u, int wr, int wc, int fr, int fq) const {
        const int row0 = u.pm * BM + wr * 64 + fr, col0 = u.pn * BM + wc * 32 + 4 * fq;
        const int s = u.pm < 128 ? (u.pm >> 5) : 4;
        const GAS float* xb = u.pm < 128 ? xl : xc - (size_t)NLAT * D;
        const GAS float* gp = mod + s * 6144 + goff + col0;
        f32x4 gv[2][2];
#pragma unroll
        for (int bj = 0; bj < 2; ++bj)
#pragma unroll
            for (int n = 0; n < 2; ++n) gv[bj][n] = *(const GAS f32x4*)(gp + bj * HALF + n * 16);
#pragma unroll
        for (int ai = 0; ai < 2; ++ai)
#pragma unroll
            for (int m = 0; m < 4; ++m) { const size_t ro = (size_t)(row0 + ai * HALF + m * 16) * D + col0; asm volatile("" ::: "memory");
#pragma unroll
                for (int bj = 0; bj < 2; ++bj)
#pragma unroll
                    for (int n = 0; n < 2; ++n) { const f32x4 xv = *(const GAS f32x4*)(xb + ro + bj * HALF + n * 16);
                        *(GAS f32x4*)(Y + ro + bj * HALF + n * 16) = xv * ALPHA + gv[bj][n] * acc[ai][bj][m][n]; } }
    }
};
struct EpiGlu {
    static constexpr bool PERM = true;
    GAS bf16* MIX; const GAS float* ya; const GAS float* gb;
    __device__ __forceinline__ void operator()(const f32x4 (&acc)[2][2][4][2], const Unit& u, int wr, int wc, int fr, int fq) const {
        const int row0 = u.pm * BM + wr * 64 + fr, col0 = wc * 32 + 8 * fq;
#pragma unroll
        for (int ai = 0; ai < 2; ++ai)
#pragma unroll
            for (int m = 0; m < 4; ++m) { const int row = row0 + ai * HALF + m * 16; asm volatile("" ::: "memory");
#pragma unroll
                for (int bj = 0; bj < 2; ++bj) { const int c = col0 + bj * HALF;
                    const f32x4 y0 = *(const GAS f32x4*)(ya + (size_t)row * 256 + c), y1 = *(const GAS f32x4*)(ya + (size_t)row * 256 + c + 4);
                    const f32x4 b0 = *(const GAS f32x4*)(gb + c), b1 = *(const GAS f32x4*)(gb + c + 4);
                    float o[8];
#pragma unroll
                    for (int i = 0; i < 4; ++i) { o[i] = y0[i] * sigmoidf_(acc[ai][bj][m][0][i] + b0[i]); o[4 + i] = y1[i] * sigmoidf_(acc[ai][bj][m][1][i] + b1[i]); }
                    v4u w; w.x = cvt_pk_bf16(o[0], o[1]); w.y = cvt_pk_bf16(o[2], o[3]); w.z = cvt_pk_bf16(o[4], o[5]); w.w = cvt_pk_bf16(o[6], o[7]);
                    *(GAS v4u*)(MIX + (size_t)row * D + 256 + c) = w; } }
    }
};
struct EpiMoeDown {
    static constexpr bool PERM = true;
    GAS bf16* O; const GAS float* rowg;
    __device__ __forceinline__ void operator()(const f32x4 (&acc)[2][2][4][2], const Unit& u, int wr, int wc, int fr, int fq) const {
        const int row0 = u.pm * BM + wr * 64 + fr, col0 = u.pn * BM + wc * 32 + 8 * fq;
#pragma unroll
        for (int ai = 0; ai < 2; ++ai)
#pragma unroll
            for (int m = 0; m < 4; ++m) { asm volatile("" ::: "memory"); const int row = row0 + ai * HALF + m * 16; const float gte = rowg[row]; GAS bf16* rowp = O + (size_t)row * D + col0;
#pragma unroll
                for (int bj = 0; bj < 2; ++bj) { const f32x4 v0 = acc[ai][bj][m][0] * gte, v1 = acc[ai][bj][m][1] * gte;
                    v4u w; w.x = cvt_pk_bf16(v0[0], v0[1]); w.y = cvt_pk_bf16(v0[2], v0[3]); w.z = cvt_pk_bf16(v1[0], v1[1]); w.w = cvt_pk_bf16(v1[2], v1[3]);
                    *(GAS v4u*)(rowp + bj * HALF) = w; } }
    }
};
}

struct Args { const float* in[34]; float* out; unsigned char* ws; int ph_lo, ph_hi; };
struct Frame {
    LAS unsigned char* lds;
    int tid, lane, wave, G, bid;
};
typedef const __attribute__((address_space(4))) unsigned long long* kaptr_t;
__device__ __forceinline__ unsigned long long karg(int i) { kaptr_t ka = (kaptr_t)__builtin_amdgcn_kernarg_segment_ptr(); asm volatile("" : "+s"(ka)); return ka[i]; }
__device__ __forceinline__ const GAS float* inp(int i) { return (const GAS float*)karg(i); }
__device__ __forceinline__ GAS float* outp() { return (GAS float*)karg(34); }
__device__ __forceinline__ GAS unsigned char* wsp() { return (GAS unsigned char*)karg(35); }
enum { I_X = 0, I_C, I_CTX, I_CCTX, I_ADAW, I_ADAB, I_WIN, I_WOUT, I_LNG, I_LNB, I_GCONV, I_GALOG, I_GDTB, I_GNW, I_S5ARE, I_S5AIM, I_S5LS, I_S5BRE, I_S5BIM, I_S5CRE, I_S5CIM,
       I_S5D, I_S5GLUW, I_S5GLUB, I_HLB, I_HNW, I_RDEC, I_FW1, I_FW3, I_FW2, I_MROUTER, I_MW1, I_MW3, I_MW2 };

__device__ __forceinline__ void frame_refresh(Frame& F) { const int ln = lane_id_opaque(); int w = F.wave, b = F.bid; asm volatile("" : "+s"(w), "+s"(b)); F.wave = w; F.bid = b; F.lane = ln; F.tid = w * 64 + ln; }
__device__ __forceinline__ int row_slot(int row) { return row < NLAT ? (row >> 13) : 4; }

__device__ __forceinline__ void transpose_item(const GAS float* W, int K, int N, GAS bf16* WT, int mode, LAS float* scr, int item, int lane) {
    const int nblk = (N + 31) / 32, kb = item / nblk, nb = item % nblk, k0 = 64 * kb, n0 = 32 * nb;
    const int nn = n0 + (lane & 31);
#pragma unroll 8
    for (int i = 0; i < 32; ++i) { const int kk = 2 * i + (lane >> 5); scr[kk * 33 + (lane & 31)] = (nn < N) ? W[(size_t)(k0 + kk) * N + nn] : 0.f; }
    LDS_WAIT(); asm volatile("" ::: "memory");
    const int c = lane & 7;
#pragma unroll
    for (int j = 0; j < 4; ++j) { const int nl = (lane >> 3) + 8 * j; const int n = n0 + nl; const LAS float* s = scr + (8 * c) * 33 + nl;
        v4u o; o.x = pk2(s[0 * 33], s[1 * 33]); o.y = pk2(s[2 * 33], s[3 * 33]); o.z = pk2(s[4 * 33], s[5 * 33]); o.w = pk2(s[6 * 33], s[7 * 33]);
        const int nr = mode == 0 ? n : ((n >> 7) * 256 + (n & 127) + (mode == 2 ? 128 : 0));
        if (n < N) *(GAS v4u*)(WT + (size_t)nr * K + k0 + 8 * c) = o; }
    LDS_WAIT(); asm volatile("" ::: "memory");
}

__device__ __forceinline__ void phase_prologue(Frame& F) {
    frame_refresh(F); GAS unsigned char* const ws = wsp();
    LAS float* scv = (LAS float*)F.lds;
    LAS float* part = (LAS float*)(F.lds + 20480);
    for (int i = F.tid; i < 5 * 1024; i += 512) { const int s = i >> 10, k = i & 1023; const float c = s < 4 ? inp(I_C)[s * 1024 + k] : inp(I_CCTX)[k]; scv[i] = siluf_(c); }
    __syncthreads();
    GAS float* MOD = (GAS float*)(ws + WS_MOD);
    for (int it = F.bid; it < 4 * 96; it += F.G) {
        const int l = it / 96, n0 = (it % 96) * 64;
        const GAS float* w = inp(I_ADAW) + (size_t)l * 1024 * 6144 + n0 + F.lane;
        float a0 = 0.f, a1 = 0.f, a2 = 0.f, a3 = 0.f, a4 = 0.f;
        const int kb = F.wave * 128;
#pragma unroll 8
        for (int k = 0; k < 128; ++k) { const float wv = w[(size_t)(kb + k) * 6144];
            a0 += scv[kb + k] * wv; a1 += scv[1024 + kb + k] * wv; a2 += scv[2048 + kb + k] * wv; a3 += scv[3072 + kb + k] * wv; a4 += scv[4096 + kb + k] * wv; }
        part[(F.wave * 5 + 0) * 64 + F.lane] = a0; part[(F.wave * 5 + 1) * 64 + F.lane] = a1; part[(F.wave * 5 + 2) * 64 + F.lane] = a2; part[(F.wave * 5 + 3) * 64 + F.lane] = a3; part[(F.wave * 5 + 4) * 64 + F.lane] = a4;
        __syncthreads();
        if (F.tid < 320) { const int s = F.tid >> 6, n = F.tid & 63; float v = inp(I_ADAB)[l * 6144 + n0 + n];
#pragma unroll
            for (int w8 = 0; w8 < 8; ++w8) v += part[(w8 * 5 + s) * 64 + n];
            MOD[(size_t)(l * 5 + s) * 6144 + n0 + n] = v; }
        __syncthreads();
    }
    const int gt = F.bid * 512 + F.tid, NT = F.G * 512;
    GAS float* LB = (GAS float*)(ws + WS_LB);
    for (int i = gt; i < 256; i += NT) {
        float v[4], mx = -1e30f; for (int l = 0; l < 4; ++l) { v[l] = inp(I_HLB)[l * 256 + i]; mx = fmaxf(mx, v[l]); }
        float s = 0.f; for (int l = 0; l < 4; ++l) { v[l] = expf(v[l] - mx); s += v[l]; }
        float cum = 0.f, first = 0.f; for (int l = 0; l < 4; ++l) { cum += v[l] / s; if (l == 0) first = cum; LB[l * 256 + i] = cum - first; }
    }
    GAS float* ROT = (GAS float*)(ws + WS_ROT);
    for (int i = gt; i < 192 * 16; i += NT) { const int pos = i >> 4, q = i & 15; const float p = (float)(pos < 128 ? pos : pos - 128);
        const float invf = expf(-(float)q * (9.210340371976184f / 16.f)); const float ang = p * invf; ROT[i * 2] = cosf(ang); ROT[i * 2 + 1] = sinf(ang); }
    GAS float* LAM = (GAS float*)(ws + WS_S5LAM); GAS float* BB = (GAS float*)(ws + WS_S5B);
    for (int i = gt; i < 4 * 2 * 16 * 64; i += NT) {
        const int ldg = i >> 6;
        const float are = inp(I_S5ARE)[i], aim = inp(I_S5AIM)[i], st = expf(inp(I_S5LS)[ldg]);
        const float x = are * st, y = aim * st, ex = expf(x), cy = cosf(y), sy = sinf(y), sh = sinf(0.5f * y);
        LAM[i * 2] = ex * cy; LAM[i * 2 + 1] = ex * sy;
        const float er = expm1f(x) * cy - 2.f * sh * sh, ei = ex * sy;
        const float den = are * are + aim * aim; const float qr = (er * are + ei * aim) / den, qi = (ei * are - er * aim) / den;
        for (int c = 0; c < 16; ++c) { const float br = inp(I_S5BRE)[(size_t)i * 16 + c], bi = inp(I_S5BIM)[(size_t)i * 16 + c];
            BB[((size_t)i * 16 + c) * 2] = qr * br - qi * bi; BB[((size_t)i * 16 + c) * 2 + 1] = qr * bi + qi * br; }
    }
    LAS float* scr = (LAS float*)(F.lds + 32768 + F.wave * 8704);
    __syncthreads();
    const int gw = F.bid * 8 + F.wave, NGW = F.G * 8;
    constexpr int I_IN = 16 * 113, I_OUT = 16 * 32, I_GLU = 4 * 8, I_F1 = 16 * 88, I_F2 = 44 * 32;
    constexpr int PER_L = I_IN + I_OUT + I_GLU, TOT = 4 * PER_L + 2 * (2 * I_F1 + I_F2);
    for (int it = gw; it < TOT; it += NGW) {
        int r = it;
        if (r < 4 * PER_L) { const int l = r / PER_L; r -= l * PER_L;
            if (r < I_IN) { transpose_item(inp(I_WIN) + (size_t)l * D * DPROJ, D, DPROJ, (GAS bf16*)(ws + WS_WIN) + (size_t)l * DPW * D, 0, scr, r, F.lane); continue; } r -= I_IN;
            if (r < I_OUT) { transpose_item(inp(I_WOUT) + (size_t)l * D * D, D, D, (GAS bf16*)(ws + WS_WOUT) + (size_t)l * D * D, 0, scr, r, F.lane); continue; } r -= I_OUT;
            transpose_item(inp(I_S5GLUW) + (size_t)l * 65536, 256, 256, (GAS bf16*)(ws + WS_WGLU) + (size_t)l * 65536, 0, scr, r, F.lane); continue; }
        r -= 4 * PER_L;
        const int j = r / (2 * I_F1 + I_F2); r -= j * (2 * I_F1 + I_F2);
        if (r < I_F1) { transpose_item(inp(I_FW1) + (size_t)j * D * FFD, D, FFD, (GAS bf16*)(ws + WS_WF13) + (size_t)j * 2 * FFD * D, 1, scr, r, F.lane); continue; } r -= I_F1;
        if (r < I_F1) { transpose_item(inp(I_FW3) + (size_t)j * D * FFD, D, FFD, (GAS bf16*)(ws + WS_WF13) + (size_t)j * 2 * FFD * D, 2, scr, r, F.lane); continue; } r -= I_F1;
        transpose_item(inp(I_FW2) + (size_t)j * FFD * D, FFD, D, (GAS bf16*)(ws + WS_WF2) + (size_t)j * D * FFD, 0, scr, r, F.lane);
    }
}
__device__ __forceinline__ void phase_moe_convert(Frame& F, int j) {
    frame_refresh(F); GAS unsigned char* const ws = wsp();
    LAS float* scr = (LAS float*)(F.lds + F.wave * 8704);
    const int gw = F.bid * 8 + F.wave, NGW = F.G * 8;
    constexpr int I_1 = 16 * 112, I_2 = 56 * 32, PER_E = 2 * I_1 + I_2;
    for (int it = gw; it < 8 * PER_E; it += NGW) {
        const int e = it / PER_E; int r = it - e * PER_E;
        const size_t wo = ((size_t)j * 8 + e) * D * FFE;
        if (r < I_1) { transpose_item(inp(I_MW1) + wo, D, FFE, (GAS bf16*)(ws + WS_WM13) + (size_t)e * 2 * FFE * D, 1, scr, r, F.lane); continue; } r -= I_1;
        if (r < I_1) { transpose_item(inp(I_MW3) + wo, D, FFE, (GAS bf16*)(ws + WS_WM13) + (size_t)e * 2 * FFE * D, 2, scr, r, F.lane); continue; } r -= I_1;
        transpose_item(inp(I_MW2) + wo, FFE, D, (GAS bf16*)(ws + WS_WM2) + (size_t)e * D * FFE, 0, scr, r, F.lane);
    }
}

__device__ __forceinline__ const GAS float* xrow_src(const GAS float* xl, const GAS float* xc, int row) { return row < NLAT ? xl + (size_t)row * D : xc + (size_t)(row - NLAT) * D; }
__device__ __forceinline__ GAS float* xrow_dst(GAS float* xl, GAS float* xc, int row) { return row < NLAT ? xl + (size_t)row * D : xc + (size_t)(row - NLAT) * D; }

__device__ __forceinline__ void store_A_row(GAS bf16* Ab, int lane_, int row, const f32x4 (&v)[4], const GAS float* modrow, int shoff, int scoff) {
    GAS bf16* ar = Ab + (size_t)row * D;
#pragma unroll
    for (int j = 0; j < 4; ++j) { const int c = 4 * lane_ + 256 * j; const f32x4 sh = *(const GAS f32x4*)(modrow + shoff + c), sc = *(const GAS f32x4*)(modrow + scoff + c);
        const f32x4 h = v[j] * (sc + 1.f) + sh; v2u w; w.x = pk2(h[0], h[1]); w.y = pk2(h[2], h[3]); *(GAS v2u*)(ar + c) = w; }
}
__device__ __forceinline__ void ln_row(f32x4 (&v)[4], const GAS float* g, const GAS float* b, int lane) {
    float s = 0.f;
#pragma unroll
    for (int j = 0; j < 4; ++j) s += (v[j][0] + v[j][1]) + (v[j][2] + v[j][3]);
    const float mean = wave_sum(s) * (1.f / D); float s2 = 0.f;
#pragma unroll
    for (int j = 0; j < 4; ++j) { v[j] = v[j] - mean; s2 += (v[j][0] * v[j][0] + v[j][1] * v[j][1]) + (v[j][2] * v[j][2] + v[j][3] * v[j][3]); }
    const float rstd = 1.f / sqrtf(wave_sum(s2) * (1.f / D) + LN_EPS);
#pragma unroll
    for (int j = 0; j < 4; ++j) { const int c = 4 * lane + 256 * j; const f32x4 gg = *(const GAS f32x4*)(g + c), bb = *(const GAS f32x4*)(b + c); v[j] = v[j] * rstd * gg + bb; }
}

__device__ __forceinline__ void phase_a0(Frame& F) {
    frame_refresh(F); GAS unsigned char* const ws = wsp();
    const GAS float* MOD = (const GAS float*)(ws + WS_MOD);
    const int gw = F.bid * 8 + F.wave, NGW = F.G * 8;
    const GAS float* xl = inp(I_X); const GAS float* xc = inp(I_CTX); GAS bf16* Ab = (GAS bf16*)(ws + WS_A);
    for (int row = gw; row < R; row += NGW) {
        const GAS float* xr = xrow_src(xl, xc, row); f32x4 v[4];
#pragma unroll
        for (int j = 0; j < 4; ++j) v[j] = *(const GAS f32x4*)(xr + 4 * F.lane + 256 * j);
        store_A_row(Ab, F.lane, row, v, MOD + (size_t)(0 * 5 + row_slot(row)) * 6144, 0, 1024);
    }
}

__device__ __forceinline__ void phase_gdn_prep(Frame& F, int l) {
    frame_refresh(F); GAS unsigned char* const ws = wsp();
    const GAS bf16* P = (const GAS bf16*)(ws + WS_P);
    GAS bf16* GQ = (GAS bf16*)(ws + WS_GQ); GAS bf16* GK = (GAS bf16*)(ws + WS_GK); GAS bf16* GV = (GAS bf16*)(ws + WS_GV);
    GAS float* GSC = (GAS float*)(ws + WS_GSC);
    const GAS float* cw = inp(I_GCONV) + (size_t)l * 3 * 768;
    const int gw = F.bid * 8 + F.wave, NGW = F.G * 8, lane = F.lane;
    f32x4 w[3][3];
#pragma unroll
    for (int kk = 0; kk < 3; ++kk)
#pragma unroll
        for (int j = 0; j < 3; ++j) w[kk][j] = *(const GAS f32x4*)(cw + kk * 768 + j * 256 + 4 * lane);
    float galog = 0.f, gdtb = 0.f;
    if (lane < 8) { galog = -__expf(inp(I_GALOG)[l * 8 + lane]); gdtb = inp(I_GDTB)[l * 8 + lane]; }
    for (int row = gw; row < R; row += NGW) {
        int t, L; if (row < NLAT) { t = row & (SEQ - 1); L = SEQ; } else { t = (row - NLAT) & (CTXL - 1); L = CTXL; }
        const GAS bf16* pr = P + (size_t)row * DPP;
        f32x4 c[3];
#pragma unroll
        for (int j = 0; j < 3; ++j) {
            const v2u x1 = *(const GAS v2u*)(pr + j * 256 + 4 * lane);
            v2u x0 = (v2u){0u, 0u}, x2 = (v2u){0u, 0u};
            if (t > 0) x0 = *(const GAS v2u*)(pr - DPP + j * 256 + 4 * lane);
            if (t < L - 1) x2 = *(const GAS v2u*)(pr + DPP + j * 256 + 4 * lane);
            f32x4 a;
            a[0] = w[0][j][0] * bflo(x0.x) + w[1][j][0] * bflo(x1.x) + w[2][j][0] * bflo(x2.x);
            a[1] = w[0][j][1] * bfhi(x0.x) + w[1][j][1] * bfhi(x1.x) + w[2][j][1] * bfhi(x2.x);
            a[2] = w[0][j][2] * bflo(x0.y) + w[1][j][2] * bflo(x1.y) + w[2][j][2] * bflo(x2.y);
            a[3] = w[0][j][3] * bfhi(x0.y) + w[1][j][3] * bfhi(x1.y) + w[2][j][3] * bfhi(x2.y);
#pragma unroll
            for (int i = 0; i < 4; ++i) a[i] = siluf_(a[i]);
            c[j] = a;
        }
        const float sq = sum16(c[0][0] * c[0][0] + c[0][1] * c[0][1] + c[0][2] * c[0][2] + c[0][3] * c[0][3]);
        const float sk = sum16(c[1][0] * c[1][0] + c[1][1] * c[1][1] + c[1][2] * c[1][2] + c[1][3] * c[1][3]);
        const float rq = 0.125f / sqrtf(sq + RMS_EPS), rk = 1.f / sqrtf(sk + RMS_EPS);
        v2u o;
        o.x = pk2(c[0][0] * rq, c[0][1] * rq); o.y = pk2(c[0][2] * rq, c[0][3] * rq); *(GAS v2u*)(GQ + (size_t)row * 256 + 4 * lane) = o;
        o.x = pk2(c[1][0] * rk, c[1][1] * rk); o.y = pk2(c[1][2] * rk, c[1][3] * rk); *(GAS v2u*)(GK + (size_t)row * 256 + 4 * lane) = o;
        o.x = pk2(c[2][0], c[2][1]); o.y = pk2(c[2][2], c[2][3]); *(GAS v2u*)(GV + (size_t)row * 256 + 4 * lane) = o;
        if (lane < 16) {
            const float a = bf2f(pr[PC_GA + lane]);
            float val;
            if (lane < 8) { const float z = a + gdtb; const float e = __expf(z); const float sp = z > 20.f ? z : (e < 0.01f ? e * (1.f - e * (0.5f - e * 0.33333333f)) : __logf(1.f + e)); val = galog * sp; }
            else val = sigmoidf_(a);
            GSC[(size_t)row * 16 + lane] = val;
        }
    }
}

__device__ __forceinline__ void chunk_rows(int b, int dir, int c, int& r0, int& step, int& t0) {
    const int s0 = c * TCH;
    if (s0 < CTXL) { t0 = -1; if (dir == 0) { r0 = NLAT + b * CTXL + s0; step = 1; } else { r0 = NLAT + b * CTXL + (CTXL - 1 - s0); step = -1; } }
    else { const int u = s0 - CTXL; if (dir == 0) { r0 = b * SEQ + u; step = 1; t0 = u; } else { r0 = b * SEQ + (SEQ - 1 - u); step = -1; t0 = SEQ - 1 - u; } }
}
constexpr int NCH64 = NSEQ / 64;
constexpr int UNITS = BATCH * 4 * 2 * NCH64;
__device__ __forceinline__ void unit_rows(int b, int dir, int n, int& r0, int& step, int& t0) {
    const int s0 = n * 64;
    if (s0 < CTXL) { t0 = -1; if (dir == 0) { r0 = NLAT + b * CTXL + s0; step = 1; } else { r0 = NLAT + b * CTXL + (CTXL - 1 - s0); step = -1; } }
    else { const int u = s0 - CTXL; if (dir == 0) { r0 = b * SEQ + u; step = 1; t0 = u; } else { r0 = b * SEQ + (SEQ - 1 - u); step = -1; t0 = SEQ - 1 - u; } }
}
__device__ __forceinline__ bf16x8 mkfrag(v2u lo, v2u hi) { v4u w; w.x = lo.x; w.y = lo.y; w.z = hi.x; w.w = hi.y; return __builtin_bit_cast(bf16x8, w); }
__device__ __forceinline__ bf16x8 ldfrag_perm(const GAS unsigned char* tile, int row0, int ks, int r16, int q) {
    const GAS unsigned char* p = tile + (row0 + r16) * 128 + (32 * ks + 4 * q) * 2;
    return mkfrag(*(const GAS v2u*)p, *(const GAS v2u*)(p + 32));
}
__device__ __forceinline__ bf16x8 pack_acc(const f32x4& a, const f32x4& b) {
    v4u w; w.x = pg8::cvt_pk_bf16(a[0], a[1]); w.y = pg8::cvt_pk_bf16(a[2], a[3]); w.z = pg8::cvt_pk_bf16(b[0], b[1]); w.w = pg8::cvt_pk_bf16(b[2], b[3]); return __builtin_bit_cast(bf16x8, w);
}
#define MFMA16(a, b, c) __builtin_amdgcn_mfma_f32_16x16x32_bf16(a, b, c, 0, 0, 0)
__device__ __forceinline__ float rdlane(float x, int i) { return __builtin_bit_cast(float, __builtin_amdgcn_readlane(__builtin_bit_cast(int, x), i)); }

template <int MODE>
__device__ __forceinline__ void chain_run(Frame& F, int sub) {
    GAS unsigned char* const ws = wsp();
    const int lane = lane_id_opaque(), r16 = lane & 15, q = lane >> 4;
    const int cb = sub & 3, dir = (sub >> 2) & 1, h = (sub >> 3) & 3, b = sub >> 5;
    constexpr int NT = (MODE == 0) ? 5 : 4, TW = 0, TU = (MODE == 0) ? 1 : 0, TKD = TU + 1, TQG = TU + 2, TATT = TU + 3;
    const int u0 = ((b * 4 + h) * 2 + dir) * NCH64;
    const GAS unsigned char* tb = ws + (MODE == 0 ? WS_TG : (MODE == 1 ? WS_TH : WS_TR)) + (size_t)u0 * NT * 8192;
    const GAS float* decp = (const GAS float*)(ws + WS_DEC) + (size_t)(MODE * UNITS + u0) * 64;
    GAS bf16* OB = (GAS bf16*)(ws + WS_OB) + (size_t)(MODE * 2 + dir) * R * 256 + h * 64 + cb * 16 + 4 * q;
    f32x4 S[4]; bf16x8 Sb[2];
#pragma unroll
    for (int m = 0; m < 4; ++m) S[m] = (f32x4){0.f, 0.f, 0.f, 0.f};
    Sb[0] = (bf16x8){0, 0, 0, 0, 0, 0, 0, 0}; Sb[1] = Sb[0];
    bf16x8 Wf[4][2], Kf[4][2], Qf[4][2], Af[4][2]; v2u Uf[4]; f32x4 dc[4];
#define LD_W(tu)  do { if (MODE == 0) { _Pragma("unroll") for (int m = 0; m < 4; ++m) _Pragma("unroll") for (int k = 0; k < 2; ++k) Wf[m][k] = ldfrag_perm((tu) + TW * 8192, 16 * m, k, r16, q); } } while (0)
#define LD_U(tu)  do { _Pragma("unroll") for (int m = 0; m < 4; ++m) Uf[m] = *(const GAS v2u*)((tu) + TU * 8192 + (cb * 16 + r16) * 128 + (16 * m + 4 * q) * 2); } while (0)
#define LD_K(tu)  do { _Pragma("unroll") for (int m = 0; m < 4; ++m) _Pragma("unroll") for (int k = 0; k < 2; ++k) Kf[m][k] = ldfrag_perm((tu) + TKD * 8192, 16 * m, k, r16, q); } while (0)
#define LD_Q(tu)  do { _Pragma("unroll") for (int m = 0; m < 4; ++m) _Pragma("unroll") for (int k = 0; k < 2; ++k) Qf[m][k] = ldfrag_perm((tu) + TQG * 8192, 16 * m, k, r16, q); } while (0)
#define LD_A(tu)  do { _Pragma("unroll") for (int m = 0; m < 4; ++m) _Pragma("unroll") for (int k = 0; k < 2; ++k) Af[m][k] = ldfrag_perm((tu) + TATT * 8192, 16 * m, k, r16, q); } while (0)
#define LD_D(n_)  do { _Pragma("unroll") for (int m = 0; m < 4; ++m) dc[m] = *(const GAS f32x4*)(decp + (size_t)(n_) * 64 + 16 * m + 4 * q); } while (0)
    LD_W(tb); LD_U(tb); LD_Q(tb); LD_A(tb); LD_K(tb); LD_D(0);
    for (int n = 0; n < NCH64; ++n) {
        const GAS unsigned char* tn = tb + (size_t)(n + 1 < NCH64 ? n + 1 : n) * NT * 8192;
        f32x4 vn[4], o[4];
#pragma unroll
        for (int m = 0; m < 4; ++m) { vn[m] = (f32x4){bflo(Uf[m].x), bfhi(Uf[m].x), bflo(Uf[m].y), bfhi(Uf[m].y)}; o[m] = (f32x4){0.f, 0.f, 0.f, 0.f}; }
        if (MODE == 0) {
#pragma unroll
            for (int m = 0; m < 4; ++m) { vn[m] = MFMA16(Wf[m][0], Sb[0], vn[m]); vn[m] = MFMA16(Wf[m][1], Sb[1], vn[m]); }
        }
#pragma unroll
        for (int m = 0; m < 4; ++m) { o[m] = MFMA16(Sb[0], Qf[m][0], o[m]); o[m] = MFMA16(Sb[1], Qf[m][1], o[m]); }
        LD_W(tn); LD_U(tn); LD_Q(tn);
        bf16x8 vb[2]; vb[0] = pack_acc(vn[0], vn[1]); vb[1] = pack_acc(vn[2], vn[3]);
#pragma unroll
        for (int m = 0; m < 4; ++m) { o[m] = MFMA16(vb[0], Af[m][0], o[m]); o[m] = MFMA16(vb[1], Af[m][1], o[m]); }
#pragma unroll
        for (int m = 0; m < 4; ++m) { S[m] = S[m] * dc[m]; S[m] = MFMA16(Kf[m][0], vb[0], S[m]); S[m] = MFMA16(Kf[m][1], vb[1], S[m]); }
        LD_A(tn); LD_K(tn); LD_D(n + 1 < NCH64 ? n + 1 : n);
        Sb[0] = pack_acc(S[0], S[1]); Sb[1] = pack_acc(S[2], S[3]);
        { int r0, step, t0; unit_rows(b, dir, n, r0, step, t0);
#pragma unroll
            for (int m = 0; m < 4; ++m) { const int row = r0 + step * (16 * m + r16); v2u w; w.x = pg8::cvt_pk_bf16(o[m][0], o[m][1]); w.y = pg8::cvt_pk_bf16(o[m][2], o[m][3]);
                *(GAS v2u*)(OB + (size_t)row * 256) = w; } }
    }
#undef LD_W
#undef LD_U
#undef LD_K
#undef LD_Q
#undef LD_A
#undef LD_D
}

__device__ __forceinline__ int swz(int rr, int kc) { return rr * 128 + ((kc ^ (rr & 7)) << 4); }
__device__ __forceinline__ v4u pack8(const float (&x)[8]) { v4u w; w.x = pk2(x[0], x[1]); w.y = pk2(x[2], x[3]); w.z = pk2(x[4], x[5]); w.w = pk2(x[6], x[7]); return w; }
__device__ __forceinline__ void unpack8(const v4u w, float (&x)[8]) { x[0] = bflo(w.x); x[1] = bfhi(w.x); x[2] = bflo(w.y); x[3] = bfhi(w.y); x[4] = bflo(w.z); x[5] = bfhi(w.z); x[6] = bflo(w.w); x[7] = bfhi(w.w); }
__device__ __forceinline__ void store_col8(GAS unsigned char* tile, int d0, int i, const float (&x)[8]) {
#pragma unroll
    for (int e = 0; e < 8; ++e) *(GAS bf16*)(tile + (d0 + e) * 128 + i * 2) = (bf16)f2bf(x[e]);
}
template <class Fac>
__device__ __forceinline__ void att_from_lds(LAS unsigned char* Qs, LAS unsigned char* Ks, GAS unsigned char* tATT, int r16, int q, const Fac& fac) {
#pragma unroll
    for (int nt = 0; nt < 4; ++nt) {
        bf16x8 bq[2];
#pragma unroll
        for (int ks = 0; ks < 2; ++ks) bq[ks] = *(const LAS bf16x8*)(Qs + swz(16 * nt + r16, ks * 4 + q));
        const int i = 16 * nt + r16;
#pragma unroll
        for (int mt = 0; mt < 4; ++mt) {
            unsigned zz; asm volatile("v_mov_b32 %0, 0" : "=v"(zz)); v2u w = (v2u){zz, zz};
            if (mt <= nt) {
                f32x4 acc = (f32x4){0.f, 0.f, 0.f, 0.f};
#pragma unroll
                for (int ks = 0; ks < 2; ++ks) { const bf16x8 ka = *(const LAS bf16x8*)(Ks + swz(16 * mt + r16, ks * 4 + q)); acc = MFMA16(ka, bq[ks], acc); }
                float y[4];
#pragma unroll
                for (int r = 0; r < 4; ++r) { const int j = 16 * mt + 4 * q + r; y[r] = (j <= i) ? acc[r] * fac(i, j) : 0.f; }
                w.x = pk2(y[0], y[1]); w.y = pk2(y[2], y[3]);
            }
            *(GAS v2u*)(tATT + i * 128 + (16 * mt + 4 * q) * 2) = w;
        }
    }
}

__device__ __forceinline__ void m1_ret(Frame& F, int l, int uidx, LAS unsigned char* lw) {
    GAS unsigned char* const ws = wsp();
    const int lane = lane_id_opaque(), r16 = lane & 15, q = lane >> 4;
    const int n = uidx % NCH64, t_ = uidx / NCH64, dir = t_ & 1, h = (t_ >> 1) & 3, b = t_ >> 3;
    int r0, step, t0; unit_rows(b, dir, n, r0, step, t0);
    const int row = r0 + step * lane, tpos = t0 < 0 ? -1 : t0 + step * lane;
    const GAS bf16* pr = (const GAS bf16*)(ws + WS_P) + (size_t)row * DPP + PC_RQKV + h * 64;
    const GAS float* ROT = (const GAS float*)(ws + WS_ROT);
    GAS unsigned char* tu = ws + WS_TR + (size_t)uidx * 4 * 8192;
    GAS unsigned char* tU = tu, *tKD = tu + 8192, *tQG = tu + 2 * 8192, *tATT = tu + 3 * 8192;
    LAS unsigned char* Qs = lw; LAS unsigned char* Ks = lw + 8192;
    const float lg = -__expf(inp(I_RDEC)[l * 8 + dir * 4 + h]);
    const float gq = __expf(lg * (float)(lane + 1)), gk = 0.125f * __expf(lg * (float)(63 - lane));
#pragma unroll
    for (int c8 = 0; c8 < 4; ++c8) {
        float ql[8], qh[8], kl[8], kh[8];
        unpack8(*(const GAS v4u*)(pr + 8 * c8), ql); unpack8(*(const GAS v4u*)(pr + 32 + 8 * c8), qh);
        unpack8(*(const GAS v4u*)(pr + 256 + 8 * c8), kl); unpack8(*(const GAS v4u*)(pr + 256 + 32 + 8 * c8), kh);
        if (tpos >= 0) {
            const GAS float* tab = ROT + (size_t)((c8 < 2 ? (tpos >> 6) : 128 + (tpos & 63)) * 16 + (c8 & 1) * 8) * 2;
#pragma unroll
            for (int e = 0; e < 8; ++e) { const float cs = tab[2 * e], sn = tab[2 * e + 1];
                const float a = ql[e] * cs - qh[e] * sn, bq = ql[e] * sn + qh[e] * cs; ql[e] = a; qh[e] = bq;
                const float c = kl[e] * cs - kh[e] * sn, dk = kl[e] * sn + kh[e] * cs; kl[e] = c; kh[e] = dk; }
        }
        *(LAS v4u*)(Qs + swz(lane, c8)) = pack8(ql); *(LAS v4u*)(Qs + swz(lane, c8 + 4)) = pack8(qh);
        *(LAS v4u*)(Ks + swz(lane, c8)) = pack8(kl); *(LAS v4u*)(Ks + swz(lane, c8 + 4)) = pack8(kh);
        float x[8];
#pragma unroll
        for (int e = 0; e < 8; ++e) x[e] = ql[e] * gq;
        *(GAS v4u*)(tQG + lane * 128 + c8 * 16) = pack8(x);
#pragma unroll
        for (int e = 0; e < 8; ++e) x[e] = qh[e] * gq;
        *(GAS v4u*)(tQG + lane * 128 + (c8 + 4) * 16) = pack8(x);
#pragma unroll
        for (int e = 0; e < 8; ++e) x[e] = kl[e] * gk;
        store_col8(tKD, 8 * c8, lane, x);
#pragma unroll
        for (int e = 0; e < 8; ++e) x[e] = kh[e] * gk;
        store_col8(tKD, 32 + 8 * c8, lane, x);
    }
#pragma unroll
    for (int c8 = 0; c8 < 8; ++c8) { float x[8]; unpack8(*(const GAS v4u*)(pr + 512 + 8 * c8), x); store_col8(tU, 8 * c8, lane, x); }
    ((GAS float*)(ws + WS_DEC))[(size_t)(2 * UNITS + uidx) * 64 + lane] = __expf(lg * 64.f);
    LDS_WAIT();
    att_from_lds(Qs, Ks, tATT, r16, q, [&](int i, int j) { return 0.125f * __expf(lg * (float)(i - j)); });
    LDS_WAIT();
}

__device__ __forceinline__ void m1_hgrn(Frame& F, int l, int uidx, LAS unsigned char* lw) {
    GAS unsigned char* const ws = wsp();
    const int lane = lane_id_opaque(), r16 = lane & 15, q = lane >> 4;
    const int n = uidx % NCH64, t_ = uidx / NCH64, dir = t_ & 1, h = (t_ >> 1) & 3, b = t_ >> 3;
    int r0, step, t0; unit_rows(b, dir, n, r0, step, t0);
    const int row = r0 + step * lane;
    const GAS bf16* pr = (const GAS bf16*)(ws + WS_P) + (size_t)row * DPP;
    const GAS float* LBp = (const GAS float*)(ws + WS_LB) + l * 256 + h * 64;
    GAS unsigned char* tu = ws + WS_TH + (size_t)uidx * 4 * 8192;
    GAS unsigned char* tU = tu, *tKD = tu + 8192, *tQG = tu + 2 * 8192, *tATT = tu + 3 * 8192;
    GAS float* decp = (GAS float*)(ws + WS_DEC) + (size_t)(1 * UNITS + uidx) * 64;
    LAS unsigned char* Qs = lw; LAS unsigned char* Ks = lw + 8192;
#pragma unroll 1
    for (int g8 = 0; g8 < 8; ++g8) {
        float qv[8], fz[8], gc[8], kk[8];
        unpack8(*(const GAS v4u*)(pr + PC_HQ + h * 64 + 8 * g8), qv); unpack8(*(const GAS v4u*)(pr + PC_HF + dir * 256 + h * 64 + 8 * g8), fz);
        const f32x4 lb0 = *(const GAS f32x4*)(LBp + 8 * g8), lb1 = *(const GAS f32x4*)(LBp + 8 * g8 + 4);
#pragma unroll
        for (int e = 0; e < 8; ++e) { const float lb = e < 4 ? lb0[e] : lb1[e - 4]; const float sg = sigmoidf_(fz[e]);
            kk[e] = (1.f - lb) * (1.f - sg); gc[e] = __logf(lb + (1.f - lb) * sg); qv[e] = siluf_(qv[e]); }
#pragma unroll
        for (int o = 1; o < 64; o <<= 1) {
#pragma unroll
            for (int e = 0; e < 8; ++e) { const float t = __shfl_up(gc[e], o); if (lane >= o) gc[e] += t; }
        }
        float xq[8], xk[8], xs[8], xt[8];
#pragma unroll
        for (int e = 0; e < 8; ++e) { const float gm = rdlane(gc[e], 31), g63 = rdlane(gc[e], 63);
            xq[e] = qv[e] * __expf(gc[e]); xk[e] = kk[e] * __expf(g63 - gc[e]);
            xs[e] = qv[e] * __expf(fminf(gc[e] - gm, 80.f)); xt[e] = kk[e] * __expf(fminf(gm - gc[e], 80.f));
            if (lane == e) decp[8 * g8 + e] = __expf(g63); }
        *(GAS v4u*)(tQG + lane * 128 + g8 * 16) = pack8(xq);
        store_col8(tKD, 8 * g8, lane, xk);
        *(LAS v4u*)(Qs + swz(lane, g8)) = pack8(xs); *(LAS v4u*)(Ks + swz(lane, g8)) = pack8(xt);
    }
#pragma unroll
    for (int c8 = 0; c8 < 8; ++c8) { float x[8]; unpack8(*(const GAS v4u*)(pr + PC_HI + h * 64 + 8 * c8), x); store_col8(tU, 8 * c8, lane, x); }
    LDS_WAIT();
    att_from_lds(Qs, Ks, tATT, r16, q, [](int, int) { return 1.f; });
    LDS_WAIT();
}

__device__ __forceinline__ void m1_gdn(Frame& F, int uidx, LAS unsigned char* lw) {
    GAS unsigned char* const ws = wsp();
    const int lane = lane_id_opaque(), r16 = lane & 15, q = lane >> 4;
    const int n = uidx % NCH64, t_ = uidx / NCH64, dir = t_ & 1, h = (t_ >> 1) & 3, b = t_ >> 3;
    int r0, step, t0; unit_rows(b, dir, n, r0, step, t0);
    const GAS bf16* GQ = (const GAS bf16*)(ws + WS_GQ) + h * 64; const GAS bf16* GK = (const GAS bf16*)(ws + WS_GK) + h * 64; const GAS bf16* GV = (const GAS bf16*)(ws + WS_GV) + h * 64;
    const GAS float* GSC = (const GAS float*)(ws + WS_GSC);
    GAS unsigned char* tu = ws + WS_TG + (size_t)uidx * 5 * 8192;
    GAS unsigned char* tW = tu, *tU = tu + 8192, *tKD = tu + 2 * 8192, *tQG = tu + 3 * 8192, *tATT = tu + 4 * 8192;
    LAS float* Am = (LAS float*)lw;
    const int myrow = r0 + step * lane;
    float gc = GSC[(size_t)myrow * 16 + dir * 4 + h]; const float beta = GSC[(size_t)myrow * 16 + 8 + dir * 4 + h];
#pragma unroll
    for (int o = 1; o < 64; o <<= 1) { const float t = __shfl_up(gc, o); if (lane >= o) gc += t; }
    const float g63 = rdlane(gc, 63);
#pragma unroll 1
    for (int nt = 0; nt < 4; ++nt) {
        const int i = 16 * nt + r16; const size_t irow = (size_t)(r0 + step * i) * 256;
        bf16x8 bk[2], bq[2];
#pragma unroll
        for (int ks = 0; ks < 2; ++ks) { bk[ks] = *(const GAS bf16x8*)(GK + irow + 32 * ks + 8 * q); bq[ks] = *(const GAS bf16x8*)(GQ + irow + 32 * ks + 8 * q); }
        const float gci = __shfl(gc, i), bti = __shfl(beta, i);
#pragma unroll
        for (int mt = 0; mt < 4; ++mt) {
            unsigned zz; asm volatile("v_mov_b32 %0, 0" : "=v"(zz)); v2u w = (v2u){zz, zz};
            if (mt <= nt) {
                f32x4 a1 = (f32x4){0.f, 0.f, 0.f, 0.f}, a2 = a1;
#pragma unroll
                for (int ks = 0; ks < 2; ++ks) { const bf16x8 ka = *(const GAS bf16x8*)(GK + (size_t)(r0 + step * (16 * mt + r16)) * 256 + 32 * ks + 8 * q); a1 = MFMA16(ka, bk[ks], a1); a2 = MFMA16(ka, bq[ks], a2); }
                f32x4 av; float y[4];
#pragma unroll
                for (int r = 0; r < 4; ++r) { const int j = 16 * mt + 4 * q + r; const float gcj = __shfl(gc, j); const float dcy = __expf(fminf(gci - gcj, 0.f));
                    av[r] = (j < i) ? bti * a1[r] * dcy : 0.f; y[r] = (j <= i) ? a2[r] * dcy : 0.f; }
                *(LAS f32x4*)(Am + i * 64 + 16 * mt + 4 * q) = av;
                w.x = pk2(y[0], y[1]); w.y = pk2(y[2], y[3]);
            }
            *(GAS v2u*)(tATT + i * 128 + (16 * mt + 4 * q) * 2) = w;
        }
    }
    { const GAS bf16* qr = GQ + (size_t)myrow * 256; const float eg = __expf(gc);
#pragma unroll
        for (int c8 = 0; c8 < 8; ++c8) { float x[8]; unpack8(*(const GAS v4u*)(qr + 8 * c8), x);
#pragma unroll
            for (int e = 0; e < 8; ++e) x[e] *= eg;
            *(GAS v4u*)(tQG + lane * 128 + c8 * 16) = pack8(x); } }
    ((GAS float*)(ws + WS_DEC))[(size_t)(0 * UNITS + uidx) * 64 + lane] = __expf(g63);
    const float begc = beta * __expf(gc), kdf = __expf(g63 - gc);
    LDS_WAIT();
#define GDN_SOLVE(x) do { _Pragma("unroll") for (int i = 1; i < 64; ++i) { asm volatile("" ::: "memory"); float su = x[i]; \
        _Pragma("unroll") for (int j4 = 0; j4 < (i + 3) / 4; ++j4) { const f32x4 a = *(const LAS f32x4*)(Am + i * 64 + 4 * j4); \
            _Pragma("unroll") for (int r = 0; r < 4; ++r) { const int j = 4 * j4 + r; if (j < i) su -= a[r] * x[j]; } } \
        asm volatile("" : "+v"(su)); x[i] = su; } } while (0)
    const unsigned ul = (unsigned)lane;
    {   float x[64];
#pragma unroll
        for (int i = 0; i < 64; ++i) { const GAS bf16* rp = GV + (size_t)(r0 + step * i) * 256; x[i] = rdlane(beta, i) * bf2f(rp[ul]); }
        GDN_SOLVE(x);
#pragma unroll
        for (int c8 = 0; c8 < 8; ++c8) { float y[8];
#pragma unroll
            for (int e = 0; e < 8; ++e) y[e] = x[8 * c8 + e];
            *(GAS v4u*)(tU + lane * 128 + c8 * 16) = pack8(y); }
    }
    asm volatile("" ::: "memory");
    {   float x[64];
#pragma unroll
        for (int i = 0; i < 64; ++i) { const GAS bf16* rp = GK + (size_t)(r0 + step * i) * 256; x[i] = rdlane(begc, i) * bf2f(rp[ul]); }
        GDN_SOLVE(x);
#pragma unroll
        for (int i = 0; i < 64; ++i) *(GAS bf16*)(tW + i * 128 + lane * 2) = (bf16)f2bf(-x[i]);
    }
    asm volatile("" ::: "memory");
#pragma unroll
    for (int c8 = 0; c8 < 8; ++c8) { float y[8];
#pragma unroll
        for (int e = 0; e < 8; ++e) { const int i = 8 * c8 + e; const GAS bf16* rp = GK + (size_t)(r0 + step * i) * 256; y[e] = bf2f(rp[ul]) * rdlane(kdf, i); }
        *(GAS v4u*)(tKD + lane * 128 + c8 * 16) = pack8(y); }
#undef GDN_SOLVE
    LDS_WAIT();
}
__device__ __forceinline__ void phase_m1(Frame& F, int l) {
    frame_refresh(F);
    LAS unsigned char* lw = F.lds + F.wave * 16384;
    const int gw = F.bid * 8 + F.wave, NGW = F.G * 8;
    for (int it = gw; it < 3 * UNITS; it += NGW) {
        const int m = it / UNITS, u = it - m * UNITS;
#ifndef M1MASK
#define M1MASK 7
#endif
        if (m == 0) { if (M1MASK & 1) m1_gdn(F, u, lw); }
        else if (m == 1) { if (M1MASK & 2) m1_hgrn(F, l, u, lw); }
        else { if (M1MASK & 4) m1_ret(F, l, u, lw); }
    }
}

__device__ __forceinline__ void scan_s5(Frame& F, int l, int sub, LAS unsigned char* lds) {
    GAS unsigned char* const ws = wsp();
    const int lane = lane_id_opaque(), g = sub & 15, dir = (sub >> 4) & 1, b = sub >> 5;
    const GAS bf16* P = (const GAS bf16*)(ws + WS_P);
    GAS float* O = (GAS float*)(ws + WS_O5) + (size_t)dir * R * 256;
    const int ldg = (l * 2 + dir) * 16 + g;
    const GAS float* LAM = (const GAS float*)(ws + WS_S5LAM) + (size_t)(ldg * 64 + lane) * 2;
    const GAS float* BB = (const GAS float*)(ws + WS_S5B) + (size_t)(ldg * 64 + lane) * 32;
    const float lr = LAM[0], li = LAM[1];
    float br[16], bi[16];
#pragma unroll
    for (int c = 0; c < 16; ++c) { br[c] = BB[2 * c]; bi[c] = BB[2 * c + 1]; }
    LAS float* US = (LAS float*)lds; LAS float* HS = US + 1024; LAS float* CS = HS + 32 * 130; LAS float* YS = CS + 2048;
    { const GAS float* cre = inp(I_S5CRE) + (size_t)ldg * 16 * 64; const GAS float* cim = inp(I_S5CIM) + (size_t)ldg * 16 * 64;
        for (int i = lane; i < 1024; i += 64) { CS[i * 2] = cre[i]; CS[i * 2 + 1] = cim[i]; } }
    float hr = 0.f, hi = 0.f;
    v4u ust;
    auto load = [&](int c) { int r0, step, t0; chunk_rows(b, dir, c, r0, step, t0); const int tt = lane >> 1, half = lane & 1; const int row = r0 + step * tt;
        ust = *(const GAS v4u*)(P + (size_t)row * DPP + PC_S5U + g * 16 + half * 8); };
    auto stage = [&](int buf) { const int tt = lane >> 1, half = lane & 1; LAS float* u = US + buf * 512 + tt * 16 + half * 8; const unsigned w[4] = {ust.x, ust.y, ust.z, ust.w};
        *(LAS f32x4*)u = (f32x4){bflo(w[0]), bfhi(w[0]), bflo(w[1]), bfhi(w[1])}; *(LAS f32x4*)(u + 4) = (f32x4){bflo(w[2]), bfhi(w[2]), bflo(w[3]), bfhi(w[3])}; };
    load(0); stage(0);
    for (int c = 0; c < NCHUNK; ++c) {
        const int buf = c & 1;
        if (c + 1 < NCHUNK) load(c + 1);
        LDS_WAIT();
        const LAS float* U = US + buf * 512;
        for (int tt = 0; tt < TCH; ++tt) {
            f32x4 u[4];
#pragma unroll
            for (int i = 0; i < 4; ++i) u[i] = *(const LAS f32x4*)(U + tt * 16 + 4 * i);
            float ar = 0.f, ai = 0.f;
#pragma unroll
            for (int cc = 0; cc < 16; ++cc) { ar += br[cc] * u[cc >> 2][cc & 3]; ai += bi[cc] * u[cc >> 2][cc & 3]; }
            const float nr = lr * hr - li * hi + ar, ni = lr * hi + li * hr + ai;
            hr = nr; hi = ni;
            *(LAS f32x2*)(HS + tt * 130 + lane * 2) = (f32x2){hr, hi};
        }
        LDS_WAIT();
        { const int cc = lane & 15, tq = lane >> 4;
            float acc[8];
#pragma unroll
            for (int k = 0; k < 8; ++k) acc[k] = 0.f;
            for (int p = 0; p < 64; ++p) {
                const f32x2 cv = *(const LAS f32x2*)(CS + (cc * 64 + p) * 2);
#pragma unroll
                for (int k = 0; k < 8; ++k) { const f32x2 hv = *(const LAS f32x2*)(HS + (tq * 8 + k) * 130 + p * 2); acc[k] += cv[0] * hv[0] - cv[1] * hv[1]; }
            }
#pragma unroll
            for (int k = 0; k < 8; ++k) YS[(tq * 8 + k) * 16 + cc] = acc[k];
        }
        LDS_WAIT();
        { int r0, step, t0; chunk_rows(b, dir, c, r0, step, t0); const int tt = lane >> 1, half = lane & 1; const int row = r0 + step * tt;
            GAS float* op = O + (size_t)row * 256 + g * 16 + half * 8;
            *(GAS f32x4*)op = *(const LAS f32x4*)(YS + tt * 16 + half * 8); *(GAS f32x4*)(op + 4) = *(const LAS f32x4*)(YS + tt * 16 + half * 8 + 4); }
        if (c + 1 < NCHUNK) stage(buf ^ 1);
    }
}
__device__ __forceinline__ void phase_scans(Frame& F, int l) {
    frame_refresh(F);
    if (F.wave < 2) {
        LAS unsigned char* lds = F.lds + F.wave * 65536;
        for (int it = F.wave * F.G + F.bid; it < 512; it += 2 * F.G) {
            const int kind = it >> 7, sub = it & 127;
            if (kind == 0) chain_run<0>(F, sub);
            else if (kind == 1) scan_s5(F, l, sub, lds);
            else if (kind == 2) chain_run<1>(F, sub);
            else chain_run<2>(F, sub);
        }
    }
}

__device__ __forceinline__ void phase_readout(Frame& F, int l) {
    frame_refresh(F); GAS unsigned char* const ws = wsp();
    const GAS bf16* P = (const GAS bf16*)(ws + WS_P);
    GAS bf16* MIX = (GAS bf16*)(ws + WS_MIX); GAS bf16* YA = (GAS bf16*)(ws + WS_GQ);
    GAS float* O5 = (GAS float*)(ws + WS_O5); const GAS bf16* OB = (const GAS bf16*)(ws + WS_OB);
    const int gw = F.bid * 8 + F.wave, NGW = F.G * 8, lane = F.lane;
    const int dch = (4 * lane) & 63;
    const f32x4 gnw = *(const GAS f32x4*)(inp(I_GNW) + l * 64 + dch), hnw = *(const GAS f32x4*)(inp(I_HNW) + l * 64 + dch);
    const f32x4 dsk = *(const GAS f32x4*)(inp(I_S5D) + l * 256 + 4 * lane);
    const size_t OBS = (size_t)R * 256;
    for (int row = gw; row < R; row += NGW) {
        const GAS bf16* pr = P + (size_t)row * DPP;
        const size_t ro = (size_t)row * 256 + 4 * lane;
#pragma unroll
        for (int m = 0; m < 3; ++m) {
            const v2u of = *(const GAS v2u*)(OB + (size_t)(m * 2) * OBS + ro), ob = *(const GAS v2u*)(OB + (size_t)(m * 2 + 1) * OBS + ro);
            const float o[4] = {bflo(of.x) + bflo(ob.x), bfhi(of.x) + bfhi(ob.x), bflo(of.y) + bflo(ob.y), bfhi(of.y) + bfhi(ob.y)};
            const float ss = sum16(o[0] * o[0] + o[1] * o[1] + o[2] * o[2] + o[3] * o[3]);
            const float r = 1.f / sqrtf(ss * (1.f / 64.f) + RMS_EPS);
            const int gc = (m == 0 ? PC_GZ : (m == 1 ? PC_HG : PC_RG)) + 4 * lane;
            const v2u gw2 = *(const GAS v2u*)(pr + gc);
            const float gt[4] = {bflo(gw2.x), bfhi(gw2.x), bflo(gw2.y), bfhi(gw2.y)};
            float y[4];
#pragma unroll
            for (int i = 0; i < 4; ++i) { const float nw = m == 0 ? gnw[i] : (m == 1 ? hnw[i] : 1.f); y[i] = o[i] * r * nw * siluf_(gt[i]); }
            v2u w; w.x = pk2(y[0], y[1]); w.y = pk2(y[2], y[3]);
            *(GAS v2u*)(MIX + (size_t)row * D + (m == 0 ? 0 : (m == 1 ? 512 : 768)) + 4 * lane) = w;
        }
        { const f32x4 o = *(const GAS f32x4*)(O5 + ro) + *(const GAS f32x4*)(O5 + OBS + ro);
            const v2u uw = *(const GAS v2u*)(pr + PC_S5U + 4 * lane);
            const float u[4] = {bflo(uw.x), bfhi(uw.x), bflo(uw.y), bfhi(uw.y)};
            f32x4 ya;
#pragma unroll
            for (int i = 0; i < 4; ++i) ya[i] = gelu_tanh(o[i] + dsk[i] * u[i]);
            *(GAS f32x4*)(O5 + ro) = ya;
            v2u w; w.x = pk2(ya[0], ya[1]); w.y = pk2(ya[2], ya[3]); *(GAS v2u*)(YA + ro) = w; }
    }
}

template <bool ROUTE>
__device__ __forceinline__ void phase_ln(Frame& F, int l, int which) {
    frame_refresh(F); GAS unsigned char* const ws = wsp();
    const GAS float* Y = (const GAS float*)(ws + WS_Y);
    const GAS float* MOD = (const GAS float*)(ws + WS_MOD);
    const GAS float* lg = inp(I_LNG) + (size_t)(l * 2 + which) * D; const GAS float* lb = inp(I_LNB) + (size_t)(l * 2 + which) * D;
    const bool last = (l == DEPTH - 1 && which == 1);
    const int nl = which == 0 ? l : l + 1, shoff = which == 0 ? 3072 : 0, scoff = which == 0 ? 4096 : 1024;
    const int lane = F.lane;
    GAS float* xl = outp(); GAS float* xc = (GAS float*)(ws + WS_XC); GAS bf16* Ab = (GAS bf16*)(ws + WS_A);
    if constexpr (!ROUTE) {
        const int gw = F.bid * 8 + F.wave, NGW = F.G * 8;
        const int nrows = last ? NLAT : R;
        for (int row = gw; row < nrows; row += NGW) {
            f32x4 v[4];
#pragma unroll
            for (int j = 0; j < 4; ++j) v[j] = *(const GAS f32x4*)(Y + (size_t)row * D + 4 * lane + 256 * j);
            ln_row(v, lg, lb, lane);
            GAS float* xd = xrow_dst(xl, xc, row);
#pragma unroll
            for (int j = 0; j < 4; ++j) *(GAS f32x4*)(xd + 4 * lane + 256 * j) = v[j];
            if (!last) store_A_row(Ab, lane, row, v, MOD + (size_t)(nl * 5 + row_slot(row)) * 6144, shoff, scoff);
        }
    } else {
        LAS int* cnt = (LAS int*)F.lds;
        if (F.tid < 8) cnt[F.tid] = 0;
        __syncthreads();
        const GAS float* rw = inp(I_MROUTER) + (size_t)(l >> 1) * D * NEXP;
        f32x4 rwa[4][4][2];
#pragma unroll
        for (int j = 0; j < 4; ++j)
#pragma unroll
            for (int i = 0; i < 4; ++i) { const GAS float* p = rw + (size_t)(4 * lane + 256 * j + i) * 8; rwa[j][i][0] = *(const GAS f32x4*)p; rwa[j][i][1] = *(const GAS f32x4*)(p + 4); }
        GAS int* TOPE = (GAS int*)(ws + WS_TOPE); GAS float* TOPG = (GAS float*)(ws + WS_TOPG);
        const int RPW = (R + F.G - 1) / F.G, rbeg = F.bid * RPW, rend = min(R, rbeg + RPW);
        for (int row = rbeg + F.wave; row < rend; row += 8) {
            f32x4 v[4];
#pragma unroll
            for (int j = 0; j < 4; ++j) v[j] = *(const GAS f32x4*)(Y + (size_t)row * D + 4 * lane + 256 * j);
            ln_row(v, lg, lb, lane);
            GAS float* xd = xrow_dst(xl, xc, row);
#pragma unroll
            for (int j = 0; j < 4; ++j) *(GAS f32x4*)(xd + 4 * lane + 256 * j) = v[j];
            const GAS float* modrow = MOD + (size_t)(nl * 5 + row_slot(row)) * 6144;
            store_A_row(Ab, lane, row, v, modrow, shoff, scoff);
            float lgt[8];
#pragma unroll
            for (int e = 0; e < 8; ++e) lgt[e] = 0.f;
#pragma unroll
            for (int j = 0; j < 4; ++j) { const int c = 4 * lane + 256 * j; const f32x4 sh = *(const GAS f32x4*)(modrow + shoff + c), sc = *(const GAS f32x4*)(modrow + scoff + c);
                const f32x4 hv = v[j] * (sc + 1.f) + sh;
#pragma unroll
                for (int i = 0; i < 4; ++i)
#pragma unroll
                    for (int e = 0; e < 8; ++e) lgt[e] += hv[i] * rwa[j][i][e >> 2][e & 3]; }
#pragma unroll
            for (int e = 0; e < 8; ++e) lgt[e] = wave_sum(lgt[e]);
            int e0 = 0; float v0 = lgt[0];
#pragma unroll
            for (int e = 1; e < 8; ++e) if (lgt[e] > v0) { v0 = lgt[e]; e0 = e; }
            int e1 = -1; float v1 = -3.0e38f;
#pragma unroll
            for (int e = 0; e < 8; ++e) if (e != e0 && lgt[e] > v1) { v1 = lgt[e]; e1 = e; }
            if (lane == 0) { const float ex = __expf(v1 - v0); const float g0 = 1.f / (1.f + ex); TOPE[row] = e0 | (e1 << 8); TOPG[row * 2] = g0; TOPG[row * 2 + 1] = ex * g0;
                __hip_atomic_fetch_add(&cnt[e0], 1, __ATOMIC_RELAXED, __HIP_MEMORY_SCOPE_WORKGROUP); __hip_atomic_fetch_add(&cnt[e1], 1, __ATOMIC_RELAXED, __HIP_MEMORY_SCOPE_WORKGROUP); }
        }
        __syncthreads();
        if (F.tid < 8) ((GAS int*)(ws + WS_WGCNT))[F.bid * 8 + F.tid] = cnt[F.tid];
    }
}

__device__ __forceinline__ void phase_moe_assign(Frame& F) {
    frame_refresh(F); GAS unsigned char* const ws = wsp();
    LAS int* sm = (LAS int*)F.lds;
    const GAS int* WGCNT = (const GAS int*)(ws + WS_WGCNT);
    if (F.tid < 8) { int tot = 0, pre = 0; for (int w = 0; w < F.G; ++w) { const int c = WGCNT[w * 8 + F.tid]; tot += c; if (w < F.bid) pre += c; } sm[16 + F.tid] = tot; sm[24 + F.tid] = pre; sm[8 + F.tid] = 0; }
    __syncthreads();
    if (F.tid == 0) { int ps = 0; GAS int* info = (GAS int*)(ws + WS_MOEINFO);
        for (int e = 0; e < 8; ++e) { sm[e] = ps + sm[24 + e]; if (F.bid == 0) info[e] = ps >> 8; ps += (sm[16 + e] + 255) & ~255; }
        if (F.bid == 0) { info[8] = ps >> 8; } }
    __syncthreads();
    if (F.bid == 0 && F.tid < 272) { GAS int* info = (GAS int*)(ws + WS_MOEINFO); int ps = 0, e = 0;
        for (int q = 0; q < 8; ++q) { ps += (sm[16 + q] + 255) >> 8; if (F.tid >= ps) e = q + 1; }
        info[16 + F.tid] = e < 8 ? e : 7; }
    __syncthreads();
    const GAS int* TOPE = (const GAS int*)(ws + WS_TOPE); const GAS float* TOPG = (const GAS float*)(ws + WS_TOPG);
    GAS int* TOKPOS = (GAS int*)(ws + WS_TOKPOS); GAS float* ROWG = (GAS float*)(ws + WS_ROWG);
    const GAS bf16* A = (const GAS bf16*)(ws + WS_A); GAS bf16* XG = (GAS bf16*)(ws + WS_XG);
    const int RPW = (R + F.G - 1) / F.G, rbeg = F.bid * RPW, rend = min(R, rbeg + RPW);
    for (int row = rbeg + F.wave; row < rend; row += 8) {
        int p0 = 0, p1 = 0;
        if (F.lane == 0) { const int te = TOPE[row]; const int e0 = te & 255, e1 = te >> 8;
            p0 = sm[e0] + __hip_atomic_fetch_add(&sm[8 + e0], 1, __ATOMIC_RELAXED, __HIP_MEMORY_SCOPE_WORKGROUP); p1 = sm[e1] + __hip_atomic_fetch_add(&sm[8 + e1], 1, __ATOMIC_RELAXED, __HIP_MEMORY_SCOPE_WORKGROUP);
            TOKPOS[row * 2] = p0; TOKPOS[row * 2 + 1] = p1; ROWG[p0] = TOPG[row * 2]; ROWG[p1] = TOPG[row * 2 + 1]; }
        p0 = __shfl(p0, 0); p1 = __shfl(p1, 0);
        const v4u a0 = *(const GAS v4u*)(A + (size_t)row * D + 8 * F.lane), a1 = *(const GAS v4u*)(A + (size_t)row * D + 512 + 8 * F.lane);
        *(GAS v4u*)(XG + (size_t)p0 * D + 8 * F.lane) = a0; *(GAS v4u*)(XG + (size_t)p0 * D + 512 + 8 * F.lane) = a1;
        *(GAS v4u*)(XG + (size_t)p1 * D + 8 * F.lane) = a0; *(GAS v4u*)(XG + (size_t)p1 * D + 512 + 8 * F.lane) = a1;
    }
}
__device__ __forceinline__ void phase_moe_combine(Frame& F, int l) {
    frame_refresh(F); GAS unsigned char* const ws = wsp();
    const GAS float* MOD = (const GAS float*)(ws + WS_MOD);
    const GAS float* lg = inp(I_LNG) + (size_t)(l * 2 + 1) * D; const GAS float* lb = inp(I_LNB) + (size_t)(l * 2 + 1) * D;
    const bool last = (l == DEPTH - 1);
    const GAS int* TOKPOS = (const GAS int*)(ws + WS_TOKPOS); const GAS bf16* YB = (const GAS bf16*)(ws + WS_XG);
    const int gw = F.bid * 8 + F.wave, NGW = F.G * 8, lane = F.lane;
    const int nrows = last ? NLAT : R;
    GAS float* xl = outp(); GAS float* xc = (GAS float*)(ws + WS_XC); GAS bf16* Ab = (GAS bf16*)(ws + WS_A);
    for (int row = gw; row < nrows; row += NGW) {
        const int p0 = TOKPOS[row * 2], p1 = TOKPOS[row * 2 + 1];
        const GAS float* xs = xrow_src(xl, xc, row);
        const GAS float* gp = MOD + (size_t)(l * 5 + row_slot(row)) * 6144 + 5120;
        f32x4 v[4];
#pragma unroll
        for (int j = 0; j < 4; ++j) { const int c = 4 * lane + 256 * j;
            const v2u y0 = *(const GAS v2u*)(YB + (size_t)p0 * D + c), y1 = *(const GAS v2u*)(YB + (size_t)p1 * D + c);
            const f32x4 f = (f32x4){bflo(y0.x) + bflo(y1.x), bfhi(y0.x) + bfhi(y1.x), bflo(y0.y) + bflo(y1.y), bfhi(y0.y) + bfhi(y1.y)};
            v[j] = *(const GAS f32x4*)(xs + c) * ALPHA + *(const GAS f32x4*)(gp + c) * f; }
        ln_row(v, lg, lb, lane);
        GAS float* xd = xrow_dst(xl, xc, row);
#pragma unroll
        for (int j = 0; j < 4; ++j) *(GAS f32x4*)(xd + 4 * lane + 256 * j) = v[j];
        if (!last) store_A_row(Ab, lane, row, v, MOD + (size_t)((l + 1) * 5 + row_slot(row)) * 6144, 0, 1024);
    }
}

#ifndef PHMASK
#define PHMASK 0xFFFFFFFFu
#endif
#define PK(k) ((PHMASK >> (k)) & 1u)
constexpr int PPL = 12, NPHASE = 2 + DEPTH * PPL;
__global__ void __launch_bounds__(512, 2) fwd(Args args) {
    extern __shared__ __attribute__((aligned(16))) unsigned char lds_raw[];
    Frame F;
    F.lds = (LAS unsigned char*)lds_raw;
    F.tid = threadIdx.x; F.lane = F.tid & 63; F.wave = __builtin_amdgcn_readfirstlane(F.tid >> 6); F.G = gridDim.x; F.bid = blockIdx.x;
    volatile LAS unsigned* MISC = (volatile LAS unsigned*)(F.lds + LDSCTL_OFF);
    if (F.tid < 64) MISC[F.tid] = 0u;
    __syncthreads();
#if MK_ONE_LAUNCH
    XcdBarrier bar = xcd_barrier_post((GAS unsigned*)(args.ws + WS_CTL) + 4096, MISC + 8, F.wave);
#else
    const int lo = args.ph_lo, hi = args.ph_hi;
    XcdBarrier bar; bar.bar = (GAS unsigned*)(args.ws + WS_CTL) + 4096; bar.x = 0; bar.st = nullptr;
    if (hi - lo > 1) bar = xcd_barrier_post((GAS unsigned*)(args.ws + WS_CTL) + 4096, MISC + 8, F.wave);
#endif
#if MK_ONE_LAUNCH
#define IN(k) true
#define SEAM(k) xcd_barrier(bar, F.wave)
#else
#define IN(k) (lo <= (k) && (k) < hi)
#define SEAM(k) do { if (IN((k) + 1)) xcd_barrier(bar, F.wave); } while (0)
#endif
    LAS unsigned char* ring = F.lds;

    if (IN(0)) { if (PK(0)) phase_prologue(F); SEAM(0); }
    if (IN(1)) { if (PK(1)) phase_a0(F); SEAM(1); }
    for (int l = 0; l < DEPTH; ++l) {
        const int pb = 2 + l * PPL;
        const bool moe = (l & 1) != 0;
        if (PK(3) && IN(pb + 0)) {
            GAS unsigned char* const ws = wsp();
            pg8::Gemm g{(const GAS bf16*)(ws + WS_A), (const GAS bf16*)(ws + WS_WIN) + (size_t)l * DPW * D, D};
            pg8::StaticOrder S; S.init(R / 256, DPW / 256, D, F.G, F.bid);
            pg8::EpiBf16 E{(GAS bf16*)(ws + WS_P), DPP, DPROJ};
            pg8::gemm_phase<pg8::EpiBf16, pg8::StaticOrder, true, true>(ring, F.wave, g, S, E);
            SEAM(pb + 0);
        }
        if (IN(pb + 1)) { if (PK(4)) phase_gdn_prep(F, l); SEAM(pb + 1); }
        if (IN(pb + 2)) { if (PK(18)) phase_m1(F, l); SEAM(pb + 2); }
        if (IN(pb + 3)) { if (PK(5)) phase_scans(F, l); SEAM(pb + 3); }
        if (IN(pb + 4)) { if (PK(6)) phase_readout(F, l); if (PK(2) && moe) phase_moe_convert(F, l >> 1); SEAM(pb + 4); }
        if (PK(7) && IN(pb + 5)) {
            GAS unsigned char* const ws = wsp();
            pg8::Gemm g{(const GAS bf16*)(ws + WS_GQ), (const GAS bf16*)(ws + WS_WGLU) + (size_t)l * 65536, 256};
            pg8::StaticOrder S; S.init(R / 256, 1, 256, F.G, F.bid);
            pg8::EpiGlu E{(GAS bf16*)(ws + WS_MIX), (const GAS float*)(ws + WS_O5), inp(I_S5GLUB) + l * 256};
            pg8::gemm_phase<pg8::EpiGlu, pg8::StaticOrder, true, true>(ring, F.wave, g, S, E);
            SEAM(pb + 5);
        }
        if (PK(8) && IN(pb + 6)) {
            GAS unsigned char* const ws = wsp(); const GAS float* modl = (const GAS float*)(ws + WS_MOD) + (size_t)l * 5 * 6144;
            pg8::Gemm g{(const GAS bf16*)(ws + WS_MIX), (const GAS bf16*)(ws + WS_WOUT) + (size_t)l * D * D, D};
            pg8::StaticOrder S; S.init(R / 256, D / 256, D, F.G, F.bid);
            pg8::EpiRes E{(GAS float*)(ws + WS_Y), l == 0 ? inp(I_X) : (const GAS float*)outp(), l == 0 ? inp(I_CTX) : (const GAS float*)(ws + WS_XC), modl, 2048};
            pg8::gemm_phase<pg8::EpiRes, pg8::StaticOrder, true, true>(ring, F.wave, g, S, E);
            SEAM(pb + 6);
        }
        if (IN(pb + 7)) { if (moe) { if (PK(9)) phase_ln<true>(F, l, 0); } else { if (PK(10)) phase_ln<false>(F, l, 0); } SEAM(pb + 7); }
        if (!moe) {
            if (PK(11) && IN(pb + 8)) {
                GAS unsigned char* const ws = wsp();
                pg8::Gemm g{(const GAS bf16*)(ws + WS_A), (const GAS bf16*)(ws + WS_WF13) + (size_t)(l >> 1) * 2 * FFD * D, D};
                pg8::StaticOrder S; S.init(R / 256, 2 * FFD / 256, D, F.G, F.bid);
                pg8::EpiSwiGlu E{(GAS bf16*)(ws + WS_HID), FFD};
                pg8::gemm_phase<pg8::EpiSwiGlu, pg8::StaticOrder, true, true>(ring, F.wave, g, S, E);
                SEAM(pb + 8);
            }
            if (PK(12) && IN(pb + 9)) {
                GAS unsigned char* const ws = wsp(); const GAS float* modl = (const GAS float*)(ws + WS_MOD) + (size_t)l * 5 * 6144;
                pg8::Gemm g{(const GAS bf16*)(ws + WS_HID), (const GAS bf16*)(ws + WS_WF2) + (size_t)(l >> 1) * D * FFD, FFD};
                pg8::StaticOrder S; S.init(R / 256, D / 256, FFD, F.G, F.bid);
                pg8::EpiRes E{(GAS float*)(ws + WS_Y), (const GAS float*)outp(), (const GAS float*)(ws + WS_XC), modl, 5120};
                pg8::gemm_phase<pg8::EpiRes, pg8::StaticOrder, true, true>(ring, F.wave, g, S, E);
                SEAM(pb + 9);
            }
            if (IN(pb + 10)) { if (PK(13)) phase_ln<false>(F, l, 1); SEAM(pb + 11); }
        } else {
            if (IN(pb + 8)) { if (PK(14)) phase_moe_assign(F); SEAM(pb + 8); }
            if (PK(15) && IN(pb + 9)) {
                GAS unsigned char* const ws = wsp();
                const GAS int* info = (const GAS int*)(ws + WS_MOEINFO);
                pg8::Gemm g{(const GAS bf16*)(ws + WS_XG), (const GAS bf16*)(ws + WS_WM13), D};
                pg8::MoeOrder S; S.init(info[8], 2 * FFE / 256, D, F.G, F.bid);
                S.texp = info + 16; S.estride = (size_t)2 * FFE * D * 2;
                pg8::EpiSwiGlu E{(GAS bf16*)(ws + WS_MHID), FFE};
                pg8::gemm_phase<pg8::EpiSwiGlu, pg8::MoeOrder, true, true>(ring, F.wave, g, S, E);
                SEAM(pb + 9);
            }
            if (PK(16) && IN(pb + 10)) {
                GAS unsigned char* const ws = wsp();
                const GAS int* info = (const GAS int*)(ws + WS_MOEINFO);
                pg8::Gemm g{(const GAS bf16*)(ws + WS_MHID), (const GAS bf16*)(ws + WS_WM2), FFE};
                pg8::MoeOrder S; S.init(info[8], D / 256, FFE, F.G, F.bid);
                S.texp = info + 16; S.estride = (size_t)D * FFE * 2;
                pg8::EpiMoeDown E{(GAS bf16*)(ws + WS_XG), (const GAS float*)(ws + WS_ROWG)};
                pg8::gemm_phase<pg8::EpiMoeDown, pg8::MoeOrder, true, true>(ring, F.wave, g, S, E);
                SEAM(pb + 10);
            }
            if (IN(pb + 11)) { if (PK(17)) phase_moe_combine(F, l); if (l < DEPTH - 1) SEAM(pb + 11); }
        }
    }
#undef IN
#undef SEAM
}

extern "C" void kernel_launch(void* const* d_in, const int* in_sizes, int n_in, void* d_out, int out_size, void* d_ws, size_t ws_size, hipStream_t stream) {
    static int grid = 0;
    if (grid == 0) {
        if (n_in != 34 || out_size != NLAT * D || ws_size < WS_END) { fprintf(stderr, "kernel_launch: unexpected shapes (n_in %d out %d ws %zu need %zu)\n", n_in, out_size, ws_size, (size_t)WS_END); grid = -1; return; }
        int dev = 0, cus = 0, per_cu = 0;
        if (hipGetDevice(&dev) != hipSuccess || hipDeviceGetAttribute(&cus, hipDeviceAttributeMultiprocessorCount, dev) != hipSuccess) { grid = -1; return; }
        if (hipFuncSetAttribute((const void*)fwd, hipFuncAttributeMaxDynamicSharedMemorySize, LDS_BYTES) != hipSuccess) { fprintf(stderr, "kernel_launch: hipFuncSetAttribute failed\n"); grid = -1; return; }
        if (hipOccupancyMaxActiveBlocksPerMultiprocessor(&per_cu, (const void*)fwd, 512, LDS_BYTES) != hipSuccess || per_cu < 1) fprintf(stderr, "kernel_launch: occupancy query reports %d\n", per_cu);
        (void)hipGetLastError();
        grid = cus;
    }
    if (grid < 0) return;
    (void)hipMemsetAsync((char*)d_ws + WS_CTL, 0, CTL_ZERO_BYTES, stream);
    Args a{};
    for (int i = 0; i < 34; ++i) a.in[i] = (const float*)d_in[i];
    a.out = (float*)d_out; a.ws = (unsigned char*)d_ws;
#if MK_ONE_LAUNCH
    a.ph_lo = 0; a.ph_hi = NPHASE;
    hipLaunchKernelGGL(fwd, dim3(grid), dim3(512), LDS_BYTES, stream, a);
#else
    for (int p = 0; p < NPHASE; ++p) {
        if (p >= 2) { const int l = (p - 2) / PPL, k = (p - 2) % PPL; const bool moe = (l & 1) != 0; if (k == 11 && !moe) continue; }
        a.ph_lo = p; a.ph_hi = p + 1;
        hipLaunchKernelGGL(fwd, dim3(grid), dim3(512), LDS_BYTES, stream, a);
    }
#endif
}
```

```cpp
#include <hip/hip_runtime.h>
#include <cstdio>
#include <cstdint>

#ifndef MK_ONE_LAUNCH
#define MK_ONE_LAUNCH 1
#endif

#define GAS __attribute__((address_space(1)))
#define LAS __attribute__((address_space(3)))
typedef unsigned short bf16;
typedef unsigned v4u __attribute__((ext_vector_type(4)));
typedef unsigned v2u __attribute__((ext_vector_type(2)));
typedef float f32x4 __attribute__((ext_vector_type(4)));
typedef float f32x2 __attribute__((ext_vector_type(2)));
typedef short bf16x8 __attribute__((ext_vector_type(8)));

constexpr int D = 1024, BATCH = 4, SEQ = 8192, CTXL = 256, DEPTH = 4;
constexpr int NLAT = BATCH * SEQ, NCTX = BATCH * CTXL, R = NLAT + NCTX;
constexpr int DPROJ = 3600, DPP = 3600, DPW = 3840;
constexpr int FFD = 2816, FFE = 3584, NEXP = 8;
constexpr int MOE_ROWS = 2 * R + NEXP * 256;
constexpr float ALPHA = 1.681792830507429f;
constexpr float LN_EPS = 1e-5f, RMS_EPS = 1e-6f;
constexpr int PC_GQKV = 0, PC_GZ = 768, PC_GA = 1024, PC_GB = 1032, PC_S5U = 1040, PC_HQ = 1296, PC_HF = 1552, PC_HI = 2064, PC_HG = 2320, PC_RQKV = 2576, PC_RG = 3344;
constexpr int NSEQ = CTXL + SEQ;
constexpr int TCH = 32, NCHUNK = NSEQ / TCH;

constexpr size_t MiB = 1u << 20;
constexpr size_t WS_CTL = 0, CTL_ZERO_BYTES = 1 * MiB;
constexpr size_t WS_MOD = 1 * MiB;
constexpr size_t WS_LB = WS_MOD + 512 * 1024;
constexpr size_t WS_ROT = WS_LB + 4096;
constexpr size_t WS_S5LAM = WS_ROT + 32768;
constexpr size_t WS_S5B = 2 * MiB;
constexpr size_t WS_TOPE = 3 * MiB;
constexpr size_t WS_TOPG = WS_TOPE + 256 * 1024;
constexpr size_t WS_TOKPOS = WS_TOPG + 512 * 1024;
constexpr size_t WS_ROWG = 4 * MiB + 256 * 1024;
constexpr size_t WS_WGCNT = 4 * MiB + 768 * 1024;
constexpr size_t WS_MOEINFO = WS_WGCNT + 16384;
constexpr size_t WS_GSC = 5 * MiB;
constexpr size_t WS_WIN = 8 * MiB;
constexpr size_t WS_WOUT = 38 * MiB;
constexpr size_t WS_WF13 = 46 * MiB;
constexpr size_t WS_WF2 = 68 * MiB;
constexpr size_t WS_WGLU = 79 * MiB;
constexpr size_t WS_WM13 = 80 * MiB;
constexpr size_t WS_WM2 = 192 * MiB;
constexpr size_t WS_XC = 248 * MiB;
constexpr size_t WS_A = 252 * MiB;
constexpr size_t WS_MIX = WS_A;
constexpr size_t WS_TG = 80 * MiB;
constexpr size_t WS_U = 318 * MiB;
constexpr size_t WS_P = WS_U;
constexpr size_t WS_Y = WS_U;
constexpr size_t WS_OB = 551 * MiB;
constexpr size_t WS_O5 = 650 * MiB;
constexpr size_t WS_S5A2 = WS_O5 + 33 * MiB;
constexpr size_t WS_S5HL = 252 * MiB;
constexpr size_t WS_S5EB = 270 * MiB;
constexpr size_t WS_S5WY = 1035 * MiB;
constexpr size_t WS_GQ = 716 * MiB, WS_GK = WS_GQ + 17 * MiB, WS_GV = WS_GK + 17 * MiB;
constexpr size_t WS_TH = 767 * MiB;
constexpr size_t WS_TR = 899 * MiB;
constexpr size_t WS_DEC = 1031 * MiB;
constexpr size_t WS_HID = 566 * MiB;
constexpr size_t WS_XG = WS_U;
constexpr size_t WS_MHID = 454 * MiB;
constexpr size_t WS_END = 1040 * MiB;
static_assert(WS_MHID + (size_t)MOE_ROWS * FFE * 2 <= WS_END && WS_XG + (size_t)MOE_ROWS * D * 2 <= WS_MHID, "ws map");
static_assert(WS_P + (size_t)R * 3600 * 2 <= WS_OB && WS_OB + (size_t)6 * R * 256 * 2 <= WS_O5 && WS_O5 + (size_t)2 * R * 256 * 4 <= WS_GQ && WS_GV + (size_t)R * 256 * 2 <= WS_TH, "ws map 2");
static_assert(WS_TH + (size_t)4224 * 4 * 8192 <= WS_TR && WS_TR + (size_t)4224 * 4 * 8192 <= WS_DEC && WS_DEC + (size_t)3 * 4224 * 256 <= WS_END && WS_TG + (size_t)4224 * 5 * 8192 <= 248 * MiB, "ws map 3");
static_assert(WS_HID + (size_t)R * FFD * 2 <= WS_END && WS_Y + (size_t)R * D * 4 <= WS_OB, "ws map 4");

constexpr int RING_BYTES = 131072, LDSCTL_OFF = RING_BYTES, LDS_BYTES = 147456;

typedef __bf16 hwbf16x2 __attribute__((ext_vector_type(2)));
__device__ __forceinline__ unsigned pk2(float lo, float hi) { f32x2 v = {lo, hi}; const hwbf16x2 r = __builtin_convertvector(v, hwbf16x2); return __builtin_bit_cast(unsigned, r); }
__device__ __forceinline__ unsigned f2bf(float f) { return pk2(f, 0.f) & 0xffffu; }
__device__ __forceinline__ float bflo(unsigned w) { return __builtin_bit_cast(float, w << 16); }
__device__ __forceinline__ float bfhi(unsigned w) { return __builtin_bit_cast(float, w & 0xffff0000u); }
__device__ __forceinline__ float bf2f(bf16 h) { return __builtin_bit_cast(float, (unsigned)h << 16); }
__device__ __forceinline__ int lane_id_opaque_fwd() { unsigned z; asm volatile("v_mov_b32 %0, 0" : "=v"(z)); return (int)__builtin_amdgcn_mbcnt_hi(~0u, __builtin_amdgcn_mbcnt_lo(~0u, z)); }
__device__ __forceinline__ float shfl_idx(float x, int src) { return __builtin_bit_cast(float, __builtin_amdgcn_ds_bpermute(src << 2, __builtin_bit_cast(int, x))); }
template <int CTRL>
__device__ __forceinline__ float dpp0(float x) { return __builtin_bit_cast(float, __builtin_amdgcn_update_dpp(0, __builtin_bit_cast(int, x), CTRL, 0xf, 0xf, true)); }
__device__ __forceinline__ float sum16(float v) {
    v += dpp0<0xB1>(v); v += dpp0<0x4E>(v); v += dpp0<0x141>(v); v += dpp0<0x140>(v); return v; }
__device__ __forceinline__ float wave_sum(float v) {
    v = sum16(v);
    const float a = __builtin_bit_cast(float, __builtin_amdgcn_readlane(__builtin_bit_cast(int, v), 0)), b = __builtin_bit_cast(float, __builtin_amdgcn_readlane(__builtin_bit_cast(int, v), 16));
    const float c = __builtin_bit_cast(float, __builtin_amdgcn_readlane(__builtin_bit_cast(int, v), 32)), d = __builtin_bit_cast(float, __builtin_amdgcn_readlane(__builtin_bit_cast(int, v), 48));
    return (a + b) + (c + d); }
__device__ __forceinline__ float sigmoidf_(float x) { return __builtin_amdgcn_rcpf(1.f + __expf(-x)); }
__device__ __forceinline__ float siluf_(float x) { return x * __builtin_amdgcn_rcpf(1.f + __expf(-x)); }
__device__ __forceinline__ float gelu_tanh(float x) { const float u = 0.7978845608028654f * (x + 0.044715f * x * x * x); const float t = 1.f - 2.f * __builtin_amdgcn_rcpf(__expf(2.f * u) + 1.f); return 0.5f * x * (1.f + t); }
#define LDS_WAIT() asm volatile("s_waitcnt lgkmcnt(0)" ::: "memory")

__device__ __forceinline__ int lane_id_opaque() { unsigned z; asm volatile("v_mov_b32 %0, 0" : "=v"(z)); return (int)__builtin_amdgcn_mbcnt_hi(~0u, __builtin_amdgcn_mbcnt_lo(~0u, z)); }
#define XB_TMO      128
#define XB_XCNT(j)  (256  + 64 * (j))
#define XB_XSUB(j)  (1280 + 64 * (j))
#define XB_XGEN(j)  (2304 + 64 * (j))
#define XB_TOP      3328
#define XB_TOPGEN   3392
#define XCD_BAR_WORDS 3456
#define XB_SPIN_CAP (1u << 18)
__device__ __forceinline__ unsigned xb_ld(GAS unsigned* p)              { return __hip_atomic_load(p, __ATOMIC_RELAXED, __HIP_MEMORY_SCOPE_AGENT); }
__device__ __forceinline__ unsigned xb_add(GAS unsigned* p, unsigned v) { return __hip_atomic_fetch_add(p, v, __ATOMIC_RELAXED, __HIP_MEMORY_SCOPE_AGENT); }
__device__ __forceinline__ unsigned xb_xcc_id() { return (unsigned)__builtin_amdgcn_s_getreg((3 << 11) | 20) & 0xFu; }
#define XB_SPIN(cond, bar) do { unsigned _sp = 0; while (cond) { __builtin_amdgcn_s_sleep(1); \
    if ((++_sp & 255u) == 0u) { if (xb_ld(&(bar)[XB_TMO])) break; if (_sp > XB_SPIN_CAP) { (void)xb_add(&(bar)[XB_TMO], 1u); break; } } } } while (0)
struct XcdBarrier { GAS unsigned* bar; unsigned x; volatile LAS unsigned* st; };
__device__ __forceinline__ bool xb_thread0(int wave_id) { return wave_id == 0 && lane_id_opaque() == 0; }
__device__ __forceinline__ XcdBarrier xcd_barrier_post(GAS unsigned* bar, volatile LAS unsigned* st, int wave_id) {
    XcdBarrier b; b.bar = bar; b.x = xb_xcc_id(); b.st = st;
    if (xb_thread0(wave_id)) (void)xb_add(&bar[XB_XCNT(b.x)], 1u);
    return b;
}
__device__ __forceinline__ void xcd_barrier_complete(GAS unsigned* bar, unsigned x, unsigned& nloc, unsigned& nx) {
    const unsigned G = gridDim.x * gridDim.y * gridDim.z;
    unsigned sum, cnt, mine, sp = 0u;
    for (;;) {
        sum = 0u; cnt = 0u; mine = 0u;
#pragma unroll
        for (unsigned j = 0; j < 16; ++j) { const unsigned c = xb_ld(&bar[XB_XCNT(j)]); sum += c; cnt += (c > 0u) ? 1u : 0u; mine = (j == x) ? c : mine; }
        if (sum == G) break;
        __builtin_amdgcn_s_sleep(1);
        if ((++sp & 255u) == 0u) { if (xb_ld(&bar[XB_TMO])) break; if (sp > XB_SPIN_CAP) { (void)xb_add(&bar[XB_TMO], 1u); break; } }
    }
    nloc = mine > 0u ? mine : 1u; nx = cnt > 0u ? cnt : 1u;
}
__device__ __forceinline__ void xcd_barrier(const XcdBarrier& b, int wave_id) {
    asm volatile("s_waitcnt vmcnt(0)" ::: "memory");
    __syncthreads();
    if (xb_thread0(wave_id)) {
        GAS unsigned* bar = b.bar; asm volatile("" : "+s"(bar));
        __builtin_amdgcn_s_waitcnt(0);
        unsigned nloc = b.st[0], nx = b.st[1];
        if (nloc == 0u) { xcd_barrier_complete(bar, b.x, nloc, nx); b.st[0] = nloc; b.st[1] = nx; }
        const unsigned old = xb_add(&bar[XB_XSUB(b.x)], 1u);
        const unsigned gen = old / nloc;
        if (old + 1u == (gen + 1u) * nloc) {
            __builtin_amdgcn_fence(__ATOMIC_RELEASE, "agent");
            asm volatile("s_waitcnt vmcnt(0)" ::: "memory");
            const unsigned og = xb_add(&bar[XB_TOP], 1u);
            const unsigned tg = og / nx;
            if (og + 1u == (tg + 1u) * nx) xb_add(&bar[XB_TOPGEN], 1u);
            else XB_SPIN(xb_ld(&bar[XB_TOPGEN]) == tg, bar);
            __builtin_amdgcn_fence(__ATOMIC_ACQUIRE, "agent");
            xb_add(&bar[XB_XGEN(b.x)], 1u);
            asm volatile("s_waitcnt vmcnt(0)" ::: "memory");
        } else {
            XB_SPIN(xb_ld(&bar[XB_XGEN(b.x)]) == gen, bar);
            __builtin_amdgcn_fence(__ATOMIC_ACQUIRE, "agent");
            asm volatile("s_waitcnt vmcnt(0)" ::: "memory");
        }
    }
    __syncthreads();
}

namespace pg8 {
constexpr int BM = 256, BK = 64, HALF = 128, HTB = HALF * BK * 2, STAGE_BYTES = 8 * HTB, NXCD = 8, WGM = 4;
__host__ __device__ __forceinline__ int lds_byte(int r, int c) { const int st = (r >> 4) * 2 + (c >> 5), rr = r & 15, cc = c & 31, ob = rr * 64 + cc * 2; return st * 1024 + (ob ^ (((ob >> 9) & 1) << 5)); }
__host__ __device__ __forceinline__ void stage_rc(int b, int& Rr, int& C) { const int st = b / 1024, sb = b % 1024, swz = sb ^ (((sb >> 9) & 1) << 5); Rr = (st >> 1) * 16 + swz / 64; C = (st & 1) * 32 + (swz % 64) / 2; }
__host__ __device__ __forceinline__ int perm32(int rho) { const int n = rho >> 4, i = rho & 15; return 8 * (i >> 2) + 4 * n + (i & 3); }
struct Unit { int pm, pn; size_t aoff, boff; };
struct Gemm { const GAS bf16* A; const GAS bf16* Bt; int K, lda; };

struct StaticOrder {
    int nM, nN, nwg, G, c, K, lda;
    __device__ void init(int nM_, int nN_, int K_, int G_, int c_, int lda_ = 0) { nM = nM_; nN = nN_; nwg = nM * nN; G = G_; K = K_; lda = lda_ ? lda_ : K_; int cc = c_; asm volatile("" : "+s"(cc)); c = cc; }
    __device__ bool map(int i, int& pm, int& pn) const {
        const long L = (long)i * G + c; if (L >= nwg) return false;
        int wgid = (int)L; { const int q = nwg / NXCD, r = nwg % NXCD, xcd = wgid % NXCD, off = wgid / NXCD; wgid = (xcd < r ? xcd * (q + 1) : r * (q + 1) + (xcd - r) * q) + off; }
        const int nig = WGM * nN, gid = wgid / nig, fm = gid * WGM, gsz = (nM - fm) < WGM ? (nM - fm) : WGM;
        pm = fm + ((wgid % nig) % gsz); pn = (wgid % nig) / gsz; return true;
    }
    __device__ bool next(int i, Unit& u) const { if (!map(i, u.pm, u.pn)) return false; u.aoff = (size_t)u.pm * 256 * lda * 2; u.boff = (size_t)u.pn * 256 * K * 2; return true; }
};
struct MoeOrder : StaticOrder {
    const GAS int* texp; size_t estride;
    __device__ bool next(int i, Unit& u) const {
        if (!map(i, u.pm, u.pn)) return false;
        const int e = __builtin_amdgcn_readfirstlane(texp[u.pm]);
        u.aoff = (size_t)u.pm * 256 * lda * 2; u.boff = (size_t)e * estride + (size_t)u.pn * 256 * K * 2; return true;
    }
};
struct S5Order : StaticOrder {
    __device__ bool next(int i, Unit& u) const {
        if (!map(i, u.pm, u.pn)) return false;
        const int g = u.pm / 9, ti = u.pm - g * 9;
        u.aoff = (size_t)(g * 2112 + ti * 256) * lda * 2; u.boff = (size_t)g * 256 * K * 2; return true;
    }
};
typedef __bf16 bf16v2_t __attribute__((ext_vector_type(2)));
__device__ __forceinline__ unsigned cvt_pk_bf16(float lo, float hi) { f32x2 v = {lo, hi}; const bf16v2_t r = __builtin_convertvector(v, bf16v2_t); return __builtin_bit_cast(unsigned, r); }

template <class Epi, class Sched, bool ALIGN_EPI, bool SP2>
__device__ __forceinline__ void gemm_phase(LAS unsigned char* lds, const int wave_id, const Gemm g, const Sched& S, const Epi& E) {
    const int lane = lane_id_opaque();
    const int wid = wave_id, tid = wid * 64 + lane, wr = wid >> 2, wc = wid & 3, fr = lane & 15, fq = lane >> 4;
    int K_ = g.K; asm volatile("" : "+s"(K_));
    const int K = K_, nt = K / BK;
    unsigned voffA, voffB;
    int lda_ = g.lda; asm volatile("" : "+s"(lda_)); const int lda = lda_;
    { int Rr, C; stage_rc(tid * 16, Rr, C); const int Rb = Epi::PERM ? ((Rr & ~31) + perm32(Rr & 31)) : Rr;
        voffA = (unsigned)(Rr * lda + C) * 2u; voffB = (unsigned)(Rb * K + C) * 2u; }
    const size_t qstepB = (size_t)64 * K * 2, qstepA = (size_t)64 * lda * 2;
    const size_t kstep = (size_t)(BK * 2);
    const size_t hstep = (size_t)HALF * K * 2, hstepA = (size_t)HALF * lda * 2;
    const unsigned ldsw = (unsigned)wid * 1024u;
    const int aoff = lds_byte(wr * 64 + fr, fq * 8), boff = lds_byte(wc * 32 + fr, fq * 8);
#define PG8_SA(b, h) (((b) * 2 + (h)) * HTB)
#define PG8_SB(b, h) ((4 + (b) * 2 + (h)) * HTB)
#define PG8_STAGE_(bufoff, gbase, voff, qs) do { _Pragma("unroll") for (int _i = 0; _i < 2; ++_i) \
        __builtin_amdgcn_global_load_lds((const GAS unsigned*)((const char*)(gbase) + _i * (qs) + (voff)), (LAS unsigned*)(lds + (bufoff) + ldsw + _i * 8192), 16, 0, 0); } while (0)
#define PG8_STAGEA(bufoff, gbase) PG8_STAGE_(bufoff, gbase, voffA, qstepA)
#define PG8_STAGEB(bufoff, gbase) PG8_STAGE_(bufoff, gbase, voffB, qstepB)
#define PG8_LDA(dst, b, h) do { _Pragma("unroll") for (int m = 0; m < 4; ++m) _Pragma("unroll") for (int k = 0; k < 2; ++k) dst[m][k] = *(const LAS bf16x8*)(lds + PG8_SA(b, h) + aoff + m * 2048 + k * 1024); } while (0)
#define PG8_LDB(dst, b, h) do { _Pragma("unroll") for (int n = 0; n < 2; ++n) _Pragma("unroll") for (int k = 0; k < 2; ++k) dst[n][k] = *(const LAS bf16x8*)(lds + PG8_SB(b, h) + boff + n * 2048 + k * 1024); } while (0)
#define PG8_MMA(ai, bj, At, Bt) do { __builtin_amdgcn_s_setprio(1); _Pragma("unroll") for (int m = 0; m < 4; ++m) _Pragma("unroll") for (int n = 0; n < 2; ++n) _Pragma("unroll") for (int k = 0; k < 2; ++k) \
        acc[ai][bj][m][n] = __builtin_amdgcn_mfma_f32_16x16x32_bf16(Bt[n][k], At[m][k], acc[ai][bj][m][n], 0, 0, 0); __builtin_amdgcn_s_setprio(0); } while (0)
#define PG8_WAIT_V(n) asm volatile("s_waitcnt vmcnt(" #n ")" ::: "memory")
#define PG8_WAIT_L(n) asm volatile("s_waitcnt lgkmcnt(" #n ")" ::: "memory")
#define PG8_BAR __builtin_amdgcn_s_barrier()
#define PG8_SCHED __builtin_amdgcn_sched_barrier(0)
    Unit cur, nxt; int ui = 0;
    if (!S.next(0, cur)) return;
    f32x4 acc[2][2][4][2];
#pragma unroll
    for (int a = 0; a < 2; ++a)
#pragma unroll
        for (int b = 0; b < 2; ++b)
#pragma unroll
            for (int m = 0; m < 4; ++m)
#pragma unroll
                for (int n = 0; n < 2; ++n) acc[a][b][m][n] = (f32x4){0.f, 0.f, 0.f, 0.f};
    bf16x8 At[4][2], B0[2][2], B1[2][2];
    const char* cA = (const char*)g.A + cur.aoff; const char* cB = (const char*)g.Bt + cur.boff;
    if constexpr (SP2) {
        PG8_STAGEB(PG8_SB(0, 0), cB); PG8_STAGEB(PG8_SB(0, 1), cB + hstep); PG8_STAGEA(PG8_SA(0, 0), cA); PG8_STAGEA(PG8_SA(0, 1), cA + hstepA);
        if (wr == 1) PG8_BAR;
        PG8_WAIT_V(2); PG8_BAR;
        PG8_STAGEB(PG8_SB(1, 0), cB + kstep); PG8_STAGEA(PG8_SA(1, 0), cA + kstep); PG8_STAGEB(PG8_SB(1, 1), cB + hstep + kstep);
        PG8_WAIT_V(6); PG8_BAR;
    } else {
        PG8_STAGEB(PG8_SB(0, 0), cB); PG8_STAGEA(PG8_SA(0, 0), cA); PG8_STAGEB(PG8_SB(0, 1), cB + hstep); PG8_STAGEA(PG8_SA(0, 1), cA + hstepA);
        if (wr == 1) PG8_BAR;
        PG8_WAIT_V(4); PG8_BAR;
        PG8_STAGEB(PG8_SB(1, 0), cB + kstep); PG8_STAGEA(PG8_SA(1, 0), cA + kstep); PG8_STAGEB(PG8_SB(1, 1), cB + hstep + kstep);
        PG8_WAIT_V(6); PG8_BAR;
    }
    for (;;) {
        const bool has_next = S.next(ui + 1, nxt);
        const char* nA = has_next ? (const char*)g.A + nxt.aoff : cA; const char* nB = has_next ? (const char*)g.Bt + nxt.boff : cB;
        for (int t = 0; t < nt; t += 2) {
            const bool last = (t == nt - 2);
            const char* a1 = cA + (size_t)(t + 1) * kstep;
            const char* a2 = last ? nA : cA + (size_t)(t + 2) * kstep; const char* b2 = last ? nB : cB + (size_t)(t + 2) * kstep;
            const char* a3 = a2 + kstep; const char* b3 = b2 + kstep;
            if constexpr (SP2) {
            PG8_LDB(B0, 0, 0); PG8_LDB(B1, 0, 1); PG8_SCHED; PG8_LDA(At, 0, 0); PG8_STAGEA(PG8_SA(1, 1), a1 + hstepA);
            PG8_WAIT_V(8); PG8_WAIT_L(0); PG8_BAR; PG8_MMA(0, 0, At, B0); PG8_MMA(0, 1, At, B1); PG8_BAR; PG8_SCHED;
            PG8_LDA(At, 0, 1); PG8_STAGEB(PG8_SB(0, 0), b2); PG8_STAGEB(PG8_SB(0, 1), b2 + hstep); PG8_STAGEA(PG8_SA(0, 0), a2);
            PG8_WAIT_V(8); PG8_WAIT_L(0); PG8_BAR; PG8_MMA(1, 0, At, B0); PG8_MMA(1, 1, At, B1); PG8_BAR; PG8_SCHED;
            PG8_LDB(B0, 1, 0); PG8_LDB(B1, 1, 1); PG8_SCHED; PG8_LDA(At, 1, 0); PG8_STAGEA(PG8_SA(0, 1), a2 + hstepA);
            PG8_WAIT_V(8); PG8_WAIT_L(0); PG8_BAR; PG8_MMA(0, 0, At, B0); PG8_MMA(0, 1, At, B1); PG8_BAR; PG8_SCHED;
            PG8_LDA(At, 1, 1); PG8_STAGEB(PG8_SB(1, 0), b3); PG8_STAGEB(PG8_SB(1, 1), b3 + hstep); PG8_STAGEA(PG8_SA(1, 0), a3);
            PG8_WAIT_V(8); PG8_WAIT_L(0); PG8_BAR; PG8_MMA(1, 0, At, B0); PG8_MMA(1, 1, At, B1); PG8_BAR; PG8_SCHED;
            } else {
            PG8_LDB(B0, 0, 0); PG8_SCHED; PG8_LDA(At, 0, 0); PG8_STAGEA(PG8_SA(1, 1), a1 + hstepA);
            PG8_WAIT_L(8); PG8_BAR; PG8_WAIT_L(0); PG8_MMA(0, 0, At, B0); PG8_BAR; PG8_SCHED;
            PG8_LDB(B1, 0, 1); PG8_STAGEB(PG8_SB(0, 0), b2);
            PG8_BAR; PG8_WAIT_L(0); PG8_MMA(0, 1, At, B1); PG8_BAR;
            PG8_LDA(At, 0, 1); PG8_STAGEA(PG8_SA(0, 0), a2);
            PG8_BAR; PG8_WAIT_L(0); PG8_MMA(1, 0, At, B0); PG8_BAR; PG8_SCHED;
            PG8_STAGEB(PG8_SB(0, 1), b2 + hstep);
            PG8_WAIT_V(6); PG8_BAR; PG8_MMA(1, 1, At, B1); PG8_BAR;
            PG8_LDB(B0, 1, 0); PG8_SCHED; PG8_LDA(At, 1, 0); PG8_STAGEA(PG8_SA(0, 1), a2 + hstepA);
            PG8_WAIT_L(8); PG8_BAR; PG8_WAIT_L(0); PG8_MMA(0, 0, At, B0); PG8_BAR; PG8_SCHED;
            PG8_LDB(B1, 1, 1); PG8_STAGEB(PG8_SB(1, 0), b3);
            PG8_BAR; PG8_WAIT_L(0); PG8_MMA(0, 1, At, B1); PG8_BAR;
            PG8_LDA(At, 1, 1); PG8_STAGEA(PG8_SA(1, 0), a3);
            PG8_BAR; PG8_WAIT_L(0); PG8_MMA(1, 0, At, B0); PG8_BAR; PG8_SCHED;
            PG8_STAGEB(PG8_SB(1, 1), b3 + hstep);
            PG8_WAIT_V(6); PG8_BAR; PG8_MMA(1, 1, At, B1); PG8_BAR;
            }
        }
        if constexpr (ALIGN_EPI) { if (wr == 0) PG8_BAR; }
        { const int l2 = lane_id_opaque(); E(acc, cur, wr, wc, l2 & 15, l2 >> 4); }
        if (!has_next) break;
#pragma unroll
        for (int a = 0; a < 2; ++a)
#pragma unroll
            for (int b = 0; b < 2; ++b)
#pragma unroll
                for (int m = 0; m < 4; ++m)
#pragma unroll
                    for (int n = 0; n < 2; ++n) acc[a][b][m][n] = (f32x4){0.f, 0.f, 0.f, 0.f};
        cur = nxt; cA = nA; cB = nB; ++ui;
        if constexpr (ALIGN_EPI) { if (wr == 1) PG8_BAR; }
    }
    PG8_WAIT_V(0);
    if constexpr (!ALIGN_EPI) { if (wr == 0) PG8_BAR; }
    PG8_BAR;
#undef PG8_SA
#undef PG8_SB
#undef PG8_STAGE_
#undef PG8_STAGEA
#undef PG8_STAGEB
#undef PG8_LDA
#undef PG8_LDB
#undef PG8_MMA
#undef PG8_WAIT_V
#undef PG8_WAIT_L
#undef PG8_BAR
#undef PG8_SCHED
}

struct EpiBf16 {
    static constexpr bool PERM = true;
    GAS bf16* O; int ldc, ncols;
    __device__ __forceinline__ void operator()(const f32x4 (&acc)[2][2][4][2], const Unit& u, int wr, int wc, int fr, int fq) const {
        const int row0 = u.pm * BM + wr * 64 + fr, col0 = u.pn * BM + wc * 32 + 8 * fq;
#pragma unroll
        for (int ai = 0; ai < 2; ++ai)
#pragma unroll
            for (int m = 0; m < 4; ++m) { GAS bf16* rowp = O + (size_t)(row0 + ai * HALF + m * 16) * ldc + col0; asm volatile("" ::: "memory");
#pragma unroll
                for (int bj = 0; bj < 2; ++bj) { const f32x4 v0 = acc[ai][bj][m][0], v1 = acc[ai][bj][m][1];
                    v4u w; w.x = cvt_pk_bf16(v0[0], v0[1]); w.y = cvt_pk_bf16(v0[2], v0[3]); w.z = cvt_pk_bf16(v1[0], v1[1]); w.w = cvt_pk_bf16(v1[2], v1[3]);
                    if (col0 + bj * HALF < ncols) *(GAS v4u*)(rowp + bj * HALF) = w; } }
    }
};
struct EpiSwiGlu {
    static constexpr bool PERM = true;
    GAS bf16* O; int ldc;
    __device__ __forceinline__ void operator()(const f32x4 (&acc)[2][2][4][2], const Unit& u, int wr, int wc, int fr, int fq) const {
        const int row0 = u.pm * BM + wr * 64 + fr, col0 = u.pn * HALF + wc * 32 + 8 * fq;
#pragma unroll
        for (int ai = 0; ai < 2; ++ai)
#pragma unroll
            for (int m = 0; m < 4; ++m) { GAS bf16* rowp = O + (size_t)(row0 + ai * HALF + m * 16) * ldc + col0; asm volatile("" ::: "memory");
                float h[8];
#pragma unroll
                for (int n = 0; n < 2; ++n)
#pragma unroll
                    for (int i = 0; i < 4; ++i) { const float a = acc[ai][0][m][n][i], b = acc[ai][1][m][n][i]; h[n * 4 + i] = a * b * __builtin_amdgcn_rcpf(1.f + __expf(-a)); }
                v4u w; w.x = cvt_pk_bf16(h[0], h[1]); w.y = cvt_pk_bf16(h[2], h[3]); w.z = cvt_pk_bf16(h[4], h[5]); w.w = cvt_pk_bf16(h[6], h[7]);
                *(GAS v4u*)rowp = w; }
    }
};
struct EpiRes {
    static constexpr bool PERM = true;
    GAS bf16* DL; const GAS float* mod; int goff;
    __device__ __forceinline__ void operator()(const f32x4 (&acc)[2][2][4][2], const Unit& u, int wr, int wc, int fr, int fq) const {
        const int row0 = u.pm * BM + wr * 64 + fr, col0 = u.pn * BM + wc * 32 + 8 * fq;
        const int s = u.pm < 128 ? (u.pm >> 5) : 4;
        const GAS float* gp = mod + s * 6144 + goff + col0;
        f32x4 gv[2][2];
#pragma unroll
        for (int bj = 0; bj < 2; ++bj)
#pragma unroll
            for (int n = 0; n < 2; ++n) gv[bj][n] = *(const GAS f32x4*)(gp + bj * HALF + n * 4);
#pragma unroll
        for (int ai = 0; ai < 2; ++ai)
#pragma unroll
            for (int m = 0; m < 4; ++m) { GAS bf16* rowp = DL + (size_t)(row0 + ai * HALF + m * 16) * D + col0; asm volatile("" ::: "memory");
#pragma unroll
                for (int bj = 0; bj < 2; ++bj) { const f32x4 v0 = gv[bj][0] * acc[ai][bj][m][0], v1 = gv[bj][1] * acc[ai][bj][m][1];
                    v4u w; w.x = cvt_pk_bf16(v0[0], v0[1]); w.y = cvt_pk_bf16(v0[2], v0[3]); w.z = cvt_pk_bf16(v1[0], v1[1]); w.w = cvt_pk_bf16(v1[2], v1[3]);
                    *(GAS v4u*)(rowp + bj * HALF) = w; } }
    }
};
struct EpiGlu {
    static constexpr bool PERM = true;
    GAS bf16* MIX; const GAS float* ya; const GAS float* gb;
    __device__ __forceinline__ void operator()(const f32x4 (&acc)[2][2][4][2], const Unit& u, int wr, int wc, int fr, int fq) const {
        const int row0 = u.pm * BM + wr * 64 + fr, col0 = wc * 32 + 8 * fq;
#pragma unroll
        for (int ai = 0; ai < 2; ++ai)
#pragma unroll
            for (int m = 0; m < 4; ++m) { const int row = row0 + ai * HALF + m * 16; asm volatile("" ::: "memory");
#pragma unroll
                for (int bj = 0; bj < 2; ++bj) { const int c = col0 + bj * HALF;
                    const f32x4 y0 = *(const GAS f32x4*)(ya + (size_t)row * 256 + c), y1 = *(const GAS f32x4*)(ya + (size_t)row * 256 + c + 4);
                    const f32x4 b0 = *(const GAS f32x4*)(gb + c), b1 = *(const GAS f32x4*)(gb + c + 4);
                    float o[8];
#pragma unroll
                    for (int i = 0; i < 4; ++i) { o[i] = y0[i] * sigmoidf_(acc[ai][bj][m][0][i] + b0[i]); o[4 + i] = y1[i] * sigmoidf_(acc[ai][bj][m][1][i] + b1[i]); }
                    v4u w; w.x = cvt_pk_bf16(o[0], o[1]); w.y = cvt_pk_bf16(o[2], o[3]); w.z = cvt_pk_bf16(o[4], o[5]); w.w = cvt_pk_bf16(o[6], o[7]);
                    *(GAS v4u*)(MIX + (size_t)row * D + 256 + c) = w; } }
    }
};
struct EpiMoeDown {
    static constexpr bool PERM = true;
    GAS bf16* O; const GAS float* rowg;
    __device__ __forceinline__ void operator()(const f32x4 (&acc)[2][2][4][2], const Unit& u, int wr, int wc, int fr, int fq) const {
        const int row0 = u.pm * BM + wr * 64 + fr, col0 = u.pn * BM + wc * 32 + 8 * fq;
#pragma unroll
        for (int ai = 0; ai < 2; ++ai)
#pragma unroll
            for (int m = 0; m < 4; ++m) { asm volatile("" ::: "memory"); const int row = row0 + ai * HALF + m * 16; const float gte = rowg[row]; GAS bf16* rowp = O + (size_t)row * D + col0;
#pragma unroll
                for (int bj = 0; bj < 2; ++bj) { const f32x4 v0 = acc[ai][bj][m][0] * gte, v1 = acc[ai][bj][m][1] * gte;
                    v4u w; w.x = cvt_pk_bf16(v0[0], v0[1]); w.y = cvt_pk_bf16(v0[2], v0[3]); w.z = cvt_pk_bf16(v1[0], v1[1]); w.w = cvt_pk_bf16(v1[2], v1[3]);
                    *(GAS v4u*)(rowp + bj * HALF) = w; } }
    }
};

struct EpiS5HL {
    static constexpr bool PERM = true;
    GAS bf16* O;
    __device__ __forceinline__ void operator()(const f32x4 (&acc)[2][2][4][2], const Unit& u, int wr, int wc, int fr, int fq) const {
        const int g = u.pm / 9, ti = u.pm - g * 9, lr0 = ti * 256 + wr * 64 + fr, col0 = wc * 32 + 8 * fq;
#pragma unroll
        for (int ai = 0; ai < 2; ++ai)
#pragma unroll
            for (int m = 0; m < 4; ++m) { const int lr = lr0 + ai * HALF + m * 16; GAS bf16* rowp = O + (size_t)(g * 2112 + lr) * 256 + col0; asm volatile("" ::: "memory");
#pragma unroll
                for (int bj = 0; bj < 2; ++bj) { const f32x4 v0 = acc[ai][bj][m][0], v1 = acc[ai][bj][m][1];
                    v4u w; w.x = cvt_pk_bf16(v0[0], v0[1]); w.y = cvt_pk_bf16(v0[2], v0[3]); w.z = cvt_pk_bf16(v1[0], v1[1]); w.w = cvt_pk_bf16(v1[2], v1[3]);
                    if (lr < 2112) *(GAS v4u*)(rowp + bj * HALF) = w; } }
    }
};
struct EpiS5Y {
    static constexpr bool PERM = true;
    GAS bf16* YA; GAS float* Y32; const GAS bf16* P; const GAS float* dsk;
    __device__ __forceinline__ void operator()(const f32x4 (&acc)[2][2][4][2], const Unit& u, int wr, int wc, int fr, int fq) const {
        const int g = u.pm / 9, ti = u.pm - g * 9, lr0 = ti * 256 + wr * 64 + fr;
#pragma unroll
        for (int ai = 0; ai < 2; ++ai)
#pragma unroll
            for (int m = 0; m < 4; ++m) { const int lr = lr0 + ai * HALF + m * 16; asm volatile("" ::: "memory");
                if (lr < 2112) { const int b = lr / 528, sc = lr - b * 528; const int r0 = sc < 16 ? NLAT + b * CTXL + sc * 16 : b * SEQ + (sc - 16) * 16;
#pragma unroll
                    for (int bj = 0; bj < 2; ++bj) { const int n = bj * HALF + wc * 32 + 8 * fq, t = n >> 4, c0 = g * 16 + (n & 15); const size_t row = (size_t)(r0 + t);
                        const v4u uw = *(const GAS v4u*)(P + row * DPP + PC_S5U + c0); const f32x4 d0 = *(const GAS f32x4*)(dsk + c0), d1 = *(const GAS f32x4*)(dsk + c0 + 4);
                        const float uu[8] = {bflo(uw.x), bfhi(uw.x), bflo(uw.y), bfhi(uw.y), bflo(uw.z), bfhi(uw.z), bflo(uw.w), bfhi(uw.w)};
                        f32x4 y0, y1;
#pragma unroll
                        for (int i = 0; i < 4; ++i) { y0[i] = gelu_tanh(acc[ai][bj][m][0][i] + d0[i] * uu[i]); y1[i] = gelu_tanh(acc[ai][bj][m][1][i] + d1[i] * uu[4 + i]); }
                        *(GAS f32x4*)(Y32 + row * 256 + c0) = y0; *(GAS f32x4*)(Y32 + row * 256 + c0 + 4) = y1;
                        v4u w; w.x = cvt_pk_bf16(y0[0], y0[1]); w.y = cvt_pk_bf16(y0[2], y0[3]); w.z = cvt_pk_bf16(y1[0], y1[1]); w.w = cvt_pk_bf16(y1[2], y1[3]);
                        *(GAS v4u*)(YA + row * 256 + c0) = w; } } }
    }
};
}

struct Args { const float* in[34]; float* out; unsigned char* ws; int ph_lo, ph_hi; };
struct Frame {
    LAS unsigned char* lds;
    int tid, lane, wave, G, bid;
};
typedef const __attribute__((address_space(4))) unsigned long long* kaptr_t;
__device__ __forceinline__ unsigned long long karg(int i) { kaptr_t ka = (kaptr_t)__builtin_amdgcn_kernarg_segment_ptr(); asm volatile("" : "+s"(ka)); return ka[i]; }
__device__ __forceinline__ const GAS float* inp(int i) { return (const GAS float*)karg(i); }
__device__ __forceinline__ GAS float* outp() { return (GAS float*)karg(34); }
__device__ __forceinline__ GAS unsigned char* wsp() { return (GAS unsigned char*)karg(35); }
enum { I_X = 0, I_C, I_CTX, I_CCTX, I_ADAW, I_ADAB, I_WIN, I_WOUT, I_LNG, I_LNB, I_GCONV, I_GALOG, I_GDTB, I_GNW, I_S5ARE, I_S5AIM, I_S5LS, I_S5BRE, I_S5BIM, I_S5CRE, I_S5CIM,
       I_S5D, I_S5GLUW, I_S5GLUB, I_HLB, I_HNW, I_RDEC, I_FW1, I_FW3, I_FW2, I_MROUTER, I_MW1, I_MW3, I_MW2 };

__device__ __forceinline__ void frame_refresh(Frame& F) { const int ln = lane_id_opaque(); int w = F.wave, b = F.bid; asm volatile("" : "+s"(w), "+s"(b)); F.wave = w; F.bid = b; F.lane = ln; F.tid = w * 64 + ln; }
__device__ __forceinline__ int row_slot(int row) { return row < NLAT ? (row >> 13) : 4; }

__device__ __forceinline__ void transpose_item(const GAS float* W, int K, int N, GAS bf16* WT, int mode, LAS float* scr, int item, int lane) {
    const int nblk = (N + 31) / 32, kb = item / nblk, nb = item % nblk, k0 = 64 * kb, n0 = 32 * nb;
    const int nn = n0 + 4 * (lane & 7), kr = lane >> 3;
    f32x4 v[8];
#pragma unroll
    for (int i = 0; i < 8; ++i) v[i] = (nn < N) ? *(const GAS f32x4*)(W + (size_t)(k0 + 8 * i + kr) * N + nn) : (f32x4){0.f, 0.f, 0.f, 0.f};
#pragma unroll
    for (int i = 0; i < 8; ++i) { LAS float* d = scr + (8 * i + kr) * 33 + 4 * (lane & 7); d[0] = v[i][0]; d[1] = v[i][1]; d[2] = v[i][2]; d[3] = v[i][3]; }
    LDS_WAIT(); asm volatile("" ::: "memory");
    const int c = lane & 7;
#pragma unroll
    for (int j = 0; j < 4; ++j) { const int nl = (lane >> 3) + 8 * j; const int n = n0 + nl; const LAS float* s = scr + (8 * c) * 33 + nl;
        v4u o; o.x = pk2(s[0 * 33], s[1 * 33]); o.y = pk2(s[2 * 33], s[3 * 33]); o.z = pk2(s[4 * 33], s[5 * 33]); o.w = pk2(s[6 * 33], s[7 * 33]);
        const int nr = mode == 0 ? n : ((n >> 7) * 256 + (n & 127) + (mode == 2 ? 128 : 0));
        if (n < N) *(GAS v4u*)(WT + (size_t)nr * K + k0 + 8 * c) = o; }
    LDS_WAIT(); asm volatile("" ::: "memory");
}

__device__ __forceinline__ void phase_prologue(Frame& F) {
    frame_refresh(F); GAS unsigned char* const ws = wsp();
    LAS float* scv = (LAS float*)F.lds;
    LAS float* part = (LAS float*)(F.lds + 20480);
    for (int i = F.tid; i < 5 * 1024; i += 512) { const int s = i >> 10, k = i & 1023; const float c = s < 4 ? inp(I_C)[s * 1024 + k] : inp(I_CCTX)[k]; scv[i] = siluf_(c); }
    __syncthreads();
    GAS float* MOD = (GAS float*)(ws + WS_MOD);
    for (int it = F.bid; it < 4 * 96; it += F.G) {
        const int l = it / 96, n0 = (it % 96) * 64;
        const GAS float* w = inp(I_ADAW) + (size_t)l * 1024 * 6144 + n0 + F.lane;
        float a0 = 0.f, a1 = 0.f, a2 = 0.f, a3 = 0.f, a4 = 0.f;
        const int kb = F.wave * 128;
#pragma unroll 8
        for (int k = 0; k < 128; ++k) { const float wv = w[(size_t)(kb + k) * 6144];
            a0 += scv[kb + k] * wv; a1 += scv[1024 + kb + k] * wv; a2 += scv[2048 + kb + k] * wv; a3 += scv[3072 + kb + k] * wv; a4 += scv[4096 + kb + k] * wv; }
        part[(F.wave * 5 + 0) * 64 + F.lane] = a0; part[(F.wave * 5 + 1) * 64 + F.lane] = a1; part[(F.wave * 5 + 2) * 64 + F.lane] = a2; part[(F.wave * 5 + 3) * 64 + F.lane] = a3; part[(F.wave * 5 + 4) * 64 + F.lane] = a4;
        __syncthreads();
        if (F.tid < 320) { const int s = F.tid >> 6, n = F.tid & 63; float v = inp(I_ADAB)[l * 6144 + n0 + n];
#pragma unroll
            for (int w8 = 0; w8 < 8; ++w8) v += part[(w8 * 5 + s) * 64 + n];
            MOD[(size_t)(l * 5 + s) * 6144 + n0 + n] = v; }
        __syncthreads();
    }
    const int gt = F.bid * 512 + F.tid, NT = F.G * 512;
    GAS float* LB = (GAS float*)(ws + WS_LB);
    for (int i = gt; i < 256; i += NT) {
        float v[4], mx = -1e30f; for (int l = 0; l < 4; ++l) { v[l] = inp(I_HLB)[l * 256 + i]; mx = fmaxf(mx, v[l]); }
        float s = 0.f; for (int l = 0; l < 4; ++l) { v[l] = expf(v[l] - mx); s += v[l]; }
        float cum = 0.f, first = 0.f; for (int l = 0; l < 4; ++l) { cum += v[l] / s; if (l == 0) first = cum; LB[l * 256 + i] = cum - first; }
    }
    GAS float* ROT = (GAS float*)(ws + WS_ROT);
    for (int i = gt; i < 192 * 16; i += NT) { const int pos = i >> 4, q = i & 15; const float p = (float)(pos < 128 ? pos : pos - 128);
        const float invf = expf(-(float)q * (9.210340371976184f / 16.f)); const float ang = p * invf; ROT[i * 2] = cosf(ang); ROT[i * 2 + 1] = sinf(ang); }
    GAS float* LAM = (GAS float*)(ws + WS_S5LAM); GAS float* BB = (GAS float*)(ws + WS_S5B);
    for (int i = gt; i < 4 * 2 * 16 * 64; i += NT) {
        const int ldg = i >> 6;
        const float are = inp(I_S5ARE)[i], aim = inp(I_S5AIM)[i], st = expf(inp(I_S5LS)[ldg]);
        const float x = are * st, y = aim * st, ex = expf(x), cy = cosf(y), sy = sinf(y), sh = sinf(0.5f * y);
        LAM[i * 2] = ex * cy; LAM[i * 2 + 1] = ex * sy;
        const float er = expm1f(x) * cy - 2.f * sh * sh, ei = ex * sy;
        const float den = are * are + aim * aim; const float qr = (er * are + ei * aim) / den, qi = (ei * are - er * aim) / den;
        for (int c = 0; c < 16; ++c) { const float br = inp(I_S5BRE)[(size_t)i * 16 + c], bi = inp(I_S5BIM)[(size_t)i * 16 + c];
            BB[((size_t)i * 16 + c) * 2] = qr * br - qi * bi; BB[((size_t)i * 16 + c) * 2 + 1] = qr * bi + qi * br; }
    }
    LAS float* scr = (LAS float*)(F.lds + 32768 + F.wave * 8704);
    __syncthreads();
    const int gw = F.bid * 8 + F.wave, NGW = F.G * 8;
    constexpr int I_IN = 16 * 113, I_OUT = 16 * 32, I_GLU = 4 * 8, I_F1 = 16 * 88, I_F2 = 44 * 32;
    constexpr int PER_L = I_IN + I_OUT + I_GLU, TOT = 4 * PER_L + 2 * (2 * I_F1 + I_F2);
    for (int it = gw; it < TOT; it += NGW) {
        int r = it;
        if (r < 4 * PER_L) { const int l = r / PER_L; r -= l * PER_L;
            if (r < I_IN) { transpose_item(inp(I_WIN) + (size_t)l * D * DPROJ, D, DPROJ, (GAS bf16*)(ws + WS_WIN) + (size_t)l * DPW * D, 0, scr, r, F.lane); continue; } r -= I_IN;
            if (r < I_OUT) { transpose_item(inp(I_WOUT) + (size_t)l * D * D, D, D, (GAS bf16*)(ws + WS_WOUT) + (size_t)l * D * D, 0, scr, r, F.lane); continue; } r -= I_OUT;
            transpose_item(inp(I_S5GLUW) + (size_t)l * 65536, 256, 256, (GAS bf16*)(ws + WS_WGLU) + (size_t)l * 65536, 0, scr, r, F.lane); continue; }
        r -= 4 * PER_L;
        const int j = r / (2 * I_F1 + I_F2); r -= j * (2 * I_F1 + I_F2);
        if (r < I_F1) { transpose_item(inp(I_FW1) + (size_t)j * D * FFD, D, FFD, (GAS bf16*)(ws + WS_WF13) + (size_t)j * 2 * FFD * D, 1, scr, r, F.lane); continue; } r -= I_F1;
        if (r < I_F1) { transpose_item(inp(I_FW3) + (size_t)j * D * FFD, D, FFD, (GAS bf16*)(ws + WS_WF13) + (size_t)j * 2 * FFD * D, 2, scr, r, F.lane); continue; } r -= I_F1;
        transpose_item(inp(I_FW2) + (size_t)j * FFD * D, FFD, D, (GAS bf16*)(ws + WS_WF2) + (size_t)j * D * FFD, 0, scr, r, F.lane);
    }
}
__device__ __forceinline__ void tr_load(const GAS float* W, int N, int item, int lane, f32x4 (&v)[8]) {
    const int nblk = (N + 31) / 32, kb = item / nblk, nb = item % nblk, k0 = 64 * kb, n0 = 32 * nb;
    const int nn = n0 + 4 * (lane & 7), kr = lane >> 3;
#pragma unroll
    for (int i = 0; i < 8; ++i) v[i] = (nn < N) ? *(const GAS f32x4*)(W + (size_t)(k0 + 8 * i + kr) * N + nn) : (f32x4){0.f, 0.f, 0.f, 0.f};
}
__device__ __forceinline__ void tr_store(int K, int N, GAS bf16* WT, int mode, LAS float* scr, int item, int lane, const f32x4 (&v)[8]) {
    const int nblk = (N + 31) / 32, kb = item / nblk, nb = item % nblk, k0 = 64 * kb, n0 = 32 * nb;
    const int kr = lane >> 3;
#pragma unroll
    for (int i = 0; i < 8; ++i) { LAS float* d = scr + (8 * i + kr) * 33 + 4 * (lane & 7); d[0] = v[i][0]; d[1] = v[i][1]; d[2] = v[i][2]; d[3] = v[i][3]; }
    LDS_WAIT(); asm volatile("" ::: "memory");
    const int c = lane & 7;
#pragma unroll
    for (int j = 0; j < 4; ++j) { const int nl = (lane >> 3) + 8 * j; const int n = n0 + nl; const LAS float* s = scr + (8 * c) * 33 + nl;
        v4u o; o.x = pk2(s[0 * 33], s[1 * 33]); o.y = pk2(s[2 * 33], s[3 * 33]); o.z = pk2(s[4 * 33], s[5 * 33]); o.w = pk2(s[6 * 33], s[7 * 33]);
        const int nr = mode == 0 ? n : ((n >> 7) * 256 + (n & 127) + (mode == 2 ? 128 : 0));
        if (n < N) *(GAS v4u*)(WT + (size_t)nr * K + k0 + 8 * c) = o; }
    LDS_WAIT(); asm volatile("" ::: "memory");
}
__device__ __forceinline__ void phase_moe_convert(Frame& F, int j) {
    frame_refresh(F); GAS unsigned char* const ws = wsp();
    LAS float* scr = (LAS float*)(F.lds + F.wave * 8704);
    const int gw = F.bid * 8 + F.wave, NGW = F.G * 8;
    constexpr int I_1 = 16 * 112, I_2 = 56 * 32, PER_E = 2 * I_1 + I_2;
    struct TI { const GAS float* W; GAS bf16* WT; int K, N, mode, item; };
    auto decode = [&](int it, TI& t) {
        const int e = it / PER_E; int r = it - e * PER_E;
        const size_t wo = ((size_t)j * 8 + e) * D * FFE;
        if (r < I_1) { t.W = inp(I_MW1) + wo; t.K = D; t.N = FFE; t.WT = (GAS bf16*)(ws + WS_WM13) + (size_t)e * 2 * FFE * D; t.mode = 1; t.item = r; return; } r -= I_1;
        if (r < I_1) { t.W = inp(I_MW3) + wo; t.K = D; t.N = FFE; t.WT = (GAS bf16*)(ws + WS_WM13) + (size_t)e * 2 * FFE * D; t.mode = 2; t.item = r; return; } r -= I_1;
        t.W = inp(I_MW2) + wo; t.K = FFE; t.N = D; t.WT = (GAS bf16*)(ws + WS_WM2) + (size_t)e * D * FFE; t.mode = 0; t.item = r; };
    int it = gw; if (it >= 8 * PER_E) return;
    const int lane = F.lane;
    TI cur; decode(it, cur); f32x4 v[8]; tr_load(cur.W, cur.N, cur.item, lane, v);
    for (;;) {
        const int itn = it + NGW; const bool more = itn < 8 * PER_E;
        TI nxt = cur; f32x4 w[8];
        if (more) { decode(itn, nxt); tr_load(nxt.W, nxt.N, nxt.item, lane, w); }
        tr_store(cur.K, cur.N, cur.WT, cur.mode, scr, cur.item, lane, v);
        if (!more) break;
        cur = nxt; it = itn;
#pragma unroll
        for (int i = 0; i < 8; ++i) v[i] = w[i];
    }
}

__device__ __forceinline__ const GAS float* xrow_src(const GAS float* xl, const GAS float* xc, int row) { return row < NLAT ? xl + (size_t)row * D : xc + (size_t)(row - NLAT) * D; }
__device__ __forceinline__ GAS float* xrow_dst(GAS float* xl, GAS float* xc, int row) { return row < NLAT ? xl + (size_t)row * D : xc + (size_t)(row - NLAT) * D; }

__device__ __forceinline__ void store_A_row(GAS bf16* Ab, int lane_, int row, const f32x4 (&v)[4], const GAS float* modrow, int shoff, int scoff) {
    GAS bf16* ar = Ab + (size_t)row * D;
#pragma unroll
    for (int j = 0; j < 4; ++j) { const int c = 4 * lane_ + 256 * j; const f32x4 sh = *(const GAS f32x4*)(modrow + shoff + c), sc = *(const GAS f32x4*)(modrow + scoff + c);
        const f32x4 h = v[j] * (sc + 1.f) + sh; v2u w; w.x = pk2(h[0], h[1]); w.y = pk2(h[2], h[3]); *(GAS v2u*)(ar + c) = w; }
}
__device__ __forceinline__ void store_A_rowh(GAS bf16* Ab, int lane_, int row, const f32x4 (&v)[4], const f32x4 (&sh)[4], const f32x4 (&sc)[4]) {
    GAS bf16* ar = Ab + (size_t)row * D;
#pragma unroll
    for (int j = 0; j < 4; ++j) { const int c = 4 * lane_ + 256 * j; const f32x4 h = v[j] * (sc[j] + 1.f) + sh[j]; v2u w; w.x = pk2(h[0], h[1]); w.y = pk2(h[2], h[3]); *(GAS v2u*)(ar + c) = w; }
}
__device__ __forceinline__ void ln_row(f32x4 (&v)[4], const GAS float* g, const GAS float* b, int lane) {
    float s = 0.f;
#pragma unroll
    for (int j = 0; j < 4; ++j) s += (v[j][0] + v[j][1]) + (v[j][2] + v[j][3]);
    const float mean = wave_sum(s) * (1.f / D); float s2 = 0.f;
#pragma unroll
    for (int j = 0; j < 4; ++j) { v[j] = v[j] - mean; s2 += (v[j][0] * v[j][0] + v[j][1] * v[j][1]) + (v[j][2] * v[j][2] + v[j][3] * v[j][3]); }
    const float rstd = 1.f / sqrtf(wave_sum(s2) * (1.f / D) + LN_EPS);
#pragma unroll
    for (int j = 0; j < 4; ++j) { const int c = 4 * lane + 256 * j; const f32x4 gg = *(const GAS f32x4*)(g + c), bb = *(const GAS f32x4*)(b + c); v[j] = v[j] * rstd * gg + bb; }
}

__device__ __forceinline__ void ln_row2h(f32x4 (&v)[4], f32x4 (&w)[4], const f32x4 (&gg)[4], const f32x4 (&bb)[4]) {
    float s = 0.f, t = 0.f;
#pragma unroll
    for (int j = 0; j < 4; ++j) { s += (v[j][0] + v[j][1]) + (v[j][2] + v[j][3]); t += (w[j][0] + w[j][1]) + (w[j][2] + w[j][3]); }
    const float mean = wave_sum(s) * (1.f / D), meanb = wave_sum(t) * (1.f / D); float s2 = 0.f, t2 = 0.f;
#pragma unroll
    for (int j = 0; j < 4; ++j) { v[j] = v[j] - mean; w[j] = w[j] - meanb;
        s2 += (v[j][0] * v[j][0] + v[j][1] * v[j][1]) + (v[j][2] * v[j][2] + v[j][3] * v[j][3]); t2 += (w[j][0] * w[j][0] + w[j][1] * w[j][1]) + (w[j][2] * w[j][2] + w[j][3] * w[j][3]); }
    const float rstd = 1.f / sqrtf(wave_sum(s2) * (1.f / D) + LN_EPS), rstdb = 1.f / sqrtf(wave_sum(t2) * (1.f / D) + LN_EPS);
#pragma unroll
    for (int j = 0; j < 4; ++j) { v[j] = v[j] * rstd * gg[j] + bb[j]; w[j] = w[j] * rstdb * gg[j] + bb[j]; }
}
__device__ __forceinline__ void ln_row2(f32x4 (&v)[4], f32x4 (&w)[4], const GAS float* g, const GAS float* b, int lane) {
    float s = 0.f, t = 0.f;
#pragma unroll
    for (int j = 0; j < 4; ++j) { s += (v[j][0] + v[j][1]) + (v[j][2] + v[j][3]); t += (w[j][0] + w[j][1]) + (w[j][2] + w[j][3]); }
    const float mean = wave_sum(s) * (1.f / D), meanb = wave_sum(t) * (1.f / D); float s2 = 0.f, t2 = 0.f;
#pragma unroll
    for (int j = 0; j < 4; ++j) { v[j] = v[j] - mean; w[j] = w[j] - meanb;
        s2 += (v[j][0] * v[j][0] + v[j][1] * v[j][1]) + (v[j][2] * v[j][2] + v[j][3] * v[j][3]); t2 += (w[j][0] * w[j][0] + w[j][1] * w[j][1]) + (w[j][2] * w[j][2] + w[j][3] * w[j][3]); }
    const float rstd = 1.f / sqrtf(wave_sum(s2) * (1.f / D) + LN_EPS), rstdb = 1.f / sqrtf(wave_sum(t2) * (1.f / D) + LN_EPS);
#pragma unroll
    for (int j = 0; j < 4; ++j) { const int c = 4 * lane + 256 * j; const f32x4 gg = *(const GAS f32x4*)(g + c), bb = *(const GAS f32x4*)(b + c); v[j] = v[j] * rstd * gg + bb; w[j] = w[j] * rstdb * gg + bb; }
}

__device__ __forceinline__ void phase_a0(Frame& F) {
    frame_refresh(F); GAS unsigned char* const ws = wsp();
    const GAS float* MOD = (const GAS float*)(ws + WS_MOD);
    const int gw = F.bid * 8 + F.wave, NGW = F.G * 8;
    const GAS float* xl = inp(I_X); const GAS float* xc = inp(I_CTX); GAS bf16* Ab = (GAS bf16*)(ws + WS_A);
    const int lane = F.lane; f32x4 shv[4], scv[4]; int cslot = -1;
    for (int row = gw; row < R; row += 2 * NGW) {
        const int rowb = row + NGW < R ? row + NGW : row;
        const GAS float* xr = xrow_src(xl, xc, row); const GAS float* xrb = xrow_src(xl, xc, rowb); f32x4 v[4], w[4];
#pragma unroll
        for (int j = 0; j < 4; ++j) { v[j] = *(const GAS f32x4*)(xr + 4 * lane + 256 * j); w[j] = *(const GAS f32x4*)(xrb + 4 * lane + 256 * j); }
        const int sl = row_slot(row), slb = row_slot(rowb);
        if (sl != cslot) { const GAS float* mr = MOD + (size_t)(0 * 5 + sl) * 6144;
#pragma unroll
            for (int j = 0; j < 4; ++j) { shv[j] = *(const GAS f32x4*)(mr + 4 * lane + 256 * j); scv[j] = *(const GAS f32x4*)(mr + 1024 + 4 * lane + 256 * j); }
            cslot = sl; }
        store_A_rowh(Ab, lane, row, v, shv, scv);
        if (slb == sl) store_A_rowh(Ab, lane, rowb, w, shv, scv); else store_A_row(Ab, lane, rowb, w, MOD + (size_t)(0 * 5 + slb) * 6144, 0, 1024);
    }
}

__device__ __forceinline__ void phase_gdn_prep(Frame& F, int l) {
    frame_refresh(F); GAS unsigned char* const ws = wsp();
    const GAS bf16* P = (const GAS bf16*)(ws + WS_P);
    GAS bf16* GQ = (GAS bf16*)(ws + WS_GQ); GAS bf16* GK = (GAS bf16*)(ws + WS_GK); GAS bf16* GV = (GAS bf16*)(ws + WS_GV);
    GAS float* GSC = (GAS float*)(ws + WS_GSC);
    const GAS float* cw = inp(I_GCONV) + (size_t)l * 3 * 768;
    const int gw = F.bid * 8 + F.wave, NGW = F.G * 8, lane = F.lane;
    f32x4 w[3][3];
#pragma unroll
    for (int kk = 0; kk < 3; ++kk)
#pragma unroll
        for (int j = 0; j < 3; ++j) w[kk][j] = *(const GAS f32x4*)(cw + kk * 768 + j * 256 + 4 * lane);
    float galog = 0.f, gdtb = 0.f;
    if (lane < 8) { galog = -__expf(inp(I_GALOG)[l * 8 + lane]); gdtb = inp(I_GDTB)[l * 8 + lane]; }
    for (int row0 = gw; row0 < R; row0 += 2 * NGW) {
        int rows[2]; rows[0] = row0; rows[1] = row0 + NGW < R ? row0 + NGW : row0;
        v2u xa[2][3], xb[2][3], xc[2][3]; float av[2];
#pragma unroll
        for (int u = 0; u < 2; ++u) { const int row = rows[u];
            int t, L; if (row < NLAT) { t = row & (SEQ - 1); L = SEQ; } else { t = (row - NLAT) & (CTXL - 1); L = CTXL; }
            const GAS bf16* pr = P + (size_t)row * DPP;
#pragma unroll
            for (int j = 0; j < 3; ++j) {
                xb[u][j] = *(const GAS v2u*)(pr + j * 256 + 4 * lane);
                xa[u][j] = (v2u){0u, 0u}; xc[u][j] = (v2u){0u, 0u};
                if (t > 0) xa[u][j] = *(const GAS v2u*)(pr - DPP + j * 256 + 4 * lane);
                if (t < L - 1) xc[u][j] = *(const GAS v2u*)(pr + DPP + j * 256 + 4 * lane); }
            av[u] = lane < 16 ? bf2f(pr[PC_GA + lane]) : 0.f; }
#pragma unroll
        for (int u = 0; u < 2; ++u) { const int row = rows[u];
            f32x4 c[3];
#pragma unroll
            for (int j = 0; j < 3; ++j) { const v2u x0 = xa[u][j], x1 = xb[u][j], x2 = xc[u][j];
                f32x4 a;
                a[0] = w[0][j][0] * bflo(x0.x) + w[1][j][0] * bflo(x1.x) + w[2][j][0] * bflo(x2.x);
                a[1] = w[0][j][1] * bfhi(x0.x) + w[1][j][1] * bfhi(x1.x) + w[2][j][1] * bfhi(x2.x);
                a[2] = w[0][j][2] * bflo(x0.y) + w[1][j][2] * bflo(x1.y) + w[2][j][2] * bflo(x2.y);
                a[3] = w[0][j][3] * bfhi(x0.y) + w[1][j][3] * bfhi(x1.y) + w[2][j][3] * bfhi(x2.y);
#pragma unroll
                for (int i = 0; i < 4; ++i) a[i] = siluf_(a[i]);
                c[j] = a; }
            const float sq = sum16(c[0][0] * c[0][0] + c[0][1] * c[0][1] + c[0][2] * c[0][2] + c[0][3] * c[0][3]);
            const float sk = sum16(c[1][0] * c[1][0] + c[1][1] * c[1][1] + c[1][2] * c[1][2] + c[1][3] * c[1][3]);
            const float rq = 0.125f * __builtin_amdgcn_rsqf(sq + RMS_EPS), rk = __builtin_amdgcn_rsqf(sk + RMS_EPS);
            v2u o;
            o.x = pk2(c[0][0] * rq, c[0][1] * rq); o.y = pk2(c[0][2] * rq, c[0][3] * rq); *(GAS v2u*)(GQ + (size_t)row * 256 + 4 * lane) = o;
            o.x = pk2(c[1][0] * rk, c[1][1] * rk); o.y = pk2(c[1][2] * rk, c[1][3] * rk); *(GAS v2u*)(GK + (size_t)row * 256 + 4 * lane) = o;
            o.x = pk2(c[2][0], c[2][1]); o.y = pk2(c[2][2], c[2][3]); *(GAS v2u*)(GV + (size_t)row * 256 + 4 * lane) = o;
            if (lane < 16) {
                const float a = av[u];
                float val;
                if (lane < 8) { const float z = a + gdtb; const float e = __expf(z); const float sp = z > 20.f ? z : (e < 0.01f ? e * (1.f - e * (0.5f - e * 0.33333333f)) : __logf(1.f + e)); val = galog * sp; }
                else val = sigmoidf_(a);
                GSC[(size_t)row * 16 + lane] = val;
            }
        }
    }
}

__device__ __forceinline__ void chunk_rows(int b, int dir, int c, int& r0, int& step, int& t0) {
    const int s0 = c * TCH;
    if (s0 < CTXL) { t0 = -1; if (dir == 0) { r0 = NLAT + b * CTXL + s0; step = 1; } else { r0 = NLAT + b * CTXL + (CTXL - 1 - s0); step = -1; } }
    else { const int u = s0 - CTXL; if (dir == 0) { r0 = b * SEQ + u; step = 1; t0 = u; } else { r0 = b * SEQ + (SEQ - 1 - u); step = -1; t0 = SEQ - 1 - u; } }
}
constexpr int NCH64 = NSEQ / 64;
constexpr int UNITS = BATCH * 4 * 2 * NCH64;
__device__ __forceinline__ void unit_rows(int b, int dir, int n, int& r0, int& step, int& t0) {
    const int s0 = n * 64;
    if (s0 < CTXL) { t0 = -1; if (dir == 0) { r0 = NLAT + b * CTXL + s0; step = 1; } else { r0 = NLAT + b * CTXL + (CTXL - 1 - s0); step = -1; } }
    else { const int u = s0 - CTXL; if (dir == 0) { r0 = b * SEQ + u; step = 1; t0 = u; } else { r0 = b * SEQ + (SEQ - 1 - u); step = -1; t0 = SEQ - 1 - u; } }
}
__device__ __forceinline__ bf16x8 mkfrag(v2u lo, v2u hi) { v4u w; w.x = lo.x; w.y = lo.y; w.z = hi.x; w.w = hi.y; return __builtin_bit_cast(bf16x8, w); }
__device__ __forceinline__ bf16x8 ldfrag_perm(const GAS unsigned char* tile, int row0, int ks, int r16, int q) {
    const GAS unsigned char* p = tile + (row0 + r16) * 128 + (32 * ks + 4 * q) * 2;
    return mkfrag(*(const GAS v2u*)p, *(const GAS v2u*)(p + 32));
}
__device__ __forceinline__ bf16x8 pack_acc(const f32x4& a, const f32x4& b) {
    v4u w; w.x = pg8::cvt_pk_bf16(a[0], a[1]); w.y = pg8::cvt_pk_bf16(a[2], a[3]); w.z = pg8::cvt_pk_bf16(b[0], b[1]); w.w = pg8::cvt_pk_bf16(b[2], b[3]); return __builtin_bit_cast(bf16x8, w);
}
#define MFMA16(a, b, c) __builtin_amdgcn_mfma_f32_16x16x32_bf16(a, b, c, 0, 0, 0)
__device__ __forceinline__ float rdlane(float x, int i) { return __builtin_bit_cast(float, __builtin_amdgcn_readlane(__builtin_bit_cast(int, x), i)); }

template <int MODE>
__device__ __forceinline__ void chain_run(Frame& F, int sub) {
    GAS unsigned char* const ws = wsp();
    const int lane = lane_id_opaque(), r16 = lane & 15, q = lane >> 4;
    const int cb = sub & 3, dir = (sub >> 2) & 1, h = (sub >> 3) & 3, b = sub >> 5;
    constexpr int NT = (MODE == 0) ? 5 : 4, TW = 0, TU = (MODE == 0) ? 1 : 0, TKD = TU + 1, TQG = TU + 2, TATT = TU + 3;
    const int u0 = ((b * 4 + h) * 2 + dir) * NCH64;
    const GAS unsigned char* tb = ws + (MODE == 0 ? WS_TG : (MODE == 1 ? WS_TH : WS_TR)) + (size_t)u0 * NT * 8192;
    const GAS float* decp = (const GAS float*)(ws + WS_DEC) + (size_t)(MODE * UNITS + u0) * 64;
    GAS bf16* OB = (GAS bf16*)(ws + WS_OB) + (size_t)(MODE * 2 + dir) * R * 256 + h * 64 + cb * 16 + 4 * q;
    f32x4 S[4]; bf16x8 Sb[2];
#pragma unroll
    for (int m = 0; m < 4; ++m) S[m] = (f32x4){0.f, 0.f, 0.f, 0.f};
    Sb[0] = (bf16x8){0, 0, 0, 0, 0, 0, 0, 0}; Sb[1] = Sb[0];
    bf16x8 Wf[4][2], Kf[4][2], Qf[4][2], Af[4][2]; v2u Uf[4]; f32x4 dc[4];
#define LD_W(tu)  do { if (MODE == 0) { _Pragma("unroll") for (int m = 0; m < 4; ++m) _Pragma("unroll") for (int k = 0; k < 2; ++k) Wf[m][k] = ldfrag_perm((tu) + TW * 8192, 16 * m, k, r16, q); } } while (0)
#define LD_U(tu)  do { _Pragma("unroll") for (int m = 0; m < 4; ++m) Uf[m] = *(const GAS v2u*)((tu) + TU * 8192 + (cb * 16 + r16) * 128 + (16 * m + 4 * q) * 2); } while (0)
#define LD_K(tu)  do { _Pragma("unroll") for (int m = 0; m < 4; ++m) _Pragma("unroll") for (int k = 0; k < 2; ++k) Kf[m][k] = ldfrag_perm((tu) + TKD * 8192, 16 * m, k, r16, q); } while (0)
#define LD_Q(tu)  do { _Pragma("unroll") for (int m = 0; m < 4; ++m) _Pragma("unroll") for (int k = 0; k < 2; ++k) Qf[m][k] = ldfrag_perm((tu) + TQG * 8192, 16 * m, k, r16, q); } while (0)
#define LD_A(tu)  do { _Pragma("unroll") for (int m = 0; m < 4; ++m) _Pragma("unroll") for (int k = 0; k < 2; ++k) Af[m][k] = ldfrag_perm((tu) + TATT * 8192, 16 * m, k, r16, q); } while (0)
#define LD_D(n_)  do { _Pragma("unroll") for (int m = 0; m < 4; ++m) dc[m] = *(const GAS f32x4*)(decp + (size_t)(n_) * 64 + 16 * m + 4 * q); } while (0)
    LD_W(tb); LD_U(tb); LD_Q(tb); LD_A(tb); LD_K(tb); LD_D(0);
    for (int n = 0; n < NCH64; ++n) {
        const GAS unsigned char* tn = tb + (size_t)(n + 1 < NCH64 ? n + 1 : n) * NT * 8192;
        f32x4 vn[4], o[4];
#pragma unroll
        for (int m = 0; m < 4; ++m) { vn[m] = (f32x4){bflo(Uf[m].x), bfhi(Uf[m].x), bflo(Uf[m].y), bfhi(Uf[m].y)}; o[m] = (f32x4){0.f, 0.f, 0.f, 0.f}; }
        if (MODE == 0) {
#pragma unroll
            for (int m = 0; m < 4; ++m) { vn[m] = MFMA16(Wf[m][0], Sb[0], vn[m]); vn[m] = MFMA16(Wf[m][1], Sb[1], vn[m]); }
        }
#pragma unroll
        for (int m = 0; m < 4; ++m) { o[m] = MFMA16(Sb[0], Qf[m][0], o[m]); o[m] = MFMA16(Sb[1], Qf[m][1], o[m]); }
        LD_W(tn); LD_U(tn); LD_Q(tn);
        bf16x8 vb[2]; vb[0] = pack_acc(vn[0], vn[1]); vb[1] = pack_acc(vn[2], vn[3]);
#pragma unroll
        for (int m = 0; m < 4; ++m) { o[m] = MFMA16(vb[0], Af[m][0], o[m]); o[m] = MFMA16(vb[1], Af[m][1], o[m]); }
#pragma unroll
        for (int m = 0; m < 4; ++m) { S[m] = S[m] * dc[m]; S[m] = MFMA16(Kf[m][0], vb[0], S[m]); S[m] = MFMA16(Kf[m][1], vb[1], S[m]); }
        LD_A(tn); LD_K(tn); LD_D(n + 1 < NCH64 ? n + 1 : n);
        Sb[0] = pack_acc(S[0], S[1]); Sb[1] = pack_acc(S[2], S[3]);
        { int r0, step, t0; unit_rows(b, dir, n, r0, step, t0);
#pragma unroll
            for (int m = 0; m < 4; ++m) { const int row = r0 + step * (16 * m + r16); v2u w; w.x = pg8::cvt_pk_bf16(o[m][0], o[m][1]); w.y = pg8::cvt_pk_bf16(o[m][2], o[m][3]);
                *(GAS v2u*)(OB + (size_t)row * 256) = w; } }
    }
#undef LD_W
#undef LD_U
#undef LD_K
#undef LD_Q
#undef LD_A
#undef LD_D
}

__device__ __forceinline__ bf16x8 ldsfrag_perm(LAS unsigned char* tile, int row, int ks, int q) {
    return *(const LAS bf16x8*)(tile + row * 128 + (((4 * ks + q) ^ ((row >> 1) & 7)) << 4));
}
template <int MODE>
__device__ __forceinline__ void chain_wg(Frame& F, int cid, int half, GAS bf16* obase = nullptr) {
    GAS unsigned char* const ws = wsp();
    const int lane = lane_id_opaque(), r16 = lane & 15, q = lane >> 4;
    const int dir = cid & 1, h = (cid >> 1) & 3, b = cid >> 3;
    constexpr int NT = (MODE == 0) ? 5 : 4, TW = 0, TU = (MODE == 0) ? 1 : 0, TKD = TU + 1, TQG = TU + 2, TATT = TU + 3;
    constexpr int STAGE = NT * 8192, LPW = NT * 2, LSTAGE = STAGE + 256;
    const int u0 = cid * NCH64;
    const GAS unsigned char* tb = ws + (MODE == 0 ? WS_TG : (MODE == 1 ? WS_TH : WS_TR)) + (size_t)u0 * STAGE;
    LAS unsigned char* ring = F.lds;
    const GAS float* decp = (const GAS float*)(ws + WS_DEC) + (size_t)(MODE * UNITS + u0) * 64;
    int wv = F.wave; asm volatile("" : "+s"(wv));
    if (wv >= 4) {
        const int lw = wv - 4;
        const int lrow = lane >> 3, lch = lane & 7;
        unsigned voff[LPW], loff[LPW];
#pragma unroll
        for (int j = 0; j < LPW; ++j) { const int p = lw + 4 * j, row = 8 * (p & 7) + lrow; voff[j] = (unsigned)((p >> 3) * 8192 + row * 128 + lch * 16); loff[j] = (unsigned)((p >> 3) * 8192 + row * 128 + ((lch ^ ((row >> 1) & 7)) << 4)); }
        float d0_, d1_, d2_, d3_;
        v4u r0_[LPW], r1_[LPW], r2_[LPW], r3_[LPW];
#define CH_SKIP(j) (((j) >> 1) == TU && ((j) & 1) != half)
#define CH_LOAD(reg, dreg, n_) do { const int nn_ = (n_) < NCH64 ? (n_) : NCH64 - 1; const GAS unsigned char* src = tb + (size_t)nn_ * STAGE; _Pragma("unroll") for (int j = 0; j < LPW; ++j) { if (CH_SKIP(j)) continue; reg[j] = *(const GAS v4u*)(src + voff[j]); } dreg = decp[(size_t)nn_ * 64 + lane]; } while (0)
#define CH_WRITE(reg, dreg, n_) do { LAS unsigned char* dst = ring + ((n_) & 1) * LSTAGE; _Pragma("unroll") for (int j = 0; j < LPW; ++j) { if (CH_SKIP(j)) continue; *(LAS v4u*)(dst + loff[j]) = reg[j]; } *(LAS float*)(dst + STAGE + lane * 4) = dreg; } while (0)
#define CH_SYNC() do { asm volatile("s_waitcnt lgkmcnt(0)" ::: "memory"); __builtin_amdgcn_s_barrier(); asm volatile("" ::: "memory"); } while (0)
        CH_LOAD(r0_, d0_, 0); CH_LOAD(r1_, d1_, 1); CH_LOAD(r2_, d2_, 2); CH_LOAD(r3_, d3_, 3);
        CH_WRITE(r0_, d0_, 0);
#define CH_FENCE() asm volatile("" ::: "memory")
        for (int n = 0; n < NCH64; n += 4) {
            CH_SYNC(); CH_LOAD(r0_, d0_, n + 4); CH_FENCE(); CH_WRITE(r1_, d1_, n + 1);
            CH_SYNC(); CH_LOAD(r1_, d1_, n + 5); CH_FENCE(); CH_WRITE(r2_, d2_, n + 2);
            CH_SYNC(); CH_LOAD(r2_, d2_, n + 6); CH_FENCE(); CH_WRITE(r3_, d3_, n + 3);
            CH_SYNC(); CH_LOAD(r3_, d3_, n + 7); CH_FENCE(); CH_WRITE(r0_, d0_, n + 4);
        }
#undef CH_FENCE
        asm volatile("s_waitcnt vmcnt(0) lgkmcnt(0)" ::: "memory");
#undef CH_SYNC
#undef CH_LOAD
#undef CH_WRITE
#undef CH_SKIP
    } else if (wv >= 2) {
        for (int n = 0; n < NCH64; ++n) __builtin_amdgcn_s_barrier();
    } else {
        const int cb = half * 2 + wv;
        GAS bf16* OB = (obase ? obase : (GAS bf16*)(ws + WS_OB)) + (size_t)(MODE * 2 + dir) * R * 256 + h * 64 + cb * 16 + 4 * q;
        f32x4 S[4]; bf16x8 Sb[2];
#pragma unroll
        for (int m = 0; m < 4; ++m) S[m] = (f32x4){0.f, 0.f, 0.f, 0.f};
        Sb[0] = (bf16x8){0, 0, 0, 0, 0, 0, 0, 0}; Sb[1] = Sb[0];
        auto step = [&](const int n) {
            asm volatile("s_waitcnt lgkmcnt(0)" ::: "memory");
            __builtin_amdgcn_s_barrier();
            asm volatile("" ::: "memory");
            LAS unsigned char* st = ring + (n & 1) * LSTAGE;
            f32x4 vn[4], o[4], dc[4];
            v2u uf[4]; bf16x8 fW[4][2], fQ[4][2], fA[4][2], fK[4][2];
#pragma unroll
            for (int m = 0; m < 4; ++m) { const int row = cb * 16 + r16;
                uf[m] = *(const LAS v2u*)(st + TU * 8192 + row * 128 + (((4 * (m >> 1) + q) ^ ((row >> 1) & 7)) << 4) + 8 * (m & 1)); }
            if (MODE == 0) {
#pragma unroll
                for (int m = 0; m < 4; ++m) { fW[m][0] = ldsfrag_perm(st + TW * 8192, 16 * m + r16, 0, q); fW[m][1] = ldsfrag_perm(st + TW * 8192, 16 * m + r16, 1, q); }
            }
#pragma unroll
            for (int m = 0; m < 4; ++m) { fQ[m][0] = ldsfrag_perm(st + TQG * 8192, 16 * m + r16, 0, q); fQ[m][1] = ldsfrag_perm(st + TQG * 8192, 16 * m + r16, 1, q); }
#pragma unroll
            for (int m = 0; m < 4; ++m) dc[m] = *(const LAS f32x4*)(st + STAGE + (16 * m + 4 * q) * 4);
            __builtin_amdgcn_sched_barrier(0);
#pragma unroll
            for (int m = 0; m < 4; ++m) { fA[m][0] = ldsfrag_perm(st + TATT * 8192, 16 * m + r16, 0, q); fA[m][1] = ldsfrag_perm(st + TATT * 8192, 16 * m + r16, 1, q); }
#pragma unroll
            for (int m = 0; m < 4; ++m) { fK[m][0] = ldsfrag_perm(st + TKD * 8192, 16 * m + r16, 0, q); fK[m][1] = ldsfrag_perm(st + TKD * 8192, 16 * m + r16, 1, q); }
            __builtin_amdgcn_sched_barrier(0);
#pragma unroll
            for (int m = 0; m < 4; ++m) { vn[m] = (f32x4){bflo(uf[m].x), bfhi(uf[m].x), bflo(uf[m].y), bfhi(uf[m].y)}; o[m] = (f32x4){0.f, 0.f, 0.f, 0.f}; }
            if (MODE == 0) {
#pragma unroll
                for (int m = 0; m < 4; ++m) { vn[m] = MFMA16(fW[m][0], Sb[0], vn[m]); vn[m] = MFMA16(fW[m][1], Sb[1], vn[m]); }
            }
#pragma unroll
            for (int m = 0; m < 4; ++m) { o[m] = MFMA16(Sb[0], fQ[m][0], o[m]); o[m] = MFMA16(Sb[1], fQ[m][1], o[m]); }
            bf16x8 vb[2]; vb[0] = pack_acc(vn[0], vn[1]); vb[1] = pack_acc(vn[2], vn[3]);
#pragma unroll
            for (int m = 0; m < 4; ++m) { S[m] = S[m] * dc[m]; S[m] = MFMA16(fK[m][0], vb[0], S[m]); S[m] = MFMA16(fK[m][1], vb[1], S[m]); }
#pragma unroll
            for (int m = 0; m < 4; ++m) { o[m] = MFMA16(vb[0], fA[m][0], o[m]); o[m] = MFMA16(vb[1], fA[m][1], o[m]); }
            Sb[0] = pack_acc(S[0], S[1]); Sb[1] = pack_acc(S[2], S[3]);
            { int r0, step, t0; unit_rows(b, dir, n, r0, step, t0);
#pragma unroll
                for (int m = 0; m < 4; ++m) { const int row = r0 + step * (16 * m + r16); v2u w; w.x = pg8::cvt_pk_bf16(o[m][0], o[m][1]); w.y = pg8::cvt_pk_bf16(o[m][2], o[m][3]);
                    *(GAS v2u*)(OB + (size_t)row * 256) = w; } }
        };
        for (int n = 0; n < NCH64; ++n) step(n);
        asm volatile("s_waitcnt lgkmcnt(0)" ::: "memory");
    }
    __builtin_amdgcn_s_barrier();
}

__device__ __forceinline__ int swz(int rr, int kc) { return rr * 128 + ((kc ^ (rr & 7)) << 4); }
__device__ __forceinline__ v4u pack8(const float (&x)[8]) { v4u w; w.x = pk2(x[0], x[1]); w.y = pk2(x[2], x[3]); w.z = pk2(x[4], x[5]); w.w = pk2(x[6], x[7]); return w; }
__device__ __forceinline__ void unpack8(const v4u w, float (&x)[8]) { x[0] = bflo(w.x); x[1] = bfhi(w.x); x[2] = bflo(w.y); x[3] = bfhi(w.y); x[4] = bflo(w.z); x[5] = bfhi(w.z); x[6] = bflo(w.w); x[7] = bfhi(w.w); }
__device__ __forceinline__ void store_col8(GAS unsigned char* tile, int d0, int i, const float (&x)[8]) {
#pragma unroll
    for (int e = 0; e < 8; ++e) *(GAS bf16*)(tile + (d0 + e) * 128 + i * 2) = (bf16)f2bf(x[e]);
}
template <class Fac>
__device__ __forceinline__ void att_from_lds(LAS unsigned char* Qs, LAS unsigned char* Ks, GAS unsigned char* tATT, int r16, int q, const Fac& fac) {
#pragma unroll
    for (int nt = 0; nt < 4; ++nt) {
        bf16x8 bq[2];
#pragma unroll
        for (int ks = 0; ks < 2; ++ks) bq[ks] = *(const LAS bf16x8*)(Qs + swz(16 * nt + r16, ks * 4 + q));
        const int i = 16 * nt + r16;
#pragma unroll
        for (int mt = 0; mt < 4; ++mt) {
            unsigned zz; asm volatile("v_mov_b32 %0, 0" : "=v"(zz)); v2u w = (v2u){zz, zz};
            if (mt <= nt) {
                f32x4 acc = (f32x4){0.f, 0.f, 0.f, 0.f};
#pragma unroll
                for (int ks = 0; ks < 2; ++ks) { const bf16x8 ka = *(const LAS bf16x8*)(Ks + swz(16 * mt + r16, ks * 4 + q)); acc = MFMA16(ka, bq[ks], acc); }
                float y[4];
#pragma unroll
                for (int r = 0; r < 4; ++r) { const int j = 16 * mt + 4 * q + r; y[r] = (j <= i) ? acc[r] * fac(i, j) : 0.f; }
                w.x = pk2(y[0], y[1]); w.y = pk2(y[2], y[3]);
            }
            *(GAS v2u*)(tATT + i * 128 + (mt >> 1) * 64 + q * 16 + (mt & 1) * 8) = w;
        }
    }
}

__device__ __forceinline__ void tile_g2l(const GAS bf16* base, size_t pitch, int r0, int step, LAS unsigned char* buf, int lane) {
    const int rr = lane >> 3, ch = lane & 7;
    v4u v[8];
#pragma unroll
    for (int i = 0; i < 8; ++i) v[i] = *(const GAS v4u*)(base + (size_t)(r0 + step * (8 * i + rr)) * pitch + ch * 8);
#pragma unroll
    for (int i = 0; i < 8; ++i) *(LAS v4u*)(buf + swz(8 * i + rr, ch)) = v[i];
}
__device__ __forceinline__ void tile_l2g(LAS unsigned char* buf, GAS unsigned char* tile, int lane) {
    const int rr = lane >> 3, ch = lane & 7;
#pragma unroll
    for (int i = 0; i < 8; ++i) { const int row = 8 * i + rr, ks = ch >> 2, q = ch & 3;
        const v2u lo = *(const LAS v2u*)(buf + swz(row, 4 * ks + (q >> 1)) + 8 * (q & 1)), hi = *(const LAS v2u*)(buf + swz(row, 4 * ks + 2 + (q >> 1)) + 8 * (q & 1));
        v4u v; v.x = lo.x; v.y = lo.y; v.z = hi.x; v.w = hi.y; *(GAS v4u*)(tile + row * 128 + ch * 16) = v; }
}
__device__ __forceinline__ void row_rd(LAS unsigned char* buf, int lane, v4u (&w)[8]) {
#pragma unroll
    for (int c = 0; c < 8; ++c) w[c] = *(const LAS v4u*)(buf + swz(lane, c));
}
__device__ __forceinline__ void row_wr(LAS unsigned char* buf, int lane, const v4u (&w)[8]) {
#pragma unroll
    for (int c = 0; c < 8; ++c) *(LAS v4u*)(buf + swz(lane, c)) = w[c];
}
__device__ __forceinline__ void col_wr_raw(LAS unsigned char* buf, int lane, int d0, const v4u w) {
    const unsigned ww[4] = {w.x, w.y, w.z, w.w};
#pragma unroll
    for (int e = 0; e < 8; ++e) { const int d = d0 + e; *(LAS bf16*)(buf + swz(d, lane >> 3) + (lane & 7) * 2) = (bf16)((e & 1) ? (ww[e >> 1] >> 16) : (ww[e >> 1] & 0xffffu)); }
}
__device__ __forceinline__ void col_wr_f(LAS unsigned char* buf, int lane, int d0, const float (&x)[8]) {
#pragma unroll
    for (int e = 0; e < 8; ++e) { const int d = d0 + e; *(LAS bf16*)(buf + swz(d, lane >> 3) + (lane & 7) * 2) = (bf16)f2bf(x[e]); }
}

__device__ __forceinline__ void m1_ret(Frame& F, int l, int uidx, LAS unsigned char* lw) {
    GAS unsigned char* const ws = wsp();
    const int lane = lane_id_opaque(), r16 = lane & 15, q = lane >> 4;
    const int n = uidx % NCH64, t_ = uidx / NCH64, dir = t_ & 1, h = (t_ >> 1) & 3, b = t_ >> 3;
    int r0, step, t0; unit_rows(b, dir, n, r0, step, t0);
    const int tpos = t0 < 0 ? -1 : t0 + step * lane;
    const GAS bf16* pq = (const GAS bf16*)(ws + WS_P) + PC_RQKV + h * 64;
    const GAS float* ROT = (const GAS float*)(ws + WS_ROT);
    GAS unsigned char* tu = ws + WS_TR + (size_t)uidx * 4 * 8192;
    GAS unsigned char* tU = tu, *tKD = tu + 8192, *tQG = tu + 2 * 8192, *tATT = tu + 3 * 8192;
    LAS unsigned char* bufA = lw; LAS unsigned char* bufB = lw + 8192;
    const float lg = -__expf(inp(I_RDEC)[l * 8 + dir * 4 + h]);
    const float gq = __expf(lg * (float)(lane + 1)), gk = 0.125f * __expf(lg * (float)(63 - lane));
    tile_g2l(pq, DPP, r0, step, bufA, lane); tile_g2l(pq + 256, DPP, r0, step, bufB, lane);
    LDS_WAIT();
    v4u qw[8], kw[8]; row_rd(bufA, lane, qw); row_rd(bufB, lane, kw);
#pragma unroll
    for (int c8 = 0; c8 < 4; ++c8) {
        float ql[8], qh[8], kl[8], kh[8];
        unpack8(qw[c8], ql); unpack8(qw[c8 + 4], qh); unpack8(kw[c8], kl); unpack8(kw[c8 + 4], kh);
        if (tpos >= 0) {
            const GAS float* tab = ROT + (size_t)((c8 < 2 ? (tpos >> 6) : 128 + (tpos & 63)) * 16 + (c8 & 1) * 8) * 2;
#pragma unroll
            for (int e = 0; e < 8; ++e) { const float cs = tab[2 * e], sn = tab[2 * e + 1];
                const float a = ql[e] * cs - qh[e] * sn, bq = ql[e] * sn + qh[e] * cs; ql[e] = a; qh[e] = bq;
                const float c = kl[e] * cs - kh[e] * sn, dk = kl[e] * sn + kh[e] * cs; kl[e] = c; kh[e] = dk; }
        }
#pragma unroll
        for (int e = 0; e < 8; ++e) { ql[e] *= gq; qh[e] *= gq; }
        qw[c8] = pack8(ql); qw[c8 + 4] = pack8(qh); kw[c8] = pack8(kl); kw[c8 + 4] = pack8(kh);
    }
    row_wr(bufA, lane, qw); row_wr(bufB, lane, kw);
    LDS_WAIT();
    att_from_lds(bufA, bufB, tATT, r16, q, [&](int, int j) { return 0.125f * __expf(-lg * (float)(j + 1)); });
    LDS_WAIT();
    tile_l2g(bufA, tQG, lane);
#pragma unroll
    for (int c = 0; c < 8; ++c) { float x[8]; unpack8(kw[c], x);
#pragma unroll
        for (int e = 0; e < 8; ++e) x[e] *= gk;
        col_wr_f(bufB, lane, 8 * c, x); }
    LDS_WAIT();
    tile_l2g(bufB, tKD, lane);
    tile_g2l(pq + 512, DPP, r0, step, bufA, lane);
    LDS_WAIT();
    row_rd(bufA, lane, qw);
#pragma unroll
    for (int c = 0; c < 8; ++c) col_wr_raw(bufB, lane, 8 * c, qw[c]);
    LDS_WAIT();
    tile_l2g(bufB, tU, lane);
    ((GAS float*)(ws + WS_DEC))[(size_t)(2 * UNITS + uidx) * 64 + lane] = __expf(lg * 64.f);
    LDS_WAIT();
}

__device__ __forceinline__ void m1_hgrn(Frame& F, int l, int uidx, LAS unsigned char* lw) {
    GAS unsigned char* const ws = wsp();
    const int lane = lane_id_opaque(), r16 = lane & 15, q = lane >> 4;
    const int n = uidx % NCH64, t_ = uidx / NCH64, dir = t_ & 1, h = (t_ >> 1) & 3, b = t_ >> 3;
    int r0, step, t0; unit_rows(b, dir, n, r0, step, t0);
    const GAS bf16* P = (const GAS bf16*)(ws + WS_P);
    const GAS float* LBp = (const GAS float*)(ws + WS_LB) + l * 256 + h * 64;
    GAS unsigned char* tu = ws + WS_TH + (size_t)uidx * 4 * 8192;
    GAS unsigned char* tU = tu, *tKD = tu + 8192, *tQG = tu + 2 * 8192, *tATT = tu + 3 * 8192;
    GAS float* decp = (GAS float*)(ws + WS_DEC) + (size_t)(1 * UNITS + uidx) * 64;
    LAS unsigned char* bufA = lw; LAS unsigned char* bufB = lw + 8192;
    tile_g2l(P + PC_HQ + h * 64, DPP, r0, step, bufA, lane); tile_g2l(P + PC_HF + dir * 256 + h * 64, DPP, r0, step, bufB, lane);
    LDS_WAIT();
    v4u xqp[8], xkp[8];
#pragma unroll
    for (int g8 = 0; g8 < 8; ++g8) {
        float qv[8], fz[8], gc[8], kk[8];
        unpack8(*(const LAS v4u*)(bufA + swz(lane, g8)), qv); unpack8(*(const LAS v4u*)(bufB + swz(lane, g8)), fz);
        const f32x4 lb0 = *(const GAS f32x4*)(LBp + 8 * g8), lb1 = *(const GAS f32x4*)(LBp + 8 * g8 + 4);
#pragma unroll
        for (int e = 0; e < 8; ++e) { const float lb = e < 4 ? lb0[e] : lb1[e - 4]; const float sg = sigmoidf_(fz[e]);
            kk[e] = (1.f - lb) * (1.f - sg); gc[e] = __logf(lb + (1.f - lb) * sg); qv[e] = siluf_(qv[e]); }
#pragma unroll
        for (int o = 1; o < 64; o <<= 1) {
#pragma unroll
            for (int e = 0; e < 8; ++e) { const float t = shfl_idx(gc[e], (lane - o) & 63); if (lane >= o) gc[e] += t; }
        }
        float xq[8], xk[8], xs[8], xt[8];
#pragma unroll
        for (int e = 0; e < 8; ++e) { const float gm = rdlane(gc[e], 31), g63 = rdlane(gc[e], 63);
            xq[e] = qv[e] * __expf(gc[e]); xk[e] = kk[e] * __expf(g63 - gc[e]);
            xs[e] = qv[e] * __expf(fminf(gc[e] - gm, 80.f)); xt[e] = kk[e] * __expf(fminf(gm - gc[e], 80.f));
            if (lane == e) decp[8 * g8 + e] = __expf(g63); }
        xqp[g8] = pack8(xq); xkp[g8] = pack8(xk);
        *(LAS v4u*)(bufA + swz(lane, g8)) = pack8(xs); *(LAS v4u*)(bufB + swz(lane, g8)) = pack8(xt);
    }
    LDS_WAIT();
    att_from_lds(bufA, bufB, tATT, r16, q, [](int, int) { return 1.f; });
    LDS_WAIT();
    row_wr(bufA, lane, xqp);
#pragma unroll
    for (int c = 0; c < 8; ++c) col_wr_raw(bufB, lane, 8 * c, xkp[c]);
    LDS_WAIT();
    tile_l2g(bufA, tQG, lane); tile_l2g(bufB, tKD, lane);
    tile_g2l(P + PC_HI + h * 64, DPP, r0, step, bufA, lane);
    LDS_WAIT();
    row_rd(bufA, lane, xqp);
#pragma unroll
    for (int c = 0; c < 8; ++c) col_wr_raw(bufB, lane, 8 * c, xqp[c]);
    LDS_WAIT();
    tile_l2g(bufB, tU, lane);
    LDS_WAIT();
}

__device__ __forceinline__ void m1_gdn(Frame& F, int uidx, LAS unsigned char* lw) {
    GAS unsigned char* const ws = wsp();
    const int lane = lane_id_opaque(), r16 = lane & 15, q = lane >> 4;
    const int n = uidx % NCH64, t_ = uidx / NCH64, dir = t_ & 1, h = (t_ >> 1) & 3, b = t_ >> 3;
    int r0, step, t0; unit_rows(b, dir, n, r0, step, t0);
    const GAS bf16* GQ = (const GAS bf16*)(ws + WS_GQ) + h * 64; const GAS bf16* GK = (const GAS bf16*)(ws + WS_GK) + h * 64; const GAS bf16* GV = (const GAS bf16*)(ws + WS_GV) + h * 64;
    const GAS float* GSC = (const GAS float*)(ws + WS_GSC);
    GAS unsigned char* tu = ws + WS_TG + (size_t)uidx * 5 * 8192;
    GAS unsigned char* tW = tu, *tU = tu + 8192, *tKD = tu + 2 * 8192, *tQG = tu + 3 * 8192, *tATT = tu + 4 * 8192;
    LAS float* Am = (LAS float*)lw;
    LAS unsigned char* bufA = lw; LAS unsigned char* bufB = lw + 8192;
    const int myrow = r0 + step * lane;
    float gc = GSC[(size_t)myrow * 16 + dir * 4 + h]; const float beta = GSC[(size_t)myrow * 16 + 8 + dir * 4 + h];
#pragma unroll
    for (int o = 1; o < 64; o <<= 1) { const float t = shfl_idx(gc, (lane - o) & 63); if (lane >= o) gc += t; }
    const float g63 = rdlane(gc, 63);
#pragma unroll 1
    for (int nt = 0; nt < 4; ++nt) {
        const int i = 16 * nt + r16; const size_t irow = (size_t)(r0 + step * i) * 256;
        bf16x8 bk[2], bq[2];
#pragma unroll
        for (int ks = 0; ks < 2; ++ks) { bk[ks] = *(const GAS bf16x8*)(GK + irow + 32 * ks + 8 * q); bq[ks] = *(const GAS bf16x8*)(GQ + irow + 32 * ks + 8 * q); }
        const float gci = shfl_idx(gc, i), bti = shfl_idx(beta, i);
#pragma unroll
        for (int mt = 0; mt < 4; ++mt) {
            unsigned zz; asm volatile("v_mov_b32 %0, 0" : "=v"(zz)); v2u w = (v2u){zz, zz};
            if (mt <= nt) {
                f32x4 a1 = (f32x4){0.f, 0.f, 0.f, 0.f}, a2 = a1;
#pragma unroll
                for (int ks = 0; ks < 2; ++ks) { const bf16x8 ka = *(const GAS bf16x8*)(GK + (size_t)(r0 + step * (16 * mt + r16)) * 256 + 32 * ks + 8 * q); a1 = MFMA16(ka, bk[ks], a1); a2 = MFMA16(ka, bq[ks], a2); }
                f32x4 av; float y[4];
#pragma unroll
                for (int r = 0; r < 4; ++r) { const int j = 16 * mt + 4 * q + r; const float gcj = shfl_idx(gc, j); const float dcy = __expf(fminf(gci - gcj, 0.f));
                    av[r] = (j < i) ? bti * a1[r] * dcy : 0.f; y[r] = (j <= i) ? a2[r] * dcy : 0.f; }
                *(LAS f32x4*)(Am + i * 64 + 16 * mt + 4 * q) = av;
                w.x = pk2(y[0], y[1]); w.y = pk2(y[2], y[3]);
            }
            *(GAS v2u*)(tATT + i * 128 + (mt >> 1) * 64 + q * 16 + (mt & 1) * 8) = w;
        }
    }
    ((GAS float*)(ws + WS_DEC))[(size_t)(0 * UNITS + uidx) * 64 + lane] = __expf(g63);
    const float begc = beta * __expf(gc), kdf = __expf(g63 - gc);
    LDS_WAIT();
#define GDN_SOLVE(x) do { _Pragma("unroll") for (int i = 1; i < 64; ++i) { asm volatile("" ::: "memory"); float s0_ = 0.f, s1_ = 0.f, s2_ = 0.f, s3_ = 0.f; \
        _Pragma("unroll") for (int j4 = 0; j4 < (i + 3) / 4; ++j4) { const f32x4 a = *(const LAS f32x4*)(Am + i * 64 + 4 * j4); \
            if (4 * j4 + 0 < i) s0_ += a[0] * x[4 * j4 + 0]; if (4 * j4 + 1 < i) s1_ += a[1] * x[4 * j4 + 1]; if (4 * j4 + 2 < i) s2_ += a[2] * x[4 * j4 + 2]; if (4 * j4 + 3 < i) s3_ += a[3] * x[4 * j4 + 3]; } \
        float su = x[i] - ((s0_ + s1_) + (s2_ + s3_)); asm volatile("" : "+v"(su)); x[i] = su; } } while (0)
    const unsigned ul = (unsigned)lane;
    {   float x[64];
#pragma unroll
        for (int i = 0; i < 64; ++i) { if ((i & 15) == 0) asm volatile("" ::: "memory"); const GAS bf16* rp = GK + (size_t)(r0 + step * i) * 256; x[i] = rdlane(begc, i) * bf2f(rp[ul]); }
        GDN_SOLVE(x);
#pragma unroll
        for (int i = 0; i < 64; ++i) *(GAS bf16*)(tW + i * 128 + (lane >> 5) * 64 + (8 * ((lane & 15) >> 2) + 4 * ((lane >> 4) & 1) + (lane & 3)) * 2) = (bf16)f2bf(-x[i]);
    }
    asm volatile("" ::: "memory");
    {   float x[64];
#pragma unroll
        for (int i = 0; i < 64; ++i) { if ((i & 15) == 0) asm volatile("" ::: "memory"); const GAS bf16* rp = GV + (size_t)(r0 + step * i) * 256; x[i] = rdlane(beta, i) * bf2f(rp[ul]); }
        GDN_SOLVE(x);
        LDS_WAIT(); asm volatile("" ::: "memory");
        const int lane = lane_id_opaque();
#pragma unroll
        for (int c8 = 0; c8 < 8; ++c8) { float y[8];
#pragma unroll
            for (int e = 0; e < 8; ++e) y[e] = x[8 * c8 + e];
            *(LAS v4u*)(bufB + swz(lane, c8)) = pack8(y); }
    }
    { const int lane = lane_id_opaque(); const unsigned ul = (unsigned)lane;
    LDS_WAIT();
    tile_l2g(bufB, tU, lane);
    { v4u kp[8];
#pragma unroll
        for (int c8 = 0; c8 < 8; ++c8) { float y[8];
#pragma unroll
            for (int e = 0; e < 8; ++e) { const int i = 8 * c8 + e; const GAS bf16* rp = GK + (size_t)(r0 + step * i) * 256; y[e] = bf2f(rp[ul]) * rdlane(kdf, i); }
            kp[c8] = pack8(y); }
        row_wr(bufA, lane, kp); }
    tile_g2l(GQ, 256, r0, step, bufB, lane);
    LDS_WAIT();
    tile_l2g(bufA, tKD, lane);
    { v4u qgp[8]; const float eg = __expf(gc); row_rd(bufB, lane, qgp);
#pragma unroll
        for (int c = 0; c < 8; ++c) { float x[8]; unpack8(qgp[c], x);
#pragma unroll
            for (int e = 0; e < 8; ++e) x[e] *= eg;
            qgp[c] = pack8(x); }
        row_wr(bufB, lane, qgp); }
    LDS_WAIT();
    tile_l2g(bufB, tQG, lane);
    }
#undef GDN_SOLVE
    LDS_WAIT();
}
__device__ __forceinline__ void phase_m1(Frame& F, int l, int sel = 7) {
    frame_refresh(F);
    LAS unsigned char* lw = F.lds + F.wave * 16384;
    const int gw = F.bid * 8 + F.wave, NGW = F.G * 8;
    for (int it = gw; it < 3 * UNITS; it += NGW) {
        const int m = it / UNITS, u = it - m * UNITS;
#ifndef M1MASK
#define M1MASK 7
#endif
        if (m == 0) { if (sel & 1) m1_gdn(F, u, lw); }
        else if (m == 1) { if (sel & 2) m1_hgrn(F, l, u, lw); }
        else { if (sel & 4) m1_ret(F, l, u, lw); }
    }
}

__device__ __forceinline__ void scan_s5(Frame& F, int l, int sub, LAS unsigned char* lds) {
    GAS unsigned char* const ws = wsp();
    const int lane = lane_id_opaque(), g = sub & 15, dir = (sub >> 4) & 1, b = sub >> 5;
    const GAS bf16* P = (const GAS bf16*)(ws + WS_P);
    GAS float* O = (GAS float*)(ws + WS_O5) + (size_t)dir * R * 256;
    const int ldg = (l * 2 + dir) * 16 + g;
    const GAS float* LAM = (const GAS float*)(ws + WS_S5LAM) + (size_t)(ldg * 64 + lane) * 2;
    const GAS float* BB = (const GAS float*)(ws + WS_S5B) + (size_t)(ldg * 64 + lane) * 32;
    const float lr = LAM[0], li = LAM[1];
    float br[16], bi[16];
#pragma unroll
    for (int c = 0; c < 16; ++c) { br[c] = BB[2 * c]; bi[c] = BB[2 * c + 1]; }
    LAS float* US = (LAS float*)lds; LAS float* HS = US + 1024; LAS float* CS = HS + 32 * 130; LAS float* YS = CS + 2048;
    { const GAS float* cre = inp(I_S5CRE) + (size_t)ldg * 16 * 64; const GAS float* cim = inp(I_S5CIM) + (size_t)ldg * 16 * 64;
        for (int i = lane; i < 1024; i += 64) { CS[i * 2] = cre[i]; CS[i * 2 + 1] = cim[i]; } }
    float hr = 0.f, hi = 0.f;
    v4u ust;
    auto load = [&](int c) { int r0, step, t0; chunk_rows(b, dir, c, r0, step, t0); const int tt = lane >> 1, half = lane & 1; const int row = r0 + step * tt;
        ust = *(const GAS v4u*)(P + (size_t)row * DPP + PC_S5U + g * 16 + half * 8); };
    auto stage = [&](int buf) { const int tt = lane >> 1, half = lane & 1; LAS float* u = US + buf * 512 + tt * 16 + half * 8; const unsigned w[4] = {ust.x, ust.y, ust.z, ust.w};
        *(LAS f32x4*)u = (f32x4){bflo(w[0]), bfhi(w[0]), bflo(w[1]), bfhi(w[1])}; *(LAS f32x4*)(u + 4) = (f32x4){bflo(w[2]), bfhi(w[2]), bflo(w[3]), bfhi(w[3])}; };
    load(0); stage(0);
    for (int c = 0; c < NCHUNK; ++c) {
        const int buf = c & 1;
        if (c + 1 < NCHUNK) load(c + 1);
        LDS_WAIT();
        const LAS float* U = US + buf * 512;
        for (int tt = 0; tt < TCH; ++tt) {
            f32x4 u[4];
#pragma unroll
            for (int i = 0; i < 4; ++i) u[i] = *(const LAS f32x4*)(U + tt * 16 + 4 * i);
            float ar = 0.f, ai = 0.f;
#pragma unroll
            for (int cc = 0; cc < 16; ++cc) { ar += br[cc] * u[cc >> 2][cc & 3]; ai += bi[cc] * u[cc >> 2][cc & 3]; }
            const float nr = lr * hr - li * hi + ar, ni = lr * hi + li * hr + ai;
            hr = nr; hi = ni;
            *(LAS f32x2*)(HS + tt * 130 + lane * 2) = (f32x2){hr, hi};
        }
        LDS_WAIT();
        { const int cc = lane & 15, tq = lane >> 4;
            float acc[8];
#pragma unroll
            for (int k = 0; k < 8; ++k) acc[k] = 0.f;
            for (int p = 0; p < 64; ++p) {
                const f32x2 cv = *(const LAS f32x2*)(CS + (cc * 64 + p) * 2);
#pragma unroll
                for (int k = 0; k < 8; ++k) { const f32x2 hv = *(const LAS f32x2*)(HS + (tq * 8 + k) * 130 + p * 2); acc[k] += cv[0] * hv[0] - cv[1] * hv[1]; }
            }
#pragma unroll
            for (int k = 0; k < 8; ++k) YS[(tq * 8 + k) * 16 + cc] = acc[k];
        }
        LDS_WAIT();
        { int r0, step, t0; chunk_rows(b, dir, c, r0, step, t0); const int tt = lane >> 1, half = lane & 1; const int row = r0 + step * tt;
            GAS float* op = O + (size_t)row * 256 + g * 16 + half * 8;
            *(GAS f32x4*)op = *(const LAS f32x4*)(YS + tt * 16 + half * 8); *(GAS f32x4*)(op + 4) = *(const LAS f32x4*)(YS + tt * 16 + half * 8 + 4); }
        if (c + 1 < NCHUNK) stage(buf ^ 1);
    }
}

__device__ __forceinline__ int s5_tokrow(int b, int sc) { return sc < 16 ? NLAT + b * CTXL + sc * 16 : b * SEQ + (sc - 16) * 16; }
__device__ __forceinline__ void s5_relayout(Frame& F) {
    GAS unsigned char* const ws = wsp();
    const GAS bf16* P = (const GAS bf16*)(ws + WS_P); GAS bf16* A2 = (GAS bf16*)(ws + WS_S5A2);
    const int gw = F.bid * 8 + F.wave, NGW = F.G * 8, lane = F.lane, g = lane & 15;
    for (int it = gw; it < 2112; it += NGW) {
        const int b = it / 528, sc = it - b * 528, r0 = s5_tokrow(b, sc);
#pragma unroll
        for (int i = 0; i < 4; ++i) { const int t = i * 4 + (lane >> 4);
            const GAS bf16* src = P + (size_t)(r0 + t) * DPP + PC_S5U + g * 16;
            GAS bf16* dst = A2 + ((size_t)(g * 2112 + it) * 512 + t * 16);
            const v4u a = *(const GAS v4u*)src, c = *(const GAS v4u*)(src + 8);
            *(GAS v4u*)dst = a; *(GAS v4u*)(dst + 8) = c; }
    }
}
__device__ __forceinline__ void s5_build(Frame& F, int l) {
    GAS unsigned char* const ws = wsp();
    const GAS float* LAM = (const GAS float*)(ws + WS_S5LAM); const GAS float* BB = (const GAS float*)(ws + WS_S5B);
    const GAS float* cre = inp(I_S5CRE); const GAS float* cim = inp(I_S5CIM);
    GAS bf16* EB = (GAS bf16*)(ws + WS_S5EB); GAS bf16* WY = (GAS bf16*)(ws + WS_S5WY);
    const int gt = F.bid * 512 + F.tid, NT = F.G * 512;
    {   LAS float* kl = (LAS float*)(F.lds + F.wave * 256);
        const int gw = F.bid * 8 + F.wave, NGW = F.G * 8, p = F.lane;
        for (int it = gw; it < 4096; it += NGW) {
            const int g = it >> 8, c = (it >> 4) & 15, c2 = it & 15;
            float Kv[32];
#pragma unroll
            for (int d = 0; d < 2; ++d) { const int i0 = ((l * 2 + d) * 16 + g) * 64 + p;
                const float lr = LAM[i0 * 2], li = LAM[i0 * 2 + 1], br = BB[((size_t)i0 * 16 + c2) * 2], bi = BB[((size_t)i0 * 16 + c2) * 2 + 1];
                const size_t ci_ = (size_t)((l * 2 + d) * 16 + g) * 1024 + c * 64 + p; const float cr = cre[ci_], ci = cim[ci_];
                float wr_ = cr * br - ci * bi, wi_ = cr * bi + ci * br;
#pragma unroll
                for (int j = 0; j < 16; ++j) { Kv[d * 16 + j] = wr_; const float nr = wr_ * lr - wi_ * li; wi_ = wr_ * li + wi_ * lr; wr_ = nr; } }
#pragma unroll
            for (int j = 0; j < 32; ++j) { const float r = wave_sum(Kv[j]); if (p == j) kl[j] = r; }
            LDS_WAIT();
            GAS bf16* wy = WY + (size_t)g * 256 * 512;
#pragma unroll
            for (int e = 0; e < 4; ++e) { const int idx = p * 4 + e, t = idx >> 4, s2 = idx & 15;
                const float v = s2 < t ? kl[t - s2] : (s2 > t ? kl[16 + s2 - t] : kl[0] + kl[16]); wy[(size_t)(t * 16 + c) * 512 + s2 * 16 + c2] = (bf16)f2bf(v); }
            LDS_WAIT();
        }
    }
    for (int it = gt; it < 32768; it += NT) {
        const int p = it & 63, c = (it >> 6) & 15, d = (it >> 10) & 1, g = it >> 11;
        const int i0 = ((l * 2 + d) * 16 + g) * 64 + p;
        const float lr = LAM[i0 * 2], li = LAM[i0 * 2 + 1], br = BB[((size_t)i0 * 16 + c) * 2], bi = BB[((size_t)i0 * 16 + c) * 2 + 1];
        const size_t ci_ = (size_t)((l * 2 + d) * 16 + g) * 1024 + c * 64 + p; const float cr = cre[ci_], ci = cim[ci_];
        float pr[17], pi[17]; pr[0] = 1.f; pi[0] = 0.f;
#pragma unroll
        for (int j = 1; j < 17; ++j) { pr[j] = pr[j - 1] * lr - pi[j - 1] * li; pi[j] = pr[j - 1] * li + pi[j - 1] * lr; }
        GAS bf16* wy = WY + (size_t)g * 256 * 512 + 256 + d * 128 + 2 * p; GAS bf16* eb = EB + (size_t)g * 256 * 256 + (size_t)(d * 128 + 2 * p) * 256;
#pragma unroll
        for (int t = 0; t < 16; ++t) {
            const int jw = d == 0 ? t + 1 : 16 - t, je = d == 0 ? 15 - t : t;
            const float xr = cr * pr[jw] - ci * pi[jw], xi = cr * pi[jw] + ci * pr[jw];
            *(GAS unsigned*)(wy + (size_t)(t * 16 + c) * 512) = pk2(xr, -xi);
            const float er = pr[je] * br - pi[je] * bi, ei = pr[je] * bi + pi[je] * br;
            eb[t * 16 + c] = (bf16)f2bf(er); eb[256 + t * 16 + c] = (bf16)f2bf(ei);
        }
    }
}
__device__ __forceinline__ void s5_scan(Frame& F, int l, int sub) {
    GAS unsigned char* const ws = wsp();
    const int lane = lane_id_opaque(), g = sub & 15, dir = (sub >> 4) & 1, b = sub >> 5;
    const GAS float* LAM = (const GAS float*)(ws + WS_S5LAM) + (size_t)((((l * 2 + dir) * 16 + g) * 64 + lane) * 2);
    float lr = LAM[0], li = LAM[1];
#pragma unroll
    for (int k = 0; k < 4; ++k) { const float nr = lr * lr - li * li; li = 2.f * lr * li; lr = nr; }
    const GAS unsigned* HL = (const GAS unsigned*)(ws + WS_S5HL) + (size_t)(g * 2112 + b * 528) * 128 + dir * 64 + lane;
    GAS unsigned* HI = (GAS unsigned*)(ws + WS_S5A2) + (size_t)(g * 2112 + b * 528) * 256 + 128 + dir * 64 + lane;
    float hr = 0.f, hi = 0.f;
#pragma unroll 1
    for (int k0 = 0; k0 < 528; k0 += 48) {
        unsigned w[48];
#pragma unroll
        for (int j = 0; j < 48; ++j) { const int k = k0 + j; const int sc = dir == 0 ? k : (k < 16 ? 15 - k : 543 - k); w[j] = HL[(size_t)sc * 128]; }
#pragma unroll
        for (int j = 0; j < 48; ++j) { const int k = k0 + j; const int sc = dir == 0 ? k : (k < 16 ? 15 - k : 543 - k);
            HI[(size_t)sc * 256] = pk2(hr, hi);
            const float nr = lr * hr - li * hi + bflo(w[j]), ni = lr * hi + li * hr + bfhi(w[j]); hr = nr; hi = ni; }
    }
}
#ifndef NEWCHAIN
#define NEWCHAIN 7
#endif
__device__ __forceinline__ void phase_scans(Frame& F, int l) {
    frame_refresh(F);
#ifdef CHAINCMP
    if (F.bid < 96) {
        const int m = F.bid >> 5, cid = F.bid & 31;
        if (F.wave < 4) { const int sub = cid * 4 + F.wave; if (m == 0) chain_run<0>(F, sub); else if (m == 1) chain_run<1>(F, sub); else chain_run<2>(F, sub); }
        __syncthreads();
        if (l == 0) { GAS bf16* ob2 = (GAS bf16*)outp(); if (m == 0) { chain_wg<0>(F, cid, 0, ob2); } else if (m == 1) { chain_wg<1>(F, cid, 0, ob2); } else { chain_wg<2>(F, cid, 0, ob2); } }
    } else {
        for (int it = (F.bid - 96) + (F.G - 96) * F.wave; it < 128; it += (F.G - 96) * 8) s5_scan(F, l, it);
    }
#else
    if (F.bid < 192) {
        const int half = (F.bid >> 3) & 1, c_ = (F.bid >> 4) * 8 + (F.bid & 7), m = c_ >> 5, cid = c_ & 31;
        if (m == 0) chain_wg<0>(F, cid, half); else if (m == 1) chain_wg<1>(F, cid, half); else chain_wg<2>(F, cid, half);
    } else {
        for (int it = (F.bid - 192) + (F.G - 192) * F.wave; it < 128; it += (F.G - 192) * 8) s5_scan(F, l, it);
    }
#endif
}

__device__ __forceinline__ void phase_readout(Frame& F, int l) {
    frame_refresh(F); GAS unsigned char* const ws = wsp();
    const GAS bf16* P = (const GAS bf16*)(ws + WS_P);
    GAS bf16* MIX = (GAS bf16*)(ws + WS_MIX); GAS bf16* YA = (GAS bf16*)(ws + WS_GQ);
    GAS float* O5 = (GAS float*)(ws + WS_O5); const GAS bf16* OB = (const GAS bf16*)(ws + WS_OB);
    const int gw = F.bid * 8 + F.wave, NGW = F.G * 8, lane = F.lane;
    const int dch = (4 * lane) & 63;
    const f32x4 gnw = *(const GAS f32x4*)(inp(I_GNW) + l * 64 + dch), hnw = *(const GAS f32x4*)(inp(I_HNW) + l * 64 + dch);
    const f32x4 dsk = *(const GAS f32x4*)(inp(I_S5D) + l * 256 + 4 * lane);
    const size_t OBS = (size_t)R * 256;
    for (int row0 = gw; row0 < R; row0 += 2 * NGW) {
        int rows[2]; rows[0] = row0; rows[1] = row0 + NGW < R ? row0 + NGW : row0;
        v2u of[2][3], ob[2][3], gg[2][3];
#pragma unroll
        for (int u = 0; u < 2; ++u) { const GAS bf16* pr = P + (size_t)rows[u] * DPP; const size_t ro = (size_t)rows[u] * 256 + 4 * lane;
#pragma unroll
            for (int m = 0; m < 3; ++m) { of[u][m] = *(const GAS v2u*)(OB + (size_t)(m * 2) * OBS + ro); ob[u][m] = *(const GAS v2u*)(OB + (size_t)(m * 2 + 1) * OBS + ro);
                gg[u][m] = *(const GAS v2u*)(pr + (m == 0 ? PC_GZ : (m == 1 ? PC_HG : PC_RG)) + 4 * lane); } }
#pragma unroll
        for (int u = 0; u < 2; ++u)
#pragma unroll
            for (int m = 0; m < 3; ++m) {
                const v2u f_ = of[u][m], b_ = ob[u][m], g_ = gg[u][m];
                const float o[4] = {bflo(f_.x) + bflo(b_.x), bfhi(f_.x) + bfhi(b_.x), bflo(f_.y) + bflo(b_.y), bfhi(f_.y) + bfhi(b_.y)};
                const float ss = sum16(o[0] * o[0] + o[1] * o[1] + o[2] * o[2] + o[3] * o[3]);
                const float r = __builtin_amdgcn_rsqf(ss * (1.f / 64.f) + RMS_EPS);
                const float gt[4] = {bflo(g_.x), bfhi(g_.x), bflo(g_.y), bfhi(g_.y)};
                float y[4];
#pragma unroll
                for (int i = 0; i < 4; ++i) { const float nw = m == 0 ? gnw[i] : (m == 1 ? hnw[i] : 1.f); y[i] = o[i] * r * nw * siluf_(gt[i]); }
                v2u w; w.x = pk2(y[0], y[1]); w.y = pk2(y[2], y[3]);
                *(GAS v2u*)(MIX + (size_t)rows[u] * D + (m == 0 ? 0 : (m == 1 ? 512 : 768)) + 4 * lane) = w;
            }
    }
}

template <bool ROUTE>
__device__ __forceinline__ void phase_ln(Frame& F, int l, int which) {
    frame_refresh(F); GAS unsigned char* const ws = wsp();
    const GAS bf16* DL = (const GAS bf16*)(ws + WS_Y);
    const bool xin = (l == 0 && which == 0);
    const GAS float* xsl = xin ? inp(I_X) : (const GAS float*)outp(); const GAS float* xsc = xin ? inp(I_CTX) : (const GAS float*)(ws + WS_XC);
    const GAS float* MOD = (const GAS float*)(ws + WS_MOD);
    const GAS float* lg = inp(I_LNG) + (size_t)(l * 2 + which) * D; const GAS float* lb = inp(I_LNB) + (size_t)(l * 2 + which) * D;
    const bool last = (l == DEPTH - 1 && which == 1);
    const int nl = which == 0 ? l : l + 1, shoff = which == 0 ? 3072 : 0, scoff = which == 0 ? 4096 : 1024;
    const int lane = F.lane;
    GAS float* xl = outp(); GAS float* xc = (GAS float*)(ws + WS_XC); GAS bf16* Ab = (GAS bf16*)(ws + WS_A);
    if constexpr (!ROUTE) {
        const int gw = F.bid * 8 + F.wave, NGW = F.G * 8;
        const int nrows = last ? NLAT : R;
        f32x4 lgv[4], lbv[4], shv[4], scv[4]; int cslot = -1;
#pragma unroll
        for (int j = 0; j < 4; ++j) { lgv[j] = *(const GAS f32x4*)(lg + 4 * lane + 256 * j); lbv[j] = *(const GAS f32x4*)(lb + 4 * lane + 256 * j); }
        for (int row = gw; row < nrows; row += 2 * NGW) {
            const int rowb = row + NGW < nrows ? row + NGW : row;
            f32x4 v[4], w[4]; const GAS float* xs = xrow_src(xsl, xsc, row); const GAS float* xsb = xrow_src(xsl, xsc, rowb);
#pragma unroll
            for (int j = 0; j < 4; ++j) { const v2u dw = *(const GAS v2u*)(DL + (size_t)row * D + 4 * lane + 256 * j), db = *(const GAS v2u*)(DL + (size_t)rowb * D + 4 * lane + 256 * j);
                v[j] = *(const GAS f32x4*)(xs + 4 * lane + 256 * j) * ALPHA + (f32x4){bflo(dw.x), bfhi(dw.x), bflo(dw.y), bfhi(dw.y)};
                w[j] = *(const GAS f32x4*)(xsb + 4 * lane + 256 * j) * ALPHA + (f32x4){bflo(db.x), bfhi(db.x), bflo(db.y), bfhi(db.y)}; }
            ln_row2h(v, w, lgv, lbv);
            GAS float* xd = xrow_dst(xl, xc, row); GAS float* xdb = xrow_dst(xl, xc, rowb);
#pragma unroll
            for (int j = 0; j < 4; ++j) { *(GAS f32x4*)(xd + 4 * lane + 256 * j) = v[j]; *(GAS f32x4*)(xdb + 4 * lane + 256 * j) = w[j]; }
            if (!last) { const int sl = row_slot(row), slb = row_slot(rowb);
                if (sl != cslot) { const GAS float* mr = MOD + (size_t)(nl * 5 + sl) * 6144;
#pragma unroll
                    for (int j = 0; j < 4; ++j) { shv[j] = *(const GAS f32x4*)(mr + shoff + 4 * lane + 256 * j); scv[j] = *(const GAS f32x4*)(mr + scoff + 4 * lane + 256 * j); }
                    cslot = sl; }
                store_A_rowh(Ab, lane, row, v, shv, scv);
                if (slb == sl) store_A_rowh(Ab, lane, rowb, w, shv, scv); else store_A_row(Ab, lane, rowb, w, MOD + (size_t)(nl * 5 + slb) * 6144, shoff, scoff); }
        }
    } else {
        LAS int* cnt = (LAS int*)F.lds;
        if (F.tid < 8) cnt[F.tid] = 0;
        __syncthreads();
        const GAS float* rw = inp(I_MROUTER) + (size_t)(l >> 1) * D * NEXP;
        f32x4 rwa[4][4][2];
#pragma unroll
        for (int j = 0; j < 4; ++j)
#pragma unroll
            for (int i = 0; i < 4; ++i) { const GAS float* p = rw + (size_t)(4 * lane + 256 * j + i) * 8; rwa[j][i][0] = *(const GAS f32x4*)p; rwa[j][i][1] = *(const GAS f32x4*)(p + 4); }
        GAS int* TOPE = (GAS int*)(ws + WS_TOPE); GAS float* TOPG = (GAS float*)(ws + WS_TOPG);
        const int Rl = (l == DEPTH - 1) ? NLAT : R;
        const int RPW = (Rl + F.G - 1) / F.G, rbeg = F.bid * RPW, rend = min(Rl, rbeg + RPW);
        for (int row0 = rbeg + F.wave; row0 < rend; row0 += 16) {
            const bool two = row0 + 8 < rend; const int rowb = two ? row0 + 8 : row0;
            f32x4 v[4], w[4]; const GAS float* xs = xrow_src(xsl, xsc, row0); const GAS float* xsb = xrow_src(xsl, xsc, rowb);
#pragma unroll
            for (int j = 0; j < 4; ++j) { const v2u dw = *(const GAS v2u*)(DL + (size_t)row0 * D + 4 * lane + 256 * j), db = *(const GAS v2u*)(DL + (size_t)rowb * D + 4 * lane + 256 * j);
                v[j] = *(const GAS f32x4*)(xs + 4 * lane + 256 * j) * ALPHA + (f32x4){bflo(dw.x), bfhi(dw.x), bflo(dw.y), bfhi(dw.y)};
                w[j] = *(const GAS f32x4*)(xsb + 4 * lane + 256 * j) * ALPHA + (f32x4){bflo(db.x), bfhi(db.x), bflo(db.y), bfhi(db.y)}; }
            ln_row2(v, w, lg, lb, lane);
            GAS float* xd = xrow_dst(xl, xc, row0); GAS float* xdb = xrow_dst(xl, xc, rowb);
#pragma unroll
            for (int j = 0; j < 4; ++j) { *(GAS f32x4*)(xd + 4 * lane + 256 * j) = v[j]; *(GAS f32x4*)(xdb + 4 * lane + 256 * j) = w[j]; }
#pragma unroll
            for (int u = 0; u < 2; ++u) {
                if (u == 1 && !two) break;
                const int row = u == 0 ? row0 : rowb; const f32x4 (&vv)[4] = u == 0 ? v : w;
                const GAS float* modrow = MOD + (size_t)(nl * 5 + row_slot(row)) * 6144;
                float lgt[8];
#pragma unroll
                for (int e = 0; e < 8; ++e) lgt[e] = 0.f;
                GAS bf16* ar = Ab + (size_t)row * D;
#pragma unroll
                for (int j = 0; j < 4; ++j) { const int c = 4 * lane + 256 * j; const f32x4 sh = *(const GAS f32x4*)(modrow + shoff + c), sc = *(const GAS f32x4*)(modrow + scoff + c);
                    const f32x4 hv = vv[j] * (sc + 1.f) + sh;
                    { v2u w2; w2.x = pk2(hv[0], hv[1]); w2.y = pk2(hv[2], hv[3]); *(GAS v2u*)(ar + c) = w2; }
#pragma unroll
                    for (int i = 0; i < 4; ++i)
#pragma unroll
                        for (int e = 0; e < 8; ++e) lgt[e] += hv[i] * rwa[j][i][e >> 2][e & 3]; }
#pragma unroll
                for (int e = 0; e < 8; ++e) lgt[e] = wave_sum(lgt[e]);
                int e0 = 0; float v0 = lgt[0];
#pragma unroll
                for (int e = 1; e < 8; ++e) if (lgt[e] > v0) { v0 = lgt[e]; e0 = e; }
                int e1 = -1; float v1 = -3.0e38f;
#pragma unroll
                for (int e = 0; e < 8; ++e) if (e != e0 && lgt[e] > v1) { v1 = lgt[e]; e1 = e; }
                if (lane == 0) { const float ex = __expf(v1 - v0); const float g0 = 1.f / (1.f + ex); TOPE[row] = e0 | (e1 << 8); TOPG[row * 2] = g0; TOPG[row * 2 + 1] = ex * g0;
                    __hip_atomic_fetch_add(&cnt[e0], 1, __ATOMIC_RELAXED, __HIP_MEMORY_SCOPE_WORKGROUP); __hip_atomic_fetch_add(&cnt[e1], 1, __ATOMIC_RELAXED, __HIP_MEMORY_SCOPE_WORKGROUP); }
            }
        }
        __syncthreads();
        if (F.tid < 8) ((GAS int*)(ws + WS_WGCNT))[F.bid * 8 + F.tid] = cnt[F.tid];
    }
}

__device__ __forceinline__ void phase_moe_assign(Frame& F, int l) {
    frame_refresh(F); GAS unsigned char* const ws = wsp();
    LAS int* sm = (LAS int*)F.lds;
    const GAS int* WGCNT = (const GAS int*)(ws + WS_WGCNT);
    if (F.tid < 8) { int tot = 0, pre = 0; for (int w = 0; w < F.G; ++w) { const int c = WGCNT[w * 8 + F.tid]; tot += c; if (w < F.bid) pre += c; } sm[16 + F.tid] = tot; sm[24 + F.tid] = pre; sm[8 + F.tid] = 0; }
    __syncthreads();
    if (F.tid == 0) { int ps = 0; GAS int* info = (GAS int*)(ws + WS_MOEINFO);
        for (int e = 0; e < 8; ++e) { sm[e] = ps + sm[24 + e]; if (F.bid == 0) info[e] = ps >> 8; ps += (sm[16 + e] + 255) & ~255; }
        if (F.bid == 0) { info[8] = ps >> 8; } }
    __syncthreads();
    if (F.bid == 0 && F.tid < 272) { GAS int* info = (GAS int*)(ws + WS_MOEINFO); int ps = 0, e = 0;
        for (int q = 0; q < 8; ++q) { ps += (sm[16 + q] + 255) >> 8; if (F.tid >= ps) e = q + 1; }
        info[16 + F.tid] = e < 8 ? e : 7; }
    __syncthreads();
    const GAS int* TOPE = (const GAS int*)(ws + WS_TOPE); const GAS float* TOPG = (const GAS float*)(ws + WS_TOPG);
    GAS int* TOKPOS = (GAS int*)(ws + WS_TOKPOS); GAS float* ROWG = (GAS float*)(ws + WS_ROWG);
    const GAS bf16* A = (const GAS bf16*)(ws + WS_A); GAS bf16* XG = (GAS bf16*)(ws + WS_XG);
    const int Rl = (l == DEPTH - 1) ? NLAT : R;
    const int RPW = (Rl + F.G - 1) / F.G, rbeg = F.bid * RPW, rend = min(Rl, rbeg + RPW);
    for (int row = rbeg + F.wave; row < rend; row += 8) {
        int p0 = 0, p1 = 0;
        if (F.lane == 0) { const int te = TOPE[row]; const int e0 = te & 255, e1 = te >> 8;
            p0 = sm[e0] + __hip_atomic_fetch_add(&sm[8 + e0], 1, __ATOMIC_RELAXED, __HIP_MEMORY_SCOPE_WORKGROUP); p1 = sm[e1] + __hip_atomic_fetch_add(&sm[8 + e1], 1, __ATOMIC_RELAXED, __HIP_MEMORY_SCOPE_WORKGROUP);
            TOKPOS[row * 2] = p0; TOKPOS[row * 2 + 1] = p1; ROWG[p0] = TOPG[row * 2]; ROWG[p1] = TOPG[row * 2 + 1]; }
        p0 = __builtin_amdgcn_readfirstlane(p0); p1 = __builtin_amdgcn_readfirstlane(p1);
        const v4u a0 = *(const GAS v4u*)(A + (size_t)row * D + 8 * F.lane), a1 = *(const GAS v4u*)(A + (size_t)row * D + 512 + 8 * F.lane);
        *(GAS v4u*)(XG + (size_t)p0 * D + 8 * F.lane) = a0; *(GAS v4u*)(XG + (size_t)p0 * D + 512 + 8 * F.lane) = a1;
        *(GAS v4u*)(XG + (size_t)p1 * D + 8 * F.lane) = a0; *(GAS v4u*)(XG + (size_t)p1 * D + 512 + 8 * F.lane) = a1;
    }
}
__device__ __forceinline__ void phase_moe_combine(Frame& F, int l) {
    frame_refresh(F); GAS unsigned char* const ws = wsp();
    const GAS float* MOD = (const GAS float*)(ws + WS_MOD);
    const GAS float* lg = inp(I_LNG) + (size_t)(l * 2 + 1) * D; const GAS float* lb = inp(I_LNB) + (size_t)(l * 2 + 1) * D;
    const bool last = (l == DEPTH - 1);
    const GAS int* TOKPOS = (const GAS int*)(ws + WS_TOKPOS); const GAS bf16* YB = (const GAS bf16*)(ws + WS_XG);
    const int gw = F.bid * 8 + F.wave, NGW = F.G * 8, lane = F.lane;
    const int nrows = last ? NLAT : R;
    GAS float* xl = outp(); GAS float* xc = (GAS float*)(ws + WS_XC); GAS bf16* Ab = (GAS bf16*)(ws + WS_A);
    f32x4 lgv[4], lbv[4], shv[4], scv[4], gtv[4]; int cslot = -1;
#pragma unroll
    for (int j = 0; j < 4; ++j) { lgv[j] = *(const GAS f32x4*)(lg + 4 * lane + 256 * j); lbv[j] = *(const GAS f32x4*)(lb + 4 * lane + 256 * j); }
    for (int row = gw; row < nrows; row += 2 * NGW) {
        const int rowb = row + NGW < nrows ? row + NGW : row;
        const int p0 = TOKPOS[row * 2], p1 = TOKPOS[row * 2 + 1], q0 = TOKPOS[rowb * 2], q1 = TOKPOS[rowb * 2 + 1];
        const GAS float* xs = xrow_src(xl, xc, row); const GAS float* xsb = xrow_src(xl, xc, rowb);
        const int sl = row_slot(row), slb = row_slot(rowb);
        if (sl != cslot) { const GAS float* mg = MOD + (size_t)(l * 5 + sl) * 6144 + 5120; const GAS float* mr = MOD + (size_t)((last ? l : l + 1) * 5 + sl) * 6144;
#pragma unroll
            for (int j = 0; j < 4; ++j) { gtv[j] = *(const GAS f32x4*)(mg + 4 * lane + 256 * j); shv[j] = *(const GAS f32x4*)(mr + 4 * lane + 256 * j); scv[j] = *(const GAS f32x4*)(mr + 1024 + 4 * lane + 256 * j); }
            cslot = sl; }
        const GAS float* gpb = MOD + (size_t)(l * 5 + slb) * 6144 + 5120;
        f32x4 v[4], w[4];
#pragma unroll
        for (int j = 0; j < 4; ++j) { const int c = 4 * lane + 256 * j;
            const v2u y0 = *(const GAS v2u*)(YB + (size_t)p0 * D + c), y1 = *(const GAS v2u*)(YB + (size_t)p1 * D + c), z0 = *(const GAS v2u*)(YB + (size_t)q0 * D + c), z1 = *(const GAS v2u*)(YB + (size_t)q1 * D + c);
            const f32x4 f = (f32x4){bflo(y0.x) + bflo(y1.x), bfhi(y0.x) + bfhi(y1.x), bflo(y0.y) + bflo(y1.y), bfhi(y0.y) + bfhi(y1.y)};
            const f32x4 h = (f32x4){bflo(z0.x) + bflo(z1.x), bfhi(z0.x) + bfhi(z1.x), bflo(z0.y) + bflo(z1.y), bfhi(z0.y) + bfhi(z1.y)};
            v[j] = *(const GAS f32x4*)(xs + c) * ALPHA + gtv[j] * f;
            const f32x4 gb_ = (slb == sl) ? gtv[j] : *(const GAS f32x4*)(gpb + c);
            w[j] = *(const GAS f32x4*)(xsb + c) * ALPHA + gb_ * h; }
        ln_row2h(v, w, lgv, lbv);
        GAS float* xd = xrow_dst(xl, xc, row); GAS float* xdb = xrow_dst(xl, xc, rowb);
#pragma unroll
        for (int j = 0; j < 4; ++j) { *(GAS f32x4*)(xd + 4 * lane + 256 * j) = v[j]; *(GAS f32x4*)(xdb + 4 * lane + 256 * j) = w[j]; }
        if (!last) { store_A_rowh(Ab, lane, row, v, shv, scv);
            if (slb == sl) store_A_rowh(Ab, lane, rowb, w, shv, scv); else store_A_row(Ab, lane, rowb, w, MOD + (size_t)((l + 1) * 5 + slb) * 6144, 0, 1024); }
    }
}

#ifndef PHMASK
#define PHMASK 0xFFFFFFFFu
#endif
#define PK(k) ((PHMASK >> (k)) & 1u)
constexpr int PPL = 12, NPHASE = 2 + DEPTH * PPL;
__global__ void __launch_bounds__(512, 2) fwd(Args args) {
    extern __shared__ __attribute__((aligned(16))) unsigned char lds_raw[];
    Frame F;
    F.lds = (LAS unsigned char*)lds_raw;
    F.tid = threadIdx.x; F.lane = F.tid & 63; F.wave = __builtin_amdgcn_readfirstlane(F.tid >> 6); F.G = gridDim.x; F.bid = blockIdx.x;
    volatile LAS unsigned* MISC = (volatile LAS unsigned*)(F.lds + LDSCTL_OFF);
    if (F.tid < 64) MISC[F.tid] = 0u;
    __syncthreads();
#if MK_ONE_LAUNCH
    XcdBarrier bar = xcd_barrier_post((GAS unsigned*)(args.ws + WS_CTL) + 4096, MISC + 8, F.wave);
#else
    const int lo = args.ph_lo, hi = args.ph_hi;
    XcdBarrier bar; bar.bar = (GAS unsigned*)(args.ws + WS_CTL) + 4096; bar.x = 0; bar.st = nullptr;
    if (hi - lo > 1) bar = xcd_barrier_post((GAS unsigned*)(args.ws + WS_CTL) + 4096, MISC + 8, F.wave);
#endif
#ifndef DUPMASK
#define DUPMASK 0u
#endif
#define NREP(kind) (((DUPMASK >> (kind)) & 1u) ? 2 : 1)
#define DUPBAR(kind, r) do { if (((DUPMASK >> (kind)) & 1u) && (r) == 0) xcd_barrier(bar, F.wave); } while (0)
#ifndef PROBE_A
#define PROBE_A -1
#endif
#ifndef PROBE_B
#define PROBE_B -1
#endif
#if PROBE_A >= 0
#define PSTAMP(kind) do { if (blockIdx.x == 0 && F.wave == 0) { const unsigned long long t_ = __builtin_amdgcn_s_memrealtime(); MISC[32 + (kind)] += (unsigned)(t_ - ((unsigned long long)MISC[30] | ((unsigned long long)MISC[31] << 32))); MISC[30] = (unsigned)t_; MISC[31] = (unsigned)(t_ >> 32); } } while (0)
#else
#define PSTAMP(kind) do { } while (0)
#endif
#if MK_ONE_LAUNCH
#define IN(k) true
#define PKIND_OF(k) (((k) < 2) ? (k) : (2 + ((k) - 2) % 12 + ((((((k) - 2) / 12) & 1) && ((k) - 2) % 12 >= 8) ? 12 : 0)))
#define SEAM(k) do { xcd_barrier(bar, F.wave); PSTAMP(PKIND_OF(k)); } while (0)
#else
#define IN(k) (lo <= (k) && (k) < hi)
#define SEAM(k) do { if (IN((k) + 1)) xcd_barrier(bar, F.wave); } while (0)
#endif
    LAS unsigned char* ring = F.lds;
    PSTAMP(31);

    if (IN(0)) { if (PK(0)) phase_prologue(F); SEAM(0); }
    if (IN(1)) { if (PK(1)) phase_a0(F); SEAM(1); }
    for (int l = 0; l < DEPTH; ++l) {
        const int pb = 2 + l * PPL;
        const bool moe = (l & 1) != 0;
        if (PK(3) && IN(pb + 0)) for (int r_ = 0; r_ < NREP(2); ++r_) {
            GAS unsigned char* const ws = wsp();
            pg8::Gemm g{(const GAS bf16*)(ws + WS_A), (const GAS bf16*)(ws + WS_WIN) + (size_t)l * DPW * D, D, D};
            pg8::StaticOrder S; S.init(R / 256, DPW / 256, D, F.G, F.bid);
            pg8::EpiBf16 E{(GAS bf16*)(ws + WS_P), DPP, DPROJ};
            pg8::gemm_phase<pg8::EpiBf16, pg8::StaticOrder, true, true>(ring, F.wave, g, S, E);
            DUPBAR(2, r_); if (r_ == NREP(2) - 1) SEAM(pb + 0);
        }
        if (IN(pb + 1)) for (int r_ = 0; r_ < NREP(3); ++r_) { if (PK(4)) { phase_gdn_prep(F, l); s5_relayout(F); s5_build(F, l); } DUPBAR(3, r_); if (r_ == NREP(3) - 1) SEAM(pb + 1); }
        if (IN(pb + 2)) for (int r_ = 0; r_ < NREP(4); ++r_) {
#ifndef M1SEL
#define M1SEL 7
#endif
#ifndef M1DUPSEL
#define M1DUPSEL 7
#endif
            if (PK(19) && r_ == 0) { GAS unsigned char* const ws = wsp();
                pg8::Gemm g{(const GAS bf16*)(ws + WS_S5A2), (const GAS bf16*)(ws + WS_S5EB), 256, 512};
                pg8::S5Order S; S.init(144, 1, 256, F.G, F.bid, 512);
                pg8::EpiS5HL E{(GAS bf16*)(ws + WS_S5HL)};
                pg8::gemm_phase<pg8::EpiS5HL, pg8::S5Order, true, true>(ring, F.wave, g, S, E); }
            if (PK(18)) phase_m1(F, l, r_ == 0 ? M1SEL : M1DUPSEL);
            DUPBAR(4, r_); if (r_ == NREP(4) - 1) SEAM(pb + 2);
        }
#ifndef DUPSCAN
#define DUPSCAN 0
#endif
        if (IN(pb + 3)) { if (PK(5)) phase_scans(F, l);
#if DUPSCAN
            xcd_barrier(bar, F.wave); phase_scans(F, l);
#endif
            SEAM(pb + 3); }
        if (IN(pb + 4)) for (int r_ = 0; r_ < NREP(6); ++r_) {
            if (PK(20)) { GAS unsigned char* const ws = wsp();
                pg8::Gemm g{(const GAS bf16*)(ws + WS_S5A2), (const GAS bf16*)(ws + WS_S5WY), 512, 512};
                pg8::S5Order S; S.init(144, 1, 512, F.G, F.bid, 512);
                pg8::EpiS5Y E{(GAS bf16*)(ws + WS_GQ), (GAS float*)(ws + WS_O5), (const GAS bf16*)(ws + WS_P), inp(I_S5D) + l * 256};
                pg8::gemm_phase<pg8::EpiS5Y, pg8::S5Order, true, true>(ring, F.wave, g, S, E); }
#ifdef CHAINCMP
            if (l == 0) { GAS unsigned char* const ws = wsp(); const GAS unsigned short* a = (const GAS unsigned short*)(ws + WS_OB); const GAS unsigned short* c = (const GAS unsigned short*)outp();
                const int ln_ = lane_id_opaque();
                for (int mm = 0; mm < 3; ++mm) { unsigned bad = 0, big = 0;
                    for (size_t i = (size_t)F.bid * 512 + F.wave * 64 + ln_; i < (size_t)2 * R * 256; i += (size_t)F.G * 512) { const size_t j = (size_t)mm * 2 * R * 256 + i; const float x = bf2f(a[j]), y = bf2f(c[j]); if (a[j] != c[j]) { ++bad; if (fabsf(x - y) > 0.02f * (fabsf(x) + 1e-3f)) ++big; } }
                    if (bad) __hip_atomic_fetch_add((GAS unsigned*)(ws + WS_CTL) + 70010 + mm, bad, __ATOMIC_RELAXED, __HIP_MEMORY_SCOPE_AGENT);
                    if (big) __hip_atomic_fetch_add((GAS unsigned*)(ws + WS_CTL) + 70020 + mm, big, __ATOMIC_RELAXED, __HIP_MEMORY_SCOPE_AGENT); } }
#endif
            if (PK(6)) phase_readout(F, l); if (PK(2) && moe) phase_moe_convert(F, l >> 1); DUPBAR(6, r_); if (r_ == NREP(6) - 1) SEAM(pb + 4);
        }
        if (PK(7) && IN(pb + 5)) for (int r_ = 0; r_ < NREP(7); ++r_) {
            GAS unsigned char* const ws = wsp();
            pg8::Gemm g{(const GAS bf16*)(ws + WS_GQ), (const GAS bf16*)(ws + WS_WGLU) + (size_t)l * 65536, 256, 256};
            pg8::StaticOrder S; S.init(R / 256, 1, 256, F.G, F.bid);
            pg8::EpiGlu E{(GAS bf16*)(ws + WS_MIX), (const GAS float*)(ws + WS_O5), inp(I_S5GLUB) + l * 256};
            pg8::gemm_phase<pg8::EpiGlu, pg8::StaticOrder, true, true>(ring, F.wave, g, S, E);
            DUPBAR(7, r_); if (r_ == NREP(7) - 1) SEAM(pb + 5);
        }
        if (PK(8) && IN(pb + 6)) for (int r_ = 0; r_ < NREP(8); ++r_) {
            GAS unsigned char* const ws = wsp(); const GAS float* modl = (const GAS float*)(ws + WS_MOD) + (size_t)l * 5 * 6144;
            pg8::Gemm g{(const GAS bf16*)(ws + WS_MIX), (const GAS bf16*)(ws + WS_WOUT) + (size_t)l * D * D, D, D};
            pg8::StaticOrder S; S.init((l == DEPTH - 1 ? NLAT : R) / 256, D / 256, D, F.G, F.bid);
            pg8::EpiRes E{(GAS bf16*)(ws + WS_Y), modl, 2048};
            pg8::gemm_phase<pg8::EpiRes, pg8::StaticOrder, true, true>(ring, F.wave, g, S, E);
            DUPBAR(8, r_); if (r_ == NREP(8) - 1) SEAM(pb + 6);
        }
        if (IN(pb + 7)) for (int r_ = 0; r_ < NREP(9); ++r_) { if (moe) { if (PK(9)) phase_ln<true>(F, l, 0); } else { if (PK(10)) phase_ln<false>(F, l, 0); } DUPBAR(9, r_); if (r_ == NREP(9) - 1) SEAM(pb + 7); }
        if (!moe) {
            if (PK(11) && IN(pb + 8)) for (int r_ = 0; r_ < NREP(10); ++r_) {
                GAS unsigned char* const ws = wsp();
                pg8::Gemm g{(const GAS bf16*)(ws + WS_A), (const GAS bf16*)(ws + WS_WF13) + (size_t)(l >> 1) * 2 * FFD * D, D, D};
                pg8::StaticOrder S; S.init(R / 256, 2 * FFD / 256, D, F.G, F.bid);
                pg8::EpiSwiGlu E{(GAS bf16*)(ws + WS_HID), FFD};
                pg8::gemm_phase<pg8::EpiSwiGlu, pg8::StaticOrder, true, true>(ring, F.wave, g, S, E);
                DUPBAR(10, r_); if (r_ == NREP(10) - 1) SEAM(pb + 8);
            }
            if (PK(12) && IN(pb + 9)) for (int r_ = 0; r_ < NREP(11); ++r_) {
                GAS unsigned char* const ws = wsp(); const GAS float* modl = (const GAS float*)(ws + WS_MOD) + (size_t)l * 5 * 6144;
                pg8::Gemm g{(const GAS bf16*)(ws + WS_HID), (const GAS bf16*)(ws + WS_WF2) + (size_t)(l >> 1) * D * FFD, FFD, FFD};
                pg8::StaticOrder S; S.init(R / 256, D / 256, FFD, F.G, F.bid);
                pg8::EpiRes E{(GAS bf16*)(ws + WS_Y), modl, 5120};
                pg8::gemm_phase<pg8::EpiRes, pg8::StaticOrder, true, true>(ring, F.wave, g, S, E);
                DUPBAR(11, r_); if (r_ == NREP(11) - 1) SEAM(pb + 9);
            }
            if (IN(pb + 10)) for (int r_ = 0; r_ < NREP(13); ++r_) { if (PK(13)) phase_ln<false>(F, l, 1); DUPBAR(13, r_); if (r_ == NREP(13) - 1) SEAM(pb + 11); }
        } else {
            if (IN(pb + 8)) for (int r_ = 0; r_ < NREP(22); ++r_) { if (PK(14)) phase_moe_assign(F, l); DUPBAR(22, r_); if (r_ == NREP(22) - 1) SEAM(pb + 8); }
            if (PK(15) && IN(pb + 9)) for (int r_ = 0; r_ < NREP(23); ++r_) {
                GAS unsigned char* const ws = wsp();
                const GAS int* info = (const GAS int*)(ws + WS_MOEINFO);
                pg8::Gemm g{(const GAS bf16*)(ws + WS_XG), (const GAS bf16*)(ws + WS_WM13), D, D};
                pg8::MoeOrder S; S.init(info[8], 2 * FFE / 256, D, F.G, F.bid);
                S.texp = info + 16; S.estride = (size_t)2 * FFE * D * 2;
                pg8::EpiSwiGlu E{(GAS bf16*)(ws + WS_MHID), FFE};
                pg8::gemm_phase<pg8::EpiSwiGlu, pg8::MoeOrder, true, true>(ring, F.wave, g, S, E);
                DUPBAR(23, r_); if (r_ == NREP(23) - 1) SEAM(pb + 9);
            }
            if (PK(16) && IN(pb + 10)) for (int r_ = 0; r_ < NREP(24); ++r_) {
                GAS unsigned char* const ws = wsp();
                const GAS int* info = (const GAS int*)(ws + WS_MOEINFO);
                pg8::Gemm g{(const GAS bf16*)(ws + WS_MHID), (const GAS bf16*)(ws + WS_WM2), FFE, FFE};
                pg8::MoeOrder S; S.init(info[8], D / 256, FFE, F.G, F.bid);
                S.texp = info + 16; S.estride = (size_t)D * FFE * 2;
                pg8::EpiMoeDown E{(GAS bf16*)(ws + WS_XG), (const GAS float*)(ws + WS_ROWG)};
                pg8::gemm_phase<pg8::EpiMoeDown, pg8::MoeOrder, true, true>(ring, F.wave, g, S, E);
                DUPBAR(24, r_); if (r_ == NREP(24) - 1) SEAM(pb + 10);
            }
            if (IN(pb + 11)) for (int r_ = 0; r_ < NREP(25); ++r_) { if (PK(17)) phase_moe_combine(F, l); DUPBAR(25, r_); if (r_ == NREP(25) - 1 && l < DEPTH - 1) SEAM(pb + 11); }
        }
    }
#ifdef CHAINCMP
    {   xcd_barrier(bar, F.wave);
        const GAS unsigned* cw = (const GAS unsigned*)(args.ws + WS_CTL) + 70010;
        const unsigned b0 = cw[0] + cw[1] + cw[2], g0 = cw[10] + cw[11] + cw[12];
        const float va = b0 == 0 ? 0.f : (b0 < 100 ? 10.f : (b0 < 10000 ? 100.f : (b0 < 1000000 ? 1000.f : 10000.f)));
        const float vb = g0 == 0 ? 0.f : (g0 < 100 ? 1.f : (g0 < 10000 ? 2.f : (g0 < 1000000 ? 3.f : 4.f)));
        GAS float* o = outp();
        for (size_t i = (size_t)blockIdx.x * 512 + F.wave * 64 + lane_id_opaque(); i < (size_t)NLAT * D; i += (size_t)gridDim.x * 512) o[i] = (i == 0) ? vb * 1.0e6f + 5.0e5f : va + 3.f;
    }
#endif
#ifdef CHAINCHECK
    {   xcd_barrier(bar, F.wave);
        const GAS unsigned* cw = (const GAS unsigned*)(args.ws + WS_CTL) + 70000;
        const unsigned c0 = cw[0], c1 = cw[1], c2 = cw[2];
        const float va = (c0 ? 100.f : 0.f) + (c1 ? 10.f : 0.f) + (c2 ? 1.f : 0.f);
        const float vb = (float)(c0 + c1 + c2);
        GAS float* o = outp();
        for (size_t i = (size_t)blockIdx.x * 512 + F.wave * 64 + lane_id_opaque(); i < (size_t)NLAT * D; i += (size_t)gridDim.x * 512) o[i] = (i == 0) ? vb * 1000.f + 7777.f : va + 3.f;
    }
#endif
#if PROBE_A >= 0
    {
        PSTAMP(25);
        GAS float* tw = (GAS float*)(args.ws + WS_CTL) + 65536;
        { const int ln_ = lane_id_opaque(); if (blockIdx.x == 0 && F.wave == 0 && ln_ < 32) tw[ln_] = (float)MISC[32 + ln_] * 0.01f; }
        xcd_barrier(bar, F.wave);
        const float va = tw[PROBE_A], vb = tw[PROBE_B] * 1000.f;
        GAS float* o = outp();
        for (size_t i = (size_t)blockIdx.x * 512 + F.wave * 64 + lane_id_opaque(); i < (size_t)NLAT * D; i += (size_t)gridDim.x * 512) o[i] = (i == 0) ? vb : va;
    }
#endif
#undef IN
#undef SEAM
}

extern "C" void kernel_launch(void* const* d_in, const int* in_sizes, int n_in, void* d_out, int out_size, void* d_ws, size_t ws_size, hipStream_t stream) {
    static int grid = 0;
    if (grid == 0) {
        if (n_in != 34 || out_size != NLAT * D || ws_size < WS_END) { fprintf(stderr, "kernel_launch: unexpected shapes (n_in %d out %d ws %zu need %zu)\n", n_in, out_size, ws_size, (size_t)WS_END); grid = -1; return; }
        int dev = 0, cus = 0, per_cu = 0;
        if (hipGetDevice(&dev) != hipSuccess || hipDeviceGetAttribute(&cus, hipDeviceAttributeMultiprocessorCount, dev) != hipSuccess) { grid = -1; return; }
        if (hipFuncSetAttribute((const void*)fwd, hipFuncAttributeMaxDynamicSharedMemorySize, LDS_BYTES) != hipSuccess) { fprintf(stderr, "kernel_launch: hipFuncSetAttribute failed\n"); grid = -1; return; }
        if (hipOccupancyMaxActiveBlocksPerMultiprocessor(&per_cu, (const void*)fwd, 512, LDS_BYTES) != hipSuccess || per_cu < 1) fprintf(stderr, "kernel_launch: occupancy query reports %d\n", per_cu);
        (void)hipGetLastError();
        grid = cus;
    }
    if (grid < 0) return;
    (void)hipMemsetAsync((char*)d_ws + WS_CTL, 0, CTL_ZERO_BYTES, stream);
    Args a{};
    for (int i = 0; i < 34; ++i) a.in[i] = (const float*)d_in[i];
    a.out = (float*)d_out; a.ws = (unsigned char*)d_ws;
#if MK_ONE_LAUNCH
    a.ph_lo = 0; a.ph_hi = NPHASE;
    hipLaunchKernelGGL(fwd, dim3(grid), dim3(512), LDS_BYTES, stream, a);
#else
    for (int p = 0; p < NPHASE; ++p) {
        if (p >= 2) { const int l = (p - 2) / PPL, k = (p - 2) % PPL; const bool moe = (l & 1) != 0; if (k == 11 && !moe) continue; }
        a.ph_lo = p; a.ph_hi = p + 1;
        hipLaunchKernelGGL(fwd, dim3(grid), dim3(512), LDS_BYTES, stream, a);
    }
#endif
}
```

```cpp
#include <hip/hip_runtime.h>
#include <cstdio>
#include <cstdint>

#ifndef MK_ONE_LAUNCH
#define MK_ONE_LAUNCH 1
#endif

#define GAS __attribute__((address_space(1)))
#define LAS __attribute__((address_space(3)))
typedef unsigned short bf16;
typedef unsigned v4u __attribute__((ext_vector_type(4)));
typedef unsigned v2u __attribute__((ext_vector_type(2)));
typedef float f32x4 __attribute__((ext_vector_type(4)));
typedef float f32x2 __attribute__((ext_vector_type(2)));
typedef short bf16x8 __attribute__((ext_vector_type(8)));

constexpr int D = 1024, BATCH = 4, SEQ = 8192, CTXL = 256, DEPTH = 4;
constexpr int NLAT = BATCH * SEQ, NCTX = BATCH * CTXL, R = NLAT + NCTX;
constexpr int DPROJ = 3600, DPP = 3600, DPW = 3840;
constexpr int FFD = 2816, FFE = 3584, NEXP = 8;
constexpr int MOE_ROWS = 2 * R + NEXP * 256;
constexpr float ALPHA = 1.681792830507429f;
constexpr float LN_EPS = 1e-5f, RMS_EPS = 1e-6f;
constexpr int PC_GQKV = 0, PC_GZ = 768, PC_GA = 1024, PC_GB = 1032, PC_S5U = 1040, PC_HQ = 1296, PC_HF = 1552, PC_HI = 2064, PC_HG = 2320, PC_RQKV = 2576, PC_RG = 3344;
constexpr int NSEQ = CTXL + SEQ;
constexpr int TCH = 32, NCHUNK = NSEQ / TCH;

constexpr size_t MiB = 1u << 20;
constexpr size_t WS_CTL = 0, CTL_ZERO_BYTES = 1 * MiB;
constexpr size_t WS_MOD = 1 * MiB;
constexpr size_t WS_LB = WS_MOD + 512 * 1024;
constexpr size_t WS_ROT = WS_LB + 4096;
constexpr size_t WS_S5LAM = WS_ROT + 32768;
constexpr size_t WS_S5B = 2 * MiB;
constexpr size_t WS_TOPE = 3 * MiB;
constexpr size_t WS_TOPG = WS_TOPE + 256 * 1024;
constexpr size_t WS_TOKPOS = WS_TOPG + 512 * 1024;
constexpr size_t WS_ROWG = 4 * MiB + 256 * 1024;
constexpr size_t WS_WGCNT = 4 * MiB + 768 * 1024;
constexpr size_t WS_MOEINFO = WS_WGCNT + 16384;
constexpr size_t WS_GSC = 5 * MiB;
constexpr size_t WS_WIN = 8 * MiB;
constexpr size_t WS_WOUT = 38 * MiB;
constexpr size_t WS_WF13 = 46 * MiB;
constexpr size_t WS_WF2 = 68 * MiB;
constexpr size_t WS_WGLU = 79 * MiB;
constexpr size_t WS_WM13 = 80 * MiB;
constexpr size_t WS_WM2 = 192 * MiB;
constexpr size_t WS_XC = 248 * MiB;
constexpr size_t WS_A = 252 * MiB;
constexpr size_t WS_MIX = WS_A;
constexpr size_t WS_TG = 80 * MiB;
constexpr size_t WS_U = 318 * MiB;
constexpr size_t WS_P = WS_U;
constexpr size_t WS_Y = WS_U;
constexpr size_t WS_OB = 551 * MiB;
constexpr size_t WS_O5 = 650 * MiB;
constexpr size_t WS_S5A2 = WS_O5 + 33 * MiB;
constexpr size_t WS_S5HL = 252 * MiB;
constexpr size_t WS_S5EB = 270 * MiB;
constexpr size_t WS_S5WY = 1035 * MiB;
constexpr size_t WS_GQ = 716 * MiB, WS_GK = WS_GQ + 17 * MiB, WS_GV = WS_GK + 17 * MiB;
constexpr size_t WS_TH = 767 * MiB;
constexpr size_t WS_TR = 899 * MiB;
constexpr size_t WS_DEC = 1031 * MiB;
constexpr size_t WS_HID = 566 * MiB;
constexpr size_t WS_XG = WS_U;
constexpr size_t WS_MHID = 454 * MiB;
constexpr size_t WS_END = 1040 * MiB;
static_assert(WS_MHID + (size_t)MOE_ROWS * FFE * 2 <= WS_END && WS_XG + (size_t)MOE_ROWS * D * 2 <= WS_MHID, "ws map");
static_assert(WS_P + (size_t)R * 3600 * 2 <= WS_OB && WS_OB + (size_t)6 * R * 256 * 2 <= WS_O5 && WS_O5 + (size_t)2 * R * 256 * 4 <= WS_GQ && WS_GV + (size_t)R * 256 * 2 <= WS_TH, "ws map 2");
static_assert(WS_TH + (size_t)4224 * 4 * 8192 <= WS_TR && WS_TR + (size_t)4224 * 4 * 8192 <= WS_DEC && WS_DEC + (size_t)3 * 4224 * 256 <= WS_END && WS_TG + (size_t)4224 * 5 * 8192 <= 248 * MiB, "ws map 3");
static_assert(WS_HID + (size_t)R * FFD * 2 <= WS_END && WS_Y + (size_t)R * D * 4 <= WS_OB, "ws map 4");

constexpr int RING_BYTES = 131072, LDSCTL_OFF = RING_BYTES, LDS_BYTES = 147456;

typedef __bf16 hwbf16x2 __attribute__((ext_vector_type(2)));
__device__ __forceinline__ unsigned pk2(float lo, float hi) { f32x2 v = {lo, hi}; const hwbf16x2 r = __builtin_convertvector(v, hwbf16x2); return __builtin_bit_cast(unsigned, r); }
__device__ __forceinline__ unsigned f2bf(float f) { return pk2(f, 0.f) & 0xffffu; }
__device__ __forceinline__ float bflo(unsigned w) { return __builtin_bit_cast(float, w << 16); }
__device__ __forceinline__ float bfhi(unsigned w) { return __builtin_bit_cast(float, w & 0xffff0000u); }
__device__ __forceinline__ float bf2f(bf16 h) { return __builtin_bit_cast(float, (unsigned)h << 16); }
__device__ __forceinline__ int lane_id_opaque_fwd() { unsigned z; asm volatile("v_mov_b32 %0, 0" : "=v"(z)); return (int)__builtin_amdgcn_mbcnt_hi(~0u, __builtin_amdgcn_mbcnt_lo(~0u, z)); }
__device__ __forceinline__ float shfl_idx(float x, int src) { return __builtin_bit_cast(float, __builtin_amdgcn_ds_bpermute(src << 2, __builtin_bit_cast(int, x))); }
template <int CTRL>
__device__ __forceinline__ float dpp0(float x) { return __builtin_bit_cast(float, __builtin_amdgcn_update_dpp(0, __builtin_bit_cast(int, x), CTRL, 0xf, 0xf, true)); }
__device__ __forceinline__ float sum16(float v) {
    v += dpp0<0xB1>(v); v += dpp0<0x4E>(v); v += dpp0<0x141>(v); v += dpp0<0x140>(v); return v; }
__device__ __forceinline__ float wave_sum(float v) {
    v = sum16(v);
    const float a = __builtin_bit_cast(float, __builtin_amdgcn_readlane(__builtin_bit_cast(int, v), 0)), b = __builtin_bit_cast(float, __builtin_amdgcn_readlane(__builtin_bit_cast(int, v), 16));
    const float c = __builtin_bit_cast(float, __builtin_amdgcn_readlane(__builtin_bit_cast(int, v), 32)), d = __builtin_bit_cast(float, __builtin_amdgcn_readlane(__builtin_bit_cast(int, v), 48));
    return (a + b) + (c + d); }
__device__ __forceinline__ float sigmoidf_(float x) { return __builtin_amdgcn_rcpf(1.f + __expf(-x)); }
__device__ __forceinline__ float siluf_(float x) { return x * __builtin_amdgcn_rcpf(1.f + __expf(-x)); }
__device__ __forceinline__ float gelu_tanh(float x) { const float u = 0.7978845608028654f * (x + 0.044715f * x * x * x); const float t = 1.f - 2.f * __builtin_amdgcn_rcpf(__expf(2.f * u) + 1.f); return 0.5f * x * (1.f + t); }
#define LDS_WAIT() asm volatile("s_waitcnt lgkmcnt(0)" ::: "memory")

__device__ __forceinline__ int lane_id_opaque() { unsigned z; asm volatile("v_mov_b32 %0, 0" : "=v"(z)); return (int)__builtin_amdgcn_mbcnt_hi(~0u, __builtin_amdgcn_mbcnt_lo(~0u, z)); }
#define XB_TMO      128
#define XB_XCNT(j)  (256  + 64 * (j))
#define XB_XSUB(j)  (1280 + 64 * (j))
#define XB_XGEN(j)  (2304 + 64 * (j))
#define XB_TOP      3328
#define XB_TOPGEN   3392
#define XCD_BAR_WORDS 3456
#define XB_SPIN_CAP (1u << 18)
__device__ __forceinline__ unsigned xb_ld(GAS unsigned* p)              { return __hip_atomic_load(p, __ATOMIC_RELAXED, __HIP_MEMORY_SCOPE_AGENT); }
__device__ __forceinline__ unsigned xb_add(GAS unsigned* p, unsigned v) { return __hip_atomic_fetch_add(p, v, __ATOMIC_RELAXED, __HIP_MEMORY_SCOPE_AGENT); }
__device__ __forceinline__ unsigned xb_xcc_id() { return (unsigned)__builtin_amdgcn_s_getreg((3 << 11) | 20) & 0xFu; }
#define XB_SPIN(cond, bar) do { unsigned _sp = 0; while (cond) { __builtin_amdgcn_s_sleep(1); \
    if ((++_sp & 255u) == 0u) { if (xb_ld(&(bar)[XB_TMO])) break; if (_sp > XB_SPIN_CAP) { (void)xb_add(&(bar)[XB_TMO], 1u); break; } } } } while (0)
struct XcdBarrier { GAS unsigned* bar; unsigned x; volatile LAS unsigned* st; };
__device__ __forceinline__ bool xb_thread0(int wave_id) { return wave_id == 0 && lane_id_opaque() == 0; }
__device__ __forceinline__ XcdBarrier xcd_barrier_post(GAS unsigned* bar, volatile LAS unsigned* st, int wave_id) {
    XcdBarrier b; b.bar = bar; b.x = xb_xcc_id(); b.st = st;
    if (xb_thread0(wave_id)) (void)xb_add(&bar[XB_XCNT(b.x)], 1u);
    return b;
}
__device__ __forceinline__ void xcd_barrier_complete(GAS unsigned* bar, unsigned x, unsigned& nloc, unsigned& nx) {
    const unsigned G = gridDim.x * gridDim.y * gridDim.z;
    unsigned sum, cnt, mine, sp = 0u;
    for (;;) {
        sum = 0u; cnt = 0u; mine = 0u;
#pragma unroll
        for (unsigned j = 0; j < 16; ++j) { const unsigned c = xb_ld(&bar[XB_XCNT(j)]); sum += c; cnt += (c > 0u) ? 1u : 0u; mine = (j == x) ? c : mine; }
        if (sum == G) break;
        __builtin_amdgcn_s_sleep(1);
        if ((++sp & 255u) == 0u) { if (xb_ld(&bar[XB_TMO])) break; if (sp > XB_SPIN_CAP) { (void)xb_add(&bar[XB_TMO], 1u); break; } }
    }
    nloc = mine > 0u ? mine : 1u; nx = cnt > 0u ? cnt : 1u;
}
__device__ __forceinline__ void xcd_barrier(const XcdBarrier& b, int wave_id) {
    asm volatile("s_waitcnt vmcnt(0)" ::: "memory");
    __syncthreads();
    if (xb_thread0(wave_id)) {
        GAS unsigned* bar = b.bar; asm volatile("" : "+s"(bar));
        __builtin_amdgcn_s_waitcnt(0);
        unsigned nloc = b.st[0], nx = b.st[1];
        if (nloc == 0u) { xcd_barrier_complete(bar, b.x, nloc, nx); b.st[0] = nloc; b.st[1] = nx; }
        const unsigned old = xb_add(&bar[XB_XSUB(b.x)], 1u);
        const unsigned gen = old / nloc;
        if (old + 1u == (gen + 1u) * nloc) {
            __builtin_amdgcn_fence(__ATOMIC_RELEASE, "agent");
            asm volatile("s_waitcnt vmcnt(0)" ::: "memory");
            const unsigned og = xb_add(&bar[XB_TOP], 1u);
            const unsigned tg = og / nx;
            if (og + 1u == (tg + 1u) * nx) xb_add(&bar[XB_TOPGEN], 1u);
            else XB_SPIN(xb_ld(&bar[XB_TOPGEN]) == tg, bar);
            __builtin_amdgcn_fence(__ATOMIC_ACQUIRE, "agent");
            xb_add(&bar[XB_XGEN(b.x)], 1u);
            asm volatile("s_waitcnt vmcnt(0)" ::: "memory");
        } else {
            XB_SPIN(xb_ld(&bar[XB_XGEN(b.x)]) == gen, bar);
            __builtin_amdgcn_fence(__ATOMIC_ACQUIRE, "agent");
            asm volatile("s_waitcnt vmcnt(0)" ::: "memory");
        }
    }
    __syncthreads();
}

namespace pg8 {
constexpr int BM = 256, BK = 64, HALF = 128, HTB = HALF * BK * 2, STAGE_BYTES = 8 * HTB, NXCD = 8, WGM = 4;
__host__ __device__ __forceinline__ int lds_byte(int r, int c) { const int st = (r >> 4) * 2 + (c >> 5), rr = r & 15, cc = c & 31, ob = rr * 64 + cc * 2; return st * 1024 + (ob ^ (((ob >> 9) & 1) << 5)); }
__host__ __device__ __forceinline__ void stage_rc(int b, int& Rr, int& C) { const int st = b / 1024, sb = b % 1024, swz = sb ^ (((sb >> 9) & 1) << 5); Rr = (st >> 1) * 16 + swz / 64; C = (st & 1) * 32 + (swz % 64) / 2; }
__host__ __device__ __forceinline__ int perm32(int rho) { const int n = rho >> 4, i = rho & 15; return 8 * (i >> 2) + 4 * n + (i & 3); }
struct Unit { int pm, pn; size_t aoff, boff; };
struct Gemm { const GAS bf16* A; const GAS bf16* Bt; int K, lda; };

struct StaticOrder {
    int nM, nN, nwg, G, c, K, lda;
    __device__ void init(int nM_, int nN_, int K_, int G_, int c_, int lda_ = 0) { nM = nM_; nN = nN_; nwg = nM * nN; G = G_; K = K_; lda = lda_ ? lda_ : K_; int cc = c_; asm volatile("" : "+s"(cc)); c = cc; }
    __device__ bool map(int i, int& pm, int& pn) const {
        const long L = (long)i * G + c; if (L >= nwg) return false;
        int wgid = (int)L; { const int q = nwg / NXCD, r = nwg % NXCD, xcd = wgid % NXCD, off = wgid / NXCD; wgid = (xcd < r ? xcd * (q + 1) : r * (q + 1) + (xcd - r) * q) + off; }
        const int nig = WGM * nN, gid = wgid / nig, fm = gid * WGM, gsz = (nM - fm) < WGM ? (nM - fm) : WGM;
        pm = fm + ((wgid % nig) % gsz); pn = (wgid % nig) / gsz; return true;
    }
    __device__ bool next(int i, Unit& u) const { if (!map(i, u.pm, u.pn)) return false; u.aoff = (size_t)u.pm * 256 * lda * 2; u.boff = (size_t)u.pn * 256 * K * 2; return true; }
};
struct MoeOrder : StaticOrder {
    const GAS int* texp; size_t estride;
    __device__ bool next(int i, Unit& u) const {
        if (!map(i, u.pm, u.pn)) return false;
        const int e = __builtin_amdgcn_readfirstlane(texp[u.pm]);
        u.aoff = (size_t)u.pm * 256 * lda * 2; u.boff = (size_t)e * estride + (size_t)u.pn * 256 * K * 2; return true;
    }
};
struct S5Order : StaticOrder {
    __device__ bool next(int i, Unit& u) const {
        if (!map(i, u.pm, u.pn)) return false;
        const int g = u.pm / 9, ti = u.pm - g * 9;
        u.aoff = (size_t)(g * 2112 + ti * 256) * lda * 2; u.boff = (size_t)g * 256 * K * 2; return true;
    }
};
typedef __bf16 bf16v2_t __attribute__((ext_vector_type(2)));
__device__ __forceinline__ unsigned cvt_pk_bf16(float lo, float hi) { f32x2 v = {lo, hi}; const bf16v2_t r = __builtin_convertvector(v, bf16v2_t); return __builtin_bit_cast(unsigned, r); }

template <class Epi, class Sched, bool ALIGN_EPI, bool SP2>
__device__ __forceinline__ void gemm_phase(LAS unsigned char* lds, const int wave_id, const Gemm g, const Sched& S, const Epi& E) {
    const int lane = lane_id_opaque();
    const int wid = wave_id, tid = wid * 64 + lane, wr = wid >> 2, wc = wid & 3, fr = lane & 15, fq = lane >> 4;
    int K_ = g.K; asm volatile("" : "+s"(K_));
    const int K = K_, nt = K / BK;
    unsigned voffA, voffB;
    int lda_ = g.lda; asm volatile("" : "+s"(lda_)); const int lda = lda_;
    { int Rr, C; stage_rc(tid * 16, Rr, C); const int Rb = Epi::PERM ? ((Rr & ~31) + perm32(Rr & 31)) : Rr;
        voffA = (unsigned)(Rr * lda + C) * 2u; voffB = (unsigned)(Rb * K + C) * 2u; }
    const size_t qstepB = (size_t)64 * K * 2, qstepA = (size_t)64 * lda * 2;
    const size_t kstep = (size_t)(BK * 2);
    const size_t hstep = (size_t)HALF * K * 2, hstepA = (size_t)HALF * lda * 2;
    const unsigned ldsw = (unsigned)wid * 1024u;
    const int aoff = lds_byte(wr * 64 + fr, fq * 8), boff = lds_byte(wc * 32 + fr, fq * 8);
#define PG8_SA(b, h) (((b) * 2 + (h)) * HTB)
#define PG8_SB(b, h) ((4 + (b) * 2 + (h)) * HTB)
#define PG8_STAGE_(bufoff, gbase, voff, qs) do { _Pragma("unroll") for (int _i = 0; _i < 2; ++_i) \
        __builtin_amdgcn_global_load_lds((const GAS unsigned*)((const char*)(gbase) + _i * (qs) + (voff)), (LAS unsigned*)(lds + (bufoff) + ldsw + _i * 8192), 16, 0, 0); } while (0)
#define PG8_STAGEA(bufoff, gbase) PG8_STAGE_(bufoff, gbase, voffA, qstepA)
#define PG8_STAGEB(bufoff, gbase) PG8_STAGE_(bufoff, gbase, voffB, qstepB)
#define PG8_LDA(dst, b, h) do { _Pragma("unroll") for (int m = 0; m < 4; ++m) _Pragma("unroll") for (int k = 0; k < 2; ++k) dst[m][k] = *(const LAS bf16x8*)(lds + PG8_SA(b, h) + aoff + m * 2048 + k * 1024); } while (0)
#define PG8_LDB(dst, b, h) do { _Pragma("unroll") for (int n = 0; n < 2; ++n) _Pragma("unroll") for (int k = 0; k < 2; ++k) dst[n][k] = *(const LAS bf16x8*)(lds + PG8_SB(b, h) + boff + n * 2048 + k * 1024); } while (0)
#define PG8_MMA(ai, bj, At, Bt) do { __builtin_amdgcn_s_setprio(1); _Pragma("unroll") for (int m = 0; m < 4; ++m) _Pragma("unroll") for (int n = 0; n < 2; ++n) _Pragma("unroll") for (int k = 0; k < 2; ++k) \
        acc[ai][bj][m][n] = __builtin_amdgcn_mfma_f32_16x16x32_bf16(Bt[n][k], At[m][k], acc[ai][bj][m][n], 0, 0, 0); __builtin_amdgcn_s_setprio(0); } while (0)
#define PG8_WAIT_V(n) asm volatile("s_waitcnt vmcnt(" #n ")" ::: "memory")
#define PG8_WAIT_L(n) asm volatile("s_waitcnt lgkmcnt(" #n ")" ::: "memory")
#define PG8_BAR __builtin_amdgcn_s_barrier()
#define PG8_SCHED __builtin_amdgcn_sched_barrier(0)
    Unit cur, nxt; int ui = 0;
    if (!S.next(0, cur)) return;
    f32x4 acc[2][2][4][2];
#pragma unroll
    for (int a = 0; a < 2; ++a)
#pragma unroll
        for (int b = 0; b < 2; ++b)
#pragma unroll
            for (int m = 0; m < 4; ++m)
#pragma unroll
                for (int n = 0; n < 2; ++n) acc[a][b][m][n] = (f32x4){0.f, 0.f, 0.f, 0.f};
    bf16x8 At[4][2], B0[2][2], B1[2][2];
    const char* cA = (const char*)g.A + cur.aoff; const char* cB = (const char*)g.Bt + cur.boff;
    if constexpr (SP2) {
        PG8_STAGEB(PG8_SB(0, 0), cB); PG8_STAGEB(PG8_SB(0, 1), cB + hstep); PG8_STAGEA(PG8_SA(0, 0), cA); PG8_STAGEA(PG8_SA(0, 1), cA + hstepA);
        if (wr == 1) PG8_BAR;
        PG8_WAIT_V(2); PG8_BAR;
        PG8_STAGEB(PG8_SB(1, 0), cB + kstep); PG8_STAGEA(PG8_SA(1, 0), cA + kstep); PG8_STAGEB(PG8_SB(1, 1), cB + hstep + kstep);
        PG8_WAIT_V(6); PG8_BAR;
    } else {
        PG8_STAGEB(PG8_SB(0, 0), cB); PG8_STAGEA(PG8_SA(0, 0), cA); PG8_STAGEB(PG8_SB(0, 1), cB + hstep); PG8_STAGEA(PG8_SA(0, 1), cA + hstepA);
        if (wr == 1) PG8_BAR;
        PG8_WAIT_V(4); PG8_BAR;
        PG8_STAGEB(PG8_SB(1, 0), cB + kstep); PG8_STAGEA(PG8_SA(1, 0), cA + kstep); PG8_STAGEB(PG8_SB(1, 1), cB + hstep + kstep);
        PG8_WAIT_V(6); PG8_BAR;
    }
    for (;;) {
        const bool has_next = S.next(ui + 1, nxt);
        const char* nA = has_next ? (const char*)g.A + nxt.aoff : cA; const char* nB = has_next ? (const char*)g.Bt + nxt.boff : cB;
        for (int t = 0; t < nt; t += 2) {
            const bool last = (t == nt - 2);
            const char* a1 = cA + (size_t)(t + 1) * kstep;
            const char* a2 = last ? nA : cA + (size_t)(t + 2) * kstep; const char* b2 = last ? nB : cB + (size_t)(t + 2) * kstep;
            const char* a3 = a2 + kstep; const char* b3 = b2 + kstep;
            if constexpr (SP2) {
            PG8_LDB(B0, 0, 0); PG8_LDB(B1, 0, 1); PG8_SCHED; PG8_LDA(At, 0, 0); PG8_STAGEA(PG8_SA(1, 1), a1 + hstepA);
            PG8_WAIT_V(8); PG8_WAIT_L(0); PG8_BAR; PG8_MMA(0, 0, At, B0); PG8_MMA(0, 1, At, B1); PG8_BAR; PG8_SCHED;
            PG8_LDA(At, 0, 1); PG8_STAGEB(PG8_SB(0, 0), b2); PG8_STAGEB(PG8_SB(0, 1), b2 + hstep); PG8_STAGEA(PG8_SA(0, 0), a2);
            PG8_WAIT_V(8); PG8_WAIT_L(0); PG8_BAR; PG8_MMA(1, 0, At, B0); PG8_MMA(1, 1, At, B1); PG8_BAR; PG8_SCHED;
            PG8_LDB(B0, 1, 0); PG8_LDB(B1, 1, 1); PG8_SCHED; PG8_LDA(At, 1, 0); PG8_STAGEA(PG8_SA(0, 1), a2 + hstepA);
            PG8_WAIT_V(8); PG8_WAIT_L(0); PG8_BAR; PG8_MMA(0, 0, At, B0); PG8_MMA(0, 1, At, B1); PG8_BAR; PG8_SCHED;
            PG8_LDA(At, 1, 1); PG8_STAGEB(PG8_SB(1, 0), b3); PG8_STAGEB(PG8_SB(1, 1), b3 + hstep); PG8_STAGEA(PG8_SA(1, 0), a3);
            PG8_WAIT_V(8); PG8_WAIT_L(0); PG8_BAR; PG8_MMA(1, 0, At, B0); PG8_MMA(1, 1, At, B1); PG8_BAR; PG8_SCHED;
            } else {
            PG8_LDB(B0, 0, 0); PG8_SCHED; PG8_LDA(At, 0, 0); PG8_STAGEA(PG8_SA(1, 1), a1 + hstepA);
            PG8_WAIT_L(8); PG8_BAR; PG8_WAIT_L(0); PG8_MMA(0, 0, At, B0); PG8_BAR; PG8_SCHED;
            PG8_LDB(B1, 0, 1); PG8_STAGEB(PG8_SB(0, 0), b2);
            PG8_BAR; PG8_WAIT_L(0); PG8_MMA(0, 1, At, B1); PG8_BAR;
            PG8_LDA(At, 0, 1); PG8_STAGEA(PG8_SA(0, 0), a2);
            PG8_BAR; PG8_WAIT_L(0); PG8_MMA(1, 0, At, B0); PG8_BAR; PG8_SCHED;
            PG8_STAGEB(PG8_SB(0, 1), b2 + hstep);
            PG8_WAIT_V(6); PG8_BAR; PG8_MMA(1, 1, At, B1); PG8_BAR;
            PG8_LDB(B0, 1, 0); PG8_SCHED; PG8_LDA(At, 1, 0); PG8_STAGEA(PG8_SA(0, 1), a2 + hstepA);
            PG8_WAIT_L(8); PG8_BAR; PG8_WAIT_L(0); PG8_MMA(0, 0, At, B0); PG8_BAR; PG8_SCHED;
            PG8_LDB(B1, 1, 1); PG8_STAGEB(PG8_SB(1, 0), b3);
            PG8_BAR; PG8_WAIT_L(0); PG8_MMA(0, 1, At, B1); PG8_BAR;
            PG8_LDA(At, 1, 1); PG8_STAGEA(PG8_SA(1, 0), a3);
            PG8_BAR; PG8_WAIT_L(0); PG8_MMA(1, 0, At, B0); PG8_BAR; PG8_SCHED;
            PG8_STAGEB(PG8_SB(1, 1), b3 + hstep);
            PG8_WAIT_V(6); PG8_BAR; PG8_MMA(1, 1, At, B1); PG8_BAR;
            }
        }
        if constexpr (ALIGN_EPI) { if (wr == 0) PG8_BAR; }
        { const int l2 = lane_id_opaque(); E(acc, cur, wr, wc, l2 & 15, l2 >> 4); }
        if (!has_next) break;
#pragma unroll
        for (int a = 0; a < 2; ++a)
#pragma unroll
            for (int b = 0; b < 2; ++b)
#pragma unroll
                for (int m = 0; m < 4; ++m)
#pragma unroll
                    for (int n = 0; n < 2; ++n) acc[a][b][m][n] = (f32x4){0.f, 0.f, 0.f, 0.f};
        cur = nxt; cA = nA; cB = nB; ++ui;
        if constexpr (ALIGN_EPI) { if (wr == 1) PG8_BAR; }
    }
    PG8_WAIT_V(0);
    if constexpr (!ALIGN_EPI) { if (wr == 0) PG8_BAR; }
    PG8_BAR;
#undef PG8_SA
#undef PG8_SB
#undef PG8_STAGE_
#undef PG8_STAGEA
#undef PG8_STAGEB
#undef PG8_LDA
#undef PG8_LDB
#undef PG8_MMA
#undef PG8_WAIT_V
#undef PG8_WAIT_L
#undef PG8_BAR
#undef PG8_SCHED
}

struct EpiBf16 {
    static constexpr bool PERM = true;
    GAS bf16* O; int ldc, ncols;
    __device__ __forceinline__ void operator()(const f32x4 (&acc)[2][2][4][2], const Unit& u, int wr, int wc, int fr, int fq) const {
        const int row0 = u.pm * BM + wr * 64 + fr, col0 = u.pn * BM + wc * 32 + 8 * fq;
#pragma unroll
        for (int ai = 0; ai < 2; ++ai)
#pragma unroll
            for (int m = 0; m < 4; ++m) { GAS bf16* rowp = O + (size_t)(row0 + ai * HALF + m * 16) * ldc + col0; asm volatile("" ::: "memory");
#pragma unroll
                for (int bj = 0; bj < 2; ++bj) { const f32x4 v0 = acc[ai][bj][m][0], v1 = acc[ai][bj][m][1];
                    v4u w; w.x = cvt_pk_bf16(v0[0], v0[1]); w.y = cvt_pk_bf16(v0[2], v0[3]); w.z = cvt_pk_bf16(v1[0], v1[1]); w.w = cvt_pk_bf16(v1[2], v1[3]);
                    if (col0 + bj * HALF < ncols) *(GAS v4u*)(rowp + bj * HALF) = w; } }
    }
};
struct EpiSwiGlu {
    static constexpr bool PERM = true;
    GAS bf16* O; int ldc;
    __device__ __forceinline__ void operator()(const f32x4 (&acc)[2][2][4][2], const Unit& u, int wr, int wc, int fr, int fq) const {
        const int row0 = u.pm * BM + wr * 64 + fr, col0 = u.pn * HALF + wc * 32 + 8 * fq;
#pragma unroll
        for (int ai = 0; ai < 2; ++ai)
#pragma unroll
            for (int m = 0; m < 4; ++m) { GAS bf16* rowp = O + (size_t)(row0 + ai * HALF + m * 16) * ldc + col0; asm volatile("" ::: "memory");
                float h[8];
#pragma unroll
                for (int n = 0; n < 2; ++n)
#pragma unroll
                    for (int i = 0; i < 4; ++i) { const float a = acc[ai][0][m][n][i], b = acc[ai][1][m][n][i]; h[n * 4 + i] = a * b * __builtin_amdgcn_rcpf(1.f + __expf(-a)); }
                v4u w; w.x = cvt_pk_bf16(h[0], h[1]); w.y = cvt_pk_bf16(h[2], h[3]); w.z = cvt_pk_bf16(h[4], h[5]); w.w = cvt_pk_bf16(h[6], h[7]);
                *(GAS v4u*)rowp = w; }
    }
};
struct EpiRes {
    static constexpr bool PERM = true;
    GAS bf16* DL; const GAS float* mod; int goff;
    __device__ __forceinline__ void operator()(const f32x4 (&acc)[2][2][4][2], const Unit& u, int wr, int wc, int fr, int fq) const {
        const int row0 = u.pm * BM + wr * 64 + fr, col0 = u.pn * BM + wc * 32 + 8 * fq;
        const int s = u.pm < 128 ? (u.pm >> 5) : 4;
        const GAS float* gp = mod + s * 6144 + goff + col0;
        f32x4 gv[2][2];
#pragma unroll
        for (int bj = 0; bj < 2; ++bj)
#pragma unroll
            for (int n = 0; n < 2; ++n) gv[bj][n] = *(const GAS f32x4*)(gp + bj * HALF + n * 4);
#pragma unroll
        for (int ai = 0; ai < 2; ++ai)
#pragma unroll
            for (int m = 0; m < 4; ++m) { GAS bf16* rowp = DL + (size_t)(row0 + ai * HALF + m * 16) * D + col0; asm volatile("" ::: "memory");
#pragma unroll
                for (int bj = 0; bj < 2; ++bj) { const f32x4 v0 = gv[bj][0] * acc[ai][bj][m][0], v1 = gv[bj][1] * acc[ai][bj][m][1];
                    v4u w; w.x = cvt_pk_bf16(v0[0], v0[1]); w.y = cvt_pk_bf16(v0[2], v0[3]); w.z = cvt_pk_bf16(v1[0], v1[1]); w.w = cvt_pk_bf16(v1[2], v1[3]);
                    *(GAS v4u*)(rowp + bj * HALF) = w; } }
    }
};
struct EpiGlu {
    static constexpr bool PERM = true;
    GAS bf16* MIX; const GAS float* ya; const GAS float* gb;
    __device__ __forceinline__ void operator()(const f32x4 (&acc)[2][2][4][2], const Unit& u, int wr, int wc, int fr, int fq) const {
        const int row0 = u.pm * BM + wr * 64 + fr, col0 = wc * 32 + 8 * fq;
#pragma unroll
        for (int ai = 0; ai < 2; ++ai)
#pragma unroll
            for (int m = 0; m < 4; ++m) { const int row = row0 + ai * HALF + m * 16; asm volatile("" ::: "memory");
#pragma unroll
                for (int bj = 0; bj < 2; ++bj) { const int c = col0 + bj * HALF;
                    const f32x4 y0 = *(const GAS f32x4*)(ya + (size_t)row * 256 + c), y1 = *(const GAS f32x4*)(ya + (size_t)row * 256 + c + 4);
                    const f32x4 b0 = *(const GAS f32x4*)(gb + c), b1 = *(const GAS f32x4*)(gb + c + 4);
                    float o[8];
#pragma unroll
                    for (int i = 0; i < 4; ++i) { o[i] = y0[i] * sigmoidf_(acc[ai][bj][m][0][i] + b0[i]); o[4 + i] = y1[i] * sigmoidf_(acc[ai][bj][m][1][i] + b1[i]); }
                    v4u w; w.x = cvt_pk_bf16(o[0], o[1]); w.y = cvt_pk_bf16(o[2], o[3]); w.z = cvt_pk_bf16(o[4], o[5]); w.w = cvt_pk_bf16(o[6], o[7]);
                    *(GAS v4u*)(MIX + (size_t)row * D + 256 + c) = w; } }
    }
};
struct EpiMoeDown {
    static constexpr bool PERM = true;
    GAS bf16* O; const GAS float* rowg;
    __device__ __forceinline__ void operator()(const f32x4 (&acc)[2][2][4][2], const Unit& u, int wr, int wc, int fr, int fq) const {
        const int row0 = u.pm * BM + wr * 64 + fr, col0 = u.pn * BM + wc * 32 + 8 * fq;
#pragma unroll
        for (int ai = 0; ai < 2; ++ai)
#pragma unroll
            for (int m = 0; m < 4; ++m) { asm volatile("" ::: "memory"); const int row = row0 + ai * HALF + m * 16; const float gte = rowg[row]; GAS bf16* rowp = O + (size_t)row * D + col0;
#pragma unroll
                for (int bj = 0; bj < 2; ++bj) { const f32x4 v0 = acc[ai][bj][m][0] * gte, v1 = acc[ai][bj][m][1] * gte;
                    v4u w; w.x = cvt_pk_bf16(v0[0], v0[1]); w.y = cvt_pk_bf16(v0[2], v0[3]); w.z = cvt_pk_bf16(v1[0], v1[1]); w.w = cvt_pk_bf16(v1[2], v1[3]);
                    *(GAS v4u*)(rowp + bj * HALF) = w; } }
    }
};

struct EpiS5HL {
    static constexpr bool PERM = true;
    GAS bf16* O;
    __device__ __forceinline__ void operator()(const f32x4 (&acc)[2][2][4][2], const Unit& u, int wr, int wc, int fr, int fq) const {
        const int g = u.pm / 9, ti = u.pm - g * 9, lr0 = ti * 256 + wr * 64 + fr, col0 = wc * 32 + 8 * fq;
#pragma unroll
        for (int ai = 0; ai < 2; ++ai)
#pragma unroll
            for (int m = 0; m < 4; ++m) { const int lr = lr0 + ai * HALF + m * 16; GAS bf16* rowp = O + (size_t)(g * 2112 + lr) * 256 + col0; asm volatile("" ::: "memory");
#pragma unroll
                for (int bj = 0; bj < 2; ++bj) { const f32x4 v0 = acc[ai][bj][m][0], v1 = acc[ai][bj][m][1];
                    v4u w; w.x = cvt_pk_bf16(v0[0], v0[1]); w.y = cvt_pk_bf16(v0[2], v0[3]); w.z = cvt_pk_bf16(v1[0], v1[1]); w.w = cvt_pk_bf16(v1[2], v1[3]);
                    if (lr < 2112) *(GAS v4u*)(rowp + bj * HALF) = w; } }
    }
};
struct EpiS5Y {
    static constexpr bool PERM = true;
    GAS bf16* YA; GAS float* Y32; const GAS bf16* P; const GAS float* dsk;
    __device__ __forceinline__ void operator()(const f32x4 (&acc)[2][2][4][2], const Unit& u, int wr, int wc, int fr, int fq) const {
        const int g = u.pm / 9, ti = u.pm - g * 9, lr0 = ti * 256 + wr * 64 + fr;
#pragma unroll
        for (int ai = 0; ai < 2; ++ai)
#pragma unroll
            for (int m = 0; m < 4; ++m) { const int lr = lr0 + ai * HALF + m * 16; asm volatile("" ::: "memory");
                if (lr < 2112) { const int b = lr / 528, sc = lr - b * 528; const int r0 = sc < 16 ? NLAT + b * CTXL + sc * 16 : b * SEQ + (sc - 16) * 16;
#pragma unroll
                    for (int bj = 0; bj < 2; ++bj) { const int n = bj * HALF + wc * 32 + 8 * fq, t = n >> 4, c0 = g * 16 + (n & 15); const size_t row = (size_t)(r0 + t);
                        const v4u uw = *(const GAS v4u*)(P + row * DPP + PC_S5U + c0); const f32x4 d0 = *(const GAS f32x4*)(dsk + c0), d1 = *(const GAS f32x4*)(dsk + c0 + 4);
                        const float uu[8] = {bflo(uw.x), bfhi(uw.x), bflo(uw.y), bfhi(uw.y), bflo(uw.z), bfhi(uw.z), bflo(uw.w), bfhi(uw.w)};
                        f32x4 y0, y1;
#pragma unroll
                        for (int i = 0; i < 4; ++i) { y0[i] = gelu_tanh(acc[ai][bj][m][0][i] + d0[i] * uu[i]); y1[i] = gelu_tanh(acc[ai][bj][m][1][i] + d1[i] * uu[4 + i]); }
                        *(GAS f32x4*)(Y32 + row * 256 + c0) = y0; *(GAS f32x4*)(Y32 + row * 256 + c0 + 4) = y1;
                        v4u w; w.x = cvt_pk_bf16(y0[0], y0[1]); w.y = cvt_pk_bf16(y0[2], y0[3]); w.z = cvt_pk_bf16(y1[0], y1[1]); w.w = cvt_pk_bf16(y1[2], y1[3]);
                        *(GAS v4u*)(YA + row * 256 + c0) = w; } } }
    }
};
}

struct Args { const float* in[34]; float* out; unsigned char* ws; int ph_lo, ph_hi; };
struct Frame {
    LAS unsigned char* lds;
    int tid, lane, wave, G, bid;
};
typedef const __attribute__((address_space(4))) unsigned long long* kaptr_t;
__device__ __forceinline__ unsigned long long karg(int i) { kaptr_t ka = (kaptr_t)__builtin_amdgcn_kernarg_segment_ptr(); asm volatile("" : "+s"(ka)); return ka[i]; }
__device__ __forceinline__ const GAS float* inp(int i) { return (const GAS float*)karg(i); }
__device__ __forceinline__ GAS float* outp() { return (GAS float*)karg(34); }
__device__ __forceinline__ GAS unsigned char* wsp() { return (GAS unsigned char*)karg(35); }
enum { I_X = 0, I_C, I_CTX, I_CCTX, I_ADAW, I_ADAB, I_WIN, I_WOUT, I_LNG, I_LNB, I_GCONV, I_GALOG, I_GDTB, I_GNW, I_S5ARE, I_S5AIM, I_S5LS, I_S5BRE, I_S5BIM, I_S5CRE, I_S5CIM,
       I_S5D, I_S5GLUW, I_S5GLUB, I_HLB, I_HNW, I_RDEC, I_FW1, I_FW3, I_FW2, I_MROUTER, I_MW1, I_MW3, I_MW2 };

__device__ __forceinline__ void frame_refresh(Frame& F) { const int ln = lane_id_opaque(); int w = F.wave, b = F.bid; asm volatile("" : "+s"(w), "+s"(b)); F.wave = w; F.bid = b; F.lane = ln; F.tid = w * 64 + ln; }
__device__ __forceinline__ int row_slot(int row) { return row < NLAT ? (row >> 13) : 4; }

__device__ __forceinline__ void transpose_item(const GAS float* W, int K, int N, GAS bf16* WT, int mode, LAS float* scr, int item, int lane) {
    const int nblk = (N + 31) / 32, kb = item / nblk, nb = item % nblk, k0 = 64 * kb, n0 = 32 * nb;
    const int nn = n0 + 4 * (lane & 7), kr = lane >> 3;
    f32x4 v[8];
#pragma unroll
    for (int i = 0; i < 8; ++i) v[i] = (nn < N) ? *(const GAS f32x4*)(W + (size_t)(k0 + 8 * i + kr) * N + nn) : (f32x4){0.f, 0.f, 0.f, 0.f};
#pragma unroll
    for (int i = 0; i < 8; ++i) { LAS float* d = scr + (8 * i + kr) * 33 + 4 * (lane & 7); d[0] = v[i][0]; d[1] = v[i][1]; d[2] = v[i][2]; d[3] = v[i][3]; }
    LDS_WAIT(); asm volatile("" ::: "memory");
    const int c = lane & 7;
#pragma unroll
    for (int j = 0; j < 4; ++j) { const int nl = (lane >> 3) + 8 * j; const int n = n0 + nl; const LAS float* s = scr + (8 * c) * 33 + nl;
        v4u o; o.x = pk2(s[0 * 33], s[1 * 33]); o.y = pk2(s[2 * 33], s[3 * 33]); o.z = pk2(s[4 * 33], s[5 * 33]); o.w = pk2(s[6 * 33], s[7 * 33]);
        const int nr = mode == 0 ? n : ((n >> 7) * 256 + (n & 127) + (mode == 2 ? 128 : 0));
        if (n < N) *(GAS v4u*)(WT + (size_t)nr * K + k0 + 8 * c) = o; }
    LDS_WAIT(); asm volatile("" ::: "memory");
}

__device__ __forceinline__ void phase_prologue(Frame& F) {
    frame_refresh(F); GAS unsigned char* const ws = wsp();
    LAS float* scv = (LAS float*)F.lds;
    LAS float* part = (LAS float*)(F.lds + 20480);
    for (int i = F.tid; i < 5 * 1024; i += 512) { const int s = i >> 10, k = i & 1023; const float c = s < 4 ? inp(I_C)[s * 1024 + k] : inp(I_CCTX)[k]; scv[i] = siluf_(c); }
    __syncthreads();
    GAS float* MOD = (GAS float*)(ws + WS_MOD);
    for (int it = F.bid; it < 4 * 96; it += F.G) {
        const int l = it / 96, n0 = (it % 96) * 64;
        const GAS float* w = inp(I_ADAW) + (size_t)l * 1024 * 6144 + n0 + F.lane;
        float a0 = 0.f, a1 = 0.f, a2 = 0.f, a3 = 0.f, a4 = 0.f;
        const int kb = F.wave * 128;
#pragma unroll 8
        for (int k = 0; k < 128; ++k) { const float wv = w[(size_t)(kb + k) * 6144];
            a0 += scv[kb + k] * wv; a1 += scv[1024 + kb + k] * wv; a2 += scv[2048 + kb + k] * wv; a3 += scv[3072 + kb + k] * wv; a4 += scv[4096 + kb + k] * wv; }
        part[(F.wave * 5 + 0) * 64 + F.lane] = a0; part[(F.wave * 5 + 1) * 64 + F.lane] = a1; part[(F.wave * 5 + 2) * 64 + F.lane] = a2; part[(F.wave * 5 + 3) * 64 + F.lane] = a3; part[(F.wave * 5 + 4) * 64 + F.lane] = a4;
        __syncthreads();
        if (F.tid < 320) { const int s = F.tid >> 6, n = F.tid & 63; float v = inp(I_ADAB)[l * 6144 + n0 + n];
#pragma unroll
            for (int w8 = 0; w8 < 8; ++w8) v += part[(w8 * 5 + s) * 64 + n];
            MOD[(size_t)(l * 5 + s) * 6144 + n0 + n] = v; }
        __syncthreads();
    }
    const int gt = F.bid * 512 + F.tid, NT = F.G * 512;
    GAS float* LB = (GAS float*)(ws + WS_LB);
    for (int i = gt; i < 256; i += NT) {
        float v[4], mx = -1e30f; for (int l = 0; l < 4; ++l) { v[l] = inp(I_HLB)[l * 256 + i]; mx = fmaxf(mx, v[l]); }
        float s = 0.f; for (int l = 0; l < 4; ++l) { v[l] = expf(v[l] - mx); s += v[l]; }
        float cum = 0.f, first = 0.f; for (int l = 0; l < 4; ++l) { cum += v[l] / s; if (l == 0) first = cum; LB[l * 256 + i] = cum - first; }
    }
    GAS float* ROT = (GAS float*)(ws + WS_ROT);
    for (int i = gt; i < 192 * 16; i += NT) { const int pos = i >> 4, q = i & 15; const float p = (float)(pos < 128 ? pos : pos - 128);
        const float invf = expf(-(float)q * (9.210340371976184f / 16.f)); const float ang = p * invf; ROT[i * 2] = cosf(ang); ROT[i * 2 + 1] = sinf(ang); }
    GAS float* LAM = (GAS float*)(ws + WS_S5LAM); GAS float* BB = (GAS float*)(ws + WS_S5B);
    for (int i = gt; i < 4 * 2 * 16 * 64; i += NT) {
        const int ldg = i >> 6;
        const float are = inp(I_S5ARE)[i], aim = inp(I_S5AIM)[i], st = expf(inp(I_S5LS)[ldg]);
        const float x = are * st, y = aim * st, ex = expf(x), cy = cosf(y), sy = sinf(y), sh = sinf(0.5f * y);
        LAM[i * 2] = ex * cy; LAM[i * 2 + 1] = ex * sy;
        const float er = expm1f(x) * cy - 2.f * sh * sh, ei = ex * sy;
        const float den = are * are + aim * aim; const float qr = (er * are + ei * aim) / den, qi = (ei * are - er * aim) / den;
        for (int c = 0; c < 16; ++c) { const float br = inp(I_S5BRE)[(size_t)i * 16 + c], bi = inp(I_S5BIM)[(size_t)i * 16 + c];
            BB[((size_t)i * 16 + c) * 2] = qr * br - qi * bi; BB[((size_t)i * 16 + c) * 2 + 1] = qr * bi + qi * br; }
    }
    LAS float* scr = (LAS float*)(F.lds + 32768 + F.wave * 8704);
    __syncthreads();
    const int gw = F.bid * 8 + F.wave, NGW = F.G * 8;
    constexpr int I_IN = 16 * 113, I_OUT = 16 * 32, I_GLU = 4 * 8, I_F1 = 16 * 88, I_F2 = 44 * 32;
    constexpr int PER_L = I_IN + I_OUT + I_GLU, TOT = 4 * PER_L + 2 * (2 * I_F1 + I_F2);
    for (int it = gw; it < TOT; it += NGW) {
        int r = it;
        if (r < 4 * PER_L) { const int l = r / PER_L; r -= l * PER_L;
            if (r < I_IN) { transpose_item(inp(I_WIN) + (size_t)l * D * DPROJ, D, DPROJ, (GAS bf16*)(ws + WS_WIN) + (size_t)l * DPW * D, 0, scr, r, F.lane); continue; } r -= I_IN;
            if (r < I_OUT) { transpose_item(inp(I_WOUT) + (size_t)l * D * D, D, D, (GAS bf16*)(ws + WS_WOUT) + (size_t)l * D * D, 0, scr, r, F.lane); continue; } r -= I_OUT;
            transpose_item(inp(I_S5GLUW) + (size_t)l * 65536, 256, 256, (GAS bf16*)(ws + WS_WGLU) + (size_t)l * 65536, 0, scr, r, F.lane); continue; }
        r -= 4 * PER_L;
        const int j = r / (2 * I_F1 + I_F2); r -= j * (2 * I_F1 + I_F2);
        if (r < I_F1) { transpose_item(inp(I_FW1) + (size_t)j * D * FFD, D, FFD, (GAS bf16*)(ws + WS_WF13) + (size_t)j * 2 * FFD * D, 1, scr, r, F.lane); continue; } r -= I_F1;
        if (r < I_F1) { transpose_item(inp(I_FW3) + (size_t)j * D * FFD, D, FFD, (GAS bf16*)(ws + WS_WF13) + (size_t)j * 2 * FFD * D, 2, scr, r, F.lane); continue; } r -= I_F1;
        transpose_item(inp(I_FW2) + (size_t)j * FFD * D, FFD, D, (GAS bf16*)(ws + WS_WF2) + (size_t)j * D * FFD, 0, scr, r, F.lane);
    }
}
__device__ __forceinline__ void tr_load(const GAS float* W, int N, int item, int lane, f32x4 (&v)[8]) {
    const int nblk = (N + 31) / 32, kb = item / nblk, nb = item % nblk, k0 = 64 * kb, n0 = 32 * nb;
    const int nn = n0 + 4 * (lane & 7), kr = lane >> 3;
#pragma unroll
    for (int i = 0; i < 8; ++i) v[i] = (nn < N) ? *(const GAS f32x4*)(W + (size_t)(k0 + 8 * i + kr) * N + nn) : (f32x4){0.f, 0.f, 0.f, 0.f};
}
__device__ __forceinline__ void tr_store(int K, int N, GAS bf16* WT, int mode, LAS float* scr, int item, int lane, const f32x4 (&v)[8]) {
    const int nblk = (N + 31) / 32, kb = item / nblk, nb = item % nblk, k0 = 64 * kb, n0 = 32 * nb;
    const int kr = lane >> 3;
#pragma unroll
    for (int i = 0; i < 8; ++i) { LAS float* d = scr + (8 * i + kr) * 33 + 4 * (lane & 7); d[0] = v[i][0]; d[1] = v[i][1]; d[2] = v[i][2]; d[3] = v[i][3]; }
    LDS_WAIT(); asm volatile("" ::: "memory");
    const int c = lane & 7;
#pragma unroll
    for (int j = 0; j < 4; ++j) { const int nl = (lane >> 3) + 8 * j; const int n = n0 + nl; const LAS float* s = scr + (8 * c) * 33 + nl;
        v4u o; o.x = pk2(s[0 * 33], s[1 * 33]); o.y = pk2(s[2 * 33], s[3 * 33]); o.z = pk2(s[4 * 33], s[5 * 33]); o.w = pk2(s[6 * 33], s[7 * 33]);
        const int nr = mode == 0 ? n : ((n >> 7) * 256 + (n & 127) + (mode == 2 ? 128 : 0));
        if (n < N) *(GAS v4u*)(WT + (size_t)nr * K + k0 + 8 * c) = o; }
    LDS_WAIT(); asm volatile("" ::: "memory");
}
__device__ __forceinline__ void phase_moe_convert(Frame& F, int j) {
    frame_refresh(F); GAS unsigned char* const ws = wsp();
    LAS float* scr = (LAS float*)(F.lds + F.wave * 8704);
    const int gw = F.bid * 8 + F.wave, NGW = F.G * 8;
    constexpr int I_1 = 16 * 112, I_2 = 56 * 32, PER_E = 2 * I_1 + I_2;
    struct TI { const GAS float* W; GAS bf16* WT; int K, N, mode, item; };
    auto decode = [&](int it, TI& t) {
        const int e = it / PER_E; int r = it - e * PER_E;
        const size_t wo = ((size_t)j * 8 + e) * D * FFE;
        if (r < I_1) { t.W = inp(I_MW1) + wo; t.K = D; t.N = FFE; t.WT = (GAS bf16*)(ws + WS_WM13) + (size_t)e * 2 * FFE * D; t.mode = 1; t.item = r; return; } r -= I_1;
        if (r < I_1) { t.W = inp(I_MW3) + wo; t.K = D; t.N = FFE; t.WT = (GAS bf16*)(ws + WS_WM13) + (size_t)e * 2 * FFE * D; t.mode = 2; t.item = r; return; } r -= I_1;
        t.W = inp(I_MW2) + wo; t.K = FFE; t.N = D; t.WT = (GAS bf16*)(ws + WS_WM2) + (size_t)e * D * FFE; t.mode = 0; t.item = r; };
    int it = gw; if (it >= 8 * PER_E) return;
    const int lane = F.lane;
    TI cur; decode(it, cur); f32x4 v[8]; tr_load(cur.W, cur.N, cur.item, lane, v);
    for (;;) {
        const int itn = it + NGW; const bool more = itn < 8 * PER_E;
        TI nxt = cur; f32x4 w[8];
        if (more) { decode(itn, nxt); tr_load(nxt.W, nxt.N, nxt.item, lane, w); }
        tr_store(cur.K, cur.N, cur.WT, cur.mode, scr, cur.item, lane, v);
        if (!more) break;
        cur = nxt; it = itn;
#pragma unroll
        for (int i = 0; i < 8; ++i) v[i] = w[i];
    }
}

__device__ __forceinline__ const GAS float* xrow_src(const GAS float* xl, const GAS float* xc, int row) { return row < NLAT ? xl + (size_t)row * D : xc + (size_t)(row - NLAT) * D; }
__device__ __forceinline__ GAS float* xrow_dst(GAS float* xl, GAS float* xc, int row) { return row < NLAT ? xl + (size_t)row * D : xc + (size_t)(row - NLAT) * D; }

__device__ __forceinline__ void store_A_row(GAS bf16* Ab, int lane_, int row, const f32x4 (&v)[4], const GAS float* modrow, int shoff, int scoff) {
    GAS bf16* ar = Ab + (size_t)row * D;
#pragma unroll
    for (int j = 0; j < 4; ++j) { const int c = 4 * lane_ + 256 * j; const f32x4 sh = *(const GAS f32x4*)(modrow + shoff + c), sc = *(const GAS f32x4*)(modrow + scoff + c);
        const f32x4 h = v[j] * (sc + 1.f) + sh; v2u w; w.x = pk2(h[0], h[1]); w.y = pk2(h[2], h[3]); *(GAS v2u*)(ar + c) = w; }
}
__device__ __forceinline__ void store_A_rowh(GAS bf16* Ab, int lane_, int row, const f32x4 (&v)[4], const f32x4 (&sh)[4], const f32x4 (&sc)[4]) {
    GAS bf16* ar = Ab + (size_t)row * D;
#pragma unroll
    for (int j = 0; j < 4; ++j) { const int c = 4 * lane_ + 256 * j; const f32x4 h = v[j] * (sc[j] + 1.f) + sh[j]; v2u w; w.x = pk2(h[0], h[1]); w.y = pk2(h[2], h[3]); *(GAS v2u*)(ar + c) = w; }
}
__device__ __forceinline__ void ln_row(f32x4 (&v)[4], const GAS float* g, const GAS float* b, int lane) {
    float s = 0.f;
#pragma unroll
    for (int j = 0; j < 4; ++j) s += (v[j][0] + v[j][1]) + (v[j][2] + v[j][3]);
    const float mean = wave_sum(s) * (1.f / D); float s2 = 0.f;
#pragma unroll
    for (int j = 0; j < 4; ++j) { v[j] = v[j] - mean; s2 += (v[j][0] * v[j][0] + v[j][1] * v[j][1]) + (v[j][2] * v[j][2] + v[j][3] * v[j][3]); }
    const float rstd = 1.f / sqrtf(wave_sum(s2) * (1.f / D) + LN_EPS);
#pragma unroll
    for (int j = 0; j < 4; ++j) { const int c = 4 * lane + 256 * j; const f32x4 gg = *(const GAS f32x4*)(g + c), bb = *(const GAS f32x4*)(b + c); v[j] = v[j] * rstd * gg + bb; }
}

__device__ __forceinline__ void ln_row2h(f32x4 (&v)[4], f32x4 (&w)[4], const f32x4 (&gg)[4], const f32x4 (&bb)[4]) {
    float s = 0.f, t = 0.f;
#pragma unroll
    for (int j = 0; j < 4; ++j) { s += (v[j][0] + v[j][1]) + (v[j][2] + v[j][3]); t += (w[j][0] + w[j][1]) + (w[j][2] + w[j][3]); }
    const float mean = wave_sum(s) * (1.f / D), meanb = wave_sum(t) * (1.f / D); float s2 = 0.f, t2 = 0.f;
#pragma unroll
    for (int j = 0; j < 4; ++j) { v[j] = v[j] - mean; w[j] = w[j] - meanb;
        s2 += (v[j][0] * v[j][0] + v[j][1] * v[j][1]) + (v[j][2] * v[j][2] + v[j][3] * v[j][3]); t2 += (w[j][0] * w[j][0] + w[j][1] * w[j][1]) + (w[j][2] * w[j][2] + w[j][3] * w[j][3]); }
    const float rstd = 1.f / sqrtf(wave_sum(s2) * (1.f / D) + LN_EPS), rstdb = 1.f / sqrtf(wave_sum(t2) * (1.f / D) + LN_EPS);
#pragma unroll
    for (int j = 0; j < 4; ++j) { v[j] = v[j] * rstd * gg[j] + bb[j]; w[j] = w[j] * rstdb * gg[j] + bb[j]; }
}
__device__ __forceinline__ void ln_row2(f32x4 (&v)[4], f32x4 (&w)[4], const GAS float* g, const GAS float* b, int lane) {
    float s = 0.f, t = 0.f;
#pragma unroll
    for (int j = 0; j < 4; ++j) { s += (v[j][0] + v[j][1]) + (v[j][2] + v[j][3]); t += (w[j][0] + w[j][1]) + (w[j][2] + w[j][3]); }
    const float mean = wave_sum(s) * (1.f / D), meanb = wave_sum(t) * (1.f / D); float s2 = 0.f, t2 = 0.f;
#pragma unroll
    for (int j = 0; j < 4; ++j) { v[j] = v[j] - mean; w[j] = w[j] - meanb;
        s2 += (v[j][0] * v[j][0] + v[j][1] * v[j][1]) + (v[j][2] * v[j][2] + v[j][3] * v[j][3]); t2 += (w[j][0] * w[j][0] + w[j][1] * w[j][1]) + (w[j][2] * w[j][2] + w[j][3] * w[j][3]); }
    const float rstd = 1.f / sqrtf(wave_sum(s2) * (1.f / D) + LN_EPS), rstdb = 1.f / sqrtf(wave_sum(t2) * (1.f / D) + LN_EPS);
#pragma unroll
    for (int j = 0; j < 4; ++j) { const int c = 4 * lane + 256 * j; const f32x4 gg = *(const GAS f32x4*)(g + c), bb = *(const GAS f32x4*)(b + c); v[j] = v[j] * rstd * gg + bb; w[j] = w[j] * rstdb * gg + bb; }
}

__device__ __forceinline__ void phase_a0(Frame& F) {
    frame_refresh(F); GAS unsigned char* const ws = wsp();
    const GAS float* MOD = (const GAS float*)(ws + WS_MOD);
    const int gw = F.bid * 8 + F.wave, NGW = F.G * 8;
    const GAS float* xl = inp(I_X); const GAS float* xc = inp(I_CTX); GAS bf16* Ab = (GAS bf16*)(ws + WS_A);
    const int lane = F.lane; f32x4 shv[4], scv[4]; int cslot = -1;
    for (int row = gw; row < R; row += 2 * NGW) {
        const int rowb = row + NGW < R ? row + NGW : row;
        const GAS float* xr = xrow_src(xl, xc, row); const GAS float* xrb = xrow_src(xl, xc, rowb); f32x4 v[4], w[4];
#pragma unroll
        for (int j = 0; j < 4; ++j) { v[j] = *(const GAS f32x4*)(xr + 4 * lane + 256 * j); w[j] = *(const GAS f32x4*)(xrb + 4 * lane + 256 * j); }
        const int sl = row_slot(row), slb = row_slot(rowb);
        if (sl != cslot) { const GAS float* mr = MOD + (size_t)(0 * 5 + sl) * 6144;
#pragma unroll
            for (int j = 0; j < 4; ++j) { shv[j] = *(const GAS f32x4*)(mr + 4 * lane + 256 * j); scv[j] = *(const GAS f32x4*)(mr + 1024 + 4 * lane + 256 * j); }
            cslot = sl; }
        store_A_rowh(Ab, lane, row, v, shv, scv);
        if (slb == sl) store_A_rowh(Ab, lane, rowb, w, shv, scv); else store_A_row(Ab, lane, rowb, w, MOD + (size_t)(0 * 5 + slb) * 6144, 0, 1024);
    }
}

__device__ __forceinline__ void phase_gdn_prep(Frame& F, int l) {
    frame_refresh(F); GAS unsigned char* const ws = wsp();
    const GAS bf16* P = (const GAS bf16*)(ws + WS_P);
    GAS bf16* GQ = (GAS bf16*)(ws + WS_GQ); GAS bf16* GK = (GAS bf16*)(ws + WS_GK); GAS bf16* GV = (GAS bf16*)(ws + WS_GV);
    GAS float* GSC = (GAS float*)(ws + WS_GSC);
    const GAS float* cw = inp(I_GCONV) + (size_t)l * 3 * 768;
    const int gw = F.bid * 8 + F.wave, NGW = F.G * 8, lane = F.lane;
    f32x4 w[3][3];
#pragma unroll
    for (int kk = 0; kk < 3; ++kk)
#pragma unroll
        for (int j = 0; j < 3; ++j) w[kk][j] = *(const GAS f32x4*)(cw + kk * 768 + j * 256 + 4 * lane);
    float galog = 0.f, gdtb = 0.f;
    if (lane < 8) { galog = -__expf(inp(I_GALOG)[l * 8 + lane]); gdtb = inp(I_GDTB)[l * 8 + lane]; }
    for (int row0 = gw; row0 < R; row0 += 2 * NGW) {
        int rows[2]; rows[0] = row0; rows[1] = row0 + NGW < R ? row0 + NGW : row0;
        v2u xa[2][3], xb[2][3], xc[2][3]; float av[2];
#pragma unroll
        for (int u = 0; u < 2; ++u) { const int row = rows[u];
            int t, L; if (row < NLAT) { t = row & (SEQ - 1); L = SEQ; } else { t = (row - NLAT) & (CTXL - 1); L = CTXL; }
            const GAS bf16* pr = P + (size_t)row * DPP;
#pragma unroll
            for (int j = 0; j < 3; ++j) {
                xb[u][j] = *(const GAS v2u*)(pr + j * 256 + 4 * lane);
                xa[u][j] = (v2u){0u, 0u}; xc[u][j] = (v2u){0u, 0u};
                if (t > 0) xa[u][j] = *(const GAS v2u*)(pr - DPP + j * 256 + 4 * lane);
                if (t < L - 1) xc[u][j] = *(const GAS v2u*)(pr + DPP + j * 256 + 4 * lane); }
            av[u] = lane < 16 ? bf2f(pr[PC_GA + lane]) : 0.f; }
#pragma unroll
        for (int u = 0; u < 2; ++u) { const int row = rows[u];
            f32x4 c[3];
#pragma unroll
            for (int j = 0; j < 3; ++j) { const v2u x0 = xa[u][j], x1 = xb[u][j], x2 = xc[u][j];
                f32x4 a;
                a[0] = w[0][j][0] * bflo(x0.x) + w[1][j][0] * bflo(x1.x) + w[2][j][0] * bflo(x2.x);
                a[1] = w[0][j][1] * bfhi(x0.x) + w[1][j][1] * bfhi(x1.x) + w[2][j][1] * bfhi(x2.x);
                a[2] = w[0][j][2] * bflo(x0.y) + w[1][j][2] * bflo(x1.y) + w[2][j][2] * bflo(x2.y);
                a[3] = w[0][j][3] * bfhi(x0.y) + w[1][j][3] * bfhi(x1.y) + w[2][j][3] * bfhi(x2.y);
#pragma unroll
                for (int i = 0; i < 4; ++i) a[i] = siluf_(a[i]);
                c[j] = a; }
            const float sq = sum16(c[0][0] * c[0][0] + c[0][1] * c[0][1] + c[0][2] * c[0][2] + c[0][3] * c[0][3]);
            const float sk = sum16(c[1][0] * c[1][0] + c[1][1] * c[1][1] + c[1][2] * c[1][2] + c[1][3] * c[1][3]);
            const float rq = 0.125f * __builtin_amdgcn_rsqf(sq + RMS_EPS), rk = __builtin_amdgcn_rsqf(sk + RMS_EPS);
            v2u o;
            o.x = pk2(c[0][0] * rq, c[0][1] * rq); o.y = pk2(c[0][2] * rq, c[0][3] * rq); *(GAS v2u*)(GQ + (size_t)row * 256 + 4 * lane) = o;
            o.x = pk2(c[1][0] * rk, c[1][1] * rk); o.y = pk2(c[1][2] * rk, c[1][3] * rk); *(GAS v2u*)(GK + (size_t)row * 256 + 4 * lane) = o;
            o.x = pk2(c[2][0], c[2][1]); o.y = pk2(c[2][2], c[2][3]); *(GAS v2u*)(GV + (size_t)row * 256 + 4 * lane) = o;
            if (lane < 16) {
                const float a = av[u];
                float val;
                if (lane < 8) { const float z = a + gdtb; const float e = __expf(z); const float sp = z > 20.f ? z : (e < 0.01f ? e * (1.f - e * (0.5f - e * 0.33333333f)) : __logf(1.f + e)); val = galog * sp; }
                else val = sigmoidf_(a);
                GSC[(size_t)row * 16 + lane] = val;
            }
        }
    }
}

__device__ __forceinline__ void chunk_rows(int b, int dir, int c, int& r0, int& step, int& t0) {
    const int s0 = c * TCH;
    if (s0 < CTXL) { t0 = -1; if (dir == 0) { r0 = NLAT + b * CTXL + s0; step = 1; } else { r0 = NLAT + b * CTXL + (CTXL - 1 - s0); step = -1; } }
    else { const int u = s0 - CTXL; if (dir == 0) { r0 = b * SEQ + u; step = 1; t0 = u; } else { r0 = b * SEQ + (SEQ - 1 - u); step = -1; t0 = SEQ - 1 - u; } }
}
constexpr int NCH64 = NSEQ / 64;
constexpr int UNITS = BATCH * 4 * 2 * NCH64;
__device__ __forceinline__ void unit_rows(int b, int dir, int n, int& r0, int& step, int& t0) {
    const int s0 = n * 64;
    if (s0 < CTXL) { t0 = -1; if (dir == 0) { r0 = NLAT + b * CTXL + s0; step = 1; } else { r0 = NLAT + b * CTXL + (CTXL - 1 - s0); step = -1; } }
    else { const int u = s0 - CTXL; if (dir == 0) { r0 = b * SEQ + u; step = 1; t0 = u; } else { r0 = b * SEQ + (SEQ - 1 - u); step = -1; t0 = SEQ - 1 - u; } }
}
__device__ __forceinline__ bf16x8 mkfrag(v2u lo, v2u hi) { v4u w; w.x = lo.x; w.y = lo.y; w.z = hi.x; w.w = hi.y; return __builtin_bit_cast(bf16x8, w); }
__device__ __forceinline__ bf16x8 ldfrag_perm(const GAS unsigned char* tile, int row0, int ks, int r16, int q) {
    const GAS unsigned char* p = tile + (row0 + r16) * 128 + (32 * ks + 4 * q) * 2;
    return mkfrag(*(const GAS v2u*)p, *(const GAS v2u*)(p + 32));
}
__device__ __forceinline__ bf16x8 pack_acc(const f32x4& a, const f32x4& b) {
    v4u w; w.x = pg8::cvt_pk_bf16(a[0], a[1]); w.y = pg8::cvt_pk_bf16(a[2], a[3]); w.z = pg8::cvt_pk_bf16(b[0], b[1]); w.w = pg8::cvt_pk_bf16(b[2], b[3]); return __builtin_bit_cast(bf16x8, w);
}
#define MFMA16(a, b, c) __builtin_amdgcn_mfma_f32_16x16x32_bf16(a, b, c, 0, 0, 0)
__device__ __forceinline__ float rdlane(float x, int i) { return __builtin_bit_cast(float, __builtin_amdgcn_readlane(__builtin_bit_cast(int, x), i)); }

template <int MODE>
__device__ __forceinline__ void chain_run(Frame& F, int sub) {
    GAS unsigned char* const ws = wsp();
    const int lane = lane_id_opaque(), r16 = lane & 15, q = lane >> 4;
    const int cb = sub & 3, dir = (sub >> 2) & 1, h = (sub >> 3) & 3, b = sub >> 5;
    constexpr int NT = (MODE == 0) ? 5 : 4, TW = 0, TU = (MODE == 0) ? 1 : 0, TKD = TU + 1, TQG = TU + 2, TATT = TU + 3;
    const int u0 = ((b * 4 + h) * 2 + dir) * NCH64;
    const GAS unsigned char* tb = ws + (MODE == 0 ? WS_TG : (MODE == 1 ? WS_TH : WS_TR)) + (size_t)u0 * NT * 8192;
    const GAS float* decp = (const GAS float*)(ws + WS_DEC) + (size_t)(MODE * UNITS + u0) * 64;
    GAS bf16* OB = (GAS bf16*)(ws + WS_OB) + (size_t)(MODE * 2 + dir) * R * 256 + h * 64 + cb * 16 + 4 * q;
    f32x4 S[4]; bf16x8 Sb[2];
#pragma unroll
    for (int m = 0; m < 4; ++m) S[m] = (f32x4){0.f, 0.f, 0.f, 0.f};
    Sb[0] = (bf16x8){0, 0, 0, 0, 0, 0, 0, 0}; Sb[1] = Sb[0];
    bf16x8 Wf[4][2], Kf[4][2], Qf[4][2], Af[4][2]; v2u Uf[4]; f32x4 dc[4];
#define LD_W(tu)  do { if (MODE == 0) { _Pragma("unroll") for (int m = 0; m < 4; ++m) _Pragma("unroll") for (int k = 0; k < 2; ++k) Wf[m][k] = ldfrag_perm((tu) + TW * 8192, 16 * m, k, r16, q); } } while (0)
#define LD_U(tu)  do { _Pragma("unroll") for (int m = 0; m < 4; ++m) Uf[m] = *(const GAS v2u*)((tu) + TU * 8192 + (cb * 16 + r16) * 128 + (16 * m + 4 * q) * 2); } while (0)
#define LD_K(tu)  do { _Pragma("unroll") for (int m = 0; m < 4; ++m) _Pragma("unroll") for (int k = 0; k < 2; ++k) Kf[m][k] = ldfrag_perm((tu) + TKD * 8192, 16 * m, k, r16, q); } while (0)
#define LD_Q(tu)  do { _Pragma("unroll") for (int m = 0; m < 4; ++m) _Pragma("unroll") for (int k = 0; k < 2; ++k) Qf[m][k] = ldfrag_perm((tu) + TQG * 8192, 16 * m, k, r16, q); } while (0)
#define LD_A(tu)  do { _Pragma("unroll") for (int m = 0; m < 4; ++m) _Pragma("unroll") for (int k = 0; k < 2; ++k) Af[m][k] = ldfrag_perm((tu) + TATT * 8192, 16 * m, k, r16, q); } while (0)
#define LD_D(n_)  do { _Pragma("unroll") for (int m = 0; m < 4; ++m) dc[m] = *(const GAS f32x4*)(decp + (size_t)(n_) * 64 + 16 * m + 4 * q); } while (0)
    LD_W(tb); LD_U(tb); LD_Q(tb); LD_A(tb); LD_K(tb); LD_D(0);
    for (int n = 0; n < NCH64; ++n) {
        const GAS unsigned char* tn = tb + (size_t)(n + 1 < NCH64 ? n + 1 : n) * NT * 8192;
        f32x4 vn[4], o[4];
#pragma unroll
        for (int m = 0; m < 4; ++m) { vn[m] = (f32x4){bflo(Uf[m].x), bfhi(Uf[m].x), bflo(Uf[m].y), bfhi(Uf[m].y)}; o[m] = (f32x4){0.f, 0.f, 0.f, 0.f}; }
        if (MODE == 0) {
#pragma unroll
            for (int m = 0; m < 4; ++m) { vn[m] = MFMA16(Wf[m][0], Sb[0], vn[m]); vn[m] = MFMA16(Wf[m][1], Sb[1], vn[m]); }
        }
#pragma unroll
        for (int m = 0; m < 4; ++m) { o[m] = MFMA16(Sb[0], Qf[m][0], o[m]); o[m] = MFMA16(Sb[1], Qf[m][1], o[m]); }
        LD_W(tn); LD_U(tn); LD_Q(tn);
        bf16x8 vb[2]; vb[0] = pack_acc(vn[0], vn[1]); vb[1] = pack_acc(vn[2], vn[3]);
#pragma unroll
        for (int m = 0; m < 4; ++m) { o[m] = MFMA16(vb[0], Af[m][0], o[m]); o[m] = MFMA16(vb[1], Af[m][1], o[m]); }
#pragma unroll
        for (int m = 0; m < 4; ++m) { S[m] = S[m] * dc[m]; S[m] = MFMA16(Kf[m][0], vb[0], S[m]); S[m] = MFMA16(Kf[m][1], vb[1], S[m]); }
        LD_A(tn); LD_K(tn); LD_D(n + 1 < NCH64 ? n + 1 : n);
        Sb[0] = pack_acc(S[0], S[1]); Sb[1] = pack_acc(S[2], S[3]);
        { int r0, step, t0; unit_rows(b, dir, n, r0, step, t0);
#pragma unroll
            for (int m = 0; m < 4; ++m) { const int row = r0 + step * (16 * m + r16); v2u w; w.x = pg8::cvt_pk_bf16(o[m][0], o[m][1]); w.y = pg8::cvt_pk_bf16(o[m][2], o[m][3]);
                *(GAS v2u*)(OB + (size_t)row * 256) = w; } }
    }
#undef LD_W
#undef LD_U
#undef LD_K
#undef LD_Q
#undef LD_A
#undef LD_D
}

__device__ __forceinline__ bf16x8 ldsfrag_perm(LAS unsigned char* tile, int row, int ks, int q) {
    return *(const LAS bf16x8*)(tile + row * 128 + (((4 * ks + q) ^ ((row >> 1) & 7)) << 4));
}
template <int MODE>
__device__ __forceinline__ void chain_wg(Frame& F, int cid, int half, GAS bf16* obase = nullptr) {
    GAS unsigned char* const ws = wsp();
    const int lane = lane_id_opaque(), r16 = lane & 15, q = lane >> 4;
    const int dir = cid & 1, h = (cid >> 1) & 3, b = cid >> 3;
    constexpr int NT = (MODE == 0) ? 5 : 4, TW = 0, TU = (MODE == 0) ? 1 : 0, TKD = TU + 1, TQG = TU + 2, TATT = TU + 3;
    constexpr int STAGE = NT * 8192, LPW = NT * 2, LSTAGE = STAGE + 256;
    const int u0 = cid * NCH64;
    const GAS unsigned char* tb = ws + (MODE == 0 ? WS_TG : (MODE == 1 ? WS_TH : WS_TR)) + (size_t)u0 * STAGE;
    LAS unsigned char* ring = F.lds;
    const GAS float* decp = (const GAS float*)(ws + WS_DEC) + (size_t)(MODE * UNITS + u0) * 64;
    int wv = F.wave; asm volatile("" : "+s"(wv));
    if (wv >= 4) {
        const int lw = wv - 4;
        const int lrow = lane >> 3, lch = lane & 7;
        unsigned voff[LPW], loff[LPW];
#pragma unroll
        for (int j = 0; j < LPW; ++j) { const int p = lw + 4 * j, row = 8 * (p & 7) + lrow; voff[j] = (unsigned)((p >> 3) * 8192 + row * 128 + lch * 16); loff[j] = (unsigned)((p >> 3) * 8192 + row * 128 + ((lch ^ ((row >> 1) & 7)) << 4)); }
        float d0_, d1_, d2_, d3_;
        v4u r0_[LPW], r1_[LPW], r2_[LPW], r3_[LPW];
#define CH_SKIP(j) (((j) >> 1) == TU && ((j) & 1) != half)
#define CH_LOAD(reg, dreg, n_) do { const int nn_ = (n_) < NCH64 ? (n_) : NCH64 - 1; const GAS unsigned char* src = tb + (size_t)nn_ * STAGE; _Pragma("unroll") for (int j = 0; j < LPW; ++j) { if (CH_SKIP(j)) continue; reg[j] = *(const GAS v4u*)(src + voff[j]); } dreg = decp[(size_t)nn_ * 64 + lane]; } while (0)
#define CH_WRITE(reg, dreg, n_) do { LAS unsigned char* dst = ring + ((n_) & 1) * LSTAGE; _Pragma("unroll") for (int j = 0; j < LPW; ++j) { if (CH_SKIP(j)) continue; *(LAS v4u*)(dst + loff[j]) = reg[j]; } *(LAS float*)(dst + STAGE + lane * 4) = dreg; } while (0)
#define CH_SYNC() do { asm volatile("s_waitcnt lgkmcnt(0)" ::: "memory"); __builtin_amdgcn_s_barrier(); asm volatile("" ::: "memory"); } while (0)
        CH_LOAD(r0_, d0_, 0); CH_LOAD(r1_, d1_, 1); CH_LOAD(r2_, d2_, 2); CH_LOAD(r3_, d3_, 3);
        CH_WRITE(r0_, d0_, 0);
#define CH_FENCE() asm volatile("" ::: "memory")
        for (int n = 0; n < NCH64; n += 4) {
            CH_SYNC(); CH_LOAD(r0_, d0_, n + 4); CH_FENCE(); CH_WRITE(r1_, d1_, n + 1);
            CH_SYNC(); CH_LOAD(r1_, d1_, n + 5); CH_FENCE(); CH_WRITE(r2_, d2_, n + 2);
            CH_SYNC(); CH_LOAD(r2_, d2_, n + 6); CH_FENCE(); CH_WRITE(r3_, d3_, n + 3);
            CH_SYNC(); CH_LOAD(r3_, d3_, n + 7); CH_FENCE(); CH_WRITE(r0_, d0_, n + 4);
        }
#undef CH_FENCE
        asm volatile("s_waitcnt vmcnt(0) lgkmcnt(0)" ::: "memory");
#undef CH_SYNC
#undef CH_LOAD
#undef CH_WRITE
#undef CH_SKIP
    } else if (wv >= 2) {
        for (int n = 0; n < NCH64; ++n) __builtin_amdgcn_s_barrier();
    } else {
        const int cb = half * 2 + wv;
        GAS bf16* OB = (obase ? obase : (GAS bf16*)(ws + WS_OB)) + (size_t)(MODE * 2 + dir) * R * 256 + h * 64 + cb * 16 + 4 * q;
        f32x4 S[4]; bf16x8 Sb[2];
#pragma unroll
        for (int m = 0; m < 4; ++m) S[m] = (f32x4){0.f, 0.f, 0.f, 0.f};
        Sb[0] = (bf16x8){0, 0, 0, 0, 0, 0, 0, 0}; Sb[1] = Sb[0];
        auto step = [&](const int n) {
            asm volatile("s_waitcnt lgkmcnt(0)" ::: "memory");
            __builtin_amdgcn_s_barrier();
            asm volatile("" ::: "memory");
            LAS unsigned char* st = ring + (n & 1) * LSTAGE;
            f32x4 vn[4], o[4], dc[4];
            v2u uf[4]; bf16x8 fW[4][2], fQ[4][2], fA[4][2], fK[4][2];
#pragma unroll
            for (int m = 0; m < 4; ++m) { const int row = cb * 16 + r16;
                uf[m] = *(const LAS v2u*)(st + TU * 8192 + row * 128 + (((4 * (m >> 1) + q) ^ ((row >> 1) & 7)) << 4) + 8 * (m & 1)); }
            if (MODE == 0) {
#pragma unroll
                for (int m = 0; m < 4; ++m) { fW[m][0] = ldsfrag_perm(st + TW * 8192, 16 * m + r16, 0, q); fW[m][1] = ldsfrag_perm(st + TW * 8192, 16 * m + r16, 1, q); }
            }
#pragma unroll
            for (int m = 0; m < 4; ++m) { fQ[m][0] = ldsfrag_perm(st + TQG * 8192, 16 * m + r16, 0, q); fQ[m][1] = ldsfrag_perm(st + TQG * 8192, 16 * m + r16, 1, q); }
#pragma unroll
            for (int m = 0; m < 4; ++m) dc[m] = *(const LAS f32x4*)(st + STAGE + (16 * m + 4 * q) * 4);
            __builtin_amdgcn_sched_barrier(0);
#pragma unroll
            for (int m = 0; m < 4; ++m) { fA[m][0] = ldsfrag_perm(st + TATT * 8192, 16 * m + r16, 0, q); fA[m][1] = ldsfrag_perm(st + TATT * 8192, 16 * m + r16, 1, q); }
#pragma unroll
            for (int m = 0; m < 4; ++m) { fK[m][0] = ldsfrag_perm(st + TKD * 8192, 16 * m + r16, 0, q); fK[m][1] = ldsfrag_perm(st + TKD * 8192, 16 * m + r16, 1, q); }
            __builtin_amdgcn_sched_barrier(0);
#pragma unroll
            for (int m = 0; m < 4; ++m) { vn[m] = (f32x4){bflo(uf[m].x), bfhi(uf[m].x), bflo(uf[m].y), bfhi(uf[m].y)}; o[m] = (f32x4){0.f, 0.f, 0.f, 0.f}; }
            if (MODE == 0) {
#pragma unroll
                for (int m = 0; m < 4; ++m) { vn[m] = MFMA16(fW[m][0], Sb[0], vn[m]); vn[m] = MFMA16(fW[m][1], Sb[1], vn[m]); }
            }
#pragma unroll
            for (int m = 0; m < 4; ++m) { o[m] = MFMA16(Sb[0], fQ[m][0], o[m]); o[m] = MFMA16(Sb[1], fQ[m][1], o[m]); }
            bf16x8 vb[2]; vb[0] = pack_acc(vn[0], vn[1]); vb[1] = pack_acc(vn[2], vn[3]);
#pragma unroll
            for (int m = 0; m < 4; ++m) { S[m] = S[m] * dc[m]; S[m] = MFMA16(fK[m][0], vb[0], S[m]); S[m] = MFMA16(fK[m][1], vb[1], S[m]); }
#pragma unroll
            for (int m = 0; m < 4; ++m) { o[m] = MFMA16(vb[0], fA[m][0], o[m]); o[m] = MFMA16(vb[1], fA[m][1], o[m]); }
            Sb[0] = pack_acc(S[0], S[1]); Sb[1] = pack_acc(S[2], S[3]);
            { int r0, step, t0; unit_rows(b, dir, n, r0, step, t0);
#pragma unroll
                for (int m = 0; m < 4; ++m) { const int row = r0 + step * (16 * m + r16); v2u w; w.x = pg8::cvt_pk_bf16(o[m][0], o[m][1]); w.y = pg8::cvt_pk_bf16(o[m][2], o[m][3]);
                    *(GAS v2u*)(OB + (size_t)row * 256) = w; } }
        };
        for (int n = 0; n < NCH64; ++n) step(n);
        asm volatile("s_waitcnt lgkmcnt(0)" ::: "memory");
    }
    __builtin_amdgcn_s_barrier();
}

__device__ __forceinline__ int swz(int rr, int kc) { return rr * 128 + ((kc ^ (rr & 7)) << 4); }
__device__ __forceinline__ v4u pack8(const float (&x)[8]) { v4u w; w.x = pk2(x[0], x[1]); w.y = pk2(x[2], x[3]); w.z = pk2(x[4], x[5]); w.w = pk2(x[6], x[7]); return w; }
__device__ __forceinline__ void unpack8(const v4u w, float (&x)[8]) { x[0] = bflo(w.x); x[1] = bfhi(w.x); x[2] = bflo(w.y); x[3] = bfhi(w.y); x[4] = bflo(w.z); x[5] = bfhi(w.z); x[6] = bflo(w.w); x[7] = bfhi(w.w); }
__device__ __forceinline__ void store_col8(GAS unsigned char* tile, int d0, int i, const float (&x)[8]) {
#pragma unroll
    for (int e = 0; e < 8; ++e) *(GAS bf16*)(tile + (d0 + e) * 128 + i * 2) = (bf16)f2bf(x[e]);
}
template <class Fac>
__device__ __forceinline__ void att_from_lds(LAS unsigned char* Qs, LAS unsigned char* Ks, GAS unsigned char* tATT, int r16, int q, const Fac& fac) {
#pragma unroll
    for (int nt = 0; nt < 4; ++nt) {
        bf16x8 bq[2];
#pragma unroll
        for (int ks = 0; ks < 2; ++ks) bq[ks] = *(const LAS bf16x8*)(Qs + swz(16 * nt + r16, ks * 4 + q));
        const int i = 16 * nt + r16;
#pragma unroll
        for (int mt = 0; mt < 4; ++mt) {
            unsigned zz; asm volatile("v_mov_b32 %0, 0" : "=v"(zz)); v2u w = (v2u){zz, zz};
            if (mt <= nt) {
                f32x4 acc = (f32x4){0.f, 0.f, 0.f, 0.f};
#pragma unroll
                for (int ks = 0; ks < 2; ++ks) { const bf16x8 ka = *(const LAS bf16x8*)(Ks + swz(16 * mt + r16, ks * 4 + q)); acc = MFMA16(ka, bq[ks], acc); }
                float y[4];
#pragma unroll
                for (int r = 0; r < 4; ++r) { const int j = 16 * mt + 4 * q + r; y[r] = (j <= i) ? acc[r] * fac(i, j) : 0.f; }
                w.x = pk2(y[0], y[1]); w.y = pk2(y[2], y[3]);
            }
            *(GAS v2u*)(tATT + i * 128 + (mt >> 1) * 64 + q * 16 + (mt & 1) * 8) = w;
        }
    }
}

__device__ __forceinline__ void tile_g2l(const GAS bf16* base, size_t pitch, int r0, int step, LAS unsigned char* buf, int lane) {
    const int rr = lane >> 3, ch = lane & 7;
    v4u v[8];
#pragma unroll
    for (int i = 0; i < 8; ++i) v[i] = *(const GAS v4u*)(base + (size_t)(r0 + step * (8 * i + rr)) * pitch + ch * 8);
#pragma unroll
    for (int i = 0; i < 8; ++i) *(LAS v4u*)(buf + swz(8 * i + rr, ch)) = v[i];
}
__device__ __forceinline__ void tile_l2g(LAS unsigned char* buf, GAS unsigned char* tile, int lane) {
    const int rr = lane >> 3, ch = lane & 7;
#pragma unroll
    for (int i = 0; i < 8; ++i) { const int row = 8 * i + rr, ks = ch >> 2, q = ch & 3;
        const v2u lo = *(const LAS v2u*)(buf + swz(row, 4 * ks + (q >> 1)) + 8 * (q & 1)), hi = *(const LAS v2u*)(buf + swz(row, 4 * ks + 2 + (q >> 1)) + 8 * (q & 1));
        v4u v; v.x = lo.x; v.y = lo.y; v.z = hi.x; v.w = hi.y; *(GAS v4u*)(tile + row * 128 + ch * 16) = v; }
}
__device__ __forceinline__ void row_rd(LAS unsigned char* buf, int lane, v4u (&w)[8]) {
#pragma unroll
    for (int c = 0; c < 8; ++c) w[c] = *(const LAS v4u*)(buf + swz(lane, c));
}
__device__ __forceinline__ void row_wr(LAS unsigned char* buf, int lane, const v4u (&w)[8]) {
#pragma unroll
    for (int c = 0; c < 8; ++c) *(LAS v4u*)(buf + swz(lane, c)) = w[c];
}
__device__ __forceinline__ void col_wr_raw(LAS unsigned char* buf, int lane, int d0, const v4u w) {
    const unsigned ww[4] = {w.x, w.y, w.z, w.w};
#pragma unroll
    for (int e = 0; e < 8; ++e) { const int d = d0 + e; *(LAS bf16*)(buf + swz(d, lane >> 3) + (lane & 7) * 2) = (bf16)((e & 1) ? (ww[e >> 1] >> 16) : (ww[e >> 1] & 0xffffu)); }
}
__device__ __forceinline__ void col_wr_f(LAS unsigned char* buf, int lane, int d0, const float (&x)[8]) {
#pragma unroll
    for (int e = 0; e < 8; ++e) { const int d = d0 + e; *(LAS bf16*)(buf + swz(d, lane >> 3) + (lane & 7) * 2) = (bf16)f2bf(x[e]); }
}

__device__ __forceinline__ void m1_ret(Frame& F, int l, int uidx, LAS unsigned char* lw) {
    GAS unsigned char* const ws = wsp();
    const int lane = lane_id_opaque(), r16 = lane & 15, q = lane >> 4;
    const int n = uidx % NCH64, t_ = uidx / NCH64, dir = t_ & 1, h = (t_ >> 1) & 3, b = t_ >> 3;
    int r0, step, t0; unit_rows(b, dir, n, r0, step, t0);
    const int tpos = t0 < 0 ? -1 : t0 + step * lane;
    const GAS bf16* pq = (const GAS bf16*)(ws + WS_P) + PC_RQKV + h * 64;
    const GAS float* ROT = (const GAS float*)(ws + WS_ROT);
    GAS unsigned char* tu = ws + WS_TR + (size_t)uidx * 4 * 8192;
    GAS unsigned char* tU = tu, *tKD = tu + 8192, *tQG = tu + 2 * 8192, *tATT = tu + 3 * 8192;
    LAS unsigned char* bufA = lw; LAS unsigned char* bufB = lw + 8192;
    const float lg = -__expf(inp(I_RDEC)[l * 8 + dir * 4 + h]);
    const float gq = __expf(lg * (float)(lane + 1)), gk = 0.125f * __expf(lg * (float)(63 - lane));
    tile_g2l(pq, DPP, r0, step, bufA, lane); tile_g2l(pq + 256, DPP, r0, step, bufB, lane);
    LDS_WAIT();
    v4u qw[8], kw[8]; row_rd(bufA, lane, qw); row_rd(bufB, lane, kw);
#pragma unroll
    for (int c8 = 0; c8 < 4; ++c8) {
        float ql[8], qh[8], kl[8], kh[8];
        unpack8(qw[c8], ql); unpack8(qw[c8 + 4], qh); unpack8(kw[c8], kl); unpack8(kw[c8 + 4], kh);
        if (tpos >= 0) {
            const GAS float* tab = ROT + (size_t)((c8 < 2 ? (tpos >> 6) : 128 + (tpos & 63)) * 16 + (c8 & 1) * 8) * 2;
#pragma unroll
            for (int e = 0; e < 8; ++e) { const float cs = tab[2 * e], sn = tab[2 * e + 1];
                const float a = ql[e] * cs - qh[e] * sn, bq = ql[e] * sn + qh[e] * cs; ql[e] = a; qh[e] = bq;
                const float c = kl[e] * cs - kh[e] * sn, dk = kl[e] * sn + kh[e] * cs; kl[e] = c; kh[e] = dk; }
        }
#pragma unroll
        for (int e = 0; e < 8; ++e) { ql[e] *= gq; qh[e] *= gq; }
        qw[c8] = pack8(ql); qw[c8 + 4] = pack8(qh); kw[c8] = pack8(kl); kw[c8 + 4] = pack8(kh);
    }
    row_wr(bufA, lane, qw); row_wr(bufB, lane, kw);
    LDS_WAIT();
    att_from_lds(bufA, bufB, tATT, r16, q, [&](int, int j) { return 0.125f * __expf(-lg * (float)(j + 1)); });
    LDS_WAIT();
    tile_l2g(bufA, tQG, lane);
#pragma unroll
    for (int c = 0; c < 8; ++c) { float x[8]; unpack8(kw[c], x);
#pragma unroll
        for (int e = 0; e < 8; ++e) x[e] *= gk;
        col_wr_f(bufB, lane, 8 * c, x); }
    LDS_WAIT();
    tile_l2g(bufB, tKD, lane);
    tile_g2l(pq + 512, DPP, r0, step, bufA, lane);
    LDS_WAIT();
    row_rd(bufA, lane, qw);
#pragma unroll
    for (int c = 0; c < 8; ++c) col_wr_raw(bufB, lane, 8 * c, qw[c]);
    LDS_WAIT();
    tile_l2g(bufB, tU, lane);
    ((GAS float*)(ws + WS_DEC))[(size_t)(2 * UNITS + uidx) * 64 + lane] = __expf(lg * 64.f);
    LDS_WAIT();
}

__device__ __forceinline__ void m1_hgrn(Frame& F, int l, int uidx, LAS unsigned char* lw) {
    GAS unsigned char* const ws = wsp();
    const int lane = lane_id_opaque(), r16 = lane & 15, q = lane >> 4;
    const int n = uidx % NCH64, t_ = uidx / NCH64, dir = t_ & 1, h = (t_ >> 1) & 3, b = t_ >> 3;
    int r0, step, t0; unit_rows(b, dir, n, r0, step, t0);
    const GAS bf16* P = (const GAS bf16*)(ws + WS_P);
    const GAS float* LBp = (const GAS float*)(ws + WS_LB) + l * 256 + h * 64;
    GAS unsigned char* tu = ws + WS_TH + (size_t)uidx * 4 * 8192;
    GAS unsigned char* tU = tu, *tKD = tu + 8192, *tQG = tu + 2 * 8192, *tATT = tu + 3 * 8192;
    GAS float* decp = (GAS float*)(ws + WS_DEC) + (size_t)(1 * UNITS + uidx) * 64;
    LAS unsigned char* bufA = lw; LAS unsigned char* bufB = lw + 8192;
    tile_g2l(P + PC_HQ + h * 64, DPP, r0, step, bufA, lane); tile_g2l(P + PC_HF + dir * 256 + h * 64, DPP, r0, step, bufB, lane);
    LDS_WAIT();
    v4u xqp[8], xkp[8];
#pragma unroll
    for (int g8 = 0; g8 < 8; ++g8) {
        float qv[8], fz[8], gc[8], kk[8];
        unpack8(*(const LAS v4u*)(bufA + swz(lane, g8)), qv); unpack8(*(const LAS v4u*)(bufB + swz(lane, g8)), fz);
        const f32x4 lb0 = *(const GAS f32x4*)(LBp + 8 * g8), lb1 = *(const GAS f32x4*)(LBp + 8 * g8 + 4);
#pragma unroll
        for (int e = 0; e < 8; ++e) { const float lb = e < 4 ? lb0[e] : lb1[e - 4]; const float sg = sigmoidf_(fz[e]);
            kk[e] = (1.f - lb) * (1.f - sg); gc[e] = __logf(lb + (1.f - lb) * sg); qv[e] = siluf_(qv[e]); }
#pragma unroll
        for (int o = 1; o < 64; o <<= 1) {
#pragma unroll
            for (int e = 0; e < 8; ++e) { const float t = shfl_idx(gc[e], (lane - o) & 63); if (lane >= o) gc[e] += t; }
        }
        float xq[8], xk[8], xs[8], xt[8];
#pragma unroll
        for (int e = 0; e < 8; ++e) { const float gm = rdlane(gc[e], 31), g63 = rdlane(gc[e], 63);
            xq[e] = qv[e] * __expf(gc[e]); xk[e] = kk[e] * __expf(g63 - gc[e]);
            xs[e] = qv[e] * __expf(fminf(gc[e] - gm, 80.f)); xt[e] = kk[e] * __expf(fminf(gm - gc[e], 80.f));
            if (lane == e) decp[8 * g8 + e] = __expf(g63); }
        xqp[g8] = pack8(xq); xkp[g8] = pack8(xk);
        *(LAS v4u*)(bufA + swz(lane, g8)) = pack8(xs); *(LAS v4u*)(bufB + swz(lane, g8)) = pack8(xt);
    }
    LDS_WAIT();
    att_from_lds(bufA, bufB, tATT, r16, q, [](int, int) { return 1.f; });
    LDS_WAIT();
    row_wr(bufA, lane, xqp);
#pragma unroll
    for (int c = 0; c < 8; ++c) col_wr_raw(bufB, lane, 8 * c, xkp[c]);
    LDS_WAIT();
    tile_l2g(bufA, tQG, lane); tile_l2g(bufB, tKD, lane);
    tile_g2l(P + PC_HI + h * 64, DPP, r0, step, bufA, lane);
    LDS_WAIT();
    row_rd(bufA, lane, xqp);
#pragma unroll
    for (int c = 0; c < 8; ++c) col_wr_raw(bufB, lane, 8 * c, xqp[c]);
    LDS_WAIT();
    tile_l2g(bufB, tU, lane);
    LDS_WAIT();
}

__device__ __forceinline__ void m1_gdn(Frame& F, int uidx, LAS unsigned char* lw) {
    GAS unsigned char* const ws = wsp();
    const int lane = lane_id_opaque(), r16 = lane & 15, q = lane >> 4;
    const int n = uidx % NCH64, t_ = uidx / NCH64, dir = t_ & 1, h = (t_ >> 1) & 3, b = t_ >> 3;
    int r0, step, t0; unit_rows(b, dir, n, r0, step, t0);
    const GAS bf16* GQ = (const GAS bf16*)(ws + WS_GQ) + h * 64; const GAS bf16* GK = (const GAS bf16*)(ws + WS_GK) + h * 64; const GAS bf16* GV = (const GAS bf16*)(ws + WS_GV) + h * 64;
    const GAS float* GSC = (const GAS float*)(ws + WS_GSC);
    GAS unsigned char* tu = ws + WS_TG + (size_t)uidx * 5 * 8192;
    GAS unsigned char* tW = tu, *tU = tu + 8192, *tKD = tu + 2 * 8192, *tQG = tu + 3 * 8192, *tATT = tu + 4 * 8192;
    LAS float* Am = (LAS float*)lw;
    LAS unsigned char* bufA = lw; LAS unsigned char* bufB = lw + 8192;
    const int myrow = r0 + step * lane;
    float gc = GSC[(size_t)myrow * 16 + dir * 4 + h]; const float beta = GSC[(size_t)myrow * 16 + 8 + dir * 4 + h];
#pragma unroll
    for (int o = 1; o < 64; o <<= 1) { const float t = shfl_idx(gc, (lane - o) & 63); if (lane >= o) gc += t; }
    const float g63 = rdlane(gc, 63);
#pragma unroll 1
    for (int nt = 0; nt < 4; ++nt) {
        const int i = 16 * nt + r16; const size_t irow = (size_t)(r0 + step * i) * 256;
        bf16x8 bk[2], bq[2];
#pragma unroll
        for (int ks = 0; ks < 2; ++ks) { bk[ks] = *(const GAS bf16x8*)(GK + irow + 32 * ks + 8 * q); bq[ks] = *(const GAS bf16x8*)(GQ + irow + 32 * ks + 8 * q); }
        const float gci = shfl_idx(gc, i), bti = shfl_idx(beta, i);
#pragma unroll
        for (int mt = 0; mt < 4; ++mt) {
            unsigned zz; asm volatile("v_mov_b32 %0, 0" : "=v"(zz)); v2u w = (v2u){zz, zz};
            if (mt <= nt) {
                f32x4 a1 = (f32x4){0.f, 0.f, 0.f, 0.f}, a2 = a1;
#pragma unroll
                for (int ks = 0; ks < 2; ++ks) { const bf16x8 ka = *(const GAS bf16x8*)(GK + (size_t)(r0 + step * (16 * mt + r16)) * 256 + 32 * ks + 8 * q); a1 = MFMA16(ka, bk[ks], a1); a2 = MFMA16(ka, bq[ks], a2); }
                f32x4 av; float y[4];
#pragma unroll
                for (int r = 0; r < 4; ++r) { const int j = 16 * mt + 4 * q + r; const float gcj = shfl_idx(gc, j); const float dcy = __expf(fminf(gci - gcj, 0.f));
                    av[r] = (j < i) ? bti * a1[r] * dcy : 0.f; y[r] = (j <= i) ? a2[r] * dcy : 0.f; }
                *(LAS f32x4*)(Am + i * 64 + 16 * mt + 4 * q) = av;
                w.x = pk2(y[0], y[1]); w.y = pk2(y[2], y[3]);
            }
            *(GAS v2u*)(tATT + i * 128 + (mt >> 1) * 64 + q * 16 + (mt & 1) * 8) = w;
        }
    }
    ((GAS float*)(ws + WS_DEC))[(size_t)(0 * UNITS + uidx) * 64 + lane] = __expf(g63);
    const float begc = beta * __expf(gc), kdf = __expf(g63 - gc);
    LDS_WAIT();
#define GDN_SOLVE(x) do { _Pragma("unroll") for (int i = 1; i < 64; ++i) { asm volatile("" ::: "memory"); float s0_ = 0.f, s1_ = 0.f, s2_ = 0.f, s3_ = 0.f; \
        _Pragma("unroll") for (int j4 = 0; j4 < (i + 3) / 4; ++j4) { const f32x4 a = *(const LAS f32x4*)(Am + i * 64 + 4 * j4); \
            if (4 * j4 + 0 < i) s0_ += a[0] * x[4 * j4 + 0]; if (4 * j4 + 1 < i) s1_ += a[1] * x[4 * j4 + 1]; if (4 * j4 + 2 < i) s2_ += a[2] * x[4 * j4 + 2]; if (4 * j4 + 3 < i) s3_ += a[3] * x[4 * j4 + 3]; } \
        float su = x[i] - ((s0_ + s1_) + (s2_ + s3_)); asm volatile("" : "+v"(su)); x[i] = su; } } while (0)
    const unsigned ul = (unsigned)lane;
    {   float x[64];
#pragma unroll
        for (int i = 0; i < 64; ++i) { if ((i & 15) == 0) asm volatile("" ::: "memory"); const GAS bf16* rp = GK + (size_t)(r0 + step * i) * 256; x[i] = rdlane(begc, i) * bf2f(rp[ul]); }
        GDN_SOLVE(x);
#pragma unroll
        for (int i = 0; i < 64; ++i) *(GAS bf16*)(tW + i * 128 + (lane >> 5) * 64 + (8 * ((lane & 15) >> 2) + 4 * ((lane >> 4) & 1) + (lane & 3)) * 2) = (bf16)f2bf(-x[i]);
    }
    asm volatile("" ::: "memory");
    {   float x[64];
#pragma unroll
        for (int i = 0; i < 64; ++i) { if ((i & 15) == 0) asm volatile("" ::: "memory"); const GAS bf16* rp = GV + (size_t)(r0 + step * i) * 256; x[i] = rdlane(beta, i) * bf2f(rp[ul]); }
        GDN_SOLVE(x);
        LDS_WAIT(); asm volatile("" ::: "memory");
        const int lane = lane_id_opaque();
#pragma unroll
        for (int c8 = 0; c8 < 8; ++c8) { float y[8];
#pragma unroll
            for (int e = 0; e < 8; ++e) y[e] = x[8 * c8 + e];
            *(LAS v4u*)(bufB + swz(lane, c8)) = pack8(y); }
    }
    { const int lane = lane_id_opaque(); const unsigned ul = (unsigned)lane;
    LDS_WAIT();
    tile_l2g(bufB, tU, lane);
    { v4u kp[8];
#pragma unroll
        for (int c8 = 0; c8 < 8; ++c8) { float y[8];
#pragma unroll
            for (int e = 0; e < 8; ++e) { const int i = 8 * c8 + e; const GAS bf16* rp = GK + (size_t)(r0 + step * i) * 256; y[e] = bf2f(rp[ul]) * rdlane(kdf, i); }
            kp[c8] = pack8(y); }
        row_wr(bufA, lane, kp); }
    tile_g2l(GQ, 256, r0, step, bufB, lane);
    LDS_WAIT();
    tile_l2g(bufA, tKD, lane);
    { v4u qgp[8]; const float eg = __expf(gc); row_rd(bufB, lane, qgp);
#pragma unroll
        for (int c = 0; c < 8; ++c) { float x[8]; unpack8(qgp[c], x);
#pragma unroll
            for (int e = 0; e < 8; ++e) x[e] *= eg;
            qgp[c] = pack8(x); }
        row_wr(bufB, lane, qgp); }
    LDS_WAIT();
    tile_l2g(bufB, tQG, lane);
    }
#undef GDN_SOLVE
    LDS_WAIT();
}
__device__ __forceinline__ void phase_m1(Frame& F, int l, int sel = 7) {
    frame_refresh(F);
    LAS unsigned char* lw = F.lds + F.wave * 16384;
    const int gw = F.bid * 8 + F.wave, NGW = F.G * 8;
    for (int it = gw; it < 3 * UNITS; it += NGW) {
        const int m = it / UNITS, u = it - m * UNITS;
#ifndef M1MASK
#define M1MASK 7
#endif
        if (m == 0) { if (sel & 1) m1_gdn(F, u, lw); }
        else if (m == 1) { if (sel & 2) m1_hgrn(F, l, u, lw); }
        else { if (sel & 4) m1_ret(F, l, u, lw); }
    }
}

__device__ __forceinline__ void scan_s5(Frame& F, int l, int sub, LAS unsigned char* lds) {
    GAS unsigned char* const ws = wsp();
    const int lane = lane_id_opaque(), g = sub & 15, dir = (sub >> 4) & 1, b = sub >> 5;
    const GAS bf16* P = (const GAS bf16*)(ws + WS_P);
    GAS float* O = (GAS float*)(ws + WS_O5) + (size_t)dir * R * 256;
    const int ldg = (l * 2 + dir) * 16 + g;
    const GAS float* LAM = (const GAS float*)(ws + WS_S5LAM) + (size_t)(ldg * 64 + lane) * 2;
    const GAS float* BB = (const GAS float*)(ws + WS_S5B) + (size_t)(ldg * 64 + lane) * 32;
    const float lr = LAM[0], li = LAM[1];
    float br[16], bi[16];
#pragma unroll
    for (int c = 0; c < 16; ++c) { br[c] = BB[2 * c]; bi[c] = BB[2 * c + 1]; }
    LAS float* US = (LAS float*)lds; LAS float* HS = US + 1024; LAS float* CS = HS + 32 * 130; LAS float* YS = CS + 2048;
    { const GAS float* cre = inp(I_S5CRE) + (size_t)ldg * 16 * 64; const GAS float* cim = inp(I_S5CIM) + (size_t)ldg * 16 * 64;
        for (int i = lane; i < 1024; i += 64) { CS[i * 2] = cre[i]; CS[i * 2 + 1] = cim[i]; } }
    float hr = 0.f, hi = 0.f;
    v4u ust;
    auto load = [&](int c) { int r0, step, t0; chunk_rows(b, dir, c, r0, step, t0); const int tt = lane >> 1, half = lane & 1; const int row = r0 + step * tt;
        ust = *(const GAS v4u*)(P + (size_t)row * DPP + PC_S5U + g * 16 + half * 8); };
    auto stage = [&](int buf) { const int tt = lane >> 1, half = lane & 1; LAS float* u = US + buf * 512 + tt * 16 + half * 8; const unsigned w[4] = {ust.x, ust.y, ust.z, ust.w};
        *(LAS f32x4*)u = (f32x4){bflo(w[0]), bfhi(w[0]), bflo(w[1]), bfhi(w[1])}; *(LAS f32x4*)(u + 4) = (f32x4){bflo(w[2]), bfhi(w[2]), bflo(w[3]), bfhi(w[3])}; };
    load(0); stage(0);
    for (int c = 0; c < NCHUNK; ++c) {
        const int buf = c & 1;
        if (c + 1 < NCHUNK) load(c + 1);
        LDS_WAIT();
        const LAS float* U = US + buf * 512;
        for (int tt = 0; tt < TCH; ++tt) {
            f32x4 u[4];
#pragma unroll
            for (int i = 0; i < 4; ++i) u[i] = *(const LAS f32x4*)(U + tt * 16 + 4 * i);
            float ar = 0.f, ai = 0.f;
#pragma unroll
            for (int cc = 0; cc < 16; ++cc) { ar += br[cc] * u[cc >> 2][cc & 3]; ai += bi[cc] * u[cc >> 2][cc & 3]; }
            const float nr = lr * hr - li * hi + ar, ni = lr * hi + li * hr + ai;
            hr = nr; hi = ni;
            *(LAS f32x2*)(HS + tt * 130 + lane * 2) = (f32x2){hr, hi};
        }
        LDS_WAIT();
        { const int cc = lane & 15, tq = lane >> 4;
            float acc[8];
#pragma unroll
            for (int k = 0; k < 8; ++k) acc[k] = 0.f;
            for (int p = 0; p < 64; ++p) {
                const f32x2 cv = *(const LAS f32x2*)(CS + (cc * 64 + p) * 2);
#pragma unroll
                for (int k = 0; k < 8; ++k) { const f32x2 hv = *(const LAS f32x2*)(HS + (tq * 8 + k) * 130 + p * 2); acc[k] += cv[0] * hv[0] - cv[1] * hv[1]; }
            }
#pragma unroll
            for (int k = 0; k < 8; ++k) YS[(tq * 8 + k) * 16 + cc] = acc[k];
        }
        LDS_WAIT();
        { int r0, step, t0; chunk_rows(b, dir, c, r0, step, t0); const int tt = lane >> 1, half = lane & 1; const int row = r0 + step * tt;
            GAS float* op = O + (size_t)row * 256 + g * 16 + half * 8;
            *(GAS f32x4*)op = *(const LAS f32x4*)(YS + tt * 16 + half * 8); *(GAS f32x4*)(op + 4) = *(const LAS f32x4*)(YS + tt * 16 + half * 8 + 4); }
        if (c + 1 < NCHUNK) stage(buf ^ 1);
    }
}

__device__ __forceinline__ int s5_tokrow(int b, int sc) { return sc < 16 ? NLAT + b * CTXL + sc * 16 : b * SEQ + (sc - 16) * 16; }
__device__ __forceinline__ void s5_relayout(Frame& F) {
    GAS unsigned char* const ws = wsp();
    const GAS bf16* P = (const GAS bf16*)(ws + WS_P); GAS bf16* A2 = (GAS bf16*)(ws + WS_S5A2);
    const int gw = F.bid * 8 + F.wave, NGW = F.G * 8, lane = F.lane, g = lane & 15;
    for (int it = gw; it < 2112; it += NGW) {
        const int b = it / 528, sc = it - b * 528, r0 = s5_tokrow(b, sc);
#pragma unroll
        for (int i = 0; i < 4; ++i) { const int t = i * 4 + (lane >> 4);
            const GAS bf16* src = P + (size_t)(r0 + t) * DPP + PC_S5U + g * 16;
            GAS bf16* dst = A2 + ((size_t)(g * 2112 + it) * 512 + t * 16);
            const v4u a = *(const GAS v4u*)src, c = *(const GAS v4u*)(src + 8);
            *(GAS v4u*)dst = a; *(GAS v4u*)(dst + 8) = c; }
    }
}
__device__ __forceinline__ void s5_build(Frame& F, int l) {
    GAS unsigned char* const ws = wsp();
    const GAS float* LAM = (const GAS float*)(ws + WS_S5LAM); const GAS float* BB = (const GAS float*)(ws + WS_S5B);
    const GAS float* cre = inp(I_S5CRE); const GAS float* cim = inp(I_S5CIM);
    GAS bf16* EB = (GAS bf16*)(ws + WS_S5EB); GAS bf16* WY = (GAS bf16*)(ws + WS_S5WY);
    const int gt = F.bid * 512 + F.tid, NT = F.G * 512;
    {   LAS float* kl = (LAS float*)(F.lds + F.wave * 256);
        const int gw = F.bid * 8 + F.wave, NGW = F.G * 8, p = F.lane;
        for (int it = gw; it < 4096; it += NGW) {
            const int g = it >> 8, c = (it >> 4) & 15, c2 = it & 15;
            float Kv[32];
#pragma unroll
            for (int d = 0; d < 2; ++d) { const int i0 = ((l * 2 + d) * 16 + g) * 64 + p;
                const float lr = LAM[i0 * 2], li = LAM[i0 * 2 + 1], br = BB[((size_t)i0 * 16 + c2) * 2], bi = BB[((size_t)i0 * 16 + c2) * 2 + 1];
                const size_t ci_ = (size_t)((l * 2 + d) * 16 + g) * 1024 + c * 64 + p; const float cr = cre[ci_], ci = cim[ci_];
                float wr_ = cr * br - ci * bi, wi_ = cr * bi + ci * br;
#pragma unroll
                for (int j = 0; j < 16; ++j) { Kv[d * 16 + j] = wr_; const float nr = wr_ * lr - wi_ * li; wi_ = wr_ * li + wi_ * lr; wr_ = nr; } }
#pragma unroll
            for (int j = 0; j < 32; ++j) { const float r = wave_sum(Kv[j]); if (p == j) kl[j] = r; }
            LDS_WAIT();
            GAS bf16* wy = WY + (size_t)g * 256 * 512;
#pragma unroll
            for (int e = 0; e < 4; ++e) { const int idx = p * 4 + e, t = idx >> 4, s2 = idx & 15;
                const float v = s2 < t ? kl[t - s2] : (s2 > t ? kl[16 + s2 - t] : kl[0] + kl[16]); wy[(size_t)(t * 16 + c) * 512 + s2 * 16 + c2] = (bf16)f2bf(v); }
            LDS_WAIT();
        }
    }
    for (int it = gt; it < 32768; it += NT) {
        const int p = it & 63, c = (it >> 6) & 15, d = (it >> 10) & 1, g = it >> 11;
        const int i0 = ((l * 2 + d) * 16 + g) * 64 + p;
        const float lr = LAM[i0 * 2], li = LAM[i0 * 2 + 1], br = BB[((size_t)i0 * 16 + c) * 2], bi = BB[((size_t)i0 * 16 + c) * 2 + 1];
        const size_t ci_ = (size_t)((l * 2 + d) * 16 + g) * 1024 + c * 64 + p; const float cr = cre[ci_], ci = cim[ci_];
        float pr[17], pi[17]; pr[0] = 1.f; pi[0] = 0.f;
#pragma unroll
        for (int j = 1; j < 17; ++j) { pr[j] = pr[j - 1] * lr - pi[j - 1] * li; pi[j] = pr[j - 1] * li + pi[j - 1] * lr; }
        GAS bf16* wy = WY + (size_t)g * 256 * 512 + 256 + d * 128 + 2 * p; GAS bf16* eb = EB + (size_t)g * 256 * 256 + (size_t)(d * 128 + 2 * p) * 256;
#pragma unroll
        for (int t = 0; t < 16; ++t) {
            const int jw = d == 0 ? t + 1 : 16 - t, je = d == 0 ? 15 - t : t;
            const float xr = cr * pr[jw] - ci * pi[jw], xi = cr * pi[jw] + ci * pr[jw];
            *(GAS unsigned*)(wy + (size_t)(t * 16 + c) * 512) = pk2(xr, -xi);
            const float er = pr[je] * br - pi[je] * bi, ei = pr[je] * bi + pi[je] * br;
            eb[t * 16 + c] = (bf16)f2bf(er); eb[256 + t * 16 + c] = (bf16)f2bf(ei);
        }
    }
}
__device__ __forceinline__ void s5_scan(Frame& F, int l, int sub) {
    GAS unsigned char* const ws = wsp();
    const int lane = lane_id_opaque(), g = sub & 15, dir = (sub >> 4) & 1, b = sub >> 5;
    const GAS float* LAM = (const GAS float*)(ws + WS_S5LAM) + (size_t)((((l * 2 + dir) * 16 + g) * 64 + lane) * 2);
    float lr = LAM[0], li = LAM[1];
#pragma unroll
    for (int k = 0; k < 4; ++k) { const float nr = lr * lr - li * li; li = 2.f * lr * li; lr = nr; }
    const GAS unsigned* HL = (const GAS unsigned*)(ws + WS_S5HL) + (size_t)(g * 2112 + b * 528) * 128 + dir * 64 + lane;
    GAS unsigned* HI = (GAS unsigned*)(ws + WS_S5A2) + (size_t)(g * 2112 + b * 528) * 256 + 128 + dir * 64 + lane;
    float hr = 0.f, hi = 0.f;
#pragma unroll 1
    for (int k0 = 0; k0 < 528; k0 += 48) {
        unsigned w[48];
#pragma unroll
        for (int j = 0; j < 48; ++j) { const int k = k0 + j; const int sc = dir == 0 ? k : (k < 16 ? 15 - k : 543 - k); w[j] = HL[(size_t)sc * 128]; }
#pragma unroll
        for (int j = 0; j < 48; ++j) { const int k = k0 + j; const int sc = dir == 0 ? k : (k < 16 ? 15 - k : 543 - k);
            HI[(size_t)sc * 256] = pk2(hr, hi);
            const float nr = lr * hr - li * hi + bflo(w[j]), ni = lr * hi + li * hr + bfhi(w[j]); hr = nr; hi = ni; }
    }
}
#ifndef NEWCHAIN
#define NEWCHAIN 7
#endif
__device__ __forceinline__ void phase_scans(Frame& F, int l) {
    frame_refresh(F);
#ifdef CHAINCMP
    if (F.bid < 96) {
        const int m = F.bid >> 5, cid = F.bid & 31;
        if (F.wave < 4) { const int sub = cid * 4 + F.wave; if (m == 0) chain_run<0>(F, sub); else if (m == 1) chain_run<1>(F, sub); else chain_run<2>(F, sub); }
        __syncthreads();
        if (l == 0) { GAS bf16* ob2 = (GAS bf16*)outp(); if (m == 0) { chain_wg<0>(F, cid, 0, ob2); } else if (m == 1) { chain_wg<1>(F, cid, 0, ob2); } else { chain_wg<2>(F, cid, 0, ob2); } }
    } else {
        for (int it = (F.bid - 96) + (F.G - 96) * F.wave; it < 128; it += (F.G - 96) * 8) s5_scan(F, l, it);
    }
#else
    if (F.bid < 192) {
        const int half = (F.bid >> 3) & 1, c_ = (F.bid >> 4) * 8 + (F.bid & 7), m = c_ >> 5, cid = c_ & 31;
        if (m == 0) chain_wg<0>(F, cid, half); else if (m == 1) chain_wg<1>(F, cid, half); else chain_wg<2>(F, cid, half);
    } else {
        for (int it = (F.bid - 192) + (F.G - 192) * F.wave; it < 128; it += (F.G - 192) * 8) s5_scan(F, l, it);
    }
#endif
}

__device__ __forceinline__ void phase_readout(Frame& F, int l) {
    frame_refresh(F); GAS unsigned char* const ws = wsp();
    const GAS bf16* P = (const GAS bf16*)(ws + WS_P);
    GAS bf16* MIX = (GAS bf16*)(ws + WS_MIX); GAS bf16* YA = (GAS bf16*)(ws + WS_GQ);
    GAS float* O5 = (GAS float*)(ws + WS_O5); const GAS bf16* OB = (const GAS bf16*)(ws + WS_OB);
    const int gw = F.bid * 8 + F.wave, NGW = F.G * 8, lane = F.lane;
    const int dch = (4 * lane) & 63;
    const f32x4 gnw = *(const GAS f32x4*)(inp(I_GNW) + l * 64 + dch), hnw = *(const GAS f32x4*)(inp(I_HNW) + l * 64 + dch);
    const f32x4 dsk = *(const GAS f32x4*)(inp(I_S5D) + l * 256 + 4 * lane);
    const size_t OBS = (size_t)R * 256;
    for (int row0 = gw; row0 < R; row0 += 2 * NGW) {
        int rows[2]; rows[0] = row0; rows[1] = row0 + NGW < R ? row0 + NGW : row0;
        v2u of[2][3], ob[2][3], gg[2][3];
#pragma unroll
        for (int u = 0; u < 2; ++u) { const GAS bf16* pr = P + (size_t)rows[u] * DPP; const size_t ro = (size_t)rows[u] * 256 + 4 * lane;
#pragma unroll
            for (int m = 0; m < 3; ++m) { of[u][m] = *(const GAS v2u*)(OB + (size_t)(m * 2) * OBS + ro); ob[u][m] = *(const GAS v2u*)(OB + (size_t)(m * 2 + 1) * OBS + ro);
                gg[u][m] = *(const GAS v2u*)(pr + (m == 0 ? PC_GZ : (m == 1 ? PC_HG : PC_RG)) + 4 * lane); } }
#pragma unroll
        for (int u = 0; u < 2; ++u)
#pragma unroll
            for (int m = 0; m < 3; ++m) {
                const v2u f_ = of[u][m], b_ = ob[u][m], g_ = gg[u][m];
                const float o[4] = {bflo(f_.x) + bflo(b_.x), bfhi(f_.x) + bfhi(b_.x), bflo(f_.y) + bflo(b_.y), bfhi(f_.y) + bfhi(b_.y)};
                const float ss = sum16(o[0] * o[0] + o[1] * o[1] + o[2] * o[2] + o[3] * o[3]);
                const float r = __builtin_amdgcn_rsqf(ss * (1.f / 64.f) + RMS_EPS);
                const float gt[4] = {bflo(g_.x), bfhi(g_.x), bflo(g_.y), bfhi(g_.y)};
                float y[4];
#pragma unroll
                for (int i = 0; i < 4; ++i) { const float nw = m == 0 ? gnw[i] : (m == 1 ? hnw[i] : 1.f); y[i] = o[i] * r * nw * siluf_(gt[i]); }
                v2u w; w.x = pk2(y[0], y[1]); w.y = pk2(y[2], y[3]);
                *(GAS v2u*)(MIX + (size_t)rows[u] * D + (m == 0 ? 0 : (m == 1 ? 512 : 768)) + 4 * lane) = w;
            }
    }
}

template <bool ROUTE>
__device__ __forceinline__ void phase_ln(Frame& F, int l, int which) {
    frame_refresh(F); GAS unsigned char* const ws = wsp();
    const GAS bf16* DL = (const GAS bf16*)(ws + WS_Y);
    const bool xin = (l == 0 && which == 0);
    const GAS float* xsl = xin ? inp(I_X) : (const GAS float*)outp(); const GAS float* xsc = xin ? inp(I_CTX) : (const GAS float*)(ws + WS_XC);
    const GAS float* MOD = (const GAS float*)(ws + WS_MOD);
    const GAS float* lg = inp(I_LNG) + (size_t)(l * 2 + which) * D; const GAS float* lb = inp(I_LNB) + (size_t)(l * 2 + which) * D;
    const bool last = (l == DEPTH - 1 && which == 1);
    const int nl = which == 0 ? l : l + 1, shoff = which == 0 ? 3072 : 0, scoff = which == 0 ? 4096 : 1024;
    const int lane = F.lane;
    GAS float* xl = outp(); GAS float* xc = (GAS float*)(ws + WS_XC); GAS bf16* Ab = (GAS bf16*)(ws + WS_A);
    if constexpr (!ROUTE) {
        const int gw = F.bid * 8 + F.wave, NGW = F.G * 8;
        const int nrows = last ? NLAT : R;
        f32x4 lgv[4], lbv[4], shv[4], scv[4]; int cslot = -1;
#pragma unroll
        for (int j = 0; j < 4; ++j) { lgv[j] = *(const GAS f32x4*)(lg + 4 * lane + 256 * j); lbv[j] = *(const GAS f32x4*)(lb + 4 * lane + 256 * j); }
        for (int row = gw; row < nrows; row += 2 * NGW) {
            const int rowb = row + NGW < nrows ? row + NGW : row;
            f32x4 v[4], w[4]; const GAS float* xs = xrow_src(xsl, xsc, row); const GAS float* xsb = xrow_src(xsl, xsc, rowb);
#pragma unroll
            for (int j = 0; j < 4; ++j) { const v2u dw = *(const GAS v2u*)(DL + (size_t)row * D + 4 * lane + 256 * j), db = *(const GAS v2u*)(DL + (size_t)rowb * D + 4 * lane + 256 * j);
                v[j] = *(const GAS f32x4*)(xs + 4 * lane + 256 * j) * ALPHA + (f32x4){bflo(dw.x), bfhi(dw.x), bflo(dw.y), bfhi(dw.y)};
                w[j] = *(const GAS f32x4*)(xsb + 4 * lane + 256 * j) * ALPHA + (f32x4){bflo(db.x), bfhi(db.x), bflo(db.y), bfhi(db.y)}; }
            ln_row2h(v, w, lgv, lbv);
            GAS float* xd = xrow_dst(xl, xc, row); GAS float* xdb = xrow_dst(xl, xc, rowb);
#pragma unroll
            for (int j = 0; j < 4; ++j) { *(GAS f32x4*)(xd + 4 * lane + 256 * j) = v[j]; *(GAS f32x4*)(xdb + 4 * lane + 256 * j) = w[j]; }
            if (!last) { const int sl = row_slot(row), slb = row_slot(rowb);
                if (sl != cslot) { const GAS float* mr = MOD + (size_t)(nl * 5 + sl) * 6144;
#pragma unroll
                    for (int j = 0; j < 4; ++j) { shv[j] = *(const GAS f32x4*)(mr + shoff + 4 * lane + 256 * j); scv[j] = *(const GAS f32x4*)(mr + scoff + 4 * lane + 256 * j); }
                    cslot = sl; }
                store_A_rowh(Ab, lane, row, v, shv, scv);
                if (slb == sl) store_A_rowh(Ab, lane, rowb, w, shv, scv); else store_A_row(Ab, lane, rowb, w, MOD + (size_t)(nl * 5 + slb) * 6144, shoff, scoff); }
        }
    } else {
        LAS int* cnt = (LAS int*)F.lds;
        if (F.tid < 8) cnt[F.tid] = 0;
        __syncthreads();
        const GAS float* rw = inp(I_MROUTER) + (size_t)(l >> 1) * D * NEXP;
        f32x4 rwa[4][4][2];
#pragma unroll
        for (int j = 0; j < 4; ++j)
#pragma unroll
            for (int i = 0; i < 4; ++i) { const GAS float* p = rw + (size_t)(4 * lane + 256 * j + i) * 8; rwa[j][i][0] = *(const GAS f32x4*)p; rwa[j][i][1] = *(const GAS f32x4*)(p + 4); }
        GAS int* TOPE = (GAS int*)(ws + WS_TOPE); GAS float* TOPG = (GAS float*)(ws + WS_TOPG);
        const int Rl = (l == DEPTH - 1) ? NLAT : R;
        const int RPW = (Rl + F.G - 1) / F.G, rbeg = F.bid * RPW, rend = min(Rl, rbeg + RPW);
        f32x4 lgv[4], lbv[4];
#pragma unroll
        for (int j = 0; j < 4; ++j) { lgv[j] = *(const GAS f32x4*)(lg + 4 * lane + 256 * j); lbv[j] = *(const GAS f32x4*)(lb + 4 * lane + 256 * j); }
        for (int row0 = rbeg + F.wave; row0 < rend; row0 += 16) {
            const bool two = row0 + 8 < rend; const int rowb = two ? row0 + 8 : row0;
            f32x4 v[4], w[4]; const GAS float* xs = xrow_src(xsl, xsc, row0); const GAS float* xsb = xrow_src(xsl, xsc, rowb);
#pragma unroll
            for (int j = 0; j < 4; ++j) { const v2u dw = *(const GAS v2u*)(DL + (size_t)row0 * D + 4 * lane + 256 * j), db = *(const GAS v2u*)(DL + (size_t)rowb * D + 4 * lane + 256 * j);
                v[j] = *(const GAS f32x4*)(xs + 4 * lane + 256 * j) * ALPHA + (f32x4){bflo(dw.x), bfhi(dw.x), bflo(dw.y), bfhi(dw.y)};
                w[j] = *(const GAS f32x4*)(xsb + 4 * lane + 256 * j) * ALPHA + (f32x4){bflo(db.x), bfhi(db.x), bflo(db.y), bfhi(db.y)}; }
            ln_row2h(v, w, lgv, lbv);
            GAS float* xd = xrow_dst(xl, xc, row0); GAS float* xdb = xrow_dst(xl, xc, rowb);
#pragma unroll
            for (int j = 0; j < 4; ++j) { *(GAS f32x4*)(xd + 4 * lane + 256 * j) = v[j]; *(GAS f32x4*)(xdb + 4 * lane + 256 * j) = w[j]; }
#pragma unroll
            for (int u = 0; u < 2; ++u) {
                if (u == 1 && !two) break;
                const int row = u == 0 ? row0 : rowb; const f32x4 (&vv)[4] = u == 0 ? v : w;
                const GAS float* modrow = MOD + (size_t)(nl * 5 + row_slot(row)) * 6144;
                float lgt[8];
#pragma unroll
                for (int e = 0; e < 8; ++e) lgt[e] = 0.f;
                GAS bf16* ar = Ab + (size_t)row * D;
#pragma unroll
                for (int j = 0; j < 4; ++j) { const int c = 4 * lane + 256 * j; const f32x4 sh = *(const GAS f32x4*)(modrow + shoff + c), sc = *(const GAS f32x4*)(modrow + scoff + c);
                    const f32x4 hv = vv[j] * (sc + 1.f) + sh;
                    { v2u w2; w2.x = pk2(hv[0], hv[1]); w2.y = pk2(hv[2], hv[3]); *(GAS v2u*)(ar + c) = w2; }
#pragma unroll
                    for (int i = 0; i < 4; ++i)
#pragma unroll
                        for (int e = 0; e < 8; ++e) lgt[e] += hv[i] * rwa[j][i][e >> 2][e & 3]; }
#pragma unroll
                for (int e = 0; e < 8; ++e) lgt[e] = wave_sum(lgt[e]);
                int e0 = 0; float v0 = lgt[0];
#pragma unroll
                for (int e = 1; e < 8; ++e) if (lgt[e] > v0) { v0 = lgt[e]; e0 = e; }
                int e1 = -1; float v1 = -3.0e38f;
#pragma unroll
                for (int e = 0; e < 8; ++e) if (e != e0 && lgt[e] > v1) { v1 = lgt[e]; e1 = e; }
                if (lane == 0) { const float ex = __expf(v1 - v0); const float g0 = 1.f / (1.f + ex); TOPE[row] = e0 | (e1 << 8); TOPG[row * 2] = g0; TOPG[row * 2 + 1] = ex * g0;
                    __hip_atomic_fetch_add(&cnt[e0], 1, __ATOMIC_RELAXED, __HIP_MEMORY_SCOPE_WORKGROUP); __hip_atomic_fetch_add(&cnt[e1], 1, __ATOMIC_RELAXED, __HIP_MEMORY_SCOPE_WORKGROUP); }
            }
        }
        __syncthreads();
        if (F.tid < 8) ((GAS int*)(ws + WS_WGCNT))[F.bid * 8 + F.tid] = cnt[F.tid];
    }
}

__device__ __forceinline__ void phase_moe_assign(Frame& F, int l) {
    frame_refresh(F); GAS unsigned char* const ws = wsp();
    LAS int* sm = (LAS int*)F.lds;
    const GAS int* WGCNT = (const GAS int*)(ws + WS_WGCNT);
    if (F.tid < 8) { int tot = 0, pre = 0; for (int w = 0; w < F.G; ++w) { const int c = WGCNT[w * 8 + F.tid]; tot += c; if (w < F.bid) pre += c; } sm[16 + F.tid] = tot; sm[24 + F.tid] = pre; sm[8 + F.tid] = 0; }
    __syncthreads();
    if (F.tid == 0) { int ps = 0; GAS int* info = (GAS int*)(ws + WS_MOEINFO);
        for (int e = 0; e < 8; ++e) { sm[e] = ps + sm[24 + e]; if (F.bid == 0) info[e] = ps >> 8; ps += (sm[16 + e] + 255) & ~255; }
        if (F.bid == 0) { info[8] = ps >> 8; } }
    __syncthreads();
    if (F.bid == 0 && F.tid < 272) { GAS int* info = (GAS int*)(ws + WS_MOEINFO); int ps = 0, e = 0;
        for (int q = 0; q < 8; ++q) { ps += (sm[16 + q] + 255) >> 8; if (F.tid >= ps) e = q + 1; }
        info[16 + F.tid] = e < 8 ? e : 7; }
    __syncthreads();
    const GAS int* TOPE = (const GAS int*)(ws + WS_TOPE); const GAS float* TOPG = (const GAS float*)(ws + WS_TOPG);
    GAS int* TOKPOS = (GAS int*)(ws + WS_TOKPOS); GAS float* ROWG = (GAS float*)(ws + WS_ROWG);
    const GAS bf16* A = (const GAS bf16*)(ws + WS_A); GAS bf16* XG = (GAS bf16*)(ws + WS_XG);
    const int Rl = (l == DEPTH - 1) ? NLAT : R;
    const int RPW = (Rl + F.G - 1) / F.G, rbeg = F.bid * RPW, rend = min(Rl, rbeg + RPW);
    for (int row = rbeg + F.wave; row < rend; row += 8) {
        int p0 = 0, p1 = 0;
        if (F.lane == 0) { const int te = TOPE[row]; const int e0 = te & 255, e1 = te >> 8;
            p0 = sm[e0] + __hip_atomic_fetch_add(&sm[8 + e0], 1, __ATOMIC_RELAXED, __HIP_MEMORY_SCOPE_WORKGROUP); p1 = sm[e1] + __hip_atomic_fetch_add(&sm[8 + e1], 1, __ATOMIC_RELAXED, __HIP_MEMORY_SCOPE_WORKGROUP);
            TOKPOS[row * 2] = p0; TOKPOS[row * 2 + 1] = p1; ROWG[p0] = TOPG[row * 2]; ROWG[p1] = TOPG[row * 2 + 1]; }
        p0 = __builtin_amdgcn_readfirstlane(p0); p1 = __builtin_amdgcn_readfirstlane(p1);
        const v4u a0 = *(const GAS v4u*)(A + (size_t)row * D + 8 * F.lane), a1 = *(const GAS v4u*)(A + (size_t)row * D + 512 + 8 * F.lane);
        *(GAS v4u*)(XG + (size_t)p0 * D + 8 * F.lane) = a0; *(GAS v4u*)(XG + (size_t)p0 * D + 512 + 8 * F.lane) = a1;
        *(GAS v4u*)(XG + (size_t)p1 * D + 8 * F.lane) = a0; *(GAS v4u*)(XG + (size_t)p1 * D + 512 + 8 * F.lane) = a1;
    }
}
__device__ __forceinline__ void phase_moe_combine(Frame& F, int l) {
    frame_refresh(F); GAS unsigned char* const ws = wsp();
    const GAS float* MOD = (const GAS float*)(ws + WS_MOD);
    const GAS float* lg = inp(I_LNG) + (size_t)(l * 2 + 1) * D; const GAS float* lb = inp(I_LNB) + (size_t)(l * 2 + 1) * D;
    const bool last = (l == DEPTH - 1);
    const GAS int* TOKPOS = (const GAS int*)(ws + WS_TOKPOS); const GAS bf16* YB = (const GAS bf16*)(ws + WS_XG);
    const int gw = F.bid * 8 + F.wave, NGW = F.G * 8, lane = F.lane;
    const int nrows = last ? NLAT : R;
    GAS float* xl = outp(); GAS float* xc = (GAS float*)(ws + WS_XC); GAS bf16* Ab = (GAS bf16*)(ws + WS_A);
    f32x4 lgv[4], lbv[4], shv[4], scv[4], gtv[4]; int cslot = -1;
#pragma unroll
    for (int j = 0; j < 4; ++j) { lgv[j] = *(const GAS f32x4*)(lg + 4 * lane + 256 * j); lbv[j] = *(const GAS f32x4*)(lb + 4 * lane + 256 * j); }
    for (int row = gw; row < nrows; row += 2 * NGW) {
        const int rowb = row + NGW < nrows ? row + NGW : row;
        const int p0 = TOKPOS[row * 2], p1 = TOKPOS[row * 2 + 1], q0 = TOKPOS[rowb * 2], q1 = TOKPOS[rowb * 2 + 1];
        const GAS float* xs = xrow_src(xl, xc, row); const GAS float* xsb = xrow_src(xl, xc, rowb);
        const int sl = row_slot(row), slb = row_slot(rowb);
        if (sl != cslot) { const GAS float* mg = MOD + (size_t)(l * 5 + sl) * 6144 + 5120; const GAS float* mr = MOD + (size_t)((last ? l : l + 1) * 5 + sl) * 6144;
#pragma unroll
            for (int j = 0; j < 4; ++j) { gtv[j] = *(const GAS f32x4*)(mg + 4 * lane + 256 * j); shv[j] = *(const GAS f32x4*)(mr + 4 * lane + 256 * j); scv[j] = *(const GAS f32x4*)(mr + 1024 + 4 * lane + 256 * j); }
            cslot = sl; }
        const GAS float* gpb = MOD + (size_t)(l * 5 + slb) * 6144 + 5120;
        f32x4 v[4], w[4];
#pragma unroll
        for (int j = 0; j < 4; ++j) { const int c = 4 * lane + 256 * j;
            const v2u y0 = *(const GAS v2u*)(YB + (size_t)p0 * D + c), y1 = *(const GAS v2u*)(YB + (size_t)p1 * D + c), z0 = *(const GAS v2u*)(YB + (size_t)q0 * D + c), z1 = *(const GAS v2u*)(YB + (size_t)q1 * D + c);
            const f32x4 f = (f32x4){bflo(y0.x) + bflo(y1.x), bfhi(y0.x) + bfhi(y1.x), bflo(y0.y) + bflo(y1.y), bfhi(y0.y) + bfhi(y1.y)};
            const f32x4 h = (f32x4){bflo(z0.x) + bflo(z1.x), bfhi(z0.x) + bfhi(z1.x), bflo(z0.y) + bflo(z1.y), bfhi(z0.y) + bfhi(z1.y)};
            v[j] = *(const GAS f32x4*)(xs + c) * ALPHA + gtv[j] * f;
            const f32x4 gb_ = (slb == sl) ? gtv[j] : *(const GAS f32x4*)(gpb + c);
            w[j] = *(const GAS f32x4*)(xsb + c) * ALPHA + gb_ * h; }
        ln_row2h(v, w, lgv, lbv);
        GAS float* xd = xrow_dst(xl, xc, row); GAS float* xdb = xrow_dst(xl, xc, rowb);
#pragma unroll
        for (int j = 0; j < 4; ++j) { *(GAS f32x4*)(xd + 4 * lane + 256 * j) = v[j]; *(GAS f32x4*)(xdb + 4 * lane + 256 * j) = w[j]; }
        if (!last) { store_A_rowh(Ab, lane, row, v, shv, scv);
            if (slb == sl) store_A_rowh(Ab, lane, rowb, w, shv, scv); else store_A_row(Ab, lane, rowb, w, MOD + (size_t)((l + 1) * 5 + slb) * 6144, 0, 1024); }
    }
}

#ifndef PHMASK
#define PHMASK 0xFFFFFFFFu
#endif
#define PK(k) ((PHMASK >> (k)) & 1u)
constexpr int PPL = 12, NPHASE = 2 + DEPTH * PPL;
__global__ void __launch_bounds__(512, 2) fwd(Args args) {
    extern __shared__ __attribute__((aligned(16))) unsigned char lds_raw[];
    Frame F;
    F.lds = (LAS unsigned char*)lds_raw;
    F.tid = threadIdx.x; F.lane = F.tid & 63; F.wave = __builtin_amdgcn_readfirstlane(F.tid >> 6); F.G = gridDim.x; F.bid = blockIdx.x;
    volatile LAS unsigned* MISC = (volatile LAS unsigned*)(F.lds + LDSCTL_OFF);
    if (F.tid < 64) MISC[F.tid] = 0u;
    __syncthreads();
#if MK_ONE_LAUNCH
    XcdBarrier bar = xcd_barrier_post((GAS unsigned*)(args.ws + WS_CTL) + 4096, MISC + 8, F.wave);
#else
    const int lo = args.ph_lo, hi = args.ph_hi;
    XcdBarrier bar; bar.bar = (GAS unsigned*)(args.ws + WS_CTL) + 4096; bar.x = 0; bar.st = nullptr;
    if (hi - lo > 1) bar = xcd_barrier_post((GAS unsigned*)(args.ws + WS_CTL) + 4096, MISC + 8, F.wave);
#endif
#ifndef DUPMASK
#define DUPMASK 0u
#endif
#define NREP(kind) (((DUPMASK >> (kind)) & 1u) ? 2 : 1)
#define DUPBAR(kind, r) do { if (((DUPMASK >> (kind)) & 1u) && (r) == 0) xcd_barrier(bar, F.wave); } while (0)
#ifndef PROBE_A
#define PROBE_A -1
#endif
#ifndef PROBE_B
#define PROBE_B -1
#endif
#if PROBE_A >= 0
#define PSTAMP(kind) do { if (blockIdx.x == 0 && F.wave == 0) { const unsigned long long t_ = __builtin_amdgcn_s_memrealtime(); MISC[32 + (kind)] += (unsigned)(t_ - ((unsigned long long)MISC[30] | ((unsigned long long)MISC[31] << 32))); MISC[30] = (unsigned)t_; MISC[31] = (unsigned)(t_ >> 32); } } while (0)
#else
#define PSTAMP(kind) do { } while (0)
#endif
#if MK_ONE_LAUNCH
#define IN(k) true
#define PKIND_OF(k) (((k) < 2) ? (k) : (2 + ((k) - 2) % 12 + ((((((k) - 2) / 12) & 1) && ((k) - 2) % 12 >= 8) ? 12 : 0)))
#define SEAM(k) do { xcd_barrier(bar, F.wave); PSTAMP(PKIND_OF(k)); } while (0)
#else
#define IN(k) (lo <= (k) && (k) < hi)
#define SEAM(k) do { if (IN((k) + 1)) xcd_barrier(bar, F.wave); } while (0)
#endif
    LAS unsigned char* ring = F.lds;
    PSTAMP(31);

    if (IN(0)) { if (PK(0)) phase_prologue(F); SEAM(0); }
    if (IN(1)) { if (PK(1)) phase_a0(F); SEAM(1); }
    for (int l = 0; l < DEPTH; ++l) {
        const int pb = 2 + l * PPL;
        const bool moe = (l & 1) != 0;
        if (PK(3) && IN(pb + 0)) for (int r_ = 0; r_ < NREP(2); ++r_) {
            GAS unsigned char* const ws = wsp();
            pg8::Gemm g{(const GAS bf16*)(ws + WS_A), (const GAS bf16*)(ws + WS_WIN) + (size_t)l * DPW * D, D, D};
            pg8::StaticOrder S; S.init(R / 256, DPW / 256, D, F.G, F.bid);
            pg8::EpiBf16 E{(GAS bf16*)(ws + WS_P), DPP, DPROJ};
            pg8::gemm_phase<pg8::EpiBf16, pg8::StaticOrder, true, true>(ring, F.wave, g, S, E);
            DUPBAR(2, r_); if (r_ == NREP(2) - 1) SEAM(pb + 0);
        }
        if (IN(pb + 1)) for (int r_ = 0; r_ < NREP(3); ++r_) { if (PK(4)) { phase_gdn_prep(F, l); s5_relayout(F); s5_build(F, l); } DUPBAR(3, r_); if (r_ == NREP(3) - 1) SEAM(pb + 1); }
        if (IN(pb + 2)) for (int r_ = 0; r_ < NREP(4); ++r_) {
#ifndef M1SEL
#define M1SEL 7
#endif
#ifndef M1DUPSEL
#define M1DUPSEL 7
#endif
            if (PK(19) && r_ == 0) { GAS unsigned char* const ws = wsp();
                pg8::Gemm g{(const GAS bf16*)(ws + WS_S5A2), (const GAS bf16*)(ws + WS_S5EB), 256, 512};
                pg8::S5Order S; S.init(144, 1, 256, F.G, F.bid, 512);
                pg8::EpiS5HL E{(GAS bf16*)(ws + WS_S5HL)};
                pg8::gemm_phase<pg8::EpiS5HL, pg8::S5Order, true, true>(ring, F.wave, g, S, E); }
            if (PK(18)) phase_m1(F, l, r_ == 0 ? M1SEL : M1DUPSEL);
            DUPBAR(4, r_); if (r_ == NREP(4) - 1) SEAM(pb + 2);
        }
#ifndef DUPSCAN
#define DUPSCAN 0
#endif
        if (IN(pb + 3)) { if (PK(5)) phase_scans(F, l);
#if DUPSCAN
            xcd_barrier(bar, F.wave); phase_scans(F, l);
#endif
            SEAM(pb + 3); }
        if (IN(pb + 4)) for (int r_ = 0; r_ < NREP(6); ++r_) {
            if (PK(20)) { GAS unsigned char* const ws = wsp();
                pg8::Gemm g{(const GAS bf16*)(ws + WS_S5A2), (const GAS bf16*)(ws + WS_S5WY), 512, 512};
                pg8::S5Order S; S.init(144, 1, 512, F.G, F.bid, 512);
                pg8::EpiS5Y E{(GAS bf16*)(ws + WS_GQ), (GAS float*)(ws + WS_O5), (const GAS bf16*)(ws + WS_P), inp(I_S5D) + l * 256};
                pg8::gemm_phase<pg8::EpiS5Y, pg8::S5Order, true, true>(ring, F.wave, g, S, E); }
#ifdef CHAINCMP
            if (l == 0) { GAS unsigned char* const ws = wsp(); const GAS unsigned short* a = (const GAS unsigned short*)(ws + WS_OB); const GAS unsigned short* c = (const GAS unsigned short*)outp();
                const int ln_ = lane_id_opaque();
                for (int mm = 0; mm < 3; ++mm) { unsigned bad = 0, big = 0;
                    for (size_t i = (size_t)F.bid * 512 + F.wave * 64 + ln_; i < (size_t)2 * R * 256; i += (size_t)F.G * 512) { const size_t j = (size_t)mm * 2 * R * 256 + i; const float x = bf2f(a[j]), y = bf2f(c[j]); if (a[j] != c[j]) { ++bad; if (fabsf(x - y) > 0.02f * (fabsf(x) + 1e-3f)) ++big; } }
                    if (bad) __hip_atomic_fetch_add((GAS unsigned*)(ws + WS_CTL) + 70010 + mm, bad, __ATOMIC_RELAXED, __HIP_MEMORY_SCOPE_AGENT);
                    if (big) __hip_atomic_fetch_add((GAS unsigned*)(ws + WS_CTL) + 70020 + mm, big, __ATOMIC_RELAXED, __HIP_MEMORY_SCOPE_AGENT); } }
#endif
            if (PK(6)) phase_readout(F, l); if (PK(2) && moe) phase_moe_convert(F, l >> 1); DUPBAR(6, r_); if (r_ == NREP(6) - 1) SEAM(pb + 4);
        }
        if (PK(7) && IN(pb + 5)) for (int r_ = 0; r_ < NREP(7); ++r_) {
            GAS unsigned char* const ws = wsp();
            pg8::Gemm g{(const GAS bf16*)(ws + WS_GQ), (const GAS bf16*)(ws + WS_WGLU) + (size_t)l * 65536, 256, 256};
            pg8::StaticOrder S; S.init(R / 256, 1, 256, F.G, F.bid);
            pg8::EpiGlu E{(GAS bf16*)(ws + WS_MIX), (const GAS float*)(ws + WS_O5), inp(I_S5GLUB) + l * 256};
            pg8::gemm_phase<pg8::EpiGlu, pg8::StaticOrder, true, true>(ring, F.wave, g, S, E);
            DUPBAR(7, r_); if (r_ == NREP(7) - 1) SEAM(pb + 5);
        }
        if (PK(8) && IN(pb + 6)) for (int r_ = 0; r_ < NREP(8); ++r_) {
            GAS unsigned char* const ws = wsp(); const GAS float* modl = (const GAS float*)(ws + WS_MOD) + (size_t)l * 5 * 6144;
            pg8::Gemm g{(const GAS bf16*)(ws + WS_MIX), (const GAS bf16*)(ws + WS_WOUT) + (size_t)l * D * D, D, D};
            pg8::StaticOrder S; S.init((l == DEPTH - 1 ? NLAT : R) / 256, D / 256, D, F.G, F.bid);
            pg8::EpiRes E{(GAS bf16*)(ws + WS_Y), modl, 2048};
            pg8::gemm_phase<pg8::EpiRes, pg8::StaticOrder, true, true>(ring, F.wave, g, S, E);
            DUPBAR(8, r_); if (r_ == NREP(8) - 1) SEAM(pb + 6);
        }
        if (IN(pb + 7)) for (int r_ = 0; r_ < NREP(9); ++r_) { if (moe) { if (PK(9)) phase_ln<true>(F, l, 0); } else { if (PK(10)) phase_ln<false>(F, l, 0); } DUPBAR(9, r_); if (r_ == NREP(9) - 1) SEAM(pb + 7); }
        if (!moe) {
            if (PK(11) && IN(pb + 8)) for (int r_ = 0; r_ < NREP(10); ++r_) {
                GAS unsigned char* const ws = wsp();
                pg8::Gemm g{(const GAS bf16*)(ws + WS_A), (const GAS bf16*)(ws + WS_WF13) + (size_t)(l >> 1) * 2 * FFD * D, D, D};
                pg8::StaticOrder S; S.init(R / 256, 2 * FFD / 256, D, F.G, F.bid);
                pg8::EpiSwiGlu E{(GAS bf16*)(ws + WS_HID), FFD};
                pg8::gemm_phase<pg8::EpiSwiGlu, pg8::StaticOrder, true, true>(ring, F.wave, g, S, E);
                DUPBAR(10, r_); if (r_ == NREP(10) - 1) SEAM(pb + 8);
            }
            if (PK(12) && IN(pb + 9)) for (int r_ = 0; r_ < NREP(11); ++r_) {
                GAS unsigned char* const ws = wsp(); const GAS float* modl = (const GAS float*)(ws + WS_MOD) + (size_t)l * 5 * 6144;
                pg8::Gemm g{(const GAS bf16*)(ws + WS_HID), (const GAS bf16*)(ws + WS_WF2) + (size_t)(l >> 1) * D * FFD, FFD, FFD};
                pg8::StaticOrder S; S.init(R / 256, D / 256, FFD, F.G, F.bid);
                pg8::EpiRes E{(GAS bf16*)(ws + WS_Y), modl, 5120};
                pg8::gemm_phase<pg8::EpiRes, pg8::StaticOrder, true, true>(ring, F.wave, g, S, E);
                DUPBAR(11, r_); if (r_ == NREP(11) - 1) SEAM(pb + 9);
            }
            if (IN(pb + 10)) for (int r_ = 0; r_ < NREP(13); ++r_) { if (PK(13)) phase_ln<false>(F, l, 1); DUPBAR(13, r_); if (r_ == NREP(13) - 1) SEAM(pb + 11); }
        } else {
            if (IN(pb + 8)) for (int r_ = 0; r_ < NREP(22); ++r_) { if (PK(14)) phase_moe_assign(F, l); DUPBAR(22, r_); if (r_ == NREP(22) - 1) SEAM(pb + 8); }
            if (PK(15) && IN(pb + 9)) for (int r_ = 0; r_ < NREP(23); ++r_) {
                GAS unsigned char* const ws = wsp();
                const GAS int* info = (const GAS int*)(ws + WS_MOEINFO);
                pg8::Gemm g{(const GAS bf16*)(ws + WS_XG), (const GAS bf16*)(ws + WS_WM13), D, D};
                pg8::MoeOrder S; S.init(info[8], 2 * FFE / 256, D, F.G, F.bid);
                S.texp = info + 16; S.estride = (size_t)2 * FFE * D * 2;
                pg8::EpiSwiGlu E{(GAS bf16*)(ws + WS_MHID), FFE};
                pg8::gemm_phase<pg8::EpiSwiGlu, pg8::MoeOrder, true, true>(ring, F.wave, g, S, E);
                DUPBAR(23, r_); if (r_ == NREP(23) - 1) SEAM(pb + 9);
            }
            if (PK(16) && IN(pb + 10)) for (int r_ = 0; r_ < NREP(24); ++r_) {
                GAS unsigned char* const ws = wsp();
                const GAS int* info = (const GAS int*)(ws + WS_MOEINFO);
                pg8::Gemm g{(const GAS bf16*)(ws + WS_MHID), (const GAS bf16*)(ws + WS_WM2), FFE, FFE};
                pg8::MoeOrder S; S.init(info[8], D / 256, FFE, F.G, F.bid);
                S.texp = info + 16; S.estride = (size_t)D * FFE * 2;
                pg8::EpiMoeDown E{(GAS bf16*)(ws + WS_XG), (const GAS float*)(ws + WS_ROWG)};
                pg8::gemm_phase<pg8::EpiMoeDown, pg8::MoeOrder, true, true>(ring, F.wave, g, S, E);
                DUPBAR(24, r_); if (r_ == NREP(24) - 1) SEAM(pb + 10);
            }
            if (IN(pb + 11)) for (int r_ = 0; r_ < NREP(25); ++r_) { if (PK(17)) phase_moe_combine(F, l); DUPBAR(25, r_); if (r_ == NREP(25) - 1 && l < DEPTH - 1) SEAM(pb + 11); }
        }
    }
#ifdef CHAINCMP
    {   xcd_barrier(bar, F.wave);
        const GAS unsigned* cw = (const GAS unsigned*)(args.ws + WS_CTL) + 70010;
        const unsigned b0 = cw[0] + cw[1] + cw[2], g0 = cw[10] + cw[11] + cw[12];
        const float va = b0 == 0 ? 0.f : (b0 < 100 ? 10.f : (b0 < 10000 ? 100.f : (b0 < 1000000 ? 1000.f : 10000.f)));
        const float vb = g0 == 0 ? 0.f : (g0 < 100 ? 1.f : (g0 < 10000 ? 2.f : (g0 < 1000000 ? 3.f : 4.f)));
        GAS float* o = outp();
        for (size_t i = (size_t)blockIdx.x * 512 + F.wave * 64 + lane_id_opaque(); i < (size_t)NLAT * D; i += (size_t)gridDim.x * 512) o[i] = (i == 0) ? vb * 1.0e6f + 5.0e5f : va + 3.f;
    }
#endif
#ifdef CHAINCHECK
    {   xcd_barrier(bar, F.wave);
        const GAS unsigned* cw = (const GAS unsigned*)(args.ws + WS_CTL) + 70000;
        const unsigned c0 = cw[0], c1 = cw[1], c2 = cw[2];
        const float va = (c0 ? 100.f : 0.f) + (c1 ? 10.f : 0.f) + (c2 ? 1.f : 0.f);
        const float vb = (float)(c0 + c1 + c2);
        GAS float* o = outp();
        for (size_t i = (size_t)blockIdx.x * 512 + F.wave * 64 + lane_id_opaque(); i < (size_t)NLAT * D; i += (size_t)gridDim.x * 512) o[i] = (i == 0) ? vb * 1000.f + 7777.f : va + 3.f;
    }
#endif
#if PROBE_A >= 0
    {
        PSTAMP(25);
        GAS float* tw = (GAS float*)(args.ws + WS_CTL) + 65536;
        { const int ln_ = lane_id_opaque(); if (blockIdx.x == 0 && F.wave == 0 && ln_ < 32) tw[ln_] = (float)MISC[32 + ln_] * 0.01f; }
        xcd_barrier(bar, F.wave);
        const float va = tw[PROBE_A], vb = tw[PROBE_B] * 1000.f;
        GAS float* o = outp();
        for (size_t i = (size_t)blockIdx.x * 512 + F.wave * 64 + lane_id_opaque(); i < (size_t)NLAT * D; i += (size_t)gridDim.x * 512) o[i] = (i == 0) ? vb : va;
    }
#endif
#undef IN
#undef SEAM
}

extern "C" void kernel_launch(void* const* d_in, const int* in_sizes, int n_in, void* d_out, int out_size, void* d_ws, size_t ws_size, hipStream_t stream) {
    static int grid = 0;
    if (grid == 0) {
        if (n_in != 34 || out_size != NLAT * D || ws_size < WS_END) { fprintf(stderr, "kernel_launch: unexpected shapes (n_in %d out %d ws %zu need %zu)\n", n_in, out_size, ws_size, (size_t)WS_END); grid = -1; return; }
        int dev = 0, cus = 0, per_cu = 0;
        if (hipGetDevice(&dev) != hipSuccess || hipDeviceGetAttribute(&cus, hipDeviceAttributeMultiprocessorCount, dev) != hipSuccess) { grid = -1; return; }
        if (hipFuncSetAttribute((const void*)fwd, hipFuncAttributeMaxDynamicSharedMemorySize, LDS_BYTES) != hipSuccess) { fprintf(stderr, "kernel_launch: hipFuncSetAttribute failed\n"); grid = -1; return; }
        if (hipOccupancyMaxActiveBlocksPerMultiprocessor(&per_cu, (const void*)fwd, 512, LDS_BYTES) != hipSuccess || per_cu < 1) fprintf(stderr, "kernel_launch: occupancy query reports %d\n", per_cu);
        (void)hipGetLastError();
        grid = cus;
    }
    if (grid < 0) return;
    (void)hipMemsetAsync((char*)d_ws + WS_CTL, 0, CTL_ZERO_BYTES, stream);
    Args a{};
    for (int i = 0; i < 34; ++i) a.in[i] = (const float*)d_in[i];
    a.out = (float*)d_out; a.ws = (unsigned char*)d_ws;
#if MK_ONE_LAUNCH
    a.ph_lo = 0; a.ph_hi = NPHASE;
    hipLaunchKernelGGL(fwd, dim3(grid), dim3(512), LDS_BYTES, stream, a);
#else
    for (int p = 0; p < NPHASE; ++p) {
        if (p >= 2) { const int l = (p - 2) / PPL, k = (p - 2) % PPL; const bool moe = (l & 1) != 0; if (k == 11 && !moe) continue; }
        a.ph_lo = p; a.ph_hi = p + 1;
        hipLaunchKernelGGL(fwd, dim3(grid), dim3(512), LDS_BYTES, stream, a);
    }
#endif
}
```

```cpp
#include <hip/hip_runtime.h>
#include <cstdio>
#include <cstdint>

#ifndef MK_ONE_LAUNCH
#define MK_ONE_LAUNCH 1
#endif

#define GAS __attribute__((address_space(1)))
#define LAS __attribute__((address_space(3)))
typedef unsigned short bf16;
typedef unsigned v4u __attribute__((ext_vector_type(4)));
typedef unsigned v2u __attribute__((ext_vector_type(2)));
typedef float f32x4 __attribute__((ext_vector_type(4)));
typedef float f32x2 __attribute__((ext_vector_type(2)));
typedef short bf16x8 __attribute__((ext_vector_type(8)));

constexpr int D = 1024, BATCH = 4, SEQ = 8192, CTXL = 256, DEPTH = 4;
constexpr int NLAT = BATCH * SEQ, NCTX = BATCH * CTXL, R = NLAT + NCTX;
constexpr int DPROJ = 3600, DPP = 3600, DPW = 3840;
constexpr int FFD = 2816, FFE = 3584, NEXP = 8;
constexpr int MOE_ROWS = 2 * R + NEXP * 256;
constexpr float ALPHA = 1.681792830507429f;
constexpr float LN_EPS = 1e-5f, RMS_EPS = 1e-6f;
constexpr int PC_GQKV = 0, PC_GZ = 768, PC_GA = 1024, PC_GB = 1032, PC_S5U = 1040, PC_HQ = 1296, PC_HF = 1552, PC_HI = 2064, PC_HG = 2320, PC_RQKV = 2576, PC_RG = 3344;
constexpr int NSEQ = CTXL + SEQ;
constexpr int TCH = 32, NCHUNK = NSEQ / TCH;

constexpr size_t MiB = 1u << 20;
constexpr size_t WS_CTL = 0, CTL_ZERO_BYTES = 1 * MiB;
constexpr size_t WS_MOD = 1 * MiB;
constexpr size_t WS_LB = WS_MOD + 512 * 1024;
constexpr size_t WS_ROT = WS_LB + 4096;
constexpr size_t WS_S5LAM = WS_ROT + 32768;
constexpr size_t WS_S5B = 2 * MiB;
constexpr size_t WS_TOPE = 3 * MiB;
constexpr size_t WS_TOPG = WS_TOPE + 256 * 1024;
constexpr size_t WS_TOKPOS = WS_TOPG + 512 * 1024;
constexpr size_t WS_ROWG = 4 * MiB + 256 * 1024;
constexpr size_t WS_WGCNT = 4 * MiB + 768 * 1024;
constexpr size_t WS_MOEINFO = WS_WGCNT + 16384;
constexpr size_t WS_GSC = 5 * MiB;
constexpr size_t WS_WIN = 8 * MiB;
constexpr size_t WS_WOUT = 38 * MiB;
constexpr size_t WS_WF13 = 46 * MiB;
constexpr size_t WS_WF2 = 68 * MiB;
constexpr size_t WS_WGLU = 79 * MiB;
constexpr size_t WS_WM13 = 80 * MiB;
constexpr size_t WS_WM2 = 192 * MiB;
constexpr size_t WS_XC = 248 * MiB;
constexpr size_t WS_A = 252 * MiB;
constexpr size_t WS_MIX = WS_A;
constexpr size_t WS_TG = 80 * MiB;
constexpr size_t WS_U = 318 * MiB;
constexpr size_t WS_P = WS_U;
constexpr size_t WS_Y = WS_U;
constexpr size_t WS_OB = 551 * MiB;
constexpr size_t WS_O5 = 650 * MiB;
constexpr size_t WS_S5A2 = WS_O5 + 33 * MiB;
constexpr size_t WS_S5HL = 252 * MiB;
constexpr size_t WS_S5EB = 270 * MiB;
constexpr size_t WS_S5WY = 1035 * MiB;
constexpr size_t WS_GQ = 716 * MiB, WS_GK = WS_GQ + 17 * MiB, WS_GV = WS_GK + 17 * MiB;
constexpr size_t WS_TH = 767 * MiB;
constexpr size_t WS_TR = 899 * MiB;
constexpr size_t WS_DEC = 1031 * MiB;
constexpr size_t WS_HID = 566 * MiB;
constexpr size_t WS_XG = WS_U;
constexpr size_t WS_MHID = 454 * MiB;
constexpr size_t WS_END = 1040 * MiB;
static_assert(WS_MHID + (size_t)MOE_ROWS * FFE * 2 <= WS_END && WS_XG + (size_t)MOE_ROWS * D * 2 <= WS_MHID, "ws map");
static_assert(WS_P + (size_t)R * 3600 * 2 <= WS_OB && WS_OB + (size_t)6 * R * 256 * 2 <= WS_O5 && WS_O5 + (size_t)2 * R * 256 * 4 <= WS_GQ && WS_GV + (size_t)R * 256 * 2 <= WS_TH, "ws map 2");
static_assert(WS_TH + (size_t)4224 * 4 * 8192 <= WS_TR && WS_TR + (size_t)4224 * 4 * 8192 <= WS_DEC && WS_DEC + (size_t)3 * 4224 * 256 <= WS_END && WS_TG + (size_t)4224 * 5 * 8192 <= 248 * MiB, "ws map 3");
static_assert(WS_HID + (size_t)R * FFD * 2 <= WS_END && WS_Y + (size_t)R * D * 4 <= WS_OB, "ws map 4");

constexpr int RING_BYTES = 131072, LDSCTL_OFF = RING_BYTES, LDS_BYTES = 147456;

typedef __bf16 hwbf16x2 __attribute__((ext_vector_type(2)));
__device__ __forceinline__ unsigned pk2(float lo, float hi) { f32x2 v = {lo, hi}; const hwbf16x2 r = __builtin_convertvector(v, hwbf16x2); return __builtin_bit_cast(unsigned, r); }
__device__ __forceinline__ unsigned f2bf(float f) { return pk2(f, 0.f) & 0xffffu; }
__device__ __forceinline__ float bflo(unsigned w) { return __builtin_bit_cast(float, w << 16); }
__device__ __forceinline__ float bfhi(unsigned w) { return __builtin_bit_cast(float, w & 0xffff0000u); }
__device__ __forceinline__ float bf2f(bf16 h) { return __builtin_bit_cast(float, (unsigned)h << 16); }
__device__ __forceinline__ int lane_id_opaque_fwd() { unsigned z; asm volatile("v_mov_b32 %0, 0" : "=v"(z)); return (int)__builtin_amdgcn_mbcnt_hi(~0u, __builtin_amdgcn_mbcnt_lo(~0u, z)); }
__device__ __forceinline__ float shfl_idx(float x, int src) { return __builtin_bit_cast(float, __builtin_amdgcn_ds_bpermute(src << 2, __builtin_bit_cast(int, x))); }
template <int CTRL>
__device__ __forceinline__ float dpp0(float x) { return __builtin_bit_cast(float, __builtin_amdgcn_update_dpp(0, __builtin_bit_cast(int, x), CTRL, 0xf, 0xf, true)); }
__device__ __forceinline__ float sum16(float v) {
    v += dpp0<0xB1>(v); v += dpp0<0x4E>(v); v += dpp0<0x141>(v); v += dpp0<0x140>(v); return v; }
__device__ __forceinline__ float wave_sum(float v) {
    v = sum16(v);
    const float a = __builtin_bit_cast(float, __builtin_amdgcn_readlane(__builtin_bit_cast(int, v), 0)), b = __builtin_bit_cast(float, __builtin_amdgcn_readlane(__builtin_bit_cast(int, v), 16));
    const float c = __builtin_bit_cast(float, __builtin_amdgcn_readlane(__builtin_bit_cast(int, v), 32)), d = __builtin_bit_cast(float, __builtin_amdgcn_readlane(__builtin_bit_cast(int, v), 48));
    return (a + b) + (c + d); }
__device__ __forceinline__ float sigmoidf_(float x) { return __builtin_amdgcn_rcpf(1.f + __expf(-x)); }
__device__ __forceinline__ float siluf_(float x) { return x * __builtin_amdgcn_rcpf(1.f + __expf(-x)); }
__device__ __forceinline__ float gelu_tanh(float x) { const float u = 0.7978845608028654f * (x + 0.044715f * x * x * x); const float t = 1.f - 2.f * __builtin_amdgcn_rcpf(__expf(2.f * u) + 1.f); return 0.5f * x * (1.f + t); }
#define LDS_WAIT() asm volatile("s_waitcnt lgkmcnt(0)" ::: "memory")

__device__ __forceinline__ int lane_id_opaque() { unsigned z; asm volatile("v_mov_b32 %0, 0" : "=v"(z)); return (int)__builtin_amdgcn_mbcnt_hi(~0u, __builtin_amdgcn_mbcnt_lo(~0u, z)); }
#define XB_TMO      128
#define XB_XCNT(j)  (256  + 64 * (j))
#define XB_XSUB(j)  (1280 + 64 * (j))
#define XB_XGEN(j)  (2304 + 64 * (j))
#define XB_TOP      3328
#define XB_TOPGEN   3392
#define XCD_BAR_WORDS 3456
#define XB_SPIN_CAP (1u << 18)
__device__ __forceinline__ unsigned xb_ld(GAS unsigned* p)              { return __hip_atomic_load(p, __ATOMIC_RELAXED, __HIP_MEMORY_SCOPE_AGENT); }
__device__ __forceinline__ unsigned xb_add(GAS unsigned* p, unsigned v) { return __hip_atomic_fetch_add(p, v, __ATOMIC_RELAXED, __HIP_MEMORY_SCOPE_AGENT); }
__device__ __forceinline__ unsigned xb_xcc_id() { return (unsigned)__builtin_amdgcn_s_getreg((3 << 11) | 20) & 0xFu; }
#define XB_SPIN(cond, bar) do { unsigned _sp = 0; while (cond) { __builtin_amdgcn_s_sleep(1); \
    if ((++_sp & 255u) == 0u) { if (xb_ld(&(bar)[XB_TMO])) break; if (_sp > XB_SPIN_CAP) { (void)xb_add(&(bar)[XB_TMO], 1u); break; } } } } while (0)
struct XcdBarrier { GAS unsigned* bar; unsigned x; volatile LAS unsigned* st; };
__device__ __forceinline__ bool xb_thread0(int wave_id) { return wave_id == 0 && lane_id_opaque() == 0; }
__device__ __forceinline__ XcdBarrier xcd_barrier_post(GAS unsigned* bar, volatile LAS unsigned* st, int wave_id) {
    XcdBarrier b; b.bar = bar; b.x = xb_xcc_id(); b.st = st;
    if (xb_thread0(wave_id)) (void)xb_add(&bar[XB_XCNT(b.x)], 1u);
    return b;
}
__device__ __forceinline__ void xcd_barrier_complete(GAS unsigned* bar, unsigned x, unsigned& nloc, unsigned& nx) {
    const unsigned G = gridDim.x * gridDim.y * gridDim.z;
    unsigned sum, cnt, mine, sp = 0u;
    for (;;) {
        sum = 0u; cnt = 0u; mine = 0u;
#pragma unroll
        for (unsigned j = 0; j < 16; ++j) { const unsigned c = xb_ld(&bar[XB_XCNT(j)]); sum += c; cnt += (c > 0u) ? 1u : 0u; mine = (j == x) ? c : mine; }
        if (sum == G) break;
        __builtin_amdgcn_s_sleep(1);
        if ((++sp & 255u) == 0u) { if (xb_ld(&bar[XB_TMO])) break; if (sp > XB_SPIN_CAP) { (void)xb_add(&bar[XB_TMO], 1u); break; } }
    }
    nloc = mine > 0u ? mine : 1u; nx = cnt > 0u ? cnt : 1u;
}
__device__ __forceinline__ void xcd_barrier(const XcdBarrier& b, int wave_id) {
    asm volatile("s_waitcnt vmcnt(0)" ::: "memory");
    __syncthreads();
    if (xb_thread0(wave_id)) {
        GAS unsigned* bar = b.bar; asm volatile("" : "+s"(bar));
        __builtin_amdgcn_s_waitcnt(0);
        unsigned nloc = b.st[0], nx = b.st[1];
        if (nloc == 0u) { xcd_barrier_complete(bar, b.x, nloc, nx); b.st[0] = nloc; b.st[1] = nx; }
        const unsigned old = xb_add(&bar[XB_XSUB(b.x)], 1u);
        const unsigned gen = old / nloc;
        if (old + 1u == (gen + 1u) * nloc) {
            __builtin_amdgcn_fence(__ATOMIC_RELEASE, "agent");
            asm volatile("s_waitcnt vmcnt(0)" ::: "memory");
            const unsigned og = xb_add(&bar[XB_TOP], 1u);
            const unsigned tg = og / nx;
            if (og + 1u == (tg + 1u) * nx) xb_add(&bar[XB_TOPGEN], 1u);
            else XB_SPIN(xb_ld(&bar[XB_TOPGEN]) == tg, bar);
            __builtin_amdgcn_fence(__ATOMIC_ACQUIRE, "agent");
            xb_add(&bar[XB_XGEN(b.x)], 1u);
            asm volatile("s_waitcnt vmcnt(0)" ::: "memory");
        } else {
            XB_SPIN(xb_ld(&bar[XB_XGEN(b.x)]) == gen, bar);
            __builtin_amdgcn_fence(__ATOMIC_ACQUIRE, "agent");
            asm volatile("s_waitcnt vmcnt(0)" ::: "memory");
        }
    }
    __syncthreads();
}

namespace pg8 {
constexpr int BM = 256, BK = 64, HALF = 128, HTB = HALF * BK * 2, STAGE_BYTES = 8 * HTB, NXCD = 8, WGM = 4;
__host__ __device__ __forceinline__ int lds_byte(int r, int c) { const int st = (r >> 4) * 2 + (c >> 5), rr = r & 15, cc = c & 31, ob = rr * 64 + cc * 2; return st * 1024 + (ob ^ (((ob >> 9) & 1) << 5)); }
__host__ __device__ __forceinline__ void stage_rc(int b, int& Rr, int& C) { const int st = b / 1024, sb = b % 1024, swz = sb ^ (((sb >> 9) & 1) << 5); Rr = (st >> 1) * 16 + swz / 64; C = (st & 1) * 32 + (swz % 64) / 2; }
__host__ __device__ __forceinline__ int perm32(int rho) { const int n = rho >> 4, i = rho & 15; return 8 * (i >> 2) + 4 * n + (i & 3); }
struct Unit { int pm, pn; size_t aoff, boff; };
struct Gemm { const GAS bf16* A; const GAS bf16* Bt; int K, lda; };

struct StaticOrder {
    int nM, nN, nwg, G, c, K, lda;
    __device__ void init(int nM_, int nN_, int K_, int G_, int c_, int lda_ = 0) { nM = nM_; nN = nN_; nwg = nM * nN; G = G_; K = K_; lda = lda_ ? lda_ : K_; int cc = c_; asm volatile("" : "+s"(cc)); c = cc; }
    __device__ bool map(int i, int& pm, int& pn) const {
        const long L = (long)i * G + c; if (L >= nwg) return false;
        int wgid = (int)L; { const int q = nwg / NXCD, r = nwg % NXCD, xcd = wgid % NXCD, off = wgid / NXCD; wgid = (xcd < r ? xcd * (q + 1) : r * (q + 1) + (xcd - r) * q) + off; }
        const int nig = WGM * nN, gid = wgid / nig, fm = gid * WGM, gsz = (nM - fm) < WGM ? (nM - fm) : WGM;
        pm = fm + ((wgid % nig) % gsz); pn = (wgid % nig) / gsz; return true;
    }
    __device__ bool next(int i, Unit& u) const { if (!map(i, u.pm, u.pn)) return false; u.aoff = (size_t)u.pm * 256 * lda * 2; u.boff = (size_t)u.pn * 256 * K * 2; return true; }
};
struct MoeOrder : StaticOrder {
    const GAS int* texp; size_t estride;
    __device__ bool next(int i, Unit& u) const {
        if (!map(i, u.pm, u.pn)) return false;
        const int e = __builtin_amdgcn_readfirstlane(texp[u.pm]);
        u.aoff = (size_t)u.pm * 256 * lda * 2; u.boff = (size_t)e * estride + (size_t)u.pn * 256 * K * 2; return true;
    }
};
struct S5Order : StaticOrder {
    __device__ bool next(int i, Unit& u) const {
        if (!map(i, u.pm, u.pn)) return false;
        const int g = u.pm / 9, ti = u.pm - g * 9;
        u.aoff = (size_t)(g * 2112 + ti * 256) * lda * 2; u.boff = (size_t)g * 256 * K * 2; return true;
    }
};
typedef __bf16 bf16v2_t __attribute__((ext_vector_type(2)));
__device__ __forceinline__ unsigned cvt_pk_bf16(float lo, float hi) { f32x2 v = {lo, hi}; const bf16v2_t r = __builtin_convertvector(v, bf16v2_t); return __builtin_bit_cast(unsigned, r); }

template <class Epi, class Sched, bool ALIGN_EPI, bool SP2>
__device__ __forceinline__ void gemm_phase(LAS unsigned char* lds, const int wave_id, const Gemm g, const Sched& S, const Epi& E) {
    const int lane = lane_id_opaque();
    const int wid = wave_id, tid = wid * 64 + lane, wr = wid >> 2, wc = wid & 3, fr = lane & 15, fq = lane >> 4;
    int K_ = g.K; asm volatile("" : "+s"(K_));
    const int K = K_, nt = K / BK;
    unsigned voffA, voffB;
    int lda_ = g.lda; asm volatile("" : "+s"(lda_)); const int lda = lda_;
    { int Rr, C; stage_rc(tid * 16, Rr, C); const int Rb = Epi::PERM ? ((Rr & ~31) + perm32(Rr & 31)) : Rr;
        voffA = (unsigned)(Rr * lda + C) * 2u; voffB = (unsigned)(Rb * K + C) * 2u; }
    const size_t qstepB = (size_t)64 * K * 2, qstepA = (size_t)64 * lda * 2;
    const size_t kstep = (size_t)(BK * 2);
    const size_t hstep = (size_t)HALF * K * 2, hstepA = (size_t)HALF * lda * 2;
    const unsigned ldsw = (unsigned)wid * 1024u;
    const int aoff = lds_byte(wr * 64 + fr, fq * 8), boff = lds_byte(wc * 32 + fr, fq * 8);
#define PG8_SA(b, h) (((b) * 2 + (h)) * HTB)
#define PG8_SB(b, h) ((4 + (b) * 2 + (h)) * HTB)
#define PG8_STAGE_(bufoff, gbase, voff, qs) do { _Pragma("unroll") for (int _i = 0; _i < 2; ++_i) \
        __builtin_amdgcn_global_load_lds((const GAS unsigned*)((const char*)(gbase) + _i * (qs) + (voff)), (LAS unsigned*)(lds + (bufoff) + ldsw + _i * 8192), 16, 0, 0); } while (0)
#define PG8_STAGEA(bufoff, gbase) PG8_STAGE_(bufoff, gbase, voffA, qstepA)
#define PG8_STAGEB(bufoff, gbase) PG8_STAGE_(bufoff, gbase, voffB, qstepB)
#define PG8_LDA(dst, b, h) do { _Pragma("unroll") for (int m = 0; m < 4; ++m) _Pragma("unroll") for (int k = 0; k < 2; ++k) dst[m][k] = *(const LAS bf16x8*)(lds + PG8_SA(b, h) + aoff + m * 2048 + k * 1024); } while (0)
#define PG8_LDB(dst, b, h) do { _Pragma("unroll") for (int n = 0; n < 2; ++n) _Pragma("unroll") for (int k = 0; k < 2; ++k) dst[n][k] = *(const LAS bf16x8*)(lds + PG8_SB(b, h) + boff + n * 2048 + k * 1024); } while (0)
#define PG8_MMA(ai, bj, At, Bt) do { __builtin_amdgcn_s_setprio(1); _Pragma("unroll") for (int m = 0; m < 4; ++m) _Pragma("unroll") for (int n = 0; n < 2; ++n) _Pragma("unroll") for (int k = 0; k < 2; ++k) \
        acc[ai][bj][m][n] = __builtin_amdgcn_mfma_f32_16x16x32_bf16(Bt[n][k], At[m][k], acc[ai][bj][m][n], 0, 0, 0); __builtin_amdgcn_s_setprio(0); } while (0)
#define PG8_WAIT_V(n) asm volatile("s_waitcnt vmcnt(" #n ")" ::: "memory")
#define PG8_WAIT_L(n) asm volatile("s_waitcnt lgkmcnt(" #n ")" ::: "memory")
#define PG8_BAR __builtin_amdgcn_s_barrier()
#define PG8_SCHED __builtin_amdgcn_sched_barrier(0)
    Unit cur, nxt; int ui = 0;
    if (!S.next(0, cur)) return;
    f32x4 acc[2][2][4][2];
#pragma unroll
    for (int a = 0; a < 2; ++a)
#pragma unroll
        for (int b = 0; b < 2; ++b)
#pragma unroll
            for (int m = 0; m < 4; ++m)
#pragma unroll
                for (int n = 0; n < 2; ++n) acc[a][b][m][n] = (f32x4){0.f, 0.f, 0.f, 0.f};
    bf16x8 At[4][2], B0[2][2], B1[2][2];
    const char* cA = (const char*)g.A + cur.aoff; const char* cB = (const char*)g.Bt + cur.boff;
    if constexpr (SP2) {
        PG8_STAGEB(PG8_SB(0, 0), cB); PG8_STAGEB(PG8_SB(0, 1), cB + hstep); PG8_STAGEA(PG8_SA(0, 0), cA); PG8_STAGEA(PG8_SA(0, 1), cA + hstepA);
        if (wr == 1) PG8_BAR;
        PG8_WAIT_V(2); PG8_BAR;
        PG8_STAGEB(PG8_SB(1, 0), cB + kstep); PG8_STAGEA(PG8_SA(1, 0), cA + kstep); PG8_STAGEB(PG8_SB(1, 1), cB + hstep + kstep);
        PG8_WAIT_V(6); PG8_BAR;
    } else {
        PG8_STAGEB(PG8_SB(0, 0), cB); PG8_STAGEA(PG8_SA(0, 0), cA); PG8_STAGEB(PG8_SB(0, 1), cB + hstep); PG8_STAGEA(PG8_SA(0, 1), cA + hstepA);
        if (wr == 1) PG8_BAR;
        PG8_WAIT_V(4); PG8_BAR;
        PG8_STAGEB(PG8_SB(1, 0), cB + kstep); PG8_STAGEA(PG8_SA(1, 0), cA + kstep); PG8_STAGEB(PG8_SB(1, 1), cB + hstep + kstep);
        PG8_WAIT_V(6); PG8_BAR;
    }
    for (;;) {
        const bool has_next = S.next(ui + 1, nxt);
        const char* nA = has_next ? (const char*)g.A + nxt.aoff : cA; const char* nB = has_next ? (const char*)g.Bt + nxt.boff : cB;
        for (int t = 0; t < nt; t += 2) {
            const bool last = (t == nt - 2);
            const char* a1 = cA + (size_t)(t + 1) * kstep;
            const char* a2 = last ? nA : cA + (size_t)(t + 2) * kstep; const char* b2 = last ? nB : cB + (size_t)(t + 2) * kstep;
            const char* a3 = a2 + kstep; const char* b3 = b2 + kstep;
            if constexpr (SP2) {
            PG8_LDB(B0, 0, 0); PG8_LDB(B1, 0, 1); PG8_SCHED; PG8_LDA(At, 0, 0); PG8_STAGEA(PG8_SA(1, 1), a1 + hstepA);
            PG8_WAIT_V(8); PG8_WAIT_L(0); PG8_BAR; PG8_MMA(0, 0, At, B0); PG8_MMA(0, 1, At, B1); PG8_BAR; PG8_SCHED;
            PG8_LDA(At, 0, 1); PG8_STAGEB(PG8_SB(0, 0), b2); PG8_STAGEB(PG8_SB(0, 1), b2 + hstep); PG8_STAGEA(PG8_SA(0, 0), a2);
            PG8_WAIT_V(8); PG8_WAIT_L(0); PG8_BAR; PG8_MMA(1, 0, At, B0); PG8_MMA(1, 1, At, B1); PG8_BAR; PG8_SCHED;
            PG8_LDB(B0, 1, 0); PG8_LDB(B1, 1, 1); PG8_SCHED; PG8_LDA(At, 1, 0); PG8_STAGEA(PG8_SA(0, 1), a2 + hstepA);
            PG8_WAIT_V(8); PG8_WAIT_L(0); PG8_BAR; PG8_MMA(0, 0, At, B0); PG8_MMA(0, 1, At, B1); PG8_BAR; PG8_SCHED;
            PG8_LDA(At, 1, 1); PG8_STAGEB(PG8_SB(1, 0), b3); PG8_STAGEB(PG8_SB(1, 1), b3 + hstep); PG8_STAGEA(PG8_SA(1, 0), a3);
            PG8_WAIT_V(8); PG8_WAIT_L(0); PG8_BAR; PG8_MMA(1, 0, At, B0); PG8_MMA(1, 1, At, B1); PG8_BAR; PG8_SCHED;
            } else {
            PG8_LDB(B0, 0, 0); PG8_SCHED; PG8_LDA(At, 0, 0); PG8_STAGEA(PG8_SA(1, 1), a1 + hstepA);
            PG8_WAIT_L(8); PG8_BAR; PG8_WAIT_L(0); PG8_MMA(0, 0, At, B0); PG8_BAR; PG8_SCHED;
            PG8_LDB(B1, 0, 1); PG8_STAGEB(PG8_SB(0, 0), b2);
            PG8_BAR; PG8_WAIT_L(0); PG8_MMA(0, 1, At, B1); PG8_BAR;
            PG8_LDA(At, 0, 1); PG8_STAGEA(PG8_SA(0, 0), a2);
            PG8_BAR; PG8_WAIT_L(0); PG8_MMA(1, 0, At, B0); PG8_BAR; PG8_SCHED;
            PG8_STAGEB(PG8_SB(0, 1), b2 + hstep);
            PG8_WAIT_V(6); PG8_BAR; PG8_MMA(1, 1, At, B1); PG8_BAR;
            PG8_LDB(B0, 1, 0); PG8_SCHED; PG8_LDA(At, 1, 0); PG8_STAGEA(PG8_SA(0, 1), a2 + hstepA);
            PG8_WAIT_L(8); PG8_BAR; PG8_WAIT_L(0); PG8_MMA(0, 0, At, B0); PG8_BAR; PG8_SCHED;
            PG8_LDB(B1, 1, 1); PG8_STAGEB(PG8_SB(1, 0), b3);
            PG8_BAR; PG8_WAIT_L(0); PG8_MMA(0, 1, At, B1); PG8_BAR;
            PG8_LDA(At, 1, 1); PG8_STAGEA(PG8_SA(1, 0), a3);
            PG8_BAR; PG8_WAIT_L(0); PG8_MMA(1, 0, At, B0); PG8_BAR; PG8_SCHED;
            PG8_STAGEB(PG8_SB(1, 1), b3 + hstep);
            PG8_WAIT_V(6); PG8_BAR; PG8_MMA(1, 1, At, B1); PG8_BAR;
            }
        }
        if constexpr (ALIGN_EPI) { if (wr == 0) PG8_BAR; }
        { const int l2 = lane_id_opaque(); E(acc, cur, wr, wc, l2 & 15, l2 >> 4); }
        if (!has_next) break;
#pragma unroll
        for (int a = 0; a < 2; ++a)
#pragma unroll
            for (int b = 0; b < 2; ++b)
#pragma unroll
                for (int m = 0; m < 4; ++m)
#pragma unroll
                    for (int n = 0; n < 2; ++n) acc[a][b][m][n] = (f32x4){0.f, 0.f, 0.f, 0.f};
        cur = nxt; cA = nA; cB = nB; ++ui;
        if constexpr (ALIGN_EPI) { if (wr == 1) PG8_BAR; }
    }
    PG8_WAIT_V(0);
    if constexpr (!ALIGN_EPI) { if (wr == 0) PG8_BAR; }
    PG8_BAR;
#undef PG8_SA
#undef PG8_SB
#undef PG8_STAGE_
#undef PG8_STAGEA
#undef PG8_STAGEB
#undef PG8_LDA
#undef PG8_LDB
#undef PG8_MMA
#undef PG8_WAIT_V
#undef PG8_WAIT_L
#undef PG8_BAR
#undef PG8_SCHED
}

struct EpiBf16 {
    static constexpr bool PERM = true;
    GAS bf16* O; int ldc, ncols;
    __device__ __forceinline__ void operator()(const f32x4 (&acc)[2][2][4][2], const Unit& u, int wr, int wc, int fr, int fq) const {
        const int row0 = u.pm * BM + wr * 64 + fr, col0 = u.pn * BM + wc * 32 + 8 * fq;
#pragma unroll
        for (int ai = 0; ai < 2; ++ai)
#pragma unroll
            for (int m = 0; m < 4; ++m) { GAS bf16* rowp = O + (size_t)(row0 + ai * HALF + m * 16) * ldc + col0; asm volatile("" ::: "memory");
#pragma unroll
                for (int bj = 0; bj < 2; ++bj) { const f32x4 v0 = acc[ai][bj][m][0], v1 = acc[ai][bj][m][1];
                    v4u w; w.x = cvt_pk_bf16(v0[0], v0[1]); w.y = cvt_pk_bf16(v0[2], v0[3]); w.z = cvt_pk_bf16(v1[0], v1[1]); w.w = cvt_pk_bf16(v1[2], v1[3]);
                    if (col0 + bj * HALF < ncols) *(GAS v4u*)(rowp + bj * HALF) = w; } }
    }
};
struct EpiSwiGlu {
    static constexpr bool PERM = true;
    GAS bf16* O; int ldc;
    __device__ __forceinline__ void operator()(const f32x4 (&acc)[2][2][4][2], const Unit& u, int wr, int wc, int fr, int fq) const {
        const int row0 = u.pm * BM + wr * 64 + fr, col0 = u.pn * HALF + wc * 32 + 8 * fq;
#pragma unroll
        for (int ai = 0; ai < 2; ++ai)
#pragma unroll
            for (int m = 0; m < 4; ++m) { GAS bf16* rowp = O + (size_t)(row0 + ai * HALF + m * 16) * ldc + col0; asm volatile("" ::: "memory");
                float h[8];
#pragma unroll
                for (int n = 0; n < 2; ++n)
#pragma unroll
                    for (int i = 0; i < 4; ++i) { const float a = acc[ai][0][m][n][i], b = acc[ai][1][m][n][i]; h[n * 4 + i] = a * b * __builtin_amdgcn_rcpf(1.f + __expf(-a)); }
                v4u w; w.x = cvt_pk_bf16(h[0], h[1]); w.y = cvt_pk_bf16(h[2], h[3]); w.z = cvt_pk_bf16(h[4], h[5]); w.w = cvt_pk_bf16(h[6], h[7]);
                *(GAS v4u*)rowp = w; }
    }
};
struct EpiRes {
    static constexpr bool PERM = true;
    GAS bf16* DL; const GAS float* mod; int goff;
    __device__ __forceinline__ void operator()(const f32x4 (&acc)[2][2][4][2], const Unit& u, int wr, int wc, int fr, int fq) const {
        const int row0 = u.pm * BM + wr * 64 + fr, col0 = u.pn * BM + wc * 32 + 8 * fq;
        const int s = u.pm < 128 ? (u.pm >> 5) : 4;
        const GAS float* gp = mod + s * 6144 + goff + col0;
        f32x4 gv[2][2];
#pragma unroll
        for (int bj = 0; bj < 2; ++bj)
#pragma unroll
            for (int n = 0; n < 2; ++n) gv[bj][n] = *(const GAS f32x4*)(gp + bj * HALF + n * 4);
#pragma unroll
        for (int ai = 0; ai < 2; ++ai)
#pragma unroll
            for (int m = 0; m < 4; ++m) { GAS bf16* rowp = DL + (size_t)(row0 + ai * HALF + m * 16) * D + col0; asm volatile("" ::: "memory");
#pragma unroll
                for (int bj = 0; bj < 2; ++bj) { const f32x4 v0 = gv[bj][0] * acc[ai][bj][m][0], v1 = gv[bj][1] * acc[ai][bj][m][1];
                    v4u w; w.x = cvt_pk_bf16(v0[0], v0[1]); w.y = cvt_pk_bf16(v0[2], v0[3]); w.z = cvt_pk_bf16(v1[0], v1[1]); w.w = cvt_pk_bf16(v1[2], v1[3]);
                    *(GAS v4u*)(rowp + bj * HALF) = w; } }
    }
};
struct EpiGlu {
    static constexpr bool PERM = true;
    GAS bf16* MIX; const GAS float* ya; const GAS float* gb;
    __device__ __forceinline__ void operator()(const f32x4 (&acc)[2][2][4][2], const Unit& u, int wr, int wc, int fr, int fq) const {
        const int row0 = u.pm * BM + wr * 64 + fr, col0 = wc * 32 + 8 * fq;
#pragma unroll
        for (int ai = 0; ai < 2; ++ai)
#pragma unroll
            for (int m = 0; m < 4; ++m) { const int row = row0 + ai * HALF + m * 16; asm volatile("" ::: "memory");
#pragma unroll
                for (int bj = 0; bj < 2; ++bj) { const int c = col0 + bj * HALF;
                    const f32x4 y0 = *(const GAS f32x4*)(ya + (size_t)row * 256 + c), y1 = *(const GAS f32x4*)(ya + (size_t)row * 256 + c + 4);
                    const f32x4 b0 = *(const GAS f32x4*)(gb + c), b1 = *(const GAS f32x4*)(gb + c + 4);
                    float o[8];
#pragma unroll
                    for (int i = 0; i < 4; ++i) { o[i] = y0[i] * sigmoidf_(acc[ai][bj][m][0][i] + b0[i]); o[4 + i] = y1[i] * sigmoidf_(acc[ai][bj][m][1][i] + b1[i]); }
                    v4u w; w.x = cvt_pk_bf16(o[0], o[1]); w.y = cvt_pk_bf16(o[2], o[3]); w.z = cvt_pk_bf16(o[4], o[5]); w.w = cvt_pk_bf16(o[6], o[7]);
                    *(GAS v4u*)(MIX + (size_t)row * D + 256 + c) = w; } }
    }
};
struct EpiMoeDown {
    static constexpr bool PERM = true;
    GAS bf16* O; const GAS float* rowg;
    __device__ __forceinline__ void operator()(const f32x4 (&acc)[2][2][4][2], const Unit& u, int wr, int wc, int fr, int fq) const {
        const int row0 = u.pm * BM + wr * 64 + fr, col0 = u.pn * BM + wc * 32 + 8 * fq;
#pragma unroll
        for (int ai = 0; ai < 2; ++ai)
#pragma unroll
            for (int m = 0; m < 4; ++m) { asm volatile("" ::: "memory"); const int row = row0 + ai * HALF + m * 16; const float gte = rowg[row]; GAS bf16* rowp = O + (size_t)row * D + col0;
#pragma unroll
                for (int bj = 0; bj < 2; ++bj) { const f32x4 v0 = acc[ai][bj][m][0] * gte, v1 = acc[ai][bj][m][1] * gte;
                    v4u w; w.x = cvt_pk_bf16(v0[0], v0[1]); w.y = cvt_pk_bf16(v0[2], v0[3]); w.z = cvt_pk_bf16(v1[0], v1[1]); w.w = cvt_pk_bf16(v1[2], v1[3]);
                    *(GAS v4u*)(rowp + bj * HALF) = w; } }
    }
};

struct EpiS5HL {
    static constexpr bool PERM = true;
    GAS bf16* O;
    __device__ __forceinline__ void operator()(const f32x4 (&acc)[2][2][4][2], const Unit& u, int wr, int wc, int fr, int fq) const {
        const int g = u.pm / 9, ti = u.pm - g * 9, lr0 = ti * 256 + wr * 64 + fr, col0 = wc * 32 + 8 * fq;
#pragma unroll
        for (int ai = 0; ai < 2; ++ai)
#pragma unroll
            for (int m = 0; m < 4; ++m) { const int lr = lr0 + ai * HALF + m * 16; GAS bf16* rowp = O + (size_t)(g * 2112 + lr) * 256 + col0; asm volatile("" ::: "memory");
#pragma unroll
                for (int bj = 0; bj < 2; ++bj) { const f32x4 v0 = acc[ai][bj][m][0], v1 = acc[ai][bj][m][1];
                    v4u w; w.x = cvt_pk_bf16(v0[0], v0[1]); w.y = cvt_pk_bf16(v0[2], v0[3]); w.z = cvt_pk_bf16(v1[0], v1[1]); w.w = cvt_pk_bf16(v1[2], v1[3]);
                    if (lr < 2112) *(GAS v4u*)(rowp + bj * HALF) = w; } }
    }
};
struct EpiS5Y {
    static constexpr bool PERM = true;
    GAS bf16* YA; GAS float* Y32; const GAS bf16* P; const GAS float* dsk;
    __device__ __forceinline__ void operator()(const f32x4 (&acc)[2][2][4][2], const Unit& u, int wr, int wc, int fr, int fq) const {
        const int g = u.pm / 9, ti = u.pm - g * 9, lr0 = ti * 256 + wr * 64 + fr;
#pragma unroll
        for (int ai = 0; ai < 2; ++ai)
#pragma unroll
            for (int m = 0; m < 4; ++m) { const int lr = lr0 + ai * HALF + m * 16; asm volatile("" ::: "memory");
                if (lr < 2112) { const int b = lr / 528, sc = lr - b * 528; const int r0 = sc < 16 ? NLAT + b * CTXL + sc * 16 : b * SEQ + (sc - 16) * 16;
#pragma unroll
                    for (int bj = 0; bj < 2; ++bj) { const int n = bj * HALF + wc * 32 + 8 * fq, t = n >> 4, c0 = g * 16 + (n & 15); const size_t row = (size_t)(r0 + t);
                        const v4u uw = *(const GAS v4u*)(P + row * DPP + PC_S5U + c0); const f32x4 d0 = *(const GAS f32x4*)(dsk + c0), d1 = *(const GAS f32x4*)(dsk + c0 + 4);
                        const float uu[8] = {bflo(uw.x), bfhi(uw.x), bflo(uw.y), bfhi(uw.y), bflo(uw.z), bfhi(uw.z), bflo(uw.w), bfhi(uw.w)};
                        f32x4 y0, y1;
#pragma unroll
                        for (int i = 0; i < 4; ++i) { y0[i] = gelu_tanh(acc[ai][bj][m][0][i] + d0[i] * uu[i]); y1[i] = gelu_tanh(acc[ai][bj][m][1][i] + d1[i] * uu[4 + i]); }
                        *(GAS f32x4*)(Y32 + row * 256 + c0) = y0; *(GAS f32x4*)(Y32 + row * 256 + c0 + 4) = y1;
                        v4u w; w.x = cvt_pk_bf16(y0[0], y0[1]); w.y = cvt_pk_bf16(y0[2], y0[3]); w.z = cvt_pk_bf16(y1[0], y1[1]); w.w = cvt_pk_bf16(y1[2], y1[3]);
                        *(GAS v4u*)(YA + row * 256 + c0) = w; } } }
    }
};
}

struct Args { const float* in[34]; float* out; unsigned char* ws; int ph_lo, ph_hi; };
struct Frame {
    LAS unsigned char* lds;
    int tid, lane, wave, G, bid;
};
typedef const __attribute__((address_space(4))) unsigned long long* kaptr_t;
__device__ __forceinline__ unsigned long long karg(int i) { kaptr_t ka = (kaptr_t)__builtin_amdgcn_kernarg_segment_ptr(); asm volatile("" : "+s"(ka)); return ka[i]; }
__device__ __forceinline__ const GAS float* inp(int i) { return (const GAS float*)karg(i); }
__device__ __forceinline__ GAS float* outp() { return (GAS float*)karg(34); }
__device__ __forceinline__ GAS unsigned char* wsp() { return (GAS unsigned char*)karg(35); }
enum { I_X = 0, I_C, I_CTX, I_CCTX, I_ADAW, I_ADAB, I_WIN, I_WOUT, I_LNG, I_LNB, I_GCONV, I_GALOG, I_GDTB, I_GNW, I_S5ARE, I_S5AIM, I_S5LS, I_S5BRE, I_S5BIM, I_S5CRE, I_S5CIM,
       I_S5D, I_S5GLUW, I_S5GLUB, I_HLB, I_HNW, I_RDEC, I_FW1, I_FW3, I_FW2, I_MROUTER, I_MW1, I_MW3, I_MW2 };

__device__ __forceinline__ void frame_refresh(Frame& F) { const int ln = lane_id_opaque(); int w = F.wave, b = F.bid; asm volatile("" : "+s"(w), "+s"(b)); F.wave = w; F.bid = b; F.lane = ln; F.tid = w * 64 + ln; }
__device__ __forceinline__ int row_slot(int row) { return row < NLAT ? (row >> 13) : 4; }

__device__ __forceinline__ void transpose_item(const GAS float* W, int K, int N, GAS bf16* WT, int mode, LAS float* scr, int item, int lane) {
    const int nblk = (N + 31) / 32, kb = item / nblk, nb = item % nblk, k0 = 64 * kb, n0 = 32 * nb;
    const int nn = n0 + 4 * (lane & 7), kr = lane >> 3;
    f32x4 v[8];
#pragma unroll
    for (int i = 0; i < 8; ++i) v[i] = (nn < N) ? *(const GAS f32x4*)(W + (size_t)(k0 + 8 * i + kr) * N + nn) : (f32x4){0.f, 0.f, 0.f, 0.f};
#pragma unroll
    for (int i = 0; i < 8; ++i) { LAS float* d = scr + (8 * i + kr) * 33 + 4 * (lane & 7); d[0] = v[i][0]; d[1] = v[i][1]; d[2] = v[i][2]; d[3] = v[i][3]; }
    LDS_WAIT(); asm volatile("" ::: "memory");
    const int c = lane & 7;
#pragma unroll
    for (int j = 0; j < 4; ++j) { const int nl = (lane >> 3) + 8 * j; const int n = n0 + nl; const LAS float* s = scr + (8 * c) * 33 + nl;
        v4u o; o.x = pk2(s[0 * 33], s[1 * 33]); o.y = pk2(s[2 * 33], s[3 * 33]); o.z = pk2(s[4 * 33], s[5 * 33]); o.w = pk2(s[6 * 33], s[7 * 33]);
        const int nr = mode == 0 ? n : ((n >> 7) * 256 + (n & 127) + (mode == 2 ? 128 : 0));
        if (n < N) *(GAS v4u*)(WT + (size_t)nr * K + k0 + 8 * c) = o; }
    LDS_WAIT(); asm volatile("" ::: "memory");
}

__device__ __forceinline__ void phase_prologue(Frame& F) {
    frame_refresh(F); GAS unsigned char* const ws = wsp();
    LAS float* scv = (LAS float*)F.lds;
    LAS float* part = (LAS float*)(F.lds + 20480);
    for (int i = F.tid; i < 5 * 1024; i += 512) { const int s = i >> 10, k = i & 1023; const float c = s < 4 ? inp(I_C)[s * 1024 + k] : inp(I_CCTX)[k]; scv[i] = siluf_(c); }
    __syncthreads();
    GAS float* MOD = (GAS float*)(ws + WS_MOD);
    for (int it = F.bid; it < 4 * 96; it += F.G) {
        const int l = it / 96, n0 = (it % 96) * 64;
        const GAS float* w = inp(I_ADAW) + (size_t)l * 1024 * 6144 + n0 + F.lane;
        float a0 = 0.f, a1 = 0.f, a2 = 0.f, a3 = 0.f, a4 = 0.f;
        const int kb = F.wave * 128;
#pragma unroll 8
        for (int k = 0; k < 128; ++k) { const float wv = w[(size_t)(kb + k) * 6144];
            a0 += scv[kb + k] * wv; a1 += scv[1024 + kb + k] * wv; a2 += scv[2048 + kb + k] * wv; a3 += scv[3072 + kb + k] * wv; a4 += scv[4096 + kb + k] * wv; }
        part[(F.wave * 5 + 0) * 64 + F.lane] = a0; part[(F.wave * 5 + 1) * 64 + F.lane] = a1; part[(F.wave * 5 + 2) * 64 + F.lane] = a2; part[(F.wave * 5 + 3) * 64 + F.lane] = a3; part[(F.wave * 5 + 4) * 64 + F.lane] = a4;
        __syncthreads();
        if (F.tid < 320) { const int s = F.tid >> 6, n = F.tid & 63; float v = inp(I_ADAB)[l * 6144 + n0 + n];
#pragma unroll
            for (int w8 = 0; w8 < 8; ++w8) v += part[(w8 * 5 + s) * 64 + n];
            MOD[(size_t)(l * 5 + s) * 6144 + n0 + n] = v; }
        __syncthreads();
    }
    const int gt = F.bid * 512 + F.tid, NT = F.G * 512;
    GAS float* LB = (GAS float*)(ws + WS_LB);
    for (int i = gt; i < 256; i += NT) {
        float v[4], mx = -1e30f; for (int l = 0; l < 4; ++l) { v[l] = inp(I_HLB)[l * 256 + i]; mx = fmaxf(mx, v[l]); }
        float s = 0.f; for (int l = 0; l < 4; ++l) { v[l] = expf(v[l] - mx); s += v[l]; }
        float cum = 0.f, first = 0.f; for (int l = 0; l < 4; ++l) { cum += v[l] / s; if (l == 0) first = cum; LB[l * 256 + i] = cum - first; }
    }
    GAS float* ROT = (GAS float*)(ws + WS_ROT);
    for (int i = gt; i < 192 * 16; i += NT) { const int pos = i >> 4, q = i & 15; const float p = (float)(pos < 128 ? pos : pos - 128);
        const float invf = expf(-(float)q * (9.210340371976184f / 16.f)); const float ang = p * invf; ROT[i * 2] = cosf(ang); ROT[i * 2 + 1] = sinf(ang); }
    GAS float* LAM = (GAS float*)(ws + WS_S5LAM); GAS float* BB = (GAS float*)(ws + WS_S5B);
    for (int i = gt; i < 4 * 2 * 16 * 64; i += NT) {
        const int ldg = i >> 6;
        const float are = inp(I_S5ARE)[i], aim = inp(I_S5AIM)[i], st = expf(inp(I_S5LS)[ldg]);
        const float x = are * st, y = aim * st, ex = expf(x), cy = cosf(y), sy = sinf(y), sh = sinf(0.5f * y);
        LAM[i * 2] = ex * cy; LAM[i * 2 + 1] = ex * sy;
        const float er = expm1f(x) * cy - 2.f * sh * sh, ei = ex * sy;
        const float den = are * are + aim * aim; const float qr = (er * are + ei * aim) / den, qi = (ei * are - er * aim) / den;
        for (int c = 0; c < 16; ++c) { const float br = inp(I_S5BRE)[(size_t)i * 16 + c], bi = inp(I_S5BIM)[(size_t)i * 16 + c];
            BB[((size_t)i * 16 + c) * 2] = qr * br - qi * bi; BB[((size_t)i * 16 + c) * 2 + 1] = qr * bi + qi * br; }
    }
    LAS float* scr = (LAS float*)(F.lds + 32768 + F.wave * 8704);
    __syncthreads();
    const int gw = F.bid * 8 + F.wave, NGW = F.G * 8;
    constexpr int I_IN = 16 * 113, I_OUT = 16 * 32, I_GLU = 4 * 8, I_F1 = 16 * 88, I_F2 = 44 * 32;
    constexpr int PER_L = I_IN + I_OUT + I_GLU, TOT = 4 * PER_L + 2 * (2 * I_F1 + I_F2);
    for (int it = gw; it < TOT; it += NGW) {
        int r = it;
        if (r < 4 * PER_L) { const int l = r / PER_L; r -= l * PER_L;
            if (r < I_IN) { transpose_item(inp(I_WIN) + (size_t)l * D * DPROJ, D, DPROJ, (GAS bf16*)(ws + WS_WIN) + (size_t)l * DPW * D, 0, scr, r, F.lane); continue; } r -= I_IN;
            if (r < I_OUT) { transpose_item(inp(I_WOUT) + (size_t)l * D * D, D, D, (GAS bf16*)(ws + WS_WOUT) + (size_t)l * D * D, 0, scr, r, F.lane); continue; } r -= I_OUT;
            transpose_item(inp(I_S5GLUW) + (size_t)l * 65536, 256, 256, (GAS bf16*)(ws + WS_WGLU) + (size_t)l * 65536, 0, scr, r, F.lane); continue; }
        r -= 4 * PER_L;
        const int j = r / (2 * I_F1 + I_F2); r -= j * (2 * I_F1 + I_F2);
        if (r < I_F1) { transpose_item(inp(I_FW1) + (size_t)j * D * FFD, D, FFD, (GAS bf16*)(ws + WS_WF13) + (size_t)j * 2 * FFD * D, 1, scr, r, F.lane); continue; } r -= I_F1;
        if (r < I_F1) { transpose_item(inp(I_FW3) + (size_t)j * D * FFD, D, FFD, (GAS bf16*)(ws + WS_WF13) + (size_t)j * 2 * FFD * D, 2, scr, r, F.lane); continue; } r -= I_F1;
        transpose_item(inp(I_FW2) + (size_t)j * FFD * D, FFD, D, (GAS bf16*)(ws + WS_WF2) + (size_t)j * D * FFD, 0, scr, r, F.lane);
    }
}
__device__ __forceinline__ void tr_load(const GAS float* W, int N, int item, int lane, f32x4 (&v)[8]) {
    const int nblk = (N + 31) / 32, kb = item / nblk, nb = item % nblk, k0 = 64 * kb, n0 = 32 * nb;
    const int nn = n0 + 4 * (lane & 7), kr = lane >> 3;
#pragma unroll
    for (int i = 0; i < 8; ++i) v[i] = (nn < N) ? *(const GAS f32x4*)(W + (size_t)(k0 + 8 * i + kr) * N + nn) : (f32x4){0.f, 0.f, 0.f, 0.f};
}
__device__ __forceinline__ void tr_store(int K, int N, GAS bf16* WT, int mode, LAS float* scr, int item, int lane, const f32x4 (&v)[8]) {
    const int nblk = (N + 31) / 32, kb = item / nblk, nb = item % nblk, k0 = 64 * kb, n0 = 32 * nb;
    const int kr = lane >> 3;
#pragma unroll
    for (int i = 0; i < 8; ++i) { LAS float* d = scr + (8 * i + kr) * 33 + 4 * (lane & 7); d[0] = v[i][0]; d[1] = v[i][1]; d[2] = v[i][2]; d[3] = v[i][3]; }
    LDS_WAIT(); asm volatile("" ::: "memory");
    const int c = lane & 7;
#pragma unroll
    for (int j = 0; j < 4; ++j) { const int nl = (lane >> 3) + 8 * j; const int n = n0 + nl; const LAS float* s = scr + (8 * c) * 33 + nl;
        v4u o; o.x = pk2(s[0 * 33], s[1 * 33]); o.y = pk2(s[2 * 33], s[3 * 33]); o.z = pk2(s[4 * 33], s[5 * 33]); o.w = pk2(s[6 * 33], s[7 * 33]);
        const int nr = mode == 0 ? n : ((n >> 7) * 256 + (n & 127) + (mode == 2 ? 128 : 0));
        if (n < N) *(GAS v4u*)(WT + (size_t)nr * K + k0 + 8 * c) = o; }
    LDS_WAIT(); asm volatile("" ::: "memory");
}
__device__ __forceinline__ void phase_moe_convert(Frame& F, int j) {
    frame_refresh(F); GAS unsigned char* const ws = wsp();
    LAS float* scr = (LAS float*)(F.lds + F.wave * 8704);
    const int gw = F.bid * 8 + F.wave, NGW = F.G * 8;
    constexpr int I_1 = 16 * 112, I_2 = 56 * 32, PER_E = 2 * I_1 + I_2;
    struct TI { const GAS float* W; GAS bf16* WT; int K, N, mode, item; };
    auto decode = [&](int it, TI& t) {
        const int e = it / PER_E; int r = it - e * PER_E;
        const size_t wo = ((size_t)j * 8 + e) * D * FFE;
        if (r < I_1) { t.W = inp(I_MW1) + wo; t.K = D; t.N = FFE; t.WT = (GAS bf16*)(ws + WS_WM13) + (size_t)e * 2 * FFE * D; t.mode = 1; t.item = r; return; } r -= I_1;
        if (r < I_1) { t.W = inp(I_MW3) + wo; t.K = D; t.N = FFE; t.WT = (GAS bf16*)(ws + WS_WM13) + (size_t)e * 2 * FFE * D; t.mode = 2; t.item = r; return; } r -= I_1;
        t.W = inp(I_MW2) + wo; t.K = FFE; t.N = D; t.WT = (GAS bf16*)(ws + WS_WM2) + (size_t)e * D * FFE; t.mode = 0; t.item = r; };
    int it = gw; if (it >= 8 * PER_E) return;
    const int lane = F.lane;
    TI cur; decode(it, cur); f32x4 v[8]; tr_load(cur.W, cur.N, cur.item, lane, v);
    for (;;) {
        const int itn = it + NGW; const bool more = itn < 8 * PER_E;
        TI nxt = cur; f32x4 w[8];
        if (more) { decode(itn, nxt); tr_load(nxt.W, nxt.N, nxt.item, lane, w); }
        tr_store(cur.K, cur.N, cur.WT, cur.mode, scr, cur.item, lane, v);
        if (!more) break;
        cur = nxt; it = itn;
#pragma unroll
        for (int i = 0; i < 8; ++i) v[i] = w[i];
    }
}

__device__ __forceinline__ const GAS float* xrow_src(const GAS float* xl, const GAS float* xc, int row) { return row < NLAT ? xl + (size_t)row * D : xc + (size_t)(row - NLAT) * D; }
__device__ __forceinline__ GAS float* xrow_dst(GAS float* xl, GAS float* xc, int row) { return row < NLAT ? xl + (size_t)row * D : xc + (size_t)(row - NLAT) * D; }

__device__ __forceinline__ void store_A_row(GAS bf16* Ab, int lane_, int row, const f32x4 (&v)[4], const GAS float* modrow, int shoff, int scoff) {
    GAS bf16* ar = Ab + (size_t)row * D;
#pragma unroll
    for (int j = 0; j < 4; ++j) { const int c = 4 * lane_ + 256 * j; const f32x4 sh = *(const GAS f32x4*)(modrow + shoff + c), sc = *(const GAS f32x4*)(modrow + scoff + c);
        const f32x4 h = v[j] * (sc + 1.f) + sh; v2u w; w.x = pk2(h[0], h[1]); w.y = pk2(h[2], h[3]); *(GAS v2u*)(ar + c) = w; }
}
__device__ __forceinline__ void store_A_rowh(GAS bf16* Ab, int lane_, int row, const f32x4 (&v)[4], const f32x4 (&sh)[4], const f32x4 (&sc)[4]) {
    GAS bf16* ar = Ab + (size_t)row * D;
#pragma unroll
    for (int j = 0; j < 4; ++j) { const int c = 4 * lane_ + 256 * j; const f32x4 h = v[j] * (sc[j] + 1.f) + sh[j]; v2u w; w.x = pk2(h[0], h[1]); w.y = pk2(h[2], h[3]); *(GAS v2u*)(ar + c) = w; }
}
__device__ __forceinline__ int cb8(int lane_, int k) { return 8 * lane_ + 512 * (k >> 1) + 4 * (k & 1); }
__device__ __forceinline__ void store_A_rowh8(GAS bf16* Ab, int lane_, int row, const f32x4 (&v)[4], const f32x4 (&sh)[4], const f32x4 (&sc)[4]) {
    GAS bf16* ar = Ab + (size_t)row * D;
#pragma unroll
    for (int jp = 0; jp < 2; ++jp) { const f32x4 h0 = v[2 * jp] * (sc[2 * jp] + 1.f) + sh[2 * jp], h1 = v[2 * jp + 1] * (sc[2 * jp + 1] + 1.f) + sh[2 * jp + 1];
        v4u w; w.x = pk2(h0[0], h0[1]); w.y = pk2(h0[2], h0[3]); w.z = pk2(h1[0], h1[1]); w.w = pk2(h1[2], h1[3]); *(GAS v4u*)(ar + 8 * lane_ + 512 * jp) = w; }
}
__device__ __forceinline__ void store_A_row8(GAS bf16* Ab, int lane_, int row, const f32x4 (&v)[4], const GAS float* modrow, int shoff, int scoff) {
    f32x4 sh[4], sc[4];
#pragma unroll
    for (int k = 0; k < 4; ++k) { sh[k] = *(const GAS f32x4*)(modrow + shoff + cb8(lane_, k)); sc[k] = *(const GAS f32x4*)(modrow + scoff + cb8(lane_, k)); }
    store_A_rowh8(Ab, lane_, row, v, sh, sc);
}
__device__ __forceinline__ void ln_row(f32x4 (&v)[4], const GAS float* g, const GAS float* b, int lane) {
    float s = 0.f;
#pragma unroll
    for (int j = 0; j < 4; ++j) s += (v[j][0] + v[j][1]) + (v[j][2] + v[j][3]);
    const float mean = wave_sum(s) * (1.f / D); float s2 = 0.f;
#pragma unroll
    for (int j = 0; j < 4; ++j) { v[j] = v[j] - mean; s2 += (v[j][0] * v[j][0] + v[j][1] * v[j][1]) + (v[j][2] * v[j][2] + v[j][3] * v[j][3]); }
    const float rstd = 1.f / sqrtf(wave_sum(s2) * (1.f / D) + LN_EPS);
#pragma unroll
    for (int j = 0; j < 4; ++j) { const int c = 4 * lane + 256 * j; const f32x4 gg = *(const GAS f32x4*)(g + c), bb = *(const GAS f32x4*)(b + c); v[j] = v[j] * rstd * gg + bb; }
}

__device__ __forceinline__ void ln_row2h(f32x4 (&v)[4], f32x4 (&w)[4], const f32x4 (&gg)[4], const f32x4 (&bb)[4]) {
    float s = 0.f, t = 0.f;
#pragma unroll
    for (int j = 0; j < 4; ++j) { s += (v[j][0] + v[j][1]) + (v[j][2] + v[j][3]); t += (w[j][0] + w[j][1]) + (w[j][2] + w[j][3]); }
    const float mean = wave_sum(s) * (1.f / D), meanb = wave_sum(t) * (1.f / D); float s2 = 0.f, t2 = 0.f;
#pragma unroll
    for (int j = 0; j < 4; ++j) { v[j] = v[j] - mean; w[j] = w[j] - meanb;
        s2 += (v[j][0] * v[j][0] + v[j][1] * v[j][1]) + (v[j][2] * v[j][2] + v[j][3] * v[j][3]); t2 += (w[j][0] * w[j][0] + w[j][1] * w[j][1]) + (w[j][2] * w[j][2] + w[j][3] * w[j][3]); }
    const float rstd = 1.f / sqrtf(wave_sum(s2) * (1.f / D) + LN_EPS), rstdb = 1.f / sqrtf(wave_sum(t2) * (1.f / D) + LN_EPS);
#pragma unroll
    for (int j = 0; j < 4; ++j) { v[j] = v[j] * rstd * gg[j] + bb[j]; w[j] = w[j] * rstdb * gg[j] + bb[j]; }
}
__device__ __forceinline__ void ln_row2(f32x4 (&v)[4], f32x4 (&w)[4], const GAS float* g, const GAS float* b, int lane) {
    float s = 0.f, t = 0.f;
#pragma unroll
    for (int j = 0; j < 4; ++j) { s += (v[j][0] + v[j][1]) + (v[j][2] + v[j][3]); t += (w[j][0] + w[j][1]) + (w[j][2] + w[j][3]); }
    const float mean = wave_sum(s) * (1.f / D), meanb = wave_sum(t) * (1.f / D); float s2 = 0.f, t2 = 0.f;
#pragma unroll
    for (int j = 0; j < 4; ++j) { v[j] = v[j] - mean; w[j] = w[j] - meanb;
        s2 += (v[j][0] * v[j][0] + v[j][1] * v[j][1]) + (v[j][2] * v[j][2] + v[j][3] * v[j][3]); t2 += (w[j][0] * w[j][0] + w[j][1] * w[j][1]) + (w[j][2] * w[j][2] + w[j][3] * w[j][3]); }
    const float rstd = 1.f / sqrtf(wave_sum(s2) * (1.f / D) + LN_EPS), rstdb = 1.f / sqrtf(wave_sum(t2) * (1.f / D) + LN_EPS);
#pragma unroll
    for (int j = 0; j < 4; ++j) { const int c = 4 * lane + 256 * j; const f32x4 gg = *(const GAS f32x4*)(g + c), bb = *(const GAS f32x4*)(b + c); v[j] = v[j] * rstd * gg + bb; w[j] = w[j] * rstdb * gg + bb; }
}

__device__ __forceinline__ void phase_a0(Frame& F) {
    frame_refresh(F); GAS unsigned char* const ws = wsp();
    const GAS float* MOD = (const GAS float*)(ws + WS_MOD);
    const int gw = F.bid * 8 + F.wave, NGW = F.G * 8;
    const GAS float* xl = inp(I_X); const GAS float* xc = inp(I_CTX); GAS bf16* Ab = (GAS bf16*)(ws + WS_A);
    const int lane = F.lane; f32x4 shv[4], scv[4]; int cslot = -1;
    for (int row = gw; row < R; row += 2 * NGW) {
        const int rowb = row + NGW < R ? row + NGW : row;
        const GAS float* xr = xrow_src(xl, xc, row); const GAS float* xrb = xrow_src(xl, xc, rowb); f32x4 v[4], w[4];
#pragma unroll
        for (int j = 0; j < 4; ++j) { v[j] = *(const GAS f32x4*)(xr + 4 * lane + 256 * j); w[j] = *(const GAS f32x4*)(xrb + 4 * lane + 256 * j); }
        const int sl = row_slot(row), slb = row_slot(rowb);
        if (sl != cslot) { const GAS float* mr = MOD + (size_t)(0 * 5 + sl) * 6144;
#pragma unroll
            for (int j = 0; j < 4; ++j) { shv[j] = *(const GAS f32x4*)(mr + 4 * lane + 256 * j); scv[j] = *(const GAS f32x4*)(mr + 1024 + 4 * lane + 256 * j); }
            cslot = sl; }
        store_A_rowh(Ab, lane, row, v, shv, scv);
        if (slb == sl) store_A_rowh(Ab, lane, rowb, w, shv, scv); else store_A_row(Ab, lane, rowb, w, MOD + (size_t)(0 * 5 + slb) * 6144, 0, 1024);
    }
}

__device__ __forceinline__ void phase_gdn_prep(Frame& F, int l) {
    frame_refresh(F); GAS unsigned char* const ws = wsp();
    const GAS bf16* P = (const GAS bf16*)(ws + WS_P);
    GAS bf16* GQ = (GAS bf16*)(ws + WS_GQ); GAS bf16* GK = (GAS bf16*)(ws + WS_GK); GAS bf16* GV = (GAS bf16*)(ws + WS_GV);
    GAS float* GSC = (GAS float*)(ws + WS_GSC);
    const GAS float* cw = inp(I_GCONV) + (size_t)l * 3 * 768;
    const int gw = F.bid * 8 + F.wave, NGW = F.G * 8, lane = F.lane;
    f32x4 w[3][3];
#pragma unroll
    for (int kk = 0; kk < 3; ++kk)
#pragma unroll
        for (int j = 0; j < 3; ++j) w[kk][j] = *(const GAS f32x4*)(cw + kk * 768 + j * 256 + 4 * lane);
    float galog = 0.f, gdtb = 0.f;
    if (lane < 8) { galog = -__expf(inp(I_GALOG)[l * 8 + lane]); gdtb = inp(I_GDTB)[l * 8 + lane]; }
    for (int row0 = gw; row0 < R; row0 += 2 * NGW) {
        int rows[2]; rows[0] = row0; rows[1] = row0 + NGW < R ? row0 + NGW : row0;
        v2u xa[2][3], xb[2][3], xc[2][3]; float av[2];
#pragma unroll
        for (int u = 0; u < 2; ++u) { const int row = rows[u];
            int t, L; if (row < NLAT) { t = row & (SEQ - 1); L = SEQ; } else { t = (row - NLAT) & (CTXL - 1); L = CTXL; }
            const GAS bf16* pr = P + (size_t)row * DPP;
#pragma unroll
            for (int j = 0; j < 3; ++j) {
                xb[u][j] = *(const GAS v2u*)(pr + j * 256 + 4 * lane);
                xa[u][j] = (v2u){0u, 0u}; xc[u][j] = (v2u){0u, 0u};
                if (t > 0) xa[u][j] = *(const GAS v2u*)(pr - DPP + j * 256 + 4 * lane);
                if (t < L - 1) xc[u][j] = *(const GAS v2u*)(pr + DPP + j * 256 + 4 * lane); }
            av[u] = lane < 16 ? bf2f(pr[PC_GA + lane]) : 0.f; }
#pragma unroll
        for (int u = 0; u < 2; ++u) { const int row = rows[u];
            f32x4 c[3];
#pragma unroll
            for (int j = 0; j < 3; ++j) { const v2u x0 = xa[u][j], x1 = xb[u][j], x2 = xc[u][j];
                f32x4 a;
                a[0] = w[0][j][0] * bflo(x0.x) + w[1][j][0] * bflo(x1.x) + w[2][j][0] * bflo(x2.x);
                a[1] = w[0][j][1] * bfhi(x0.x) + w[1][j][1] * bfhi(x1.x) + w[2][j][1] * bfhi(x2.x);
                a[2] = w[0][j][2] * bflo(x0.y) + w[1][j][2] * bflo(x1.y) + w[2][j][2] * bflo(x2.y);
                a[3] = w[0][j][3] * bfhi(x0.y) + w[1][j][3] * bfhi(x1.y) + w[2][j][3] * bfhi(x2.y);
#pragma unroll
                for (int i = 0; i < 4; ++i) a[i] = siluf_(a[i]);
                c[j] = a; }
            const float sq = sum16(c[0][0] * c[0][0] + c[0][1] * c[0][1] + c[0][2] * c[0][2] + c[0][3] * c[0][3]);
            const float sk = sum16(c[1][0] * c[1][0] + c[1][1] * c[1][1] + c[1][2] * c[1][2] + c[1][3] * c[1][3]);
            const float rq = 0.125f * __builtin_amdgcn_rsqf(sq + RMS_EPS), rk = __builtin_amdgcn_rsqf(sk + RMS_EPS);
            v2u o;
            o.x = pk2(c[0][0] * rq, c[0][1] * rq); o.y = pk2(c[0][2] * rq, c[0][3] * rq); *(GAS v2u*)(GQ + (size_t)row * 256 + 4 * lane) = o;
            o.x = pk2(c[1][0] * rk, c[1][1] * rk); o.y = pk2(c[1][2] * rk, c[1][3] * rk); *(GAS v2u*)(GK + (size_t)row * 256 + 4 * lane) = o;
            o.x = pk2(c[2][0], c[2][1]); o.y = pk2(c[2][2], c[2][3]); *(GAS v2u*)(GV + (size_t)row * 256 + 4 * lane) = o;
            if (lane < 16) {
                const float a = av[u];
                float val;
                if (lane < 8) { const float z = a + gdtb; const float e = __expf(z); const float sp = z > 20.f ? z : (e < 0.01f ? e * (1.f - e * (0.5f - e * 0.33333333f)) : __logf(1.f + e)); val = galog * sp; }
                else val = sigmoidf_(a);
                GSC[(size_t)row * 16 + lane] = val;
            }
        }
    }
}

__device__ __forceinline__ void chunk_rows(int b, int dir, int c, int& r0, int& step, int& t0) {
    const int s0 = c * TCH;
    if (s0 < CTXL) { t0 = -1; if (dir == 0) { r0 = NLAT + b * CTXL + s0; step = 1; } else { r0 = NLAT + b * CTXL + (CTXL - 1 - s0); step = -1; } }
    else { const int u = s0 - CTXL; if (dir == 0) { r0 = b * SEQ + u; step = 1; t0 = u; } else { r0 = b * SEQ + (SEQ - 1 - u); step = -1; t0 = SEQ - 1 - u; } }
}
constexpr int NCH64 = NSEQ / 64;
constexpr int UNITS = BATCH * 4 * 2 * NCH64;
__device__ __forceinline__ void unit_rows(int b, int dir, int n, int& r0, int& step, int& t0) {
    const int s0 = n * 64;
    if (s0 < CTXL) { t0 = -1; if (dir == 0) { r0 = NLAT + b * CTXL + s0; step = 1; } else { r0 = NLAT + b * CTXL + (CTXL - 1 - s0); step = -1; } }
    else { const int u = s0 - CTXL; if (dir == 0) { r0 = b * SEQ + u; step = 1; t0 = u; } else { r0 = b * SEQ + (SEQ - 1 - u); step = -1; t0 = SEQ - 1 - u; } }
}
__device__ __forceinline__ bf16x8 mkfrag(v2u lo, v2u hi) { v4u w; w.x = lo.x; w.y = lo.y; w.z = hi.x; w.w = hi.y; return __builtin_bit_cast(bf16x8, w); }
__device__ __forceinline__ bf16x8 ldfrag_perm(const GAS unsigned char* tile, int row0, int ks, int r16, int q) {
    const GAS unsigned char* p = tile + (row0 + r16) * 128 + (32 * ks + 4 * q) * 2;
    return mkfrag(*(const GAS v2u*)p, *(const GAS v2u*)(p + 32));
}
__device__ __forceinline__ bf16x8 pack_acc(const f32x4& a, const f32x4& b) {
    v4u w; w.x = pg8::cvt_pk_bf16(a[0], a[1]); w.y = pg8::cvt_pk_bf16(a[2], a[3]); w.z = pg8::cvt_pk_bf16(b[0], b[1]); w.w = pg8::cvt_pk_bf16(b[2], b[3]); return __builtin_bit_cast(bf16x8, w);
}
#define MFMA16(a, b, c) __builtin_amdgcn_mfma_f32_16x16x32_bf16(a, b, c, 0, 0, 0)
__device__ __forceinline__ float rdlane(float x, int i) { return __builtin_bit_cast(float, __builtin_amdgcn_readlane(__builtin_bit_cast(int, x), i)); }

template <int MODE>
__device__ __forceinline__ void chain_run(Frame& F, int sub) {
    GAS unsigned char* const ws = wsp();
    const int lane = lane_id_opaque(), r16 = lane & 15, q = lane >> 4;
    const int cb = sub & 3, dir = (sub >> 2) & 1, h = (sub >> 3) & 3, b = sub >> 5;
    constexpr int NT = (MODE == 0) ? 5 : 4, TW = 0, TU = (MODE == 0) ? 1 : 0, TKD = TU + 1, TQG = TU + 2, TATT = TU + 3;
    const int u0 = ((b * 4 + h) * 2 + dir) * NCH64;
    const GAS unsigned char* tb = ws + (MODE == 0 ? WS_TG : (MODE == 1 ? WS_TH : WS_TR)) + (size_t)u0 * NT * 8192;
    const GAS float* decp = (const GAS float*)(ws + WS_DEC) + (size_t)(MODE * UNITS + u0) * 64;
    GAS bf16* OB = (GAS bf16*)(ws + WS_OB) + (size_t)(MODE * 2 + dir) * R * 256 + h * 64 + cb * 16 + 4 * q;
    f32x4 S[4]; bf16x8 Sb[2];
#pragma unroll
    for (int m = 0; m < 4; ++m) S[m] = (f32x4){0.f, 0.f, 0.f, 0.f};
    Sb[0] = (bf16x8){0, 0, 0, 0, 0, 0, 0, 0}; Sb[1] = Sb[0];
    bf16x8 Wf[4][2], Kf[4][2], Qf[4][2], Af[4][2]; v2u Uf[4]; f32x4 dc[4];
#define LD_W(tu)  do { if (MODE == 0) { _Pragma("unroll") for (int m = 0; m < 4; ++m) _Pragma("unroll") for (int k = 0; k < 2; ++k) Wf[m][k] = ldfrag_perm((tu) + TW * 8192, 16 * m, k, r16, q); } } while (0)
#define LD_U(tu)  do { _Pragma("unroll") for (int m = 0; m < 4; ++m) Uf[m] = *(const GAS v2u*)((tu) + TU * 8192 + (cb * 16 + r16) * 128 + (16 * m + 4 * q) * 2); } while (0)
#define LD_K(tu)  do { _Pragma("unroll") for (int m = 0; m < 4; ++m) _Pragma("unroll") for (int k = 0; k < 2; ++k) Kf[m][k] = ldfrag_perm((tu) + TKD * 8192, 16 * m, k, r16, q); } while (0)
#define LD_Q(tu)  do { _Pragma("unroll") for (int m = 0; m < 4; ++m) _Pragma("unroll") for (int k = 0; k < 2; ++k) Qf[m][k] = ldfrag_perm((tu) + TQG * 8192, 16 * m, k, r16, q); } while (0)
#define LD_A(tu)  do { _Pragma("unroll") for (int m = 0; m < 4; ++m) _Pragma("unroll") for (int k = 0; k < 2; ++k) Af[m][k] = ldfrag_perm((tu) + TATT * 8192, 16 * m, k, r16, q); } while (0)
#define LD_D(n_)  do { _Pragma("unroll") for (int m = 0; m < 4; ++m) dc[m] = *(const GAS f32x4*)(decp + (size_t)(n_) * 64 + 16 * m + 4 * q); } while (0)
    LD_W(tb); LD_U(tb); LD_Q(tb); LD_A(tb); LD_K(tb); LD_D(0);
    for (int n = 0; n < NCH64; ++n) {
        const GAS unsigned char* tn = tb + (size_t)(n + 1 < NCH64 ? n + 1 : n) * NT * 8192;
        f32x4 vn[4], o[4];
#pragma unroll
        for (int m = 0; m < 4; ++m) { vn[m] = (f32x4){bflo(Uf[m].x), bfhi(Uf[m].x), bflo(Uf[m].y), bfhi(Uf[m].y)}; o[m] = (f32x4){0.f, 0.f, 0.f, 0.f}; }
        if (MODE == 0) {
#pragma unroll
            for (int m = 0; m < 4; ++m) { vn[m] = MFMA16(Wf[m][0], Sb[0], vn[m]); vn[m] = MFMA16(Wf[m][1], Sb[1], vn[m]); }
        }
#pragma unroll
        for (int m = 0; m < 4; ++m) { o[m] = MFMA16(Sb[0], Qf[m][0], o[m]); o[m] = MFMA16(Sb[1], Qf[m][1], o[m]); }
        LD_W(tn); LD_U(tn); LD_Q(tn);
        bf16x8 vb[2]; vb[0] = pack_acc(vn[0], vn[1]); vb[1] = pack_acc(vn[2], vn[3]);
#pragma unroll
        for (int m = 0; m < 4; ++m) { o[m] = MFMA16(vb[0], Af[m][0], o[m]); o[m] = MFMA16(vb[1], Af[m][1], o[m]); }
#pragma unroll
        for (int m = 0; m < 4; ++m) { S[m] = S[m] * dc[m]; S[m] = MFMA16(Kf[m][0], vb[0], S[m]); S[m] = MFMA16(Kf[m][1], vb[1], S[m]); }
        LD_A(tn); LD_K(tn); LD_D(n + 1 < NCH64 ? n + 1 : n);
        Sb[0] = pack_acc(S[0], S[1]); Sb[1] = pack_acc(S[2], S[3]);
        { int r0, step, t0; unit_rows(b, dir, n, r0, step, t0);
#pragma unroll
            for (int m = 0; m < 4; ++m) { const int row = r0 + step * (16 * m + r16); v2u w; w.x = pg8::cvt_pk_bf16(o[m][0], o[m][1]); w.y = pg8::cvt_pk_bf16(o[m][2], o[m][3]);
                *(GAS v2u*)(OB + (size_t)row * 256) = w; } }
    }
#undef LD_W
#undef LD_U
#undef LD_K
#undef LD_Q
#undef LD_A
#undef LD_D
}

__device__ __forceinline__ bf16x8 ldsfrag_perm(LAS unsigned char* tile, int row, int ks, int q) {
    return *(const LAS bf16x8*)(tile + row * 128 + (((4 * ks + q) ^ ((row >> 1) & 7)) << 4));
}
template <int MODE>
__device__ __forceinline__ void chain_wg(Frame& F, int cid, int half, GAS bf16* obase = nullptr) {
    GAS unsigned char* const ws = wsp();
    const int lane = lane_id_opaque(), r16 = lane & 15, q = lane >> 4;
    const int dir = cid & 1, h = (cid >> 1) & 3, b = cid >> 3;
    constexpr int NT = (MODE == 0) ? 5 : 4, TW = 0, TU = (MODE == 0) ? 1 : 0, TKD = TU + 1, TQG = TU + 2, TATT = TU + 3;
    constexpr int STAGE = NT * 8192, LPW = NT * 2, LSTAGE = STAGE + 256;
    const int u0 = cid * NCH64;
    const GAS unsigned char* tb = ws + (MODE == 0 ? WS_TG : (MODE == 1 ? WS_TH : WS_TR)) + (size_t)u0 * STAGE;
    LAS unsigned char* ring = F.lds;
    const GAS float* decp = (const GAS float*)(ws + WS_DEC) + (size_t)(MODE * UNITS + u0) * 64;
    int wv = F.wave; asm volatile("" : "+s"(wv));
    if (wv >= 4) {
        const int lw = wv - 4;
        const int lrow = lane >> 3, lch = lane & 7;
        unsigned voff[LPW], loff[LPW];
#pragma unroll
        for (int j = 0; j < LPW; ++j) { const int p = lw + 4 * j, row = 8 * (p & 7) + lrow; voff[j] = (unsigned)((p >> 3) * 8192 + row * 128 + lch * 16); loff[j] = (unsigned)((p >> 3) * 8192 + row * 128 + ((lch ^ ((row >> 1) & 7)) << 4)); }
        float d0_, d1_, d2_, d3_;
        v4u r0_[LPW], r1_[LPW], r2_[LPW], r3_[LPW];
#define CH_SKIP(j) (((j) >> 1) == TU && ((j) & 1) != half)
#define CH_LOAD(reg, dreg, n_) do { const int nn_ = (n_) < NCH64 ? (n_) : NCH64 - 1; const GAS unsigned char* src = tb + (size_t)nn_ * STAGE; _Pragma("unroll") for (int j = 0; j < LPW; ++j) { if (CH_SKIP(j)) continue; reg[j] = *(const GAS v4u*)(src + voff[j]); } dreg = decp[(size_t)nn_ * 64 + lane]; } while (0)
#define CH_WRITE(reg, dreg, n_) do { LAS unsigned char* dst = ring + ((n_) & 1) * LSTAGE; _Pragma("unroll") for (int j = 0; j < LPW; ++j) { if (CH_SKIP(j)) continue; *(LAS v4u*)(dst + loff[j]) = reg[j]; } *(LAS float*)(dst + STAGE + lane * 4) = dreg; } while (0)
#define CH_SYNC() do { asm volatile("s_waitcnt lgkmcnt(0)" ::: "memory"); __builtin_amdgcn_s_barrier(); asm volatile("" ::: "memory"); } while (0)
        CH_LOAD(r0_, d0_, 0); CH_LOAD(r1_, d1_, 1); CH_LOAD(r2_, d2_, 2); CH_LOAD(r3_, d3_, 3);
        CH_WRITE(r0_, d0_, 0);
#define CH_FENCE() asm volatile("" ::: "memory")
        for (int n = 0; n < NCH64; n += 4) {
            CH_SYNC(); CH_LOAD(r0_, d0_, n + 4); CH_FENCE(); CH_WRITE(r1_, d1_, n + 1);
            CH_SYNC(); CH_LOAD(r1_, d1_, n + 5); CH_FENCE(); CH_WRITE(r2_, d2_, n + 2);
            CH_SYNC(); CH_LOAD(r2_, d2_, n + 6); CH_FENCE(); CH_WRITE(r3_, d3_, n + 3);
            CH_SYNC(); CH_LOAD(r3_, d3_, n + 7); CH_FENCE(); CH_WRITE(r0_, d0_, n + 4);
        }
#undef CH_FENCE
        asm volatile("s_waitcnt vmcnt(0) lgkmcnt(0)" ::: "memory");
#undef CH_SYNC
#undef CH_LOAD
#undef CH_WRITE
#undef CH_SKIP
    } else if (wv >= 2) {
        for (int n = 0; n < NCH64; ++n) __builtin_amdgcn_s_barrier();
    } else {
        const int cb = half * 2 + wv;
        GAS bf16* OB = (obase ? obase : (GAS bf16*)(ws + WS_OB)) + (size_t)(MODE * 2 + dir) * R * 256 + h * 64 + cb * 16 + 4 * q;
        f32x4 S[4]; bf16x8 Sb[2];
#pragma unroll
        for (int m = 0; m < 4; ++m) S[m] = (f32x4){0.f, 0.f, 0.f, 0.f};
        Sb[0] = (bf16x8){0, 0, 0, 0, 0, 0, 0, 0}; Sb[1] = Sb[0];
        auto step = [&](const int n) {
            asm volatile("s_waitcnt lgkmcnt(0)" ::: "memory");
            __builtin_amdgcn_s_barrier();
            asm volatile("" ::: "memory");
            LAS unsigned char* st = ring + (n & 1) * LSTAGE;
            f32x4 vn[4], o[4], dc[4];
            v2u uf[4]; bf16x8 fW[4][2], fQ[4][2], fA[4][2], fK[4][2];
#pragma unroll
            for (int m = 0; m < 4; ++m) { const int row = cb * 16 + r16;
                uf[m] = *(const LAS v2u*)(st + TU * 8192 + row * 128 + (((4 * (m >> 1) + q) ^ ((row >> 1) & 7)) << 4) + 8 * (m & 1)); }
            if (MODE == 0) {
#pragma unroll
                for (int m = 0; m < 4; ++m) { fW[m][0] = ldsfrag_perm(st + TW * 8192, 16 * m + r16, 0, q); fW[m][1] = ldsfrag_perm(st + TW * 8192, 16 * m + r16, 1, q); }
            }
#pragma unroll
            for (int m = 0; m < 4; ++m) { fQ[m][0] = ldsfrag_perm(st + TQG * 8192, 16 * m + r16, 0, q); fQ[m][1] = ldsfrag_perm(st + TQG * 8192, 16 * m + r16, 1, q); }
#pragma unroll
            for (int m = 0; m < 4; ++m) dc[m] = *(const LAS f32x4*)(st + STAGE + (16 * m + 4 * q) * 4);
            __builtin_amdgcn_sched_barrier(0);
#pragma unroll
            for (int m = 0; m < 4; ++m) { fA[m][0] = ldsfrag_perm(st + TATT * 8192, 16 * m + r16, 0, q); fA[m][1] = ldsfrag_perm(st + TATT * 8192, 16 * m + r16, 1, q); }
#pragma unroll
            for (int m = 0; m < 4; ++m) { fK[m][0] = ldsfrag_perm(st + TKD * 8192, 16 * m + r16, 0, q); fK[m][1] = ldsfrag_perm(st + TKD * 8192, 16 * m + r16, 1, q); }
            __builtin_amdgcn_sched_barrier(0);
#pragma unroll
            for (int m = 0; m < 4; ++m) { vn[m] = (f32x4){bflo(uf[m].x), bfhi(uf[m].x), bflo(uf[m].y), bfhi(uf[m].y)}; o[m] = (f32x4){0.f, 0.f, 0.f, 0.f}; }
            if (MODE == 0) {
#pragma unroll
                for (int m = 0; m < 4; ++m) { vn[m] = MFMA16(fW[m][0], Sb[0], vn[m]); vn[m] = MFMA16(fW[m][1], Sb[1], vn[m]); }
            }
#pragma unroll
            for (int m = 0; m < 4; ++m) { o[m] = MFMA16(Sb[0], fQ[m][0], o[m]); o[m] = MFMA16(Sb[1], fQ[m][1], o[m]); }
            bf16x8 vb[2]; vb[0] = pack_acc(vn[0], vn[1]); vb[1] = pack_acc(vn[2], vn[3]);
#pragma unroll
            for (int m = 0; m < 4; ++m) { S[m] = S[m] * dc[m]; S[m] = MFMA16(fK[m][0], vb[0], S[m]); S[m] = MFMA16(fK[m][1], vb[1], S[m]); }
#pragma unroll
            for (int m = 0; m < 4; ++m) { o[m] = MFMA16(vb[0], fA[m][0], o[m]); o[m] = MFMA16(vb[1], fA[m][1], o[m]); }
            Sb[0] = pack_acc(S[0], S[1]); Sb[1] = pack_acc(S[2], S[3]);
            { int r0, step, t0; unit_rows(b, dir, n, r0, step, t0);
#pragma unroll
                for (int m = 0; m < 4; ++m) { const int row = r0 + step * (16 * m + r16); v2u w; w.x = pg8::cvt_pk_bf16(o[m][0], o[m][1]); w.y = pg8::cvt_pk_bf16(o[m][2], o[m][3]);
                    *(GAS v2u*)(OB + (size_t)row * 256) = w; } }
        };
        for (int n = 0; n < NCH64; ++n) step(n);
        asm volatile("s_waitcnt lgkmcnt(0)" ::: "memory");
    }
    __builtin_amdgcn_s_barrier();
}

__device__ __forceinline__ int swz(int rr, int kc) { return rr * 128 + ((kc ^ (rr & 7)) << 4); }
__device__ __forceinline__ v4u pack8(const float (&x)[8]) { v4u w; w.x = pk2(x[0], x[1]); w.y = pk2(x[2], x[3]); w.z = pk2(x[4], x[5]); w.w = pk2(x[6], x[7]); return w; }
__device__ __forceinline__ void unpack8(const v4u w, float (&x)[8]) { x[0] = bflo(w.x); x[1] = bfhi(w.x); x[2] = bflo(w.y); x[3] = bfhi(w.y); x[4] = bflo(w.z); x[5] = bfhi(w.z); x[6] = bflo(w.w); x[7] = bfhi(w.w); }
__device__ __forceinline__ void store_col8(GAS unsigned char* tile, int d0, int i, const float (&x)[8]) {
#pragma unroll
    for (int e = 0; e < 8; ++e) *(GAS bf16*)(tile + (d0 + e) * 128 + i * 2) = (bf16)f2bf(x[e]);
}
template <class Fac>
__device__ __forceinline__ void att_from_lds(LAS unsigned char* Qs, LAS unsigned char* Ks, GAS unsigned char* tATT, int r16, int q, const Fac& fac) {
#pragma unroll
    for (int nt = 0; nt < 4; ++nt) {
        bf16x8 bq[2];
#pragma unroll
        for (int ks = 0; ks < 2; ++ks) bq[ks] = *(const LAS bf16x8*)(Qs + swz(16 * nt + r16, ks * 4 + q));
        const int i = 16 * nt + r16;
#pragma unroll
        for (int mt = 0; mt < 4; ++mt) {
            unsigned zz; asm volatile("v_mov_b32 %0, 0" : "=v"(zz)); v2u w = (v2u){zz, zz};
            if (mt <= nt) {
                f32x4 acc = (f32x4){0.f, 0.f, 0.f, 0.f};
#pragma unroll
                for (int ks = 0; ks < 2; ++ks) { const bf16x8 ka = *(const LAS bf16x8*)(Ks + swz(16 * mt + r16, ks * 4 + q)); acc = MFMA16(ka, bq[ks], acc); }
                float y[4];
#pragma unroll
                for (int r = 0; r < 4; ++r) { const int j = 16 * mt + 4 * q + r; y[r] = (j <= i) ? acc[r] * fac(i, j) : 0.f; }
                w.x = pk2(y[0], y[1]); w.y = pk2(y[2], y[3]);
            }
            *(GAS v2u*)(tATT + i * 128 + (mt >> 1) * 64 + q * 16 + (mt & 1) * 8) = w;
        }
    }
}

__device__ __forceinline__ void tile_g2l(const GAS bf16* base, size_t pitch, int r0, int step, LAS unsigned char* buf, int lane) {
    const int rr = lane >> 3, ch = lane & 7;
    v4u v[8];
#pragma unroll
    for (int i = 0; i < 8; ++i) v[i] = *(const GAS v4u*)(base + (size_t)(r0 + step * (8 * i + rr)) * pitch + ch * 8);
#pragma unroll
    for (int i = 0; i < 8; ++i) *(LAS v4u*)(buf + swz(8 * i + rr, ch)) = v[i];
}
__device__ __forceinline__ void tile_l2g(LAS unsigned char* buf, GAS unsigned char* tile, int lane) {
    const int rr = lane >> 3, ch = lane & 7;
#pragma unroll
    for (int i = 0; i < 8; ++i) { const int row = 8 * i + rr, ks = ch >> 2, q = ch & 3;
        const v2u lo = *(const LAS v2u*)(buf + swz(row, 4 * ks + (q >> 1)) + 8 * (q & 1)), hi = *(const LAS v2u*)(buf + swz(row, 4 * ks + 2 + (q >> 1)) + 8 * (q & 1));
        v4u v; v.x = lo.x; v.y = lo.y; v.z = hi.x; v.w = hi.y; *(GAS v4u*)(tile + row * 128 + ch * 16) = v; }
}
__device__ __forceinline__ void row_rd(LAS unsigned char* buf, int lane, v4u (&w)[8]) {
#pragma unroll
    for (int c = 0; c < 8; ++c) w[c] = *(const LAS v4u*)(buf + swz(lane, c));
}
__device__ __forceinline__ void row_wr(LAS unsigned char* buf, int lane, const v4u (&w)[8]) {
#pragma unroll
    for (int c = 0; c < 8; ++c) *(LAS v4u*)(buf + swz(lane, c)) = w[c];
}
__device__ __forceinline__ void col_wr_raw(LAS unsigned char* buf, int lane, int d0, const v4u w) {
    const unsigned ww[4] = {w.x, w.y, w.z, w.w};
#pragma unroll
    for (int e = 0; e < 8; ++e) { const int d = d0 + e; *(LAS bf16*)(buf + swz(d, lane >> 3) + (lane & 7) * 2) = (bf16)((e & 1) ? (ww[e >> 1] >> 16) : (ww[e >> 1] & 0xffffu)); }
}
__device__ __forceinline__ void col_wr_f(LAS unsigned char* buf, int lane, int d0, const float (&x)[8]) {
#pragma unroll
    for (int e = 0; e < 8; ++e) { const int d = d0 + e; *(LAS bf16*)(buf + swz(d, lane >> 3) + (lane & 7) * 2) = (bf16)f2bf(x[e]); }
}

__device__ __forceinline__ void m1_ret(Frame& F, int l, int uidx, LAS unsigned char* lw) {
    GAS unsigned char* const ws = wsp();
    const int lane = lane_id_opaque(), r16 = lane & 15, q = lane >> 4;
    const int n = uidx % NCH64, t_ = uidx / NCH64, dir = t_ & 1, h = (t_ >> 1) & 3, b = t_ >> 3;
    int r0, step, t0; unit_rows(b, dir, n, r0, step, t0);
    const int tpos = t0 < 0 ? -1 : t0 + step * lane;
    const GAS bf16* pq = (const GAS bf16*)(ws + WS_P) + PC_RQKV + h * 64;
    const GAS float* ROT = (const GAS float*)(ws + WS_ROT);
    GAS unsigned char* tu = ws + WS_TR + (size_t)uidx * 4 * 8192;
    GAS unsigned char* tU = tu, *tKD = tu + 8192, *tQG = tu + 2 * 8192, *tATT = tu + 3 * 8192;
    LAS unsigned char* bufA = lw; LAS unsigned char* bufB = lw + 8192;
    const float lg = -__expf(inp(I_RDEC)[l * 8 + dir * 4 + h]);
    const float gq = __expf(lg * (float)(lane + 1)), gk = 0.125f * __expf(lg * (float)(63 - lane));
    tile_g2l(pq, DPP, r0, step, bufA, lane); tile_g2l(pq + 256, DPP, r0, step, bufB, lane);
    LDS_WAIT();
    v4u qw[8], kw[8]; row_rd(bufA, lane, qw); row_rd(bufB, lane, kw);
#pragma unroll
    for (int c8 = 0; c8 < 4; ++c8) {
        float ql[8], qh[8], kl[8], kh[8];
        unpack8(qw[c8], ql); unpack8(qw[c8 + 4], qh); unpack8(kw[c8], kl); unpack8(kw[c8 + 4], kh);
        if (tpos >= 0) {
            const GAS float* tab = ROT + (size_t)((c8 < 2 ? (tpos >> 6) : 128 + (tpos & 63)) * 16 + (c8 & 1) * 8) * 2;
#pragma unroll
            for (int e = 0; e < 8; ++e) { const float cs = tab[2 * e], sn = tab[2 * e + 1];
                const float a = ql[e] * cs - qh[e] * sn, bq = ql[e] * sn + qh[e] * cs; ql[e] = a; qh[e] = bq;
                const float c = kl[e] * cs - kh[e] * sn, dk = kl[e] * sn + kh[e] * cs; kl[e] = c; kh[e] = dk; }
        }
#pragma unroll
        for (int e = 0; e < 8; ++e) { ql[e] *= gq; qh[e] *= gq; }
        qw[c8] = pack8(ql); qw[c8 + 4] = pack8(qh); kw[c8] = pack8(kl); kw[c8 + 4] = pack8(kh);
    }
    row_wr(bufA, lane, qw); row_wr(bufB, lane, kw);
    LDS_WAIT();
    att_from_lds(bufA, bufB, tATT, r16, q, [&](int, int j) { return 0.125f * __expf(-lg * (float)(j + 1)); });
    LDS_WAIT();
    tile_l2g(bufA, tQG, lane);
#pragma unroll
    for (int c = 0; c < 8; ++c) { float x[8]; unpack8(kw[c], x);
#pragma unroll
        for (int e = 0; e < 8; ++e) x[e] *= gk;
        col_wr_f(bufB, lane, 8 * c, x); }
    LDS_WAIT();
    tile_l2g(bufB, tKD, lane);
    tile_g2l(pq + 512, DPP, r0, step, bufA, lane);
    LDS_WAIT();
    row_rd(bufA, lane, qw);
#pragma unroll
    for (int c = 0; c < 8; ++c) col_wr_raw(bufB, lane, 8 * c, qw[c]);
    LDS_WAIT();
    tile_l2g(bufB, tU, lane);
    ((GAS float*)(ws + WS_DEC))[(size_t)(2 * UNITS + uidx) * 64 + lane] = __expf(lg * 64.f);
    LDS_WAIT();
}

__device__ __forceinline__ void m1_hgrn(Frame& F, int l, int uidx, LAS unsigned char* lw) {
    GAS unsigned char* const ws = wsp();
    const int lane = lane_id_opaque(), r16 = lane & 15, q = lane >> 4;
    const int n = uidx % NCH64, t_ = uidx / NCH64, dir = t_ & 1, h = (t_ >> 1) & 3, b = t_ >> 3;
    int r0, step, t0; unit_rows(b, dir, n, r0, step, t0);
    const GAS bf16* P = (const GAS bf16*)(ws + WS_P);
    const GAS float* LBp = (const GAS float*)(ws + WS_LB) + l * 256 + h * 64;
    GAS unsigned char* tu = ws + WS_TH + (size_t)uidx * 4 * 8192;
    GAS unsigned char* tU = tu, *tKD = tu + 8192, *tQG = tu + 2 * 8192, *tATT = tu + 3 * 8192;
    GAS float* decp = (GAS float*)(ws + WS_DEC) + (size_t)(1 * UNITS + uidx) * 64;
    LAS unsigned char* bufA = lw; LAS unsigned char* bufB = lw + 8192;
    tile_g2l(P + PC_HQ + h * 64, DPP, r0, step, bufA, lane); tile_g2l(P + PC_HF + dir * 256 + h * 64, DPP, r0, step, bufB, lane);
    LDS_WAIT();
    v4u xqp[8], xkp[8];
#pragma unroll
    for (int g8 = 0; g8 < 8; ++g8) {
        float qv[8], fz[8], gc[8], kk[8];
        unpack8(*(const LAS v4u*)(bufA + swz(lane, g8)), qv); unpack8(*(const LAS v4u*)(bufB + swz(lane, g8)), fz);
        const f32x4 lb0 = *(const GAS f32x4*)(LBp + 8 * g8), lb1 = *(const GAS f32x4*)(LBp + 8 * g8 + 4);
#pragma unroll
        for (int e = 0; e < 8; ++e) { const float lb = e < 4 ? lb0[e] : lb1[e - 4]; const float sg = sigmoidf_(fz[e]);
            kk[e] = (1.f - lb) * (1.f - sg); gc[e] = __logf(lb + (1.f - lb) * sg); qv[e] = siluf_(qv[e]); }
#pragma unroll
        for (int o = 1; o < 64; o <<= 1) {
#pragma unroll
            for (int e = 0; e < 8; ++e) { const float t = shfl_idx(gc[e], (lane - o) & 63); if (lane >= o) gc[e] += t; }
        }
        float xq[8], xk[8], xs[8], xt[8];
#pragma unroll
        for (int e = 0; e < 8; ++e) { const float gm = rdlane(gc[e], 31), g63 = rdlane(gc[e], 63);
            xq[e] = qv[e] * __expf(gc[e]); xk[e] = kk[e] * __expf(g63 - gc[e]);
            xs[e] = qv[e] * __expf(fminf(gc[e] - gm, 80.f)); xt[e] = kk[e] * __expf(fminf(gm - gc[e], 80.f));
            if (lane == e) decp[8 * g8 + e] = __expf(g63); }
        xqp[g8] = pack8(xq); xkp[g8] = pack8(xk);
        *(LAS v4u*)(bufA + swz(lane, g8)) = pack8(xs); *(LAS v4u*)(bufB + swz(lane, g8)) = pack8(xt);
    }
    LDS_WAIT();
    att_from_lds(bufA, bufB, tATT, r16, q, [](int, int) { return 1.f; });
    LDS_WAIT();
    row_wr(bufA, lane, xqp);
#pragma unroll
    for (int c = 0; c < 8; ++c) col_wr_raw(bufB, lane, 8 * c, xkp[c]);
    LDS_WAIT();
    tile_l2g(bufA, tQG, lane); tile_l2g(bufB, tKD, lane);
    tile_g2l(P + PC_HI + h * 64, DPP, r0, step, bufA, lane);
    LDS_WAIT();
    row_rd(bufA, lane, xqp);
#pragma unroll
    for (int c = 0; c < 8; ++c) col_wr_raw(bufB, lane, 8 * c, xqp[c]);
    LDS_WAIT();
    tile_l2g(bufB, tU, lane);
    LDS_WAIT();
}

__device__ __forceinline__ void m1_gdn(Frame& F, int uidx, LAS unsigned char* lw) {
    GAS unsigned char* const ws = wsp();
    const int lane = lane_id_opaque(), r16 = lane & 15, q = lane >> 4;
    const int n = uidx % NCH64, t_ = uidx / NCH64, dir = t_ & 1, h = (t_ >> 1) & 3, b = t_ >> 3;
    int r0, step, t0; unit_rows(b, dir, n, r0, step, t0);
    const GAS bf16* GQ = (const GAS bf16*)(ws + WS_GQ) + h * 64; const GAS bf16* GK = (const GAS bf16*)(ws + WS_GK) + h * 64; const GAS bf16* GV = (const GAS bf16*)(ws + WS_GV) + h * 64;
    const GAS float* GSC = (const GAS float*)(ws + WS_GSC);
    GAS unsigned char* tu = ws + WS_TG + (size_t)uidx * 5 * 8192;
    GAS unsigned char* tW = tu, *tU = tu + 8192, *tKD = tu + 2 * 8192, *tQG = tu + 3 * 8192, *tATT = tu + 4 * 8192;
    LAS float* Am = (LAS float*)lw;
    LAS unsigned char* bufA = lw; LAS unsigned char* bufB = lw + 8192;
    const int myrow = r0 + step * lane;
    float gc = GSC[(size_t)myrow * 16 + dir * 4 + h]; const float beta = GSC[(size_t)myrow * 16 + 8 + dir * 4 + h];
#pragma unroll
    for (int o = 1; o < 64; o <<= 1) { const float t = shfl_idx(gc, (lane - o) & 63); if (lane >= o) gc += t; }
    const float g63 = rdlane(gc, 63);
#pragma unroll 1
    for (int nt = 0; nt < 4; ++nt) {
        const int i = 16 * nt + r16; const size_t irow = (size_t)(r0 + step * i) * 256;
        bf16x8 bk[2], bq[2];
#pragma unroll
        for (int ks = 0; ks < 2; ++ks) { bk[ks] = *(const GAS bf16x8*)(GK + irow + 32 * ks + 8 * q); bq[ks] = *(const GAS bf16x8*)(GQ + irow + 32 * ks + 8 * q); }
        const float gci = shfl_idx(gc, i), bti = shfl_idx(beta, i);
#pragma unroll
        for (int mt = 0; mt < 4; ++mt) {
            unsigned zz; asm volatile("v_mov_b32 %0, 0" : "=v"(zz)); v2u w = (v2u){zz, zz};
            if (mt <= nt) {
                f32x4 a1 = (f32x4){0.f, 0.f, 0.f, 0.f}, a2 = a1;
#pragma unroll
                for (int ks = 0; ks < 2; ++ks) { const bf16x8 ka = *(const GAS bf16x8*)(GK + (size_t)(r0 + step * (16 * mt + r16)) * 256 + 32 * ks + 8 * q); a1 = MFMA16(ka, bk[ks], a1); a2 = MFMA16(ka, bq[ks], a2); }
                f32x4 av; float y[4];
#pragma unroll
                for (int r = 0; r < 4; ++r) { const int j = 16 * mt + 4 * q + r; const float gcj = shfl_idx(gc, j); const float dcy = __expf(fminf(gci - gcj, 0.f));
                    av[r] = (j < i) ? bti * a1[r] * dcy : 0.f; y[r] = (j <= i) ? a2[r] * dcy : 0.f; }
                *(LAS f32x4*)(Am + i * 64 + 16 * mt + 4 * q) = av;
                w.x = pk2(y[0], y[1]); w.y = pk2(y[2], y[3]);
            }
            *(GAS v2u*)(tATT + i * 128 + (mt >> 1) * 64 + q * 16 + (mt & 1) * 8) = w;
        }
    }
    ((GAS float*)(ws + WS_DEC))[(size_t)(0 * UNITS + uidx) * 64 + lane] = __expf(g63);
    const float begc = beta * __expf(gc), kdf = __expf(g63 - gc);
    LDS_WAIT();
#define GDN_SOLVE(x) do { _Pragma("unroll") for (int i = 1; i < 64; ++i) { asm volatile("" ::: "memory"); float s0_ = 0.f, s1_ = 0.f, s2_ = 0.f, s3_ = 0.f; \
        _Pragma("unroll") for (int j4 = 0; j4 < (i + 3) / 4; ++j4) { const f32x4 a = *(const LAS f32x4*)(Am + i * 64 + 4 * j4); \
            if (4 * j4 + 0 < i) s0_ += a[0] * x[4 * j4 + 0]; if (4 * j4 + 1 < i) s1_ += a[1] * x[4 * j4 + 1]; if (4 * j4 + 2 < i) s2_ += a[2] * x[4 * j4 + 2]; if (4 * j4 + 3 < i) s3_ += a[3] * x[4 * j4 + 3]; } \
        float su = x[i] - ((s0_ + s1_) + (s2_ + s3_)); asm volatile("" : "+v"(su)); x[i] = su; } } while (0)
    const unsigned ul = (unsigned)lane;
    {   float x[64];
#pragma unroll
        for (int i = 0; i < 64; ++i) { if ((i & 15) == 0) asm volatile("" ::: "memory"); const GAS bf16* rp = GK + (size_t)(r0 + step * i) * 256; x[i] = rdlane(begc, i) * bf2f(rp[ul]); }
        GDN_SOLVE(x);
#pragma unroll
        for (int i = 0; i < 64; ++i) *(GAS bf16*)(tW + i * 128 + (lane >> 5) * 64 + (8 * ((lane & 15) >> 2) + 4 * ((lane >> 4) & 1) + (lane & 3)) * 2) = (bf16)f2bf(-x[i]);
    }
    asm volatile("" ::: "memory");
    {   float x[64];
#pragma unroll
        for (int i = 0; i < 64; ++i) { if ((i & 15) == 0) asm volatile("" ::: "memory"); const GAS bf16* rp = GV + (size_t)(r0 + step * i) * 256; x[i] = rdlane(beta, i) * bf2f(rp[ul]); }
        GDN_SOLVE(x);
        LDS_WAIT(); asm volatile("" ::: "memory");
        const int lane = lane_id_opaque();
#pragma unroll
        for (int c8 = 0; c8 < 8; ++c8) { float y[8];
#pragma unroll
            for (int e = 0; e < 8; ++e) y[e] = x[8 * c8 + e];
            *(LAS v4u*)(bufB + swz(lane, c8)) = pack8(y); }
    }
    { const int lane = lane_id_opaque(); const unsigned ul = (unsigned)lane;
    LDS_WAIT();
    tile_l2g(bufB, tU, lane);
    { v4u kp[8];
#pragma unroll
        for (int c8 = 0; c8 < 8; ++c8) { float y[8];
#pragma unroll
            for (int e = 0; e < 8; ++e) { const int i = 8 * c8 + e; const GAS bf16* rp = GK + (size_t)(r0 + step * i) * 256; y[e] = bf2f(rp[ul]) * rdlane(kdf, i); }
            kp[c8] = pack8(y); }
        row_wr(bufA, lane, kp); }
    tile_g2l(GQ, 256, r0, step, bufB, lane);
    LDS_WAIT();
    tile_l2g(bufA, tKD, lane);
    { v4u qgp[8]; const float eg = __expf(gc); row_rd(bufB, lane, qgp);
#pragma unroll
        for (int c = 0; c < 8; ++c) { float x[8]; unpack8(qgp[c], x);
#pragma unroll
            for (int e = 0; e < 8; ++e) x[e] *= eg;
            qgp[c] = pack8(x); }
        row_wr(bufB, lane, qgp); }
    LDS_WAIT();
    tile_l2g(bufB, tQG, lane);
    }
#undef GDN_SOLVE
    LDS_WAIT();
}
__device__ __forceinline__ void phase_m1(Frame& F, int l, int sel = 7) {
    frame_refresh(F);
    LAS unsigned char* lw = F.lds + F.wave * 16384;
    const int gw = F.bid * 8 + F.wave, NGW = F.G * 8;
    for (int it = gw; it < 3 * UNITS; it += NGW) {
        const int m = it / UNITS, u = it - m * UNITS;
#ifndef M1MASK
#define M1MASK 7
#endif
        if (m == 0) { if (sel & 1) m1_gdn(F, u, lw); }
        else if (m == 1) { if (sel & 2) m1_hgrn(F, l, u, lw); }
        else { if (sel & 4) m1_ret(F, l, u, lw); }
    }
}

__device__ __forceinline__ void scan_s5(Frame& F, int l, int sub, LAS unsigned char* lds) {
    GAS unsigned char* const ws = wsp();
    const int lane = lane_id_opaque(), g = sub & 15, dir = (sub >> 4) & 1, b = sub >> 5;
    const GAS bf16* P = (const GAS bf16*)(ws + WS_P);
    GAS float* O = (GAS float*)(ws + WS_O5) + (size_t)dir * R * 256;
    const int ldg = (l * 2 + dir) * 16 + g;
    const GAS float* LAM = (const GAS float*)(ws + WS_S5LAM) + (size_t)(ldg * 64 + lane) * 2;
    const GAS float* BB = (const GAS float*)(ws + WS_S5B) + (size_t)(ldg * 64 + lane) * 32;
    const float lr = LAM[0], li = LAM[1];
    float br[16], bi[16];
#pragma unroll
    for (int c = 0; c < 16; ++c) { br[c] = BB[2 * c]; bi[c] = BB[2 * c + 1]; }
    LAS float* US = (LAS float*)lds; LAS float* HS = US + 1024; LAS float* CS = HS + 32 * 130; LAS float* YS = CS + 2048;
    { const GAS float* cre = inp(I_S5CRE) + (size_t)ldg * 16 * 64; const GAS float* cim = inp(I_S5CIM) + (size_t)ldg * 16 * 64;
        for (int i = lane; i < 1024; i += 64) { CS[i * 2] = cre[i]; CS[i * 2 + 1] = cim[i]; } }
    float hr = 0.f, hi = 0.f;
    v4u ust;
    auto load = [&](int c) { int r0, step, t0; chunk_rows(b, dir, c, r0, step, t0); const int tt = lane >> 1, half = lane & 1; const int row = r0 + step * tt;
        ust = *(const GAS v4u*)(P + (size_t)row * DPP + PC_S5U + g * 16 + half * 8); };
    auto stage = [&](int buf) { const int tt = lane >> 1, half = lane & 1; LAS float* u = US + buf * 512 + tt * 16 + half * 8; const unsigned w[4] = {ust.x, ust.y, ust.z, ust.w};
        *(LAS f32x4*)u = (f32x4){bflo(w[0]), bfhi(w[0]), bflo(w[1]), bfhi(w[1])}; *(LAS f32x4*)(u + 4) = (f32x4){bflo(w[2]), bfhi(w[2]), bflo(w[3]), bfhi(w[3])}; };
    load(0); stage(0);
    for (int c = 0; c < NCHUNK; ++c) {
        const int buf = c & 1;
        if (c + 1 < NCHUNK) load(c + 1);
        LDS_WAIT();
        const LAS float* U = US + buf * 512;
        for (int tt = 0; tt < TCH; ++tt) {
            f32x4 u[4];
#pragma unroll
            for (int i = 0; i < 4; ++i) u[i] = *(const LAS f32x4*)(U + tt * 16 + 4 * i);
            float ar = 0.f, ai = 0.f;
#pragma unroll
            for (int cc = 0; cc < 16; ++cc) { ar += br[cc] * u[cc >> 2][cc & 3]; ai += bi[cc] * u[cc >> 2][cc & 3]; }
            const float nr = lr * hr - li * hi + ar, ni = lr * hi + li * hr + ai;
            hr = nr; hi = ni;
            *(LAS f32x2*)(HS + tt * 130 + lane * 2) = (f32x2){hr, hi};
        }
        LDS_WAIT();
        { const int cc = lane & 15, tq = lane >> 4;
            float acc[8];
#pragma unroll
            for (int k = 0; k < 8; ++k) acc[k] = 0.f;
            for (int p = 0; p < 64; ++p) {
                const f32x2 cv = *(const LAS f32x2*)(CS + (cc * 64 + p) * 2);
#pragma unroll
                for (int k = 0; k < 8; ++k) { const f32x2 hv = *(const LAS f32x2*)(HS + (tq * 8 + k) * 130 + p * 2); acc[k] += cv[0] * hv[0] - cv[1] * hv[1]; }
            }
#pragma unroll
            for (int k = 0; k < 8; ++k) YS[(tq * 8 + k) * 16 + cc] = acc[k];
        }
        LDS_WAIT();
        { int r0, step, t0; chunk_rows(b, dir, c, r0, step, t0); const int tt = lane >> 1, half = lane & 1; const int row = r0 + step * tt;
            GAS float* op = O + (size_t)row * 256 + g * 16 + half * 8;
            *(GAS f32x4*)op = *(const LAS f32x4*)(YS + tt * 16 + half * 8); *(GAS f32x4*)(op + 4) = *(const LAS f32x4*)(YS + tt * 16 + half * 8 + 4); }
        if (c + 1 < NCHUNK) stage(buf ^ 1);
    }
}

__device__ __forceinline__ int s5_tokrow(int b, int sc) { return sc < 16 ? NLAT + b * CTXL + sc * 16 : b * SEQ + (sc - 16) * 16; }
__device__ __forceinline__ void s5_relayout(Frame& F) {
    GAS unsigned char* const ws = wsp();
    const GAS bf16* P = (const GAS bf16*)(ws + WS_P); GAS bf16* A2 = (GAS bf16*)(ws + WS_S5A2);
    const int gw = F.bid * 8 + F.wave, NGW = F.G * 8, lane = F.lane, g = lane & 15;
    for (int it = gw; it < 2112; it += NGW) {
        const int b = it / 528, sc = it - b * 528, r0 = s5_tokrow(b, sc);
#pragma unroll
        for (int i = 0; i < 4; ++i) { const int t = i * 4 + (lane >> 4);
            const GAS bf16* src = P + (size_t)(r0 + t) * DPP + PC_S5U + g * 16;
            GAS bf16* dst = A2 + ((size_t)(g * 2112 + it) * 512 + t * 16);
            const v4u a = *(const GAS v4u*)src, c = *(const GAS v4u*)(src + 8);
            *(GAS v4u*)dst = a; *(GAS v4u*)(dst + 8) = c; }
    }
}
__device__ __forceinline__ void s5_build(Frame& F, int l) {
    GAS unsigned char* const ws = wsp();
    const GAS float* LAM = (const GAS float*)(ws + WS_S5LAM); const GAS float* BB = (const GAS float*)(ws + WS_S5B);
    const GAS float* cre = inp(I_S5CRE); const GAS float* cim = inp(I_S5CIM);
    GAS bf16* EB = (GAS bf16*)(ws + WS_S5EB); GAS bf16* WY = (GAS bf16*)(ws + WS_S5WY);
    const int gt = F.bid * 512 + F.tid, NT = F.G * 512;
    {   LAS float* kl = (LAS float*)(F.lds + F.wave * 256);
        const int gw = F.bid * 8 + F.wave, NGW = F.G * 8, p = F.lane;
        for (int it = gw; it < 4096; it += NGW) {
            const int g = it >> 8, c = (it >> 4) & 15, c2 = it & 15;
            float Kv[32];
#pragma unroll
            for (int d = 0; d < 2; ++d) { const int i0 = ((l * 2 + d) * 16 + g) * 64 + p;
                const float lr = LAM[i0 * 2], li = LAM[i0 * 2 + 1], br = BB[((size_t)i0 * 16 + c2) * 2], bi = BB[((size_t)i0 * 16 + c2) * 2 + 1];
                const size_t ci_ = (size_t)((l * 2 + d) * 16 + g) * 1024 + c * 64 + p; const float cr = cre[ci_], ci = cim[ci_];
                float wr_ = cr * br - ci * bi, wi_ = cr * bi + ci * br;
#pragma unroll
                for (int j = 0; j < 16; ++j) { Kv[d * 16 + j] = wr_; const float nr = wr_ * lr - wi_ * li; wi_ = wr_ * li + wi_ * lr; wr_ = nr; } }
#pragma unroll
            for (int j = 0; j < 32; ++j) { const float r = wave_sum(Kv[j]); if (p == j) kl[j] = r; }
            LDS_WAIT();
            GAS bf16* wy = WY + (size_t)g * 256 * 512;
#pragma unroll
            for (int e = 0; e < 4; ++e) { const int idx = p * 4 + e, t = idx >> 4, s2 = idx & 15;
                const float v = s2 < t ? kl[t - s2] : (s2 > t ? kl[16 + s2 - t] : kl[0] + kl[16]); wy[(size_t)(t * 16 + c) * 512 + s2 * 16 + c2] = (bf16)f2bf(v); }
            LDS_WAIT();
        }
    }
    for (int it = gt; it < 32768; it += NT) {
        const int p = it & 63, c = (it >> 6) & 15, d = (it >> 10) & 1, g = it >> 11;
        const int i0 = ((l * 2 + d) * 16 + g) * 64 + p;
        const float lr = LAM[i0 * 2], li = LAM[i0 * 2 + 1], br = BB[((size_t)i0 * 16 + c) * 2], bi = BB[((size_t)i0 * 16 + c) * 2 + 1];
        const size_t ci_ = (size_t)((l * 2 + d) * 16 + g) * 1024 + c * 64 + p; const float cr = cre[ci_], ci = cim[ci_];
        float pr[17], pi[17]; pr[0] = 1.f; pi[0] = 0.f;
#pragma unroll
        for (int j = 1; j < 17; ++j) { pr[j] = pr[j - 1] * lr - pi[j - 1] * li; pi[j] = pr[j - 1] * li + pi[j - 1] * lr; }
        GAS bf16* wy = WY + (size_t)g * 256 * 512 + 256 + d * 128 + 2 * p; GAS bf16* eb = EB + (size_t)g * 256 * 256 + (size_t)(d * 128 + 2 * p) * 256;
#pragma unroll
        for (int t = 0; t < 16; ++t) {
            const int jw = d == 0 ? t + 1 : 16 - t, je = d == 0 ? 15 - t : t;
            const float xr = cr * pr[jw] - ci * pi[jw], xi = cr * pi[jw] + ci * pr[jw];
            *(GAS unsigned*)(wy + (size_t)(t * 16 + c) * 512) = pk2(xr, -xi);
            const float er = pr[je] * br - pi[je] * bi, ei = pr[je] * bi + pi[je] * br;
            eb[t * 16 + c] = (bf16)f2bf(er); eb[256 + t * 16 + c] = (bf16)f2bf(ei);
        }
    }
}
__device__ __forceinline__ void s5_scan(Frame& F, int l, int sub) {
    GAS unsigned char* const ws = wsp();
    const int lane = lane_id_opaque(), g = sub & 15, dir = (sub >> 4) & 1, b = sub >> 5;
    const GAS float* LAM = (const GAS float*)(ws + WS_S5LAM) + (size_t)((((l * 2 + dir) * 16 + g) * 64 + lane) * 2);
    float lr = LAM[0], li = LAM[1];
#pragma unroll
    for (int k = 0; k < 4; ++k) { const float nr = lr * lr - li * li; li = 2.f * lr * li; lr = nr; }
    const GAS unsigned* HL = (const GAS unsigned*)(ws + WS_S5HL) + (size_t)(g * 2112 + b * 528) * 128 + dir * 64 + lane;
    GAS unsigned* HI = (GAS unsigned*)(ws + WS_S5A2) + (size_t)(g * 2112 + b * 528) * 256 + 128 + dir * 64 + lane;
    float hr = 0.f, hi = 0.f;
#pragma unroll 1
    for (int k0 = 0; k0 < 528; k0 += 48) {
        unsigned w[48];
#pragma unroll
        for (int j = 0; j < 48; ++j) { const int k = k0 + j; const int sc = dir == 0 ? k : (k < 16 ? 15 - k : 543 - k); w[j] = HL[(size_t)sc * 128]; }
#pragma unroll
        for (int j = 0; j < 48; ++j) { const int k = k0 + j; const int sc = dir == 0 ? k : (k < 16 ? 15 - k : 543 - k);
            HI[(size_t)sc * 256] = pk2(hr, hi);
            const float nr = lr * hr - li * hi + bflo(w[j]), ni = lr * hi + li * hr + bfhi(w[j]); hr = nr; hi = ni; }
    }
}
#ifndef NEWCHAIN
#define NEWCHAIN 7
#endif
__device__ __forceinline__ void phase_scans(Frame& F, int l) {
    frame_refresh(F);
#ifdef CHAINCMP
    if (F.bid < 96) {
        const int m = F.bid >> 5, cid = F.bid & 31;
        if (F.wave < 4) { const int sub = cid * 4 + F.wave; if (m == 0) chain_run<0>(F, sub); else if (m == 1) chain_run<1>(F, sub); else chain_run<2>(F, sub); }
        __syncthreads();
        if (l == 0) { GAS bf16* ob2 = (GAS bf16*)outp(); if (m == 0) { chain_wg<0>(F, cid, 0, ob2); } else if (m == 1) { chain_wg<1>(F, cid, 0, ob2); } else { chain_wg<2>(F, cid, 0, ob2); } }
    } else {
        for (int it = (F.bid - 96) + (F.G - 96) * F.wave; it < 128; it += (F.G - 96) * 8) s5_scan(F, l, it);
    }
#else
    if (F.bid < 192) {
        const int half = (F.bid >> 3) & 1, c_ = (F.bid >> 4) * 8 + (F.bid & 7), m = c_ >> 5, cid = c_ & 31;
        if (m == 0) chain_wg<0>(F, cid, half); else if (m == 1) chain_wg<1>(F, cid, half); else chain_wg<2>(F, cid, half);
    } else {
        for (int it = (F.bid - 192) + (F.G - 192) * F.wave; it < 128; it += (F.G - 192) * 8) s5_scan(F, l, it);
    }
#endif
}

__device__ __forceinline__ void phase_readout(Frame& F, int l) {
    frame_refresh(F); GAS unsigned char* const ws = wsp();
    const GAS bf16* P = (const GAS bf16*)(ws + WS_P);
    GAS bf16* MIX = (GAS bf16*)(ws + WS_MIX); GAS bf16* YA = (GAS bf16*)(ws + WS_GQ);
    GAS float* O5 = (GAS float*)(ws + WS_O5); const GAS bf16* OB = (const GAS bf16*)(ws + WS_OB);
    const int gw = F.bid * 8 + F.wave, NGW = F.G * 8, lane = F.lane;
    const int dch = (4 * lane) & 63;
    const f32x4 gnw = *(const GAS f32x4*)(inp(I_GNW) + l * 64 + dch), hnw = *(const GAS f32x4*)(inp(I_HNW) + l * 64 + dch);
    const f32x4 dsk = *(const GAS f32x4*)(inp(I_S5D) + l * 256 + 4 * lane);
    const size_t OBS = (size_t)R * 256;
    for (int row0 = gw; row0 < R; row0 += 2 * NGW) {
        int rows[2]; rows[0] = row0; rows[1] = row0 + NGW < R ? row0 + NGW : row0;
        v2u of[2][3], ob[2][3], gg[2][3];
#pragma unroll
        for (int u = 0; u < 2; ++u) { const GAS bf16* pr = P + (size_t)rows[u] * DPP; const size_t ro = (size_t)rows[u] * 256 + 4 * lane;
#pragma unroll
            for (int m = 0; m < 3; ++m) { of[u][m] = *(const GAS v2u*)(OB + (size_t)(m * 2) * OBS + ro); ob[u][m] = *(const GAS v2u*)(OB + (size_t)(m * 2 + 1) * OBS + ro);
                gg[u][m] = *(const GAS v2u*)(pr + (m == 0 ? PC_GZ : (m == 1 ? PC_HG : PC_RG)) + 4 * lane); } }
#pragma unroll
        for (int u = 0; u < 2; ++u)
#pragma unroll
            for (int m = 0; m < 3; ++m) {
                const v2u f_ = of[u][m], b_ = ob[u][m], g_ = gg[u][m];
                const float o[4] = {bflo(f_.x) + bflo(b_.x), bfhi(f_.x) + bfhi(b_.x), bflo(f_.y) + bflo(b_.y), bfhi(f_.y) + bfhi(b_.y)};
                const float ss = sum16(o[0] * o[0] + o[1] * o[1] + o[2] * o[2] + o[3] * o[3]);
                const float r = __builtin_amdgcn_rsqf(ss * (1.f / 64.f) + RMS_EPS);
                const float gt[4] = {bflo(g_.x), bfhi(g_.x), bflo(g_.y), bfhi(g_.y)};
                float y[4];
#pragma unroll
                for (int i = 0; i < 4; ++i) { const float nw = m == 0 ? gnw[i] : (m == 1 ? hnw[i] : 1.f); y[i] = o[i] * r * nw * siluf_(gt[i]); }
                v2u w; w.x = pk2(y[0], y[1]); w.y = pk2(y[2], y[3]);
                *(GAS v2u*)(MIX + (size_t)rows[u] * D + (m == 0 ? 0 : (m == 1 ? 512 : 768)) + 4 * lane) = w;
            }
    }
}

template <bool ROUTE>
__device__ __forceinline__ void phase_ln(Frame& F, int l, int which) {
    frame_refresh(F); GAS unsigned char* const ws = wsp();
    const GAS bf16* DL = (const GAS bf16*)(ws + WS_Y);
    const bool xin = (l == 0 && which == 0);
    const GAS float* xsl = xin ? inp(I_X) : (const GAS float*)outp(); const GAS float* xsc = xin ? inp(I_CTX) : (const GAS float*)(ws + WS_XC);
    const GAS float* MOD = (const GAS float*)(ws + WS_MOD);
    const GAS float* lg = inp(I_LNG) + (size_t)(l * 2 + which) * D; const GAS float* lb = inp(I_LNB) + (size_t)(l * 2 + which) * D;
    const bool last = (l == DEPTH - 1 && which == 1);
    const int nl = which == 0 ? l : l + 1, shoff = which == 0 ? 3072 : 0, scoff = which == 0 ? 4096 : 1024;
    const int lane = F.lane;
    GAS float* xl = outp(); GAS float* xc = (GAS float*)(ws + WS_XC); GAS bf16* Ab = (GAS bf16*)(ws + WS_A);
    if constexpr (!ROUTE) {
        const int gw = F.bid * 8 + F.wave, NGW = F.G * 8;
        const int nrows = last ? NLAT : R;
        f32x4 lgv[4], lbv[4], shv[4], scv[4]; int cslot = -1;
#pragma unroll
        for (int k = 0; k < 4; ++k) { lgv[k] = *(const GAS f32x4*)(lg + cb8(lane, k)); lbv[k] = *(const GAS f32x4*)(lb + cb8(lane, k)); }
        for (int row = gw; row < nrows; row += 2 * NGW) {
            const int rowb = row + NGW < nrows ? row + NGW : row;
            f32x4 v[4], w[4]; const GAS float* xs = xrow_src(xsl, xsc, row); const GAS float* xsb = xrow_src(xsl, xsc, rowb);
#pragma unroll
            for (int jp = 0; jp < 2; ++jp) { const v4u dw = *(const GAS v4u*)(DL + (size_t)row * D + 8 * lane + 512 * jp), db = *(const GAS v4u*)(DL + (size_t)rowb * D + 8 * lane + 512 * jp);
                v[2 * jp]     = *(const GAS f32x4*)(xs + cb8(lane, 2 * jp)) * ALPHA     + (f32x4){bflo(dw.x), bfhi(dw.x), bflo(dw.y), bfhi(dw.y)};
                v[2 * jp + 1] = *(const GAS f32x4*)(xs + cb8(lane, 2 * jp + 1)) * ALPHA + (f32x4){bflo(dw.z), bfhi(dw.z), bflo(dw.w), bfhi(dw.w)};
                w[2 * jp]     = *(const GAS f32x4*)(xsb + cb8(lane, 2 * jp)) * ALPHA     + (f32x4){bflo(db.x), bfhi(db.x), bflo(db.y), bfhi(db.y)};
                w[2 * jp + 1] = *(const GAS f32x4*)(xsb + cb8(lane, 2 * jp + 1)) * ALPHA + (f32x4){bflo(db.z), bfhi(db.z), bflo(db.w), bfhi(db.w)}; }
            ln_row2h(v, w, lgv, lbv);
            GAS float* xd = xrow_dst(xl, xc, row); GAS float* xdb = xrow_dst(xl, xc, rowb);
#pragma unroll
            for (int k = 0; k < 4; ++k) { *(GAS f32x4*)(xd + cb8(lane, k)) = v[k]; *(GAS f32x4*)(xdb + cb8(lane, k)) = w[k]; }
            if (!last) { const int sl = row_slot(row), slb = row_slot(rowb);
                if (sl != cslot) { const GAS float* mr = MOD + (size_t)(nl * 5 + sl) * 6144;
#pragma unroll
                    for (int k = 0; k < 4; ++k) { shv[k] = *(const GAS f32x4*)(mr + shoff + cb8(lane, k)); scv[k] = *(const GAS f32x4*)(mr + scoff + cb8(lane, k)); }
                    cslot = sl; }
                store_A_rowh8(Ab, lane, row, v, shv, scv);
                if (slb == sl) store_A_rowh8(Ab, lane, rowb, w, shv, scv); else store_A_row8(Ab, lane, rowb, w, MOD + (size_t)(nl * 5 + slb) * 6144, shoff, scoff); }
        }
    } else {
        LAS int* cnt = (LAS int*)F.lds;
        if (F.tid < 8) cnt[F.tid] = 0;
        __syncthreads();
        const GAS float* rw = inp(I_MROUTER) + (size_t)(l >> 1) * D * NEXP;
        f32x4 rwa[4][4][2];
#pragma unroll
        for (int j = 0; j < 4; ++j)
#pragma unroll
            for (int i = 0; i < 4; ++i) { const GAS float* p = rw + (size_t)(4 * lane + 256 * j + i) * 8; rwa[j][i][0] = *(const GAS f32x4*)p; rwa[j][i][1] = *(const GAS f32x4*)(p + 4); }
        GAS int* TOPE = (GAS int*)(ws + WS_TOPE); GAS float* TOPG = (GAS float*)(ws + WS_TOPG);
        const int Rl = (l == DEPTH - 1) ? NLAT : R;
        const int RPW = (Rl + F.G - 1) / F.G, rbeg = F.bid * RPW, rend = min(Rl, rbeg + RPW);
        f32x4 lgv[4], lbv[4];
#pragma unroll
        for (int j = 0; j < 4; ++j) { lgv[j] = *(const GAS f32x4*)(lg + 4 * lane + 256 * j); lbv[j] = *(const GAS f32x4*)(lb + 4 * lane + 256 * j); }
        for (int row0 = rbeg + F.wave; row0 < rend; row0 += 16) {
            const bool two = row0 + 8 < rend; const int rowb = two ? row0 + 8 : row0;
            f32x4 v[4], w[4]; const GAS float* xs = xrow_src(xsl, xsc, row0); const GAS float* xsb = xrow_src(xsl, xsc, rowb);
#pragma unroll
            for (int j = 0; j < 4; ++j) { const v2u dw = *(const GAS v2u*)(DL + (size_t)row0 * D + 4 * lane + 256 * j), db = *(const GAS v2u*)(DL + (size_t)rowb * D + 4 * lane + 256 * j);
                v[j] = *(const GAS f32x4*)(xs + 4 * lane + 256 * j) * ALPHA + (f32x4){bflo(dw.x), bfhi(dw.x), bflo(dw.y), bfhi(dw.y)};
                w[j] = *(const GAS f32x4*)(xsb + 4 * lane + 256 * j) * ALPHA + (f32x4){bflo(db.x), bfhi(db.x), bflo(db.y), bfhi(db.y)}; }
            ln_row2h(v, w, lgv, lbv);
            GAS float* xd = xrow_dst(xl, xc, row0); GAS float* xdb = xrow_dst(xl, xc, rowb);
#pragma unroll
            for (int j = 0; j < 4; ++j) { *(GAS f32x4*)(xd + 4 * lane + 256 * j) = v[j]; *(GAS f32x4*)(xdb + 4 * lane + 256 * j) = w[j]; }
#pragma unroll
            for (int u = 0; u < 2; ++u) {
                if (u == 1 && !two) break;
                const int row = u == 0 ? row0 : rowb; const f32x4 (&vv)[4] = u == 0 ? v : w;
                const GAS float* modrow = MOD + (size_t)(nl * 5 + row_slot(row)) * 6144;
                float lgt[8];
#pragma unroll
                for (int e = 0; e < 8; ++e) lgt[e] = 0.f;
                GAS bf16* ar = Ab + (size_t)row * D;
#pragma unroll
                for (int j = 0; j < 4; ++j) { const int c = 4 * lane + 256 * j; const f32x4 sh = *(const GAS f32x4*)(modrow + shoff + c), sc = *(const GAS f32x4*)(modrow + scoff + c);
                    const f32x4 hv = vv[j] * (sc + 1.f) + sh;
                    { v2u w2; w2.x = pk2(hv[0], hv[1]); w2.y = pk2(hv[2], hv[3]); *(GAS v2u*)(ar + c) = w2; }
#pragma unroll
                    for (int i = 0; i < 4; ++i)
#pragma unroll
                        for (int e = 0; e < 8; ++e) lgt[e] += hv[i] * rwa[j][i][e >> 2][e & 3]; }
#pragma unroll
                for (int e = 0; e < 8; ++e) lgt[e] = wave_sum(lgt[e]);
                int e0 = 0; float v0 = lgt[0];
#pragma unroll
                for (int e = 1; e < 8; ++e) if (lgt[e] > v0) { v0 = lgt[e]; e0 = e; }
                int e1 = -1; float v1 = -3.0e38f;
#pragma unroll
                for (int e = 0; e < 8; ++e) if (e != e0 && lgt[e] > v1) { v1 = lgt[e]; e1 = e; }
                if (lane == 0) { const float ex = __expf(v1 - v0); const float g0 = 1.f / (1.f + ex); TOPE[row] = e0 | (e1 << 8); TOPG[row * 2] = g0; TOPG[row * 2 + 1] = ex * g0;
                    __hip_atomic_fetch_add(&cnt[e0], 1, __ATOMIC_RELAXED, __HIP_MEMORY_SCOPE_WORKGROUP); __hip_atomic_fetch_add(&cnt[e1], 1, __ATOMIC_RELAXED, __HIP_MEMORY_SCOPE_WORKGROUP); }
            }
        }
        __syncthreads();
        if (F.tid < 8) ((GAS int*)(ws + WS_WGCNT))[F.bid * 8 + F.tid] = cnt[F.tid];
    }
}

__device__ __forceinline__ void phase_moe_assign(Frame& F, int l) {
    frame_refresh(F); GAS unsigned char* const ws = wsp();
    LAS int* sm = (LAS int*)F.lds;
    const GAS int* WGCNT = (const GAS int*)(ws + WS_WGCNT);
    if (F.tid < 8) { int tot = 0, pre = 0; for (int w = 0; w < F.G; ++w) { const int c = WGCNT[w * 8 + F.tid]; tot += c; if (w < F.bid) pre += c; } sm[16 + F.tid] = tot; sm[24 + F.tid] = pre; sm[8 + F.tid] = 0; }
    __syncthreads();
    if (F.tid == 0) { int ps = 0; GAS int* info = (GAS int*)(ws + WS_MOEINFO);
        for (int e = 0; e < 8; ++e) { sm[e] = ps + sm[24 + e]; if (F.bid == 0) info[e] = ps >> 8; ps += (sm[16 + e] + 255) & ~255; }
        if (F.bid == 0) { info[8] = ps >> 8; } }
    __syncthreads();
    if (F.bid == 0 && F.tid < 272) { GAS int* info = (GAS int*)(ws + WS_MOEINFO); int ps = 0, e = 0;
        for (int q = 0; q < 8; ++q) { ps += (sm[16 + q] + 255) >> 8; if (F.tid >= ps) e = q + 1; }
        info[16 + F.tid] = e < 8 ? e : 7; }
    __syncthreads();
    const GAS int* TOPE = (const GAS int*)(ws + WS_TOPE); const GAS float* TOPG = (const GAS float*)(ws + WS_TOPG);
    GAS int* TOKPOS = (GAS int*)(ws + WS_TOKPOS); GAS float* ROWG = (GAS float*)(ws + WS_ROWG);
    const GAS bf16* A = (const GAS bf16*)(ws + WS_A); GAS bf16* XG = (GAS bf16*)(ws + WS_XG);
    const int Rl = (l == DEPTH - 1) ? NLAT : R;
    const int RPW = (Rl + F.G - 1) / F.G, rbeg = F.bid * RPW, rend = min(Rl, rbeg + RPW);
    for (int row = rbeg + F.wave; row < rend; row += 8) {
        int p0 = 0, p1 = 0;
        if (F.lane == 0) { const int te = TOPE[row]; const int e0 = te & 255, e1 = te >> 8;
            p0 = sm[e0] + __hip_atomic_fetch_add(&sm[8 + e0], 1, __ATOMIC_RELAXED, __HIP_MEMORY_SCOPE_WORKGROUP); p1 = sm[e1] + __hip_atomic_fetch_add(&sm[8 + e1], 1, __ATOMIC_RELAXED, __HIP_MEMORY_SCOPE_WORKGROUP);
            TOKPOS[row * 2] = p0; TOKPOS[row * 2 + 1] = p1; ROWG[p0] = TOPG[row * 2]; ROWG[p1] = TOPG[row * 2 + 1]; }
        p0 = __builtin_amdgcn_readfirstlane(p0); p1 = __builtin_amdgcn_readfirstlane(p1);
        const v4u a0 = *(const GAS v4u*)(A + (size_t)row * D + 8 * F.lane), a1 = *(const GAS v4u*)(A + (size_t)row * D + 512 + 8 * F.lane);
        *(GAS v4u*)(XG + (size_t)p0 * D + 8 * F.lane) = a0; *(GAS v4u*)(XG + (size_t)p0 * D + 512 + 8 * F.lane) = a1;
        *(GAS v4u*)(XG + (size_t)p1 * D + 8 * F.lane) = a0; *(GAS v4u*)(XG + (size_t)p1 * D + 512 + 8 * F.lane) = a1;
    }
}
__device__ __forceinline__ void phase_moe_combine(Frame& F, int l) {
    frame_refresh(F); GAS unsigned char* const ws = wsp();
    const GAS float* MOD = (const GAS float*)(ws + WS_MOD);
    const GAS float* lg = inp(I_LNG) + (size_t)(l * 2 + 1) * D; const GAS float* lb = inp(I_LNB) + (size_t)(l * 2 + 1) * D;
    const bool last = (l == DEPTH - 1);
    const GAS int* TOKPOS = (const GAS int*)(ws + WS_TOKPOS); const GAS bf16* YB = (const GAS bf16*)(ws + WS_XG);
    const int gw = F.bid * 8 + F.wave, NGW = F.G * 8, lane = F.lane;
    const int nrows = last ? NLAT : R;
    GAS float* xl = outp(); GAS float* xc = (GAS float*)(ws + WS_XC); GAS bf16* Ab = (GAS bf16*)(ws + WS_A);
    f32x4 lgv[4], lbv[4], shv[4], scv[4], gtv[4]; int cslot = -1;
#pragma unroll
    for (int j = 0; j < 4; ++j) { lgv[j] = *(const GAS f32x4*)(lg + 4 * lane + 256 * j); lbv[j] = *(const GAS f32x4*)(lb + 4 * lane + 256 * j); }
    for (int row = gw; row < nrows; row += 2 * NGW) {
        const int rowb = row + NGW < nrows ? row + NGW : row;
        const int p0 = TOKPOS[row * 2], p1 = TOKPOS[row * 2 + 1], q0 = TOKPOS[rowb * 2], q1 = TOKPOS[rowb * 2 + 1];
        const GAS float* xs = xrow_src(xl, xc, row); const GAS float* xsb = xrow_src(xl, xc, rowb);
        const int sl = row_slot(row), slb = row_slot(rowb);
        if (sl != cslot) { const GAS float* mg = MOD + (size_t)(l * 5 + sl) * 6144 + 5120; const GAS float* mr = MOD + (size_t)((last ? l : l + 1) * 5 + sl) * 6144;
#pragma unroll
            for (int j = 0; j < 4; ++j) { gtv[j] = *(const GAS f32x4*)(mg + 4 * lane + 256 * j); shv[j] = *(const GAS f32x4*)(mr + 4 * lane + 256 * j); scv[j] = *(const GAS f32x4*)(mr + 1024 + 4 * lane + 256 * j); }
            cslot = sl; }
        const GAS float* gpb = MOD + (size_t)(l * 5 + slb) * 6144 + 5120;
        f32x4 v[4], w[4];
#pragma unroll
        for (int j = 0; j < 4; ++j) { const int c = 4 * lane + 256 * j;
            const v2u y0 = *(const GAS v2u*)(YB + (size_t)p0 * D + c), y1 = *(const GAS v2u*)(YB + (size_t)p1 * D + c), z0 = *(const GAS v2u*)(YB + (size_t)q0 * D + c), z1 = *(const GAS v2u*)(YB + (size_t)q1 * D + c);
            const f32x4 f = (f32x4){bflo(y0.x) + bflo(y1.x), bfhi(y0.x) + bfhi(y1.x), bflo(y0.y) + bflo(y1.y), bfhi(y0.y) + bfhi(y1.y)};
            const f32x4 h = (f32x4){bflo(z0.x) + bflo(z1.x), bfhi(z0.x) + bfhi(z1.x), bflo(z0.y) + bflo(z1.y), bfhi(z0.y) + bfhi(z1.y)};
            v[j] = *(const GAS f32x4*)(xs + c) * ALPHA + gtv[j] * f;
            const f32x4 gb_ = (slb == sl) ? gtv[j] : *(const GAS f32x4*)(gpb + c);
            w[j] = *(const GAS f32x4*)(xsb + c) * ALPHA + gb_ * h; }
        ln_row2h(v, w, lgv, lbv);
        GAS float* xd = xrow_dst(xl, xc, row); GAS float* xdb = xrow_dst(xl, xc, rowb);
#pragma unroll
        for (int j = 0; j < 4; ++j) { *(GAS f32x4*)(xd + 4 * lane + 256 * j) = v[j]; *(GAS f32x4*)(xdb + 4 * lane + 256 * j) = w[j]; }
        if (!last) { store_A_rowh(Ab, lane, row, v, shv, scv);
            if (slb == sl) store_A_rowh(Ab, lane, rowb, w, shv, scv); else store_A_row(Ab, lane, rowb, w, MOD + (size_t)((l + 1) * 5 + slb) * 6144, 0, 1024); }
    }
}

#ifndef PHMASK
#define PHMASK 0xFFFFFFFFu
#endif
#define PK(k) ((PHMASK >> (k)) & 1u)
constexpr int PPL = 12, NPHASE = 2 + DEPTH * PPL;
__global__ void __launch_bounds__(512, 2) fwd(Args args) {
    extern __shared__ __attribute__((aligned(16))) unsigned char lds_raw[];
    Frame F;
    F.lds = (LAS unsigned char*)lds_raw;
    F.tid = threadIdx.x; F.lane = F.tid & 63; F.wave = __builtin_amdgcn_readfirstlane(F.tid >> 6); F.G = gridDim.x; F.bid = blockIdx.x;
    volatile LAS unsigned* MISC = (volatile LAS unsigned*)(F.lds + LDSCTL_OFF);
    if (F.tid < 64) MISC[F.tid] = 0u;
    __syncthreads();
#if MK_ONE_LAUNCH
    XcdBarrier bar = xcd_barrier_post((GAS unsigned*)(args.ws + WS_CTL) + 4096, MISC + 8, F.wave);
#else
    const int lo = args.ph_lo, hi = args.ph_hi;
    XcdBarrier bar; bar.bar = (GAS unsigned*)(args.ws + WS_CTL) + 4096; bar.x = 0; bar.st = nullptr;
    if (hi - lo > 1) bar = xcd_barrier_post((GAS unsigned*)(args.ws + WS_CTL) + 4096, MISC + 8, F.wave);
#endif
#ifndef DUPMASK
#define DUPMASK 0u
#endif
#define NREP(kind) (((DUPMASK >> (kind)) & 1u) ? 2 : 1)
#define DUPBAR(kind, r) do { if (((DUPMASK >> (kind)) & 1u) && (r) == 0) xcd_barrier(bar, F.wave); } while (0)
#ifndef PROBE_A
#define PROBE_A -1
#endif
#ifndef PROBE_B
#define PROBE_B -1
#endif
#if PROBE_A >= 0
#define PSTAMP(kind) do { if (blockIdx.x == 0 && F.wave == 0) { const unsigned long long t_ = __builtin_amdgcn_s_memrealtime(); MISC[32 + (kind)] += (unsigned)(t_ - ((unsigned long long)MISC[30] | ((unsigned long long)MISC[31] << 32))); MISC[30] = (unsigned)t_; MISC[31] = (unsigned)(t_ >> 32); } } while (0)
#else
#define PSTAMP(kind) do { } while (0)
#endif
#if MK_ONE_LAUNCH
#define IN(k) true
#define PKIND_OF(k) (((k) < 2) ? (k) : (2 + ((k) - 2) % 12 + ((((((k) - 2) / 12) & 1) && ((k) - 2) % 12 >= 8) ? 12 : 0)))
#define SEAM(k) do { xcd_barrier(bar, F.wave); PSTAMP(PKIND_OF(k)); } while (0)
#else
#define IN(k) (lo <= (k) && (k) < hi)
#define SEAM(k) do { if (IN((k) + 1)) xcd_barrier(bar, F.wave); } while (0)
#endif
    LAS unsigned char* ring = F.lds;
    PSTAMP(31);

    if (IN(0)) { if (PK(0)) phase_prologue(F); SEAM(0); }
    if (IN(1)) { if (PK(1)) phase_a0(F); SEAM(1); }
    for (int l = 0; l < DEPTH; ++l) {
        const int pb = 2 + l * PPL;
        const bool moe = (l & 1) != 0;
        if (PK(3) && IN(pb + 0)) for (int r_ = 0; r_ < NREP(2); ++r_) {
            GAS unsigned char* const ws = wsp();
            pg8::Gemm g{(const GAS bf16*)(ws + WS_A), (const GAS bf16*)(ws + WS_WIN) + (size_t)l * DPW * D, D, D};
            pg8::StaticOrder S; S.init(R / 256, DPW / 256, D, F.G, F.bid);
            pg8::EpiBf16 E{(GAS bf16*)(ws + WS_P), DPP, DPROJ};
            pg8::gemm_phase<pg8::EpiBf16, pg8::StaticOrder, true, true>(ring, F.wave, g, S, E);
            DUPBAR(2, r_); if (r_ == NREP(2) - 1) SEAM(pb + 0);
        }
        if (IN(pb + 1)) for (int r_ = 0; r_ < NREP(3); ++r_) { if (PK(4)) { phase_gdn_prep(F, l); s5_relayout(F); s5_build(F, l); } DUPBAR(3, r_); if (r_ == NREP(3) - 1) SEAM(pb + 1); }
        if (IN(pb + 2)) for (int r_ = 0; r_ < NREP(4); ++r_) {
#ifndef M1SEL
#define M1SEL 7
#endif
#ifndef M1DUPSEL
#define M1DUPSEL 7
#endif
            if (PK(19) && r_ == 0) { GAS unsigned char* const ws = wsp();
                pg8::Gemm g{(const GAS bf16*)(ws + WS_S5A2), (const GAS bf16*)(ws + WS_S5EB), 256, 512};
                pg8::S5Order S; S.init(144, 1, 256, F.G, F.bid, 512);
                pg8::EpiS5HL E{(GAS bf16*)(ws + WS_S5HL)};
                pg8::gemm_phase<pg8::EpiS5HL, pg8::S5Order, true, true>(ring, F.wave, g, S, E); }
            if (PK(18)) phase_m1(F, l, r_ == 0 ? M1SEL : M1DUPSEL);
            DUPBAR(4, r_); if (r_ == NREP(4) - 1) SEAM(pb + 2);
        }
#ifndef DUPSCAN
#define DUPSCAN 0
#endif
        if (IN(pb + 3)) { if (PK(5)) phase_scans(F, l);
#if DUPSCAN
            xcd_barrier(bar, F.wave); phase_scans(F, l);
#endif
            SEAM(pb + 3); }
        if (IN(pb + 4)) for (int r_ = 0; r_ < NREP(6); ++r_) {
            if (PK(20)) { GAS unsigned char* const ws = wsp();
                pg8::Gemm g{(const GAS bf16*)(ws + WS_S5A2), (const GAS bf16*)(ws + WS_S5WY), 512, 512};
                pg8::S5Order S; S.init(144, 1, 512, F.G, F.bid, 512);
                pg8::EpiS5Y E{(GAS bf16*)(ws + WS_GQ), (GAS float*)(ws + WS_O5), (const GAS bf16*)(ws + WS_P), inp(I_S5D) + l * 256};
                pg8::gemm_phase<pg8::EpiS5Y, pg8::S5Order, true, true>(ring, F.wave, g, S, E); }
#ifdef CHAINCMP
            if (l == 0) { GAS unsigned char* const ws = wsp(); const GAS unsigned short* a = (const GAS unsigned short*)(ws + WS_OB); const GAS unsigned short* c = (const GAS unsigned short*)outp();
                const int ln_ = lane_id_opaque();
                for (int mm = 0; mm < 3; ++mm) { unsigned bad = 0, big = 0;
                    for (size_t i = (size_t)F.bid * 512 + F.wave * 64 + ln_; i < (size_t)2 * R * 256; i += (size_t)F.G * 512) { const size_t j = (size_t)mm * 2 * R * 256 + i; const float x = bf2f(a[j]), y = bf2f(c[j]); if (a[j] != c[j]) { ++bad; if (fabsf(x - y) > 0.02f * (fabsf(x) + 1e-3f)) ++big; } }
                    if (bad) __hip_atomic_fetch_add((GAS unsigned*)(ws + WS_CTL) + 70010 + mm, bad, __ATOMIC_RELAXED, __HIP_MEMORY_SCOPE_AGENT);
                    if (big) __hip_atomic_fetch_add((GAS unsigned*)(ws + WS_CTL) + 70020 + mm, big, __ATOMIC_RELAXED, __HIP_MEMORY_SCOPE_AGENT); } }
#endif
            if (PK(6)) phase_readout(F, l); if (PK(2) && moe) phase_moe_convert(F, l >> 1); DUPBAR(6, r_); if (r_ == NREP(6) - 1) SEAM(pb + 4);
        }
        if (PK(7) && IN(pb + 5)) for (int r_ = 0; r_ < NREP(7); ++r_) {
            GAS unsigned char* const ws = wsp();
            pg8::Gemm g{(const GAS bf16*)(ws + WS_GQ), (const GAS bf16*)(ws + WS_WGLU) + (size_t)l * 65536, 256, 256};
            pg8::StaticOrder S; S.init(R / 256, 1, 256, F.G, F.bid);
            pg8::EpiGlu E{(GAS bf16*)(ws + WS_MIX), (const GAS float*)(ws + WS_O5), inp(I_S5GLUB) + l * 256};
            pg8::gemm_phase<pg8::EpiGlu, pg8::StaticOrder, true, true>(ring, F.wave, g, S, E);
            DUPBAR(7, r_); if (r_ == NREP(7) - 1) SEAM(pb + 5);
        }
        if (PK(8) && IN(pb + 6)) for (int r_ = 0; r_ < NREP(8); ++r_) {
            GAS unsigned char* const ws = wsp(); const GAS float* modl = (const GAS float*)(ws + WS_MOD) + (size_t)l * 5 * 6144;
            pg8::Gemm g{(const GAS bf16*)(ws + WS_MIX), (const GAS bf16*)(ws + WS_WOUT) + (size_t)l * D * D, D, D};
            pg8::StaticOrder S; S.init((l == DEPTH - 1 ? NLAT : R) / 256, D / 256, D, F.G, F.bid);
            pg8::EpiRes E{(GAS bf16*)(ws + WS_Y), modl, 2048};
            pg8::gemm_phase<pg8::EpiRes, pg8::StaticOrder, true, true>(ring, F.wave, g, S, E);
            DUPBAR(8, r_); if (r_ == NREP(8) - 1) SEAM(pb + 6);
        }
        if (IN(pb + 7)) for (int r_ = 0; r_ < NREP(9); ++r_) { if (moe) { if (PK(9)) phase_ln<true>(F, l, 0); } else { if (PK(10)) phase_ln<false>(F, l, 0); } DUPBAR(9, r_); if (r_ == NREP(9) - 1) SEAM(pb + 7); }
        if (!moe) {
            if (PK(11) && IN(pb + 8)) for (int r_ = 0; r_ < NREP(10); ++r_) {
                GAS unsigned char* const ws = wsp();
                pg8::Gemm g{(const GAS bf16*)(ws + WS_A), (const GAS bf16*)(ws + WS_WF13) + (size_t)(l >> 1) * 2 * FFD * D, D, D};
                pg8::StaticOrder S; S.init(R / 256, 2 * FFD / 256, D, F.G, F.bid);
                pg8::EpiSwiGlu E{(GAS bf16*)(ws + WS_HID), FFD};
                pg8::gemm_phase<pg8::EpiSwiGlu, pg8::StaticOrder, true, true>(ring, F.wave, g, S, E);
                DUPBAR(10, r_); if (r_ == NREP(10) - 1) SEAM(pb + 8);
            }
            if (PK(12) && IN(pb + 9)) for (int r_ = 0; r_ < NREP(11); ++r_) {
                GAS unsigned char* const ws = wsp(); const GAS float* modl = (const GAS float*)(ws + WS_MOD) + (size_t)l * 5 * 6144;
                pg8::Gemm g{(const GAS bf16*)(ws + WS_HID), (const GAS bf16*)(ws + WS_WF2) + (size_t)(l >> 1) * D * FFD, FFD, FFD};
                pg8::StaticOrder S; S.init(R / 256, D / 256, FFD, F.G, F.bid);
                pg8::EpiRes E{(GAS bf16*)(ws + WS_Y), modl, 5120};
                pg8::gemm_phase<pg8::EpiRes, pg8::StaticOrder, true, true>(ring, F.wave, g, S, E);
                DUPBAR(11, r_); if (r_ == NREP(11) - 1) SEAM(pb + 9);
            }
            if (IN(pb + 10)) for (int r_ = 0; r_ < NREP(13); ++r_) { if (PK(13)) phase_ln<false>(F, l, 1); DUPBAR(13, r_); if (r_ == NREP(13) - 1) SEAM(pb + 11); }
        } else {
            if (IN(pb + 8)) for (int r_ = 0; r_ < NREP(22); ++r_) { if (PK(14)) phase_moe_assign(F, l); DUPBAR(22, r_); if (r_ == NREP(22) - 1) SEAM(pb + 8); }
            if (PK(15) && IN(pb + 9)) for (int r_ = 0; r_ < NREP(23); ++r_) {
                GAS unsigned char* const ws = wsp();
                const GAS int* info = (const GAS int*)(ws + WS_MOEINFO);
                pg8::Gemm g{(const GAS bf16*)(ws + WS_XG), (const GAS bf16*)(ws + WS_WM13), D, D};
                pg8::MoeOrder S; S.init(info[8], 2 * FFE / 256, D, F.G, F.bid);
                S.texp = info + 16; S.estride = (size_t)2 * FFE * D * 2;
                pg8::EpiSwiGlu E{(GAS bf16*)(ws + WS_MHID), FFE};
                pg8::gemm_phase<pg8::EpiSwiGlu, pg8::MoeOrder, true, true>(ring, F.wave, g, S, E);
                DUPBAR(23, r_); if (r_ == NREP(23) - 1) SEAM(pb + 9);
            }
            if (PK(16) && IN(pb + 10)) for (int r_ = 0; r_ < NREP(24); ++r_) {
                GAS unsigned char* const ws = wsp();
                const GAS int* info = (const GAS int*)(ws + WS_MOEINFO);
                pg8::Gemm g{(const GAS bf16*)(ws + WS_MHID), (const GAS bf16*)(ws + WS_WM2), FFE, FFE};
                pg8::MoeOrder S; S.init(info[8], D / 256, FFE, F.G, F.bid);
                S.texp = info + 16; S.estride = (size_t)D * FFE * 2;
                pg8::EpiMoeDown E{(GAS bf16*)(ws + WS_XG), (const GAS float*)(ws + WS_ROWG)};
                pg8::gemm_phase<pg8::EpiMoeDown, pg8::MoeOrder, true, true>(ring, F.wave, g, S, E);
                DUPBAR(24, r_); if (r_ == NREP(24) - 1) SEAM(pb + 10);
            }
            if (IN(pb + 11)) for (int r_ = 0; r_ < NREP(25); ++r_) { if (PK(17)) phase_moe_combine(F, l); DUPBAR(25, r_); if (r_ == NREP(25) - 1 && l < DEPTH - 1) SEAM(pb + 11); }
        }
    }
#ifdef CHAINCMP
    {   xcd_barrier(bar, F.wave);
        const GAS unsigned* cw = (const GAS unsigned*)(args.ws + WS_CTL) + 70010;
        const unsigned b0 = cw[0] + cw[1] + cw[2], g0 = cw[10] + cw[11] + cw[12];
        const float va = b0 == 0 ? 0.f : (b0 < 100 ? 10.f : (b0 < 10000 ? 100.f : (b0 < 1000000 ? 1000.f : 10000.f)));
        const float vb = g0 == 0 ? 0.f : (g0 < 100 ? 1.f : (g0 < 10000 ? 2.f : (g0 < 1000000 ? 3.f : 4.f)));
        GAS float* o = outp();
        for (size_t i = (size_t)blockIdx.x * 512 + F.wave * 64 + lane_id_opaque(); i < (size_t)NLAT * D; i += (size_t)gridDim.x * 512) o[i] = (i == 0) ? vb * 1.0e6f + 5.0e5f : va + 3.f;
    }
#endif
#ifdef CHAINCHECK
    {   xcd_barrier(bar, F.wave);
        const GAS unsigned* cw = (const GAS unsigned*)(args.ws + WS_CTL) + 70000;
        const unsigned c0 = cw[0], c1 = cw[1], c2 = cw[2];
        const float va = (c0 ? 100.f : 0.f) + (c1 ? 10.f : 0.f) + (c2 ? 1.f : 0.f);
        const float vb = (float)(c0 + c1 + c2);
        GAS float* o = outp();
        for (size_t i = (size_t)blockIdx.x * 512 + F.wave * 64 + lane_id_opaque(); i < (size_t)NLAT * D; i += (size_t)gridDim.x * 512) o[i] = (i == 0) ? vb * 1000.f + 7777.f : va + 3.f;
    }
#endif
#if PROBE_A >= 0
    {
        PSTAMP(25);
        GAS float* tw = (GAS float*)(args.ws + WS_CTL) + 65536;
        { const int ln_ = lane_id_opaque(); if (blockIdx.x == 0 && F.wave == 0 && ln_ < 32) tw[ln_] = (float)MISC[32 + ln_] * 0.01f; }
        xcd_barrier(bar, F.wave);
        const float va = tw[PROBE_A], vb = tw[PROBE_B] * 1000.f;
        GAS float* o = outp();
        for (size_t i = (size_t)blockIdx.x * 512 + F.wave * 64 + lane_id_opaque(); i < (size_t)NLAT * D; i += (size_t)gridDim.x * 512) o[i] = (i == 0) ? vb : va;
    }
#endif
#undef IN
#undef SEAM
}

extern "C" void kernel_launch(void* const* d_in, const int* in_sizes, int n_in, void* d_out, int out_size, void* d_ws, size_t ws_size, hipStream_t stream) {
    static int grid = 0;
    if (grid == 0) {
        if (n_in != 34 || out_size != NLAT * D || ws_size < WS_END) { fprintf(stderr, "kernel_launch: unexpected shapes (n_in %d out %d ws %zu need %zu)\n", n_in, out_size, ws_size, (size_t)WS_END); grid = -1; return; }
        int dev = 0, cus = 0, per_cu = 0;
        if (hipGetDevice(&dev) != hipSuccess || hipDeviceGetAttribute(&cus, hipDeviceAttributeMultiprocessorCount, dev) != hipSuccess) { grid = -1; return; }
        if (hipFuncSetAttribute((const void*)fwd, hipFuncAttributeMaxDynamicSharedMemorySize, LDS_BYTES) != hipSuccess) { fprintf(stderr, "kernel_launch: hipFuncSetAttribute failed\n"); grid = -1; return; }
        if (hipOccupancyMaxActiveBlocksPerMultiprocessor(&per_cu, (const void*)fwd, 512, LDS_BYTES) != hipSuccess || per_cu < 1) fprintf(stderr, "kernel_launch: occupancy query reports %d\n", per_cu);
        (void)hipGetLastError();
        grid = cus;
    }
    if (grid < 0) return;
    (void)hipMemsetAsync((char*)d_ws + WS_CTL, 0, CTL_ZERO_BYTES, stream);
    Args a{};
    for (int i = 0; i < 34; ++i) a.in[i] = (const float*)d_in[i];
    a.out = (float*)d_out; a.ws = (unsigned char*)d_ws;
#if MK_ONE_LAUNCH
    a.ph_lo = 0; a.ph_hi = NPHASE;
    hipLaunchKernelGGL(fwd, dim3(grid), dim3(512), LDS_BYTES, stream, a);
#else
    for (int p = 0; p < NPHASE; ++p) {
        if (p >= 2) { const int l = (p - 2) / PPL, k = (p - 2) % PPL; const bool moe = (l & 1) != 0; if (k == 11 && !moe) continue; }
        a.ph_lo = p; a.ph_hi = p + 1;
        hipLaunchKernelGGL(fwd, dim3(grid), dim3(512), LDS_BYTES, stream, a);
    }
#endif
}
```

```cpp
#include <hip/hip_runtime.h>
#include <cstdio>
#include <cstdint>

#ifndef MK_ONE_LAUNCH
#define MK_ONE_LAUNCH 1
#endif

#define GAS __attribute__((address_space(1)))
#define LAS __attribute__((address_space(3)))
typedef unsigned short bf16;
typedef unsigned v4u __attribute__((ext_vector_type(4)));
typedef unsigned v2u __attribute__((ext_vector_type(2)));
typedef float f32x4 __attribute__((ext_vector_type(4)));
typedef float f32x2 __attribute__((ext_vector_type(2)));
typedef short bf16x8 __attribute__((ext_vector_type(8)));

constexpr int D = 1024, BATCH = 4, SEQ = 8192, CTXL = 256, DEPTH = 4;
constexpr int NLAT = BATCH * SEQ, NCTX = BATCH * CTXL, R = NLAT + NCTX;
constexpr int DPROJ = 3600, DPP = 3600, DPW = 3840;
constexpr int FFD = 2816, FFE = 3584, NEXP = 8;
constexpr int MOE_ROWS = 2 * R + NEXP * 256;
constexpr float ALPHA = 1.681792830507429f;
constexpr float LN_EPS = 1e-5f, RMS_EPS = 1e-6f;
constexpr int PC_GQKV = 0, PC_GZ = 768, PC_GA = 1024, PC_GB = 1032, PC_S5U = 1040, PC_HQ = 1296, PC_HF = 1552, PC_HI = 2064, PC_HG = 2320, PC_RQKV = 2576, PC_RG = 3344;
constexpr int NSEQ = CTXL + SEQ;
constexpr int TCH = 32, NCHUNK = NSEQ / TCH;

constexpr size_t MiB = 1u << 20;
constexpr size_t WS_CTL = 0, CTL_ZERO_BYTES = 1 * MiB;
constexpr size_t WS_MOD = 1 * MiB;
constexpr size_t WS_LB = WS_MOD + 512 * 1024;
constexpr size_t WS_ROT = WS_LB + 4096;
constexpr size_t WS_S5LAM = WS_ROT + 32768;
constexpr size_t WS_S5B = 2 * MiB;
constexpr size_t WS_TOPE = 3 * MiB;
constexpr size_t WS_TOPG = WS_TOPE + 256 * 1024;
constexpr size_t WS_TOKPOS = WS_TOPG + 512 * 1024;
constexpr size_t WS_ROWG = 4 * MiB + 256 * 1024;
constexpr size_t WS_WGCNT = 4 * MiB + 768 * 1024;
constexpr size_t WS_MOEINFO = WS_WGCNT + 16384;
constexpr size_t WS_GSC = 5 * MiB;
constexpr size_t WS_WIN = 8 * MiB;
constexpr size_t WS_WOUT = 38 * MiB;
constexpr size_t WS_WF13 = 46 * MiB;
constexpr size_t WS_WF2 = 68 * MiB;
constexpr size_t WS_WGLU = 79 * MiB;
constexpr size_t WS_WM13 = 80 * MiB;
constexpr size_t WS_WM2 = 192 * MiB;
constexpr size_t WS_XC = 248 * MiB;
constexpr size_t WS_A = 252 * MiB;
constexpr size_t WS_MIX = WS_A;
constexpr size_t WS_TG = 80 * MiB;
constexpr size_t WS_U = 318 * MiB;
constexpr size_t WS_P = WS_U;
constexpr size_t WS_Y = WS_U;
constexpr size_t WS_OB = 551 * MiB;
constexpr size_t WS_O5 = 650 * MiB;
constexpr size_t WS_S5A2 = WS_O5 + 33 * MiB;
constexpr size_t WS_S5HL = 252 * MiB;
constexpr size_t WS_S5EB = 270 * MiB;
constexpr size_t WS_S5WY = 1035 * MiB;
constexpr size_t WS_GQ = 716 * MiB, WS_GK = WS_GQ + 17 * MiB, WS_GV = WS_GK + 17 * MiB;
constexpr size_t WS_TH = 767 * MiB;
constexpr size_t WS_TR = 899 * MiB;
constexpr size_t WS_DEC = 1031 * MiB;
constexpr size_t WS_HID = 566 * MiB;
constexpr size_t WS_XG = WS_U;
constexpr size_t WS_MHID = 454 * MiB;
constexpr size_t WS_END = 1040 * MiB;
static_assert(WS_MHID + (size_t)MOE_ROWS * FFE * 2 <= WS_END && WS_XG + (size_t)MOE_ROWS * D * 2 <= WS_MHID, "ws map");
static_assert(WS_P + (size_t)R * 3600 * 2 <= WS_OB && WS_OB + (size_t)6 * R * 256 * 2 <= WS_O5 && WS_O5 + (size_t)2 * R * 256 * 4 <= WS_GQ && WS_GV + (size_t)R * 256 * 2 <= WS_TH, "ws map 2");
static_assert(WS_TH + (size_t)4224 * 4 * 8192 <= WS_TR && WS_TR + (size_t)4224 * 4 * 8192 <= WS_DEC && WS_DEC + (size_t)3 * 4224 * 256 <= WS_END && WS_TG + (size_t)4224 * 5 * 8192 <= 248 * MiB, "ws map 3");
static_assert(WS_HID + (size_t)R * FFD * 2 <= WS_END && WS_Y + (size_t)R * D * 4 <= WS_OB, "ws map 4");

constexpr int RING_BYTES = 131072, LDSCTL_OFF = RING_BYTES, LDS_BYTES = 147456;

typedef __bf16 hwbf16x2 __attribute__((ext_vector_type(2)));
__device__ __forceinline__ unsigned pk2(float lo, float hi) { f32x2 v = {lo, hi}; const hwbf16x2 r = __builtin_convertvector(v, hwbf16x2); return __builtin_bit_cast(unsigned, r); }
__device__ __forceinline__ unsigned f2bf(float f) { return pk2(f, 0.f) & 0xffffu; }
__device__ __forceinline__ float bflo(unsigned w) { return __builtin_bit_cast(float, w << 16); }
__device__ __forceinline__ float bfhi(unsigned w) { return __builtin_bit_cast(float, w & 0xffff0000u); }
__device__ __forceinline__ float bf2f(bf16 h) { return __builtin_bit_cast(float, (unsigned)h << 16); }
__device__ __forceinline__ int lane_id_opaque_fwd() { unsigned z; asm volatile("v_mov_b32 %0, 0" : "=v"(z)); return (int)__builtin_amdgcn_mbcnt_hi(~0u, __builtin_amdgcn_mbcnt_lo(~0u, z)); }
__device__ __forceinline__ float shfl_idx(float x, int src) { return __builtin_bit_cast(float, __builtin_amdgcn_ds_bpermute(src << 2, __builtin_bit_cast(int, x))); }
template <int CTRL>
__device__ __forceinline__ float dpp0(float x) { return __builtin_bit_cast(float, __builtin_amdgcn_update_dpp(0, __builtin_bit_cast(int, x), CTRL, 0xf, 0xf, true)); }
__device__ __forceinline__ float sum8(float v) {
    v += dpp0<0xB1>(v); v += dpp0<0x4E>(v); v += dpp0<0x141>(v); return v; }
__device__ __forceinline__ float sum16(float v) {
    v += dpp0<0xB1>(v); v += dpp0<0x4E>(v); v += dpp0<0x141>(v); v += dpp0<0x140>(v); return v; }
__device__ __forceinline__ float wave_sum(float v) {
    v = sum16(v);
    const float a = __builtin_bit_cast(float, __builtin_amdgcn_readlane(__builtin_bit_cast(int, v), 0)), b = __builtin_bit_cast(float, __builtin_amdgcn_readlane(__builtin_bit_cast(int, v), 16));
    const float c = __builtin_bit_cast(float, __builtin_amdgcn_readlane(__builtin_bit_cast(int, v), 32)), d = __builtin_bit_cast(float, __builtin_amdgcn_readlane(__builtin_bit_cast(int, v), 48));
    return (a + b) + (c + d); }
__device__ __forceinline__ float sigmoidf_(float x) { return __builtin_amdgcn_rcpf(1.f + __expf(-x)); }
__device__ __forceinline__ float siluf_(float x) { return x * __builtin_amdgcn_rcpf(1.f + __expf(-x)); }
__device__ __forceinline__ float gelu_tanh(float x) { const float u = 0.7978845608028654f * (x + 0.044715f * x * x * x); const float t = 1.f - 2.f * __builtin_amdgcn_rcpf(__expf(2.f * u) + 1.f); return 0.5f * x * (1.f + t); }
#define LDS_WAIT() asm volatile("s_waitcnt lgkmcnt(0)" ::: "memory")

__device__ __forceinline__ int lane_id_opaque() { unsigned z; asm volatile("v_mov_b32 %0, 0" : "=v"(z)); return (int)__builtin_amdgcn_mbcnt_hi(~0u, __builtin_amdgcn_mbcnt_lo(~0u, z)); }
#define XB_TMO      128
#define XB_XCNT(j)  (256  + 64 * (j))
#define XB_XSUB(j)  (1280 + 64 * (j))
#define XB_XGEN(j)  (2304 + 64 * (j))
#define XB_TOP      3328
#define XB_TOPGEN   3392
#define XCD_BAR_WORDS 3456
#define XB_SPIN_CAP (1u << 18)
__device__ __forceinline__ unsigned xb_ld(GAS unsigned* p)              { return __hip_atomic_load(p, __ATOMIC_RELAXED, __HIP_MEMORY_SCOPE_AGENT); }
__device__ __forceinline__ unsigned xb_add(GAS unsigned* p, unsigned v) { return __hip_atomic_fetch_add(p, v, __ATOMIC_RELAXED, __HIP_MEMORY_SCOPE_AGENT); }
__device__ __forceinline__ unsigned xb_xcc_id() { return (unsigned)__builtin_amdgcn_s_getreg((3 << 11) | 20) & 0xFu; }
#define XB_SPIN(cond, bar) do { unsigned _sp = 0; while (cond) { __builtin_amdgcn_s_sleep(1); \
    if ((++_sp & 255u) == 0u) { if (xb_ld(&(bar)[XB_TMO])) break; if (_sp > XB_SPIN_CAP) { (void)xb_add(&(bar)[XB_TMO], 1u); break; } } } } while (0)
struct XcdBarrier { GAS unsigned* bar; unsigned x; volatile LAS unsigned* st; };
__device__ __forceinline__ bool xb_thread0(int wave_id) { return wave_id == 0 && lane_id_opaque() == 0; }
__device__ __forceinline__ XcdBarrier xcd_barrier_post(GAS unsigned* bar, volatile LAS unsigned* st, int wave_id) {
    XcdBarrier b; b.bar = bar; b.x = xb_xcc_id(); b.st = st;
    if (xb_thread0(wave_id)) (void)xb_add(&bar[XB_XCNT(b.x)], 1u);
    return b;
}
__device__ __forceinline__ void xcd_barrier_complete(GAS unsigned* bar, unsigned x, unsigned& nloc, unsigned& nx) {
    const unsigned G = gridDim.x * gridDim.y * gridDim.z;
    unsigned sum, cnt, mine, sp = 0u;
    for (;;) {
        sum = 0u; cnt = 0u; mine = 0u;
#pragma unroll
        for (unsigned j = 0; j < 16; ++j) { const unsigned c = xb_ld(&bar[XB_XCNT(j)]); sum += c; cnt += (c > 0u) ? 1u : 0u; mine = (j == x) ? c : mine; }
        if (sum == G) break;
        __builtin_amdgcn_s_sleep(1);
        if ((++sp & 255u) == 0u) { if (xb_ld(&bar[XB_TMO])) break; if (sp > XB_SPIN_CAP) { (void)xb_add(&bar[XB_TMO], 1u); break; } }
    }
    nloc = mine > 0u ? mine : 1u; nx = cnt > 0u ? cnt : 1u;
}
__device__ __forceinline__ void xcd_barrier(const XcdBarrier& b, int wave_id) {
    asm volatile("s_waitcnt vmcnt(0)" ::: "memory");
    __syncthreads();
    if (xb_thread0(wave_id)) {
        GAS unsigned* bar = b.bar; asm volatile("" : "+s"(bar));
        __builtin_amdgcn_s_waitcnt(0);
        unsigned nloc = b.st[0], nx = b.st[1];
        if (nloc == 0u) { xcd_barrier_complete(bar, b.x, nloc, nx); b.st[0] = nloc; b.st[1] = nx; }
        const unsigned old = xb_add(&bar[XB_XSUB(b.x)], 1u);
        const unsigned gen = old / nloc;
        if (old + 1u == (gen + 1u) * nloc) {
            __builtin_amdgcn_fence(__ATOMIC_RELEASE, "agent");
            asm volatile("s_waitcnt vmcnt(0)" ::: "memory");
            const unsigned og = xb_add(&bar[XB_TOP], 1u);
            const unsigned tg = og / nx;
            if (og + 1u == (tg + 1u) * nx) xb_add(&bar[XB_TOPGEN], 1u);
            else XB_SPIN(xb_ld(&bar[XB_TOPGEN]) == tg, bar);
            __builtin_amdgcn_fence(__ATOMIC_ACQUIRE, "agent");
            xb_add(&bar[XB_XGEN(b.x)], 1u);
            asm volatile("s_waitcnt vmcnt(0)" ::: "memory");
        } else {
            XB_SPIN(xb_ld(&bar[XB_XGEN(b.x)]) == gen, bar);
            __builtin_amdgcn_fence(__ATOMIC_ACQUIRE, "agent");
            asm volatile("s_waitcnt vmcnt(0)" ::: "memory");
        }
    }
    __syncthreads();
}

namespace pg8 {
constexpr int BM = 256, BK = 64, HALF = 128, HTB = HALF * BK * 2, STAGE_BYTES = 8 * HTB, NXCD = 8, WGM = 4;
__host__ __device__ __forceinline__ int lds_byte(int r, int c) { const int st = (r >> 4) * 2 + (c >> 5), rr = r & 15, cc = c & 31, ob = rr * 64 + cc * 2; return st * 1024 + (ob ^ (((ob >> 9) & 1) << 5)); }
__host__ __device__ __forceinline__ void stage_rc(int b, int& Rr, int& C) { const int st = b / 1024, sb = b % 1024, swz = sb ^ (((sb >> 9) & 1) << 5); Rr = (st >> 1) * 16 + swz / 64; C = (st & 1) * 32 + (swz % 64) / 2; }
__host__ __device__ __forceinline__ int perm32(int rho) { const int n = rho >> 4, i = rho & 15; return 8 * (i >> 2) + 4 * n + (i & 3); }
struct Unit { int pm, pn; size_t aoff, boff; };
struct Gemm { const GAS bf16* A; const GAS bf16* Bt; int K, lda; };

struct StaticOrder {
    int nM, nN, nwg, G, c, K, lda;
    __device__ void init(int nM_, int nN_, int K_, int G_, int c_, int lda_ = 0) { nM = nM_; nN = nN_; nwg = nM * nN; G = G_; K = K_; lda = lda_ ? lda_ : K_; int cc = c_; asm volatile("" : "+s"(cc)); c = cc; }
    __device__ bool map(int i, int& pm, int& pn) const {
        const long L = (long)i * G + c; if (L >= nwg) return false;
        int wgid = (int)L; { const int q = nwg / NXCD, r = nwg % NXCD, xcd = wgid % NXCD, off = wgid / NXCD; wgid = (xcd < r ? xcd * (q + 1) : r * (q + 1) + (xcd - r) * q) + off; }
        const int nig = WGM * nN, gid = wgid / nig, fm = gid * WGM, gsz = (nM - fm) < WGM ? (nM - fm) : WGM;
        pm = fm + ((wgid % nig) % gsz); pn = (wgid % nig) / gsz; return true;
    }
    __device__ bool next(int i, Unit& u) const { if (!map(i, u.pm, u.pn)) return false; u.aoff = (size_t)u.pm * 256 * lda * 2; u.boff = (size_t)u.pn * 256 * K * 2; return true; }
};
struct MoeOrder : StaticOrder {
    const GAS int* texp; size_t estride;
    __device__ bool next(int i, Unit& u) const {
        if (!map(i, u.pm, u.pn)) return false;
        const int e = __builtin_amdgcn_readfirstlane(texp[u.pm]);
        u.aoff = (size_t)u.pm * 256 * lda * 2; u.boff = (size_t)e * estride + (size_t)u.pn * 256 * K * 2; return true;
    }
};
struct S5Order : StaticOrder {
    __device__ bool next(int i, Unit& u) const {
        if (!map(i, u.pm, u.pn)) return false;
        const int g = u.pm / 9, ti = u.pm - g * 9;
        u.aoff = (size_t)(g * 2112 + ti * 256) * lda * 2; u.boff = (size_t)g * 256 * K * 2; return true;
    }
};
typedef __bf16 bf16v2_t __attribute__((ext_vector_type(2)));
__device__ __forceinline__ unsigned cvt_pk_bf16(float lo, float hi) { f32x2 v = {lo, hi}; const bf16v2_t r = __builtin_convertvector(v, bf16v2_t); return __builtin_bit_cast(unsigned, r); }

template <class Epi, class Sched, bool ALIGN_EPI, bool SP2>
__device__ __forceinline__ void gemm_phase(LAS unsigned char* lds, const int wave_id, const Gemm g, const Sched& S, const Epi& E) {
    const int lane = lane_id_opaque();
    const int wid = wave_id, tid = wid * 64 + lane, wr = wid >> 2, wc = wid & 3, fr = lane & 15, fq = lane >> 4;
    int K_ = g.K; asm volatile("" : "+s"(K_));
    const int K = K_, nt = K / BK;
    unsigned voffA, voffB;
    int lda_ = g.lda; asm volatile("" : "+s"(lda_)); const int lda = lda_;
    { int Rr, C; stage_rc(tid * 16, Rr, C); const int Rb = Epi::PERM ? ((Rr & ~31) + perm32(Rr & 31)) : Rr;
        voffA = (unsigned)(Rr * lda + C) * 2u; voffB = (unsigned)(Rb * K + C) * 2u; }
    const size_t qstepB = (size_t)64 * K * 2, qstepA = (size_t)64 * lda * 2;
    const size_t kstep = (size_t)(BK * 2);
    const size_t hstep = (size_t)HALF * K * 2, hstepA = (size_t)HALF * lda * 2;
    const unsigned ldsw = (unsigned)wid * 1024u;
    const int aoff = lds_byte(wr * 64 + fr, fq * 8), boff = lds_byte(wc * 32 + fr, fq * 8);
#define PG8_SA(b, h) (((b) * 2 + (h)) * HTB)
#define PG8_SB(b, h) ((4 + (b) * 2 + (h)) * HTB)
#define PG8_STAGE_(bufoff, gbase, voff, qs) do { _Pragma("unroll") for (int _i = 0; _i < 2; ++_i) \
        __builtin_amdgcn_global_load_lds((const GAS unsigned*)((const char*)(gbase) + _i * (qs) + (voff)), (LAS unsigned*)(lds + (bufoff) + ldsw + _i * 8192), 16, 0, 0); } while (0)
#define PG8_STAGEA(bufoff, gbase) PG8_STAGE_(bufoff, gbase, voffA, qstepA)
#define PG8_STAGEB(bufoff, gbase) PG8_STAGE_(bufoff, gbase, voffB, qstepB)
#define PG8_LDA(dst, b, h) do { _Pragma("unroll") for (int m = 0; m < 4; ++m) _Pragma("unroll") for (int k = 0; k < 2; ++k) dst[m][k] = *(const LAS bf16x8*)(lds + PG8_SA(b, h) + aoff + m * 2048 + k * 1024); } while (0)
#define PG8_LDB(dst, b, h) do { _Pragma("unroll") for (int n = 0; n < 2; ++n) _Pragma("unroll") for (int k = 0; k < 2; ++k) dst[n][k] = *(const LAS bf16x8*)(lds + PG8_SB(b, h) + boff + n * 2048 + k * 1024); } while (0)
#define PG8_MMA(ai, bj, At, Bt) do { __builtin_amdgcn_s_setprio(1); _Pragma("unroll") for (int m = 0; m < 4; ++m) _Pragma("unroll") for (int n = 0; n < 2; ++n) _Pragma("unroll") for (int k = 0; k < 2; ++k) \
        acc[ai][bj][m][n] = __builtin_amdgcn_mfma_f32_16x16x32_bf16(Bt[n][k], At[m][k], acc[ai][bj][m][n], 0, 0, 0); __builtin_amdgcn_s_setprio(0); } while (0)
#define PG8_WAIT_V(n) asm volatile("s_waitcnt vmcnt(" #n ")" ::: "memory")
#define PG8_WAIT_L(n) asm volatile("s_waitcnt lgkmcnt(" #n ")" ::: "memory")
#define PG8_BAR __builtin_amdgcn_s_barrier()
#define PG8_SCHED __builtin_amdgcn_sched_barrier(0)
    Unit cur, nxt; int ui = 0;
    if (!S.next(0, cur)) return;
    f32x4 acc[2][2][4][2];
#pragma unroll
    for (int a = 0; a < 2; ++a)
#pragma unroll
        for (int b = 0; b < 2; ++b)
#pragma unroll
            for (int m = 0; m < 4; ++m)
#pragma unroll
                for (int n = 0; n < 2; ++n) acc[a][b][m][n] = (f32x4){0.f, 0.f, 0.f, 0.f};
    bf16x8 At[4][2], B0[2][2], B1[2][2];
    const char* cA = (const char*)g.A + cur.aoff; const char* cB = (const char*)g.Bt + cur.boff;
    if constexpr (SP2) {
        PG8_STAGEB(PG8_SB(0, 0), cB); PG8_STAGEB(PG8_SB(0, 1), cB + hstep); PG8_STAGEA(PG8_SA(0, 0), cA); PG8_STAGEA(PG8_SA(0, 1), cA + hstepA);
        if (wr == 1) PG8_BAR;
        PG8_WAIT_V(2); PG8_BAR;
        PG8_STAGEB(PG8_SB(1, 0), cB + kstep); PG8_STAGEA(PG8_SA(1, 0), cA + kstep); PG8_STAGEB(PG8_SB(1, 1), cB + hstep + kstep);
        PG8_WAIT_V(6); PG8_BAR;
    } else {
        PG8_STAGEB(PG8_SB(0, 0), cB); PG8_STAGEA(PG8_SA(0, 0), cA); PG8_STAGEB(PG8_SB(0, 1), cB + hstep); PG8_STAGEA(PG8_SA(0, 1), cA + hstepA);
        if (wr == 1) PG8_BAR;
        PG8_WAIT_V(4); PG8_BAR;
        PG8_STAGEB(PG8_SB(1, 0), cB + kstep); PG8_STAGEA(PG8_SA(1, 0), cA + kstep); PG8_STAGEB(PG8_SB(1, 1), cB + hstep + kstep);
        PG8_WAIT_V(6); PG8_BAR;
    }
    for (;;) {
        const bool has_next = S.next(ui + 1, nxt);
        const char* nA = has_next ? (const char*)g.A + nxt.aoff : cA; const char* nB = has_next ? (const char*)g.Bt + nxt.boff : cB;
        for (int t = 0; t < nt; t += 2) {
            const bool last = (t == nt - 2);
            const char* a1 = cA + (size_t)(t + 1) * kstep;
            const char* a2 = last ? nA : cA + (size_t)(t + 2) * kstep; const char* b2 = last ? nB : cB + (size_t)(t + 2) * kstep;
            const char* a3 = a2 + kstep; const char* b3 = b2 + kstep;
            if constexpr (SP2) {
            PG8_LDB(B0, 0, 0); PG8_LDB(B1, 0, 1); PG8_SCHED; PG8_LDA(At, 0, 0); PG8_STAGEA(PG8_SA(1, 1), a1 + hstepA);
            PG8_WAIT_V(8); PG8_WAIT_L(0); PG8_BAR; PG8_MMA(0, 0, At, B0); PG8_MMA(0, 1, At, B1); PG8_BAR; PG8_SCHED;
            PG8_LDA(At, 0, 1); PG8_STAGEB(PG8_SB(0, 0), b2); PG8_STAGEB(PG8_SB(0, 1), b2 + hstep); PG8_STAGEA(PG8_SA(0, 0), a2);
            PG8_WAIT_V(8); PG8_WAIT_L(0); PG8_BAR; PG8_MMA(1, 0, At, B0); PG8_MMA(1, 1, At, B1); PG8_BAR; PG8_SCHED;
            PG8_LDB(B0, 1, 0); PG8_LDB(B1, 1, 1); PG8_SCHED; PG8_LDA(At, 1, 0); PG8_STAGEA(PG8_SA(0, 1), a2 + hstepA);
            PG8_WAIT_V(8); PG8_WAIT_L(0); PG8_BAR; PG8_MMA(0, 0, At, B0); PG8_MMA(0, 1, At, B1); PG8_BAR; PG8_SCHED;
            PG8_LDA(At, 1, 1); PG8_STAGEB(PG8_SB(1, 0), b3); PG8_STAGEB(PG8_SB(1, 1), b3 + hstep); PG8_STAGEA(PG8_SA(1, 0), a3);
            PG8_WAIT_V(8); PG8_WAIT_L(0); PG8_BAR; PG8_MMA(1, 0, At, B0); PG8_MMA(1, 1, At, B1); PG8_BAR; PG8_SCHED;
            } else {
            PG8_LDB(B0, 0, 0); PG8_SCHED; PG8_LDA(At, 0, 0); PG8_STAGEA(PG8_SA(1, 1), a1 + hstepA);
            PG8_WAIT_L(8); PG8_BAR; PG8_WAIT_L(0); PG8_MMA(0, 0, At, B0); PG8_BAR; PG8_SCHED;
            PG8_LDB(B1, 0, 1); PG8_STAGEB(PG8_SB(0, 0), b2);
            PG8_BAR; PG8_WAIT_L(0); PG8_MMA(0, 1, At, B1); PG8_BAR;
            PG8_LDA(At, 0, 1); PG8_STAGEA(PG8_SA(0, 0), a2);
            PG8_BAR; PG8_WAIT_L(0); PG8_MMA(1, 0, At, B0); PG8_BAR; PG8_SCHED;
            PG8_STAGEB(PG8_SB(0, 1), b2 + hstep);
            PG8_WAIT_V(6); PG8_BAR; PG8_MMA(1, 1, At, B1); PG8_BAR;
            PG8_LDB(B0, 1, 0); PG8_SCHED; PG8_LDA(At, 1, 0); PG8_STAGEA(PG8_SA(0, 1), a2 + hstepA);
            PG8_WAIT_L(8); PG8_BAR; PG8_WAIT_L(0); PG8_MMA(0, 0, At, B0); PG8_BAR; PG8_SCHED;
            PG8_LDB(B1, 1, 1); PG8_STAGEB(PG8_SB(1, 0), b3);
            PG8_BAR; PG8_WAIT_L(0); PG8_MMA(0, 1, At, B1); PG8_BAR;
            PG8_LDA(At, 1, 1); PG8_STAGEA(PG8_SA(1, 0), a3);
            PG8_BAR; PG8_WAIT_L(0); PG8_MMA(1, 0, At, B0); PG8_BAR; PG8_SCHED;
            PG8_STAGEB(PG8_SB(1, 1), b3 + hstep);
            PG8_WAIT_V(6); PG8_BAR; PG8_MMA(1, 1, At, B1); PG8_BAR;
            }
        }
        if constexpr (ALIGN_EPI) { if (wr == 0) PG8_BAR; }
        { const int l2 = lane_id_opaque(); E(acc, cur, wr, wc, l2 & 15, l2 >> 4); }
        if (!has_next) break;
#pragma unroll
        for (int a = 0; a < 2; ++a)
#pragma unroll
            for (int b = 0; b < 2; ++b)
#pragma unroll
                for (int m = 0; m < 4; ++m)
#pragma unroll
                    for (int n = 0; n < 2; ++n) acc[a][b][m][n] = (f32x4){0.f, 0.f, 0.f, 0.f};
        cur = nxt; cA = nA; cB = nB; ++ui;
        if constexpr (ALIGN_EPI) { if (wr == 1) PG8_BAR; }
    }
    PG8_WAIT_V(0);
    if constexpr (!ALIGN_EPI) { if (wr == 0) PG8_BAR; }
    PG8_BAR;
#undef PG8_SA
#undef PG8_SB
#undef PG8_STAGE_
#undef PG8_STAGEA
#undef PG8_STAGEB
#undef PG8_LDA
#undef PG8_LDB
#undef PG8_MMA
#undef PG8_WAIT_V
#undef PG8_WAIT_L
#undef PG8_BAR
#undef PG8_SCHED
}

struct EpiBf16 {
    static constexpr bool PERM = true;
    GAS bf16* O; int ldc, ncols;
    __device__ __forceinline__ void operator()(const f32x4 (&acc)[2][2][4][2], const Unit& u, int wr, int wc, int fr, int fq) const {
        const int row0 = u.pm * BM + wr * 64 + fr, col0 = u.pn * BM + wc * 32 + 8 * fq;
#pragma unroll
        for (int ai = 0; ai < 2; ++ai)
#pragma unroll
            for (int m = 0; m < 4; ++m) { GAS bf16* rowp = O + (size_t)(row0 + ai * HALF + m * 16) * ldc + col0; asm volatile("" ::: "memory");
#pragma unroll
                for (int bj = 0; bj < 2; ++bj) { const f32x4 v0 = acc[ai][bj][m][0], v1 = acc[ai][bj][m][1];
                    v4u w; w.x = cvt_pk_bf16(v0[0], v0[1]); w.y = cvt_pk_bf16(v0[2], v0[3]); w.z = cvt_pk_bf16(v1[0], v1[1]); w.w = cvt_pk_bf16(v1[2], v1[3]);
                    if (col0 + bj * HALF < ncols) *(GAS v4u*)(rowp + bj * HALF) = w; } }
    }
};
struct EpiSwiGlu {
    static constexpr bool PERM = true;
    GAS bf16* O; int ldc;
    __device__ __forceinline__ void operator()(const f32x4 (&acc)[2][2][4][2], const Unit& u, int wr, int wc, int fr, int fq) const {
        const int row0 = u.pm * BM + wr * 64 + fr, col0 = u.pn * HALF + wc * 32 + 8 * fq;
#pragma unroll
        for (int ai = 0; ai < 2; ++ai)
#pragma unroll
            for (int m = 0; m < 4; ++m) { GAS bf16* rowp = O + (size_t)(row0 + ai * HALF + m * 16) * ldc + col0; asm volatile("" ::: "memory");
                float h[8];
#pragma unroll
                for (int n = 0; n < 2; ++n)
#pragma unroll
                    for (int i = 0; i < 4; ++i) { const float a = acc[ai][0][m][n][i], b = acc[ai][1][m][n][i]; h[n * 4 + i] = a * b * __builtin_amdgcn_rcpf(1.f + __expf(-a)); }
                v4u w; w.x = cvt_pk_bf16(h[0], h[1]); w.y = cvt_pk_bf16(h[2], h[3]); w.z = cvt_pk_bf16(h[4], h[5]); w.w = cvt_pk_bf16(h[6], h[7]);
                *(GAS v4u*)rowp = w; }
    }
};
struct EpiRes {
    static constexpr bool PERM = true;
    GAS bf16* DL; const GAS float* mod; int goff;
    __device__ __forceinline__ void operator()(const f32x4 (&acc)[2][2][4][2], const Unit& u, int wr, int wc, int fr, int fq) const {
        const int row0 = u.pm * BM + wr * 64 + fr, col0 = u.pn * BM + wc * 32 + 8 * fq;
        const int s = u.pm < 128 ? (u.pm >> 5) : 4;
        const GAS float* gp = mod + s * 6144 + goff + col0;
        f32x4 gv[2][2];
#pragma unroll
        for (int bj = 0; bj < 2; ++bj)
#pragma unroll
            for (int n = 0; n < 2; ++n) gv[bj][n] = *(const GAS f32x4*)(gp + bj * HALF + n * 4);
#pragma unroll
        for (int ai = 0; ai < 2; ++ai)
#pragma unroll
            for (int m = 0; m < 4; ++m) { GAS bf16* rowp = DL + (size_t)(row0 + ai * HALF + m * 16) * D + col0; asm volatile("" ::: "memory");
#pragma unroll
                for (int bj = 0; bj < 2; ++bj) { const f32x4 v0 = gv[bj][0] * acc[ai][bj][m][0], v1 = gv[bj][1] * acc[ai][bj][m][1];
                    v4u w; w.x = cvt_pk_bf16(v0[0], v0[1]); w.y = cvt_pk_bf16(v0[2], v0[3]); w.z = cvt_pk_bf16(v1[0], v1[1]); w.w = cvt_pk_bf16(v1[2], v1[3]);
                    *(GAS v4u*)(rowp + bj * HALF) = w; } }
    }
};
struct EpiGlu {
    static constexpr bool PERM = true;
    GAS bf16* MIX; const GAS float* ya; const GAS float* gb;
    __device__ __forceinline__ void operator()(const f32x4 (&acc)[2][2][4][2], const Unit& u, int wr, int wc, int fr, int fq) const {
        const int row0 = u.pm * BM + wr * 64 + fr, col0 = wc * 32 + 8 * fq;
#pragma unroll
        for (int ai = 0; ai < 2; ++ai)
#pragma unroll
            for (int m = 0; m < 4; ++m) { const int row = row0 + ai * HALF + m * 16; asm volatile("" ::: "memory");
#pragma unroll
                for (int bj = 0; bj < 2; ++bj) { const int c = col0 + bj * HALF;
                    const f32x4 y0 = *(const GAS f32x4*)(ya + (size_t)row * 256 + c), y1 = *(const GAS f32x4*)(ya + (size_t)row * 256 + c + 4);
                    const f32x4 b0 = *(const GAS f32x4*)(gb + c), b1 = *(const GAS f32x4*)(gb + c + 4);
                    float o[8];
#pragma unroll
                    for (int i = 0; i < 4; ++i) { o[i] = y0[i] * sigmoidf_(acc[ai][bj][m][0][i] + b0[i]); o[4 + i] = y1[i] * sigmoidf_(acc[ai][bj][m][1][i] + b1[i]); }
                    v4u w; w.x = cvt_pk_bf16(o[0], o[1]); w.y = cvt_pk_bf16(o[2], o[3]); w.z = cvt_pk_bf16(o[4], o[5]); w.w = cvt_pk_bf16(o[6], o[7]);
                    *(GAS v4u*)(MIX + (size_t)row * D + 256 + c) = w; } }
    }
};
struct EpiMoeDown {
    static constexpr bool PERM = true;
    GAS bf16* O; const GAS float* rowg;
    __device__ __forceinline__ void operator()(const f32x4 (&acc)[2][2][4][2], const Unit& u, int wr, int wc, int fr, int fq) const {
        const int row0 = u.pm * BM + wr * 64 + fr, col0 = u.pn * BM + wc * 32 + 8 * fq;
#pragma unroll
        for (int ai = 0; ai < 2; ++ai)
#pragma unroll
            for (int m = 0; m < 4; ++m) { asm volatile("" ::: "memory"); const int row = row0 + ai * HALF + m * 16; const float gte = rowg[row]; GAS bf16* rowp = O + (size_t)row * D + col0;
#pragma unroll
                for (int bj = 0; bj < 2; ++bj) { const f32x4 v0 = acc[ai][bj][m][0] * gte, v1 = acc[ai][bj][m][1] * gte;
                    v4u w; w.x = cvt_pk_bf16(v0[0], v0[1]); w.y = cvt_pk_bf16(v0[2], v0[3]); w.z = cvt_pk_bf16(v1[0], v1[1]); w.w = cvt_pk_bf16(v1[2], v1[3]);
                    *(GAS v4u*)(rowp + bj * HALF) = w; } }
    }
};

struct EpiS5HL {
    static constexpr bool PERM = true;
    GAS bf16* O;
    __device__ __forceinline__ void operator()(const f32x4 (&acc)[2][2][4][2], const Unit& u, int wr, int wc, int fr, int fq) const {
        const int g = u.pm / 9, ti = u.pm - g * 9, lr0 = ti * 256 + wr * 64 + fr, col0 = wc * 32 + 8 * fq;
#pragma unroll
        for (int ai = 0; ai < 2; ++ai)
#pragma unroll
            for (int m = 0; m < 4; ++m) { const int lr = lr0 + ai * HALF + m * 16; GAS bf16* rowp = O + (size_t)(g * 2112 + lr) * 256 + col0; asm volatile("" ::: "memory");
#pragma unroll
                for (int bj = 0; bj < 2; ++bj) { const f32x4 v0 = acc[ai][bj][m][0], v1 = acc[ai][bj][m][1];
                    v4u w; w.x = cvt_pk_bf16(v0[0], v0[1]); w.y = cvt_pk_bf16(v0[2], v0[3]); w.z = cvt_pk_bf16(v1[0], v1[1]); w.w = cvt_pk_bf16(v1[2], v1[3]);
                    if (lr < 2112) *(GAS v4u*)(rowp + bj * HALF) = w; } }
    }
};
struct EpiS5Y {
    static constexpr bool PERM = true;
    GAS bf16* YA; GAS float* Y32; const GAS bf16* P; const GAS float* dsk;
    __device__ __forceinline__ void operator()(const f32x4 (&acc)[2][2][4][2], const Unit& u, int wr, int wc, int fr, int fq) const {
        const int g = u.pm / 9, ti = u.pm - g * 9, lr0 = ti * 256 + wr * 64 + fr;
#pragma unroll
        for (int ai = 0; ai < 2; ++ai)
#pragma unroll
            for (int m = 0; m < 4; ++m) { const int lr = lr0 + ai * HALF + m * 16; asm volatile("" ::: "memory");
                if (lr < 2112) { const int b = lr / 528, sc = lr - b * 528; const int r0 = sc < 16 ? NLAT + b * CTXL + sc * 16 : b * SEQ + (sc - 16) * 16;
#pragma unroll
                    for (int bj = 0; bj < 2; ++bj) { const int n = bj * HALF + wc * 32 + 8 * fq, t = n >> 4, c0 = g * 16 + (n & 15); const size_t row = (size_t)(r0 + t);
                        const v4u uw = *(const GAS v4u*)(P + row * DPP + PC_S5U + c0); const f32x4 d0 = *(const GAS f32x4*)(dsk + c0), d1 = *(const GAS f32x4*)(dsk + c0 + 4);
                        const float uu[8] = {bflo(uw.x), bfhi(uw.x), bflo(uw.y), bfhi(uw.y), bflo(uw.z), bfhi(uw.z), bflo(uw.w), bfhi(uw.w)};
                        f32x4 y0, y1;
#pragma unroll
                        for (int i = 0; i < 4; ++i) { y0[i] = gelu_tanh(acc[ai][bj][m][0][i] + d0[i] * uu[i]); y1[i] = gelu_tanh(acc[ai][bj][m][1][i] + d1[i] * uu[4 + i]); }
                        *(GAS f32x4*)(Y32 + row * 256 + c0) = y0; *(GAS f32x4*)(Y32 + row * 256 + c0 + 4) = y1;
                        v4u w; w.x = cvt_pk_bf16(y0[0], y0[1]); w.y = cvt_pk_bf16(y0[2], y0[3]); w.z = cvt_pk_bf16(y1[0], y1[1]); w.w = cvt_pk_bf16(y1[2], y1[3]);
                        *(GAS v4u*)(YA + row * 256 + c0) = w; } } }
    }
};
}

struct Args { const float* in[34]; float* out; unsigned char* ws; int ph_lo, ph_hi; };
struct Frame {
    LAS unsigned char* lds;
    int tid, lane, wave, G, bid;
};
typedef const __attribute__((address_space(4))) unsigned long long* kaptr_t;
__device__ __forceinline__ unsigned long long karg(int i) { kaptr_t ka = (kaptr_t)__builtin_amdgcn_kernarg_segment_ptr(); asm volatile("" : "+s"(ka)); return ka[i]; }
__device__ __forceinline__ const GAS float* inp(int i) { return (const GAS float*)karg(i); }
__device__ __forceinline__ GAS float* outp() { return (GAS float*)karg(34); }
__device__ __forceinline__ GAS unsigned char* wsp() { return (GAS unsigned char*)karg(35); }
enum { I_X = 0, I_C, I_CTX, I_CCTX, I_ADAW, I_ADAB, I_WIN, I_WOUT, I_LNG, I_LNB, I_GCONV, I_GALOG, I_GDTB, I_GNW, I_S5ARE, I_S5AIM, I_S5LS, I_S5BRE, I_S5BIM, I_S5CRE, I_S5CIM,
       I_S5D, I_S5GLUW, I_S5GLUB, I_HLB, I_HNW, I_RDEC, I_FW1, I_FW3, I_FW2, I_MROUTER, I_MW1, I_MW3, I_MW2 };

__device__ __forceinline__ void frame_refresh(Frame& F) { const int ln = lane_id_opaque(); int w = F.wave, b = F.bid; asm volatile("" : "+s"(w), "+s"(b)); F.wave = w; F.bid = b; F.lane = ln; F.tid = w * 64 + ln; }
__device__ __forceinline__ int row_slot(int row) { return row < NLAT ? (row >> 13) : 4; }

__device__ __forceinline__ void transpose_item(const GAS float* W, int K, int N, GAS bf16* WT, int mode, LAS float* scr, int item, int lane) {
    const int nblk = (N + 31) / 32, kb = item / nblk, nb = item % nblk, k0 = 64 * kb, n0 = 32 * nb;
    const int nn = n0 + 4 * (lane & 7), kr = lane >> 3;
    f32x4 v[8];
#pragma unroll
    for (int i = 0; i < 8; ++i) v[i] = (nn < N) ? *(const GAS f32x4*)(W + (size_t)(k0 + 8 * i + kr) * N + nn) : (f32x4){0.f, 0.f, 0.f, 0.f};
#pragma unroll
    for (int i = 0; i < 8; ++i) { LAS float* d = scr + (8 * i + kr) * 33 + 4 * (lane & 7); d[0] = v[i][0]; d[1] = v[i][1]; d[2] = v[i][2]; d[3] = v[i][3]; }
    LDS_WAIT(); asm volatile("" ::: "memory");
    const int c = lane & 7;
#pragma unroll
    for (int j = 0; j < 4; ++j) { const int nl = (lane >> 3) + 8 * j; const int n = n0 + nl; const LAS float* s = scr + (8 * c) * 33 + nl;
        v4u o; o.x = pk2(s[0 * 33], s[1 * 33]); o.y = pk2(s[2 * 33], s[3 * 33]); o.z = pk2(s[4 * 33], s[5 * 33]); o.w = pk2(s[6 * 33], s[7 * 33]);
        const int nr = mode == 0 ? n : ((n >> 7) * 256 + (n & 127) + (mode == 2 ? 128 : 0));
        if (n < N) *(GAS v4u*)(WT + (size_t)nr * K + k0 + 8 * c) = o; }
    LDS_WAIT(); asm volatile("" ::: "memory");
}

__device__ __forceinline__ void phase_prologue(Frame& F) {
    frame_refresh(F); GAS unsigned char* const ws = wsp();
    LAS float* scv = (LAS float*)F.lds;
    LAS float* part = (LAS float*)(F.lds + 20480);
    for (int i = F.tid; i < 5 * 1024; i += 512) { const int s = i >> 10, k = i & 1023; const float c = s < 4 ? inp(I_C)[s * 1024 + k] : inp(I_CCTX)[k]; scv[i] = siluf_(c); }
    __syncthreads();
    GAS float* MOD = (GAS float*)(ws + WS_MOD);
    for (int it = F.bid; it < 4 * 96; it += F.G) {
        const int l = it / 96, n0 = (it % 96) * 64;
        const GAS float* w = inp(I_ADAW) + (size_t)l * 1024 * 6144 + n0 + F.lane;
        float a0 = 0.f, a1 = 0.f, a2 = 0.f, a3 = 0.f, a4 = 0.f;
        const int kb = F.wave * 128;
#pragma unroll 8
        for (int k = 0; k < 128; ++k) { const float wv = w[(size_t)(kb + k) * 6144];
            a0 += scv[kb + k] * wv; a1 += scv[1024 + kb + k] * wv; a2 += scv[2048 + kb + k] * wv; a3 += scv[3072 + kb + k] * wv; a4 += scv[4096 + kb + k] * wv; }
        part[(F.wave * 5 + 0) * 64 + F.lane] = a0; part[(F.wave * 5 + 1) * 64 + F.lane] = a1; part[(F.wave * 5 + 2) * 64 + F.lane] = a2; part[(F.wave * 5 + 3) * 64 + F.lane] = a3; part[(F.wave * 5 + 4) * 64 + F.lane] = a4;
        __syncthreads();
        if (F.tid < 320) { const int s = F.tid >> 6, n = F.tid & 63; float v = inp(I_ADAB)[l * 6144 + n0 + n];
#pragma unroll
            for (int w8 = 0; w8 < 8; ++w8) v += part[(w8 * 5 + s) * 64 + n];
            MOD[(size_t)(l * 5 + s) * 6144 + n0 + n] = v; }
        __syncthreads();
    }
    const int gt = F.bid * 512 + F.tid, NT = F.G * 512;
    GAS float* LB = (GAS float*)(ws + WS_LB);
    for (int i = gt; i < 256; i += NT) {
        float v[4], mx = -1e30f; for (int l = 0; l < 4; ++l) { v[l] = inp(I_HLB)[l * 256 + i]; mx = fmaxf(mx, v[l]); }
        float s = 0.f; for (int l = 0; l < 4; ++l) { v[l] = expf(v[l] - mx); s += v[l]; }
        float cum = 0.f, first = 0.f; for (int l = 0; l < 4; ++l) { cum += v[l] / s; if (l == 0) first = cum; LB[l * 256 + i] = cum - first; }
    }
    GAS float* ROT = (GAS float*)(ws + WS_ROT);
    for (int i = gt; i < 192 * 16; i += NT) { const int pos = i >> 4, q = i & 15; const float p = (float)(pos < 128 ? pos : pos - 128);
        const float invf = expf(-(float)q * (9.210340371976184f / 16.f)); const float ang = p * invf; ROT[i * 2] = cosf(ang); ROT[i * 2 + 1] = sinf(ang); }
    GAS float* LAM = (GAS float*)(ws + WS_S5LAM); GAS float* BB = (GAS float*)(ws + WS_S5B);
    for (int i = gt; i < 4 * 2 * 16 * 64; i += NT) {
        const int ldg = i >> 6;
        const float are = inp(I_S5ARE)[i], aim = inp(I_S5AIM)[i], st = expf(inp(I_S5LS)[ldg]);
        const float x = are * st, y = aim * st, ex = expf(x), cy = cosf(y), sy = sinf(y), sh = sinf(0.5f * y);
        LAM[i * 2] = ex * cy; LAM[i * 2 + 1] = ex * sy;
        const float er = expm1f(x) * cy - 2.f * sh * sh, ei = ex * sy;
        const float den = are * are + aim * aim; const float qr = (er * are + ei * aim) / den, qi = (ei * are - er * aim) / den;
        for (int c = 0; c < 16; ++c) { const float br = inp(I_S5BRE)[(size_t)i * 16 + c], bi = inp(I_S5BIM)[(size_t)i * 16 + c];
            BB[((size_t)i * 16 + c) * 2] = qr * br - qi * bi; BB[((size_t)i * 16 + c) * 2 + 1] = qr * bi + qi * br; }
    }
    LAS float* scr = (LAS float*)(F.lds + 32768 + F.wave * 8704);
    __syncthreads();
    const int gw = F.bid * 8 + F.wave, NGW = F.G * 8;
    constexpr int I_IN = 16 * 113, I_OUT = 16 * 32, I_GLU = 4 * 8, I_F1 = 16 * 88, I_F2 = 44 * 32;
    constexpr int PER_L = I_IN + I_OUT + I_GLU, TOT = 4 * PER_L + 2 * (2 * I_F1 + I_F2);
    for (int it = gw; it < TOT; it += NGW) {
        int r = it;
        if (r < 4 * PER_L) { const int l = r / PER_L; r -= l * PER_L;
            if (r < I_IN) { transpose_item(inp(I_WIN) + (size_t)l * D * DPROJ, D, DPROJ, (GAS bf16*)(ws + WS_WIN) + (size_t)l * DPW * D, 0, scr, r, F.lane); continue; } r -= I_IN;
            if (r < I_OUT) { transpose_item(inp(I_WOUT) + (size_t)l * D * D, D, D, (GAS bf16*)(ws + WS_WOUT) + (size_t)l * D * D, 0, scr, r, F.lane); continue; } r -= I_OUT;
            transpose_item(inp(I_S5GLUW) + (size_t)l * 65536, 256, 256, (GAS bf16*)(ws + WS_WGLU) + (size_t)l * 65536, 0, scr, r, F.lane); continue; }
        r -= 4 * PER_L;
        const int j = r / (2 * I_F1 + I_F2); r -= j * (2 * I_F1 + I_F2);
        if (r < I_F1) { transpose_item(inp(I_FW1) + (size_t)j * D * FFD, D, FFD, (GAS bf16*)(ws + WS_WF13) + (size_t)j * 2 * FFD * D, 1, scr, r, F.lane); continue; } r -= I_F1;
        if (r < I_F1) { transpose_item(inp(I_FW3) + (size_t)j * D * FFD, D, FFD, (GAS bf16*)(ws + WS_WF13) + (size_t)j * 2 * FFD * D, 2, scr, r, F.lane); continue; } r -= I_F1;
        transpose_item(inp(I_FW2) + (size_t)j * FFD * D, FFD, D, (GAS bf16*)(ws + WS_WF2) + (size_t)j * D * FFD, 0, scr, r, F.lane);
    }
}
__device__ __forceinline__ void tr_load(const GAS float* W, int N, int item, int lane, f32x4 (&v)[8]) {
    const int nblk = (N + 31) / 32, kb = item / nblk, nb = item % nblk, k0 = 64 * kb, n0 = 32 * nb;
    const int nn = n0 + 4 * (lane & 7), kr = lane >> 3;
#pragma unroll
    for (int i = 0; i < 8; ++i) v[i] = (nn < N) ? *(const GAS f32x4*)(W + (size_t)(k0 + 8 * i + kr) * N + nn) : (f32x4){0.f, 0.f, 0.f, 0.f};
}
__device__ __forceinline__ void tr_store(int K, int N, GAS bf16* WT, int mode, LAS float* scr, int item, int lane, const f32x4 (&v)[8]) {
    const int nblk = (N + 31) / 32, kb = item / nblk, nb = item % nblk, k0 = 64 * kb, n0 = 32 * nb;
    const int kr = lane >> 3;
#pragma unroll
    for (int i = 0; i < 8; ++i) { LAS float* d = scr + (8 * i + kr) * 33 + 4 * (lane & 7); d[0] = v[i][0]; d[1] = v[i][1]; d[2] = v[i][2]; d[3] = v[i][3]; }
    LDS_WAIT(); asm volatile("" ::: "memory");
    const int c = lane & 7;
#pragma unroll
    for (int j = 0; j < 4; ++j) { const int nl = (lane >> 3) + 8 * j; const int n = n0 + nl; const LAS float* s = scr + (8 * c) * 33 + nl;
        v4u o; o.x = pk2(s[0 * 33], s[1 * 33]); o.y = pk2(s[2 * 33], s[3 * 33]); o.z = pk2(s[4 * 33], s[5 * 33]); o.w = pk2(s[6 * 33], s[7 * 33]);
        const int nr = mode == 0 ? n : ((n >> 7) * 256 + (n & 127) + (mode == 2 ? 128 : 0));
        if (n < N) *(GAS v4u*)(WT + (size_t)nr * K + k0 + 8 * c) = o; }
    LDS_WAIT(); asm volatile("" ::: "memory");
}
__device__ __forceinline__ void phase_moe_convert(Frame& F, int j) {
    frame_refresh(F); GAS unsigned char* const ws = wsp();
    LAS float* scr = (LAS float*)(F.lds + F.wave * 8704);
    const int gw = F.bid * 8 + F.wave, NGW = F.G * 8;
    constexpr int I_1 = 16 * 112, I_2 = 56 * 32, PER_E = 2 * I_1 + I_2;
    struct TI { const GAS float* W; GAS bf16* WT; int K, N, mode, item; };
    auto decode = [&](int it, TI& t) {
        const int e = it / PER_E; int r = it - e * PER_E;
        const size_t wo = ((size_t)j * 8 + e) * D * FFE;
        if (r < I_1) { t.W = inp(I_MW1) + wo; t.K = D; t.N = FFE; t.WT = (GAS bf16*)(ws + WS_WM13) + (size_t)e * 2 * FFE * D; t.mode = 1; t.item = r; return; } r -= I_1;
        if (r < I_1) { t.W = inp(I_MW3) + wo; t.K = D; t.N = FFE; t.WT = (GAS bf16*)(ws + WS_WM13) + (size_t)e * 2 * FFE * D; t.mode = 2; t.item = r; return; } r -= I_1;
        t.W = inp(I_MW2) + wo; t.K = FFE; t.N = D; t.WT = (GAS bf16*)(ws + WS_WM2) + (size_t)e * D * FFE; t.mode = 0; t.item = r; };
    int it = gw; if (it >= 8 * PER_E) return;
    const int lane = F.lane;
    TI cur; decode(it, cur); f32x4 v[8]; tr_load(cur.W, cur.N, cur.item, lane, v);
    for (;;) {
        const int itn = it + NGW; const bool more = itn < 8 * PER_E;
        TI nxt = cur; f32x4 w[8];
        if (more) { decode(itn, nxt); tr_load(nxt.W, nxt.N, nxt.item, lane, w); }
        tr_store(cur.K, cur.N, cur.WT, cur.mode, scr, cur.item, lane, v);
        if (!more) break;
        cur = nxt; it = itn;
#pragma unroll
        for (int i = 0; i < 8; ++i) v[i] = w[i];
    }
}

__device__ __forceinline__ const GAS float* xrow_src(const GAS float* xl, const GAS float* xc, int row) { return row < NLAT ? xl + (size_t)row * D : xc + (size_t)(row - NLAT) * D; }
__device__ __forceinline__ GAS float* xrow_dst(GAS float* xl, GAS float* xc, int row) { return row < NLAT ? xl + (size_t)row * D : xc + (size_t)(row - NLAT) * D; }

__device__ __forceinline__ void store_A_row(GAS bf16* Ab, int lane_, int row, const f32x4 (&v)[4], const GAS float* modrow, int shoff, int scoff) {
    GAS bf16* ar = Ab + (size_t)row * D;
#pragma unroll
    for (int j = 0; j < 4; ++j) { const int c = 4 * lane_ + 256 * j; const f32x4 sh = *(const GAS f32x4*)(modrow + shoff + c), sc = *(const GAS f32x4*)(modrow + scoff + c);
        const f32x4 h = v[j] * (sc + 1.f) + sh; v2u w; w.x = pk2(h[0], h[1]); w.y = pk2(h[2], h[3]); *(GAS v2u*)(ar + c) = w; }
}
__device__ __forceinline__ void store_A_rowh(GAS bf16* Ab, int lane_, int row, const f32x4 (&v)[4], const f32x4 (&sh)[4], const f32x4 (&sc)[4]) {
    GAS bf16* ar = Ab + (size_t)row * D;
#pragma unroll
    for (int j = 0; j < 4; ++j) { const int c = 4 * lane_ + 256 * j; const f32x4 h = v[j] * (sc[j] + 1.f) + sh[j]; v2u w; w.x = pk2(h[0], h[1]); w.y = pk2(h[2], h[3]); *(GAS v2u*)(ar + c) = w; }
}
__device__ __forceinline__ int cb8(int lane_, int k) { return 8 * lane_ + 512 * (k >> 1) + 4 * (k & 1); }
__device__ __forceinline__ void store_A_rowh8(GAS bf16* Ab, int lane_, int row, const f32x4 (&v)[4], const f32x4 (&sh)[4], const f32x4 (&sc)[4]) {
    GAS bf16* ar = Ab + (size_t)row * D;
#pragma unroll
    for (int jp = 0; jp < 2; ++jp) { const f32x4 h0 = v[2 * jp] * (sc[2 * jp] + 1.f) + sh[2 * jp], h1 = v[2 * jp + 1] * (sc[2 * jp + 1] + 1.f) + sh[2 * jp + 1];
        v4u w; w.x = pk2(h0[0], h0[1]); w.y = pk2(h0[2], h0[3]); w.z = pk2(h1[0], h1[1]); w.w = pk2(h1[2], h1[3]); *(GAS v4u*)(ar + 8 * lane_ + 512 * jp) = w; }
}
__device__ __forceinline__ void store_A_row8(GAS bf16* Ab, int lane_, int row, const f32x4 (&v)[4], const GAS float* modrow, int shoff, int scoff) {
    f32x4 sh[4], sc[4];
#pragma unroll
    for (int k = 0; k < 4; ++k) { sh[k] = *(const GAS f32x4*)(modrow + shoff + cb8(lane_, k)); sc[k] = *(const GAS f32x4*)(modrow + scoff + cb8(lane_, k)); }
    store_A_rowh8(Ab, lane_, row, v, sh, sc);
}
__device__ __forceinline__ void ln_row(f32x4 (&v)[4], const GAS float* g, const GAS float* b, int lane) {
    float s = 0.f;
#pragma unroll
    for (int j = 0; j < 4; ++j) s += (v[j][0] + v[j][1]) + (v[j][2] + v[j][3]);
    const float mean = wave_sum(s) * (1.f / D); float s2 = 0.f;
#pragma unroll
    for (int j = 0; j < 4; ++j) { v[j] = v[j] - mean; s2 += (v[j][0] * v[j][0] + v[j][1] * v[j][1]) + (v[j][2] * v[j][2] + v[j][3] * v[j][3]); }
    const float rstd = 1.f / sqrtf(wave_sum(s2) * (1.f / D) + LN_EPS);
#pragma unroll
    for (int j = 0; j < 4; ++j) { const int c = 4 * lane + 256 * j; const f32x4 gg = *(const GAS f32x4*)(g + c), bb = *(const GAS f32x4*)(b + c); v[j] = v[j] * rstd * gg + bb; }
}

__device__ __forceinline__ void ln_row2h(f32x4 (&v)[4], f32x4 (&w)[4], const f32x4 (&gg)[4], const f32x4 (&bb)[4]) {
    float s = 0.f, t = 0.f;
#pragma unroll
    for (int j = 0; j < 4; ++j) { s += (v[j][0] + v[j][1]) + (v[j][2] + v[j][3]); t += (w[j][0] + w[j][1]) + (w[j][2] + w[j][3]); }
    const float mean = wave_sum(s) * (1.f / D), meanb = wave_sum(t) * (1.f / D); float s2 = 0.f, t2 = 0.f;
#pragma unroll
    for (int j = 0; j < 4; ++j) { v[j] = v[j] - mean; w[j] = w[j] - meanb;
        s2 += (v[j][0] * v[j][0] + v[j][1] * v[j][1]) + (v[j][2] * v[j][2] + v[j][3] * v[j][3]); t2 += (w[j][0] * w[j][0] + w[j][1] * w[j][1]) + (w[j][2] * w[j][2] + w[j][3] * w[j][3]); }
    const float rstd = 1.f / sqrtf(wave_sum(s2) * (1.f / D) + LN_EPS), rstdb = 1.f / sqrtf(wave_sum(t2) * (1.f / D) + LN_EPS);
#pragma unroll
    for (int j = 0; j < 4; ++j) { v[j] = v[j] * rstd * gg[j] + bb[j]; w[j] = w[j] * rstdb * gg[j] + bb[j]; }
}
__device__ __forceinline__ void ln_row2(f32x4 (&v)[4], f32x4 (&w)[4], const GAS float* g, const GAS float* b, int lane) {
    float s = 0.f, t = 0.f;
#pragma unroll
    for (int j = 0; j < 4; ++j) { s += (v[j][0] + v[j][1]) + (v[j][2] + v[j][3]); t += (w[j][0] + w[j][1]) + (w[j][2] + w[j][3]); }
    const float mean = wave_sum(s) * (1.f / D), meanb = wave_sum(t) * (1.f / D); float s2 = 0.f, t2 = 0.f;
#pragma unroll
    for (int j = 0; j < 4; ++j) { v[j] = v[j] - mean; w[j] = w[j] - meanb;
        s2 += (v[j][0] * v[j][0] + v[j][1] * v[j][1]) + (v[j][2] * v[j][2] + v[j][3] * v[j][3]); t2 += (w[j][0] * w[j][0] + w[j][1] * w[j][1]) + (w[j][2] * w[j][2] + w[j][3] * w[j][3]); }
    const float rstd = 1.f / sqrtf(wave_sum(s2) * (1.f / D) + LN_EPS), rstdb = 1.f / sqrtf(wave_sum(t2) * (1.f / D) + LN_EPS);
#pragma unroll
    for (int j = 0; j < 4; ++j) { const int c = 4 * lane + 256 * j; const f32x4 gg = *(const GAS f32x4*)(g + c), bb = *(const GAS f32x4*)(b + c); v[j] = v[j] * rstd * gg + bb; w[j] = w[j] * rstdb * gg + bb; }
}

__device__ __forceinline__ void phase_a0(Frame& F) {
    frame_refresh(F); GAS unsigned char* const ws = wsp();
    const GAS float* MOD = (const GAS float*)(ws + WS_MOD);
    const int gw = F.bid * 8 + F.wave, NGW = F.G * 8;
    const GAS float* xl = inp(I_X); const GAS float* xc = inp(I_CTX); GAS bf16* Ab = (GAS bf16*)(ws + WS_A);
    const int lane = F.lane; f32x4 shv[4], scv[4]; int cslot = -1;
    for (int row = gw; row < R; row += 2 * NGW) {
        const int rowb = row + NGW < R ? row + NGW : row;
        const GAS float* xr = xrow_src(xl, xc, row); const GAS float* xrb = xrow_src(xl, xc, rowb); f32x4 v[4], w[4];
#pragma unroll
        for (int j = 0; j < 4; ++j) { v[j] = *(const GAS f32x4*)(xr + 4 * lane + 256 * j); w[j] = *(const GAS f32x4*)(xrb + 4 * lane + 256 * j); }
        const int sl = row_slot(row), slb = row_slot(rowb);
        if (sl != cslot) { const GAS float* mr = MOD + (size_t)(0 * 5 + sl) * 6144;
#pragma unroll
            for (int j = 0; j < 4; ++j) { shv[j] = *(const GAS f32x4*)(mr + 4 * lane + 256 * j); scv[j] = *(const GAS f32x4*)(mr + 1024 + 4 * lane + 256 * j); }
            cslot = sl; }
        store_A_rowh(Ab, lane, row, v, shv, scv);
        if (slb == sl) store_A_rowh(Ab, lane, rowb, w, shv, scv); else store_A_row(Ab, lane, rowb, w, MOD + (size_t)(0 * 5 + slb) * 6144, 0, 1024);
    }
}

__device__ __forceinline__ void phase_gdn_prep(Frame& F, int l) {
    frame_refresh(F); GAS unsigned char* const ws = wsp();
    const GAS bf16* P = (const GAS bf16*)(ws + WS_P);
    GAS bf16* GQ = (GAS bf16*)(ws + WS_GQ); GAS bf16* GK = (GAS bf16*)(ws + WS_GK); GAS bf16* GV = (GAS bf16*)(ws + WS_GV);
    GAS float* GSC = (GAS float*)(ws + WS_GSC);
    const GAS float* cw = inp(I_GCONV) + (size_t)l * 3 * 768;
    const int gw = F.bid * 8 + F.wave, NGW = F.G * 8, lane = F.lane;
    f32x4 w[3][3];
#pragma unroll
    for (int kk = 0; kk < 3; ++kk)
#pragma unroll
        for (int j = 0; j < 3; ++j) w[kk][j] = *(const GAS f32x4*)(cw + kk * 768 + j * 256 + 4 * lane);
    float galog = 0.f, gdtb = 0.f;
    if (lane < 8) { galog = -__expf(inp(I_GALOG)[l * 8 + lane]); gdtb = inp(I_GDTB)[l * 8 + lane]; }
    for (int row0 = gw; row0 < R; row0 += 2 * NGW) {
        int rows[2]; rows[0] = row0; rows[1] = row0 + NGW < R ? row0 + NGW : row0;
        v2u xa[2][3], xb[2][3], xc[2][3]; float av[2];
#pragma unroll
        for (int u = 0; u < 2; ++u) { const int row = rows[u];
            int t, L; if (row < NLAT) { t = row & (SEQ - 1); L = SEQ; } else { t = (row - NLAT) & (CTXL - 1); L = CTXL; }
            const GAS bf16* pr = P + (size_t)row * DPP;
#pragma unroll
            for (int j = 0; j < 3; ++j) {
                xb[u][j] = *(const GAS v2u*)(pr + j * 256 + 4 * lane);
                xa[u][j] = (v2u){0u, 0u}; xc[u][j] = (v2u){0u, 0u};
                if (t > 0) xa[u][j] = *(const GAS v2u*)(pr - DPP + j * 256 + 4 * lane);
                if (t < L - 1) xc[u][j] = *(const GAS v2u*)(pr + DPP + j * 256 + 4 * lane); }
            av[u] = lane < 16 ? bf2f(pr[PC_GA + lane]) : 0.f; }
#pragma unroll
        for (int u = 0; u < 2; ++u) { const int row = rows[u];
            f32x4 c[3];
#pragma unroll
            for (int j = 0; j < 3; ++j) { const v2u x0 = xa[u][j], x1 = xb[u][j], x2 = xc[u][j];
                f32x4 a;
                a[0] = w[0][j][0] * bflo(x0.x) + w[1][j][0] * bflo(x1.x) + w[2][j][0] * bflo(x2.x);
                a[1] = w[0][j][1] * bfhi(x0.x) + w[1][j][1] * bfhi(x1.x) + w[2][j][1] * bfhi(x2.x);
                a[2] = w[0][j][2] * bflo(x0.y) + w[1][j][2] * bflo(x1.y) + w[2][j][2] * bflo(x2.y);
                a[3] = w[0][j][3] * bfhi(x0.y) + w[1][j][3] * bfhi(x1.y) + w[2][j][3] * bfhi(x2.y);
#pragma unroll
                for (int i = 0; i < 4; ++i) a[i] = siluf_(a[i]);
                c[j] = a; }
            const float sq = sum16(c[0][0] * c[0][0] + c[0][1] * c[0][1] + c[0][2] * c[0][2] + c[0][3] * c[0][3]);
            const float sk = sum16(c[1][0] * c[1][0] + c[1][1] * c[1][1] + c[1][2] * c[1][2] + c[1][3] * c[1][3]);
            const float rq = 0.125f * __builtin_amdgcn_rsqf(sq + RMS_EPS), rk = __builtin_amdgcn_rsqf(sk + RMS_EPS);
            v2u o;
            o.x = pk2(c[0][0] * rq, c[0][1] * rq); o.y = pk2(c[0][2] * rq, c[0][3] * rq); *(GAS v2u*)(GQ + (size_t)row * 256 + 4 * lane) = o;
            o.x = pk2(c[1][0] * rk, c[1][1] * rk); o.y = pk2(c[1][2] * rk, c[1][3] * rk); *(GAS v2u*)(GK + (size_t)row * 256 + 4 * lane) = o;
            o.x = pk2(c[2][0], c[2][1]); o.y = pk2(c[2][2], c[2][3]); *(GAS v2u*)(GV + (size_t)row * 256 + 4 * lane) = o;
            if (lane < 16) {
                const float a = av[u];
                float val;
                if (lane < 8) { const float z = a + gdtb; const float e = __expf(z); const float sp = z > 20.f ? z : (e < 0.01f ? e * (1.f - e * (0.5f - e * 0.33333333f)) : __logf(1.f + e)); val = galog * sp; }
                else val = sigmoidf_(a);
                GSC[(size_t)row * 16 + lane] = val;
            }
        }
    }
}

__device__ __forceinline__ void chunk_rows(int b, int dir, int c, int& r0, int& step, int& t0) {
    const int s0 = c * TCH;
    if (s0 < CTXL) { t0 = -1; if (dir == 0) { r0 = NLAT + b * CTXL + s0; step = 1; } else { r0 = NLAT + b * CTXL + (CTXL - 1 - s0); step = -1; } }
    else { const int u = s0 - CTXL; if (dir == 0) { r0 = b * SEQ + u; step = 1; t0 = u; } else { r0 = b * SEQ + (SEQ - 1 - u); step = -1; t0 = SEQ - 1 - u; } }
}
constexpr int NCH64 = NSEQ / 64;
constexpr int UNITS = BATCH * 4 * 2 * NCH64;
__device__ __forceinline__ void unit_rows(int b, int dir, int n, int& r0, int& step, int& t0) {
    const int s0 = n * 64;
    if (s0 < CTXL) { t0 = -1; if (dir == 0) { r0 = NLAT + b * CTXL + s0; step = 1; } else { r0 = NLAT + b * CTXL + (CTXL - 1 - s0); step = -1; } }
    else { const int u = s0 - CTXL; if (dir == 0) { r0 = b * SEQ + u; step = 1; t0 = u; } else { r0 = b * SEQ + (SEQ - 1 - u); step = -1; t0 = SEQ - 1 - u; } }
}
__device__ __forceinline__ bf16x8 mkfrag(v2u lo, v2u hi) { v4u w; w.x = lo.x; w.y = lo.y; w.z = hi.x; w.w = hi.y; return __builtin_bit_cast(bf16x8, w); }
__device__ __forceinline__ bf16x8 ldfrag_perm(const GAS unsigned char* tile, int row0, int ks, int r16, int q) {
    const GAS unsigned char* p = tile + (row0 + r16) * 128 + (32 * ks + 4 * q) * 2;
    return mkfrag(*(const GAS v2u*)p, *(const GAS v2u*)(p + 32));
}
__device__ __forceinline__ bf16x8 pack_acc(const f32x4& a, const f32x4& b) {
    v4u w; w.x = pg8::cvt_pk_bf16(a[0], a[1]); w.y = pg8::cvt_pk_bf16(a[2], a[3]); w.z = pg8::cvt_pk_bf16(b[0], b[1]); w.w = pg8::cvt_pk_bf16(b[2], b[3]); return __builtin_bit_cast(bf16x8, w);
}
#define MFMA16(a, b, c) __builtin_amdgcn_mfma_f32_16x16x32_bf16(a, b, c, 0, 0, 0)
__device__ __forceinline__ float rdlane(float x, int i) { return __builtin_bit_cast(float, __builtin_amdgcn_readlane(__builtin_bit_cast(int, x), i)); }

template <int MODE>
__device__ __forceinline__ void chain_run(Frame& F, int sub) {
    GAS unsigned char* const ws = wsp();
    const int lane = lane_id_opaque(), r16 = lane & 15, q = lane >> 4;
    const int cb = sub & 3, dir = (sub >> 2) & 1, h = (sub >> 3) & 3, b = sub >> 5;
    constexpr int NT = (MODE == 0) ? 5 : 4, TW = 0, TU = (MODE == 0) ? 1 : 0, TKD = TU + 1, TQG = TU + 2, TATT = TU + 3;
    const int u0 = ((b * 4 + h) * 2 + dir) * NCH64;
    const GAS unsigned char* tb = ws + (MODE == 0 ? WS_TG : (MODE == 1 ? WS_TH : WS_TR)) + (size_t)u0 * NT * 8192;
    const GAS float* decp = (const GAS float*)(ws + WS_DEC) + (size_t)(MODE * UNITS + u0) * 64;
    GAS bf16* OB = (GAS bf16*)(ws + WS_OB) + (size_t)(MODE * 2 + dir) * R * 256 + h * 64 + cb * 16 + 4 * q;
    f32x4 S[4]; bf16x8 Sb[2];
#pragma unroll
    for (int m = 0; m < 4; ++m) S[m] = (f32x4){0.f, 0.f, 0.f, 0.f};
    Sb[0] = (bf16x8){0, 0, 0, 0, 0, 0, 0, 0}; Sb[1] = Sb[0];
    bf16x8 Wf[4][2], Kf[4][2], Qf[4][2], Af[4][2]; v2u Uf[4]; f32x4 dc[4];
#define LD_W(tu)  do { if (MODE == 0) { _Pragma("unroll") for (int m = 0; m < 4; ++m) _Pragma("unroll") for (int k = 0; k < 2; ++k) Wf[m][k] = ldfrag_perm((tu) + TW * 8192, 16 * m, k, r16, q); } } while (0)
#define LD_U(tu)  do { _Pragma("unroll") for (int m = 0; m < 4; ++m) Uf[m] = *(const GAS v2u*)((tu) + TU * 8192 + (cb * 16 + r16) * 128 + (16 * m + 4 * q) * 2); } while (0)
#define LD_K(tu)  do { _Pragma("unroll") for (int m = 0; m < 4; ++m) _Pragma("unroll") for (int k = 0; k < 2; ++k) Kf[m][k] = ldfrag_perm((tu) + TKD * 8192, 16 * m, k, r16, q); } while (0)
#define LD_Q(tu)  do { _Pragma("unroll") for (int m = 0; m < 4; ++m) _Pragma("unroll") for (int k = 0; k < 2; ++k) Qf[m][k] = ldfrag_perm((tu) + TQG * 8192, 16 * m, k, r16, q); } while (0)
#define LD_A(tu)  do { _Pragma("unroll") for (int m = 0; m < 4; ++m) _Pragma("unroll") for (int k = 0; k < 2; ++k) Af[m][k] = ldfrag_perm((tu) + TATT * 8192, 16 * m, k, r16, q); } while (0)
#define LD_D(n_)  do { _Pragma("unroll") for (int m = 0; m < 4; ++m) dc[m] = *(const GAS f32x4*)(decp + (size_t)(n_) * 64 + 16 * m + 4 * q); } while (0)
    LD_W(tb); LD_U(tb); LD_Q(tb); LD_A(tb); LD_K(tb); LD_D(0);
    for (int n = 0; n < NCH64; ++n) {
        const GAS unsigned char* tn = tb + (size_t)(n + 1 < NCH64 ? n + 1 : n) * NT * 8192;
        f32x4 vn[4], o[4];
#pragma unroll
        for (int m = 0; m < 4; ++m) { vn[m] = (f32x4){bflo(Uf[m].x), bfhi(Uf[m].x), bflo(Uf[m].y), bfhi(Uf[m].y)}; o[m] = (f32x4){0.f, 0.f, 0.f, 0.f}; }
        if (MODE == 0) {
#pragma unroll
            for (int m = 0; m < 4; ++m) { vn[m] = MFMA16(Wf[m][0], Sb[0], vn[m]); vn[m] = MFMA16(Wf[m][1], Sb[1], vn[m]); }
        }
#pragma unroll
        for (int m = 0; m < 4; ++m) { o[m] = MFMA16(Sb[0], Qf[m][0], o[m]); o[m] = MFMA16(Sb[1], Qf[m][1], o[m]); }
        LD_W(tn); LD_U(tn); LD_Q(tn);
        bf16x8 vb[2]; vb[0] = pack_acc(vn[0], vn[1]); vb[1] = pack_acc(vn[2], vn[3]);
#pragma unroll
        for (int m = 0; m < 4; ++m) { o[m] = MFMA16(vb[0], Af[m][0], o[m]); o[m] = MFMA16(vb[1], Af[m][1], o[m]); }
#pragma unroll
        for (int m = 0; m < 4; ++m) { S[m] = S[m] * dc[m]; S[m] = MFMA16(Kf[m][0], vb[0], S[m]); S[m] = MFMA16(Kf[m][1], vb[1], S[m]); }
        LD_A(tn); LD_K(tn); LD_D(n + 1 < NCH64 ? n + 1 : n);
        Sb[0] = pack_acc(S[0], S[1]); Sb[1] = pack_acc(S[2], S[3]);
        { int r0, step, t0; unit_rows(b, dir, n, r0, step, t0);
#pragma unroll
            for (int m = 0; m < 4; ++m) { const int row = r0 + step * (16 * m + r16); v2u w; w.x = pg8::cvt_pk_bf16(o[m][0], o[m][1]); w.y = pg8::cvt_pk_bf16(o[m][2], o[m][3]);
                *(GAS v2u*)(OB + (size_t)row * 256) = w; } }
    }
#undef LD_W
#undef LD_U
#undef LD_K
#undef LD_Q
#undef LD_A
#undef LD_D
}

__device__ __forceinline__ bf16x8 ldsfrag_perm(LAS unsigned char* tile, int row, int ks, int q) {
    return *(const LAS bf16x8*)(tile + row * 128 + (((4 * ks + q) ^ ((row >> 1) & 7)) << 4));
}
template <int MODE>
__device__ __forceinline__ void chain_wg(Frame& F, int cid, int half, GAS bf16* obase = nullptr) {
    GAS unsigned char* const ws = wsp();
    const int lane = lane_id_opaque(), r16 = lane & 15, q = lane >> 4;
    const int dir = cid & 1, h = (cid >> 1) & 3, b = cid >> 3;
    constexpr int NT = (MODE == 0) ? 5 : 4, TW = 0, TU = (MODE == 0) ? 1 : 0, TKD = TU + 1, TQG = TU + 2, TATT = TU + 3;
    constexpr int STAGE = NT * 8192, LPW = NT * 2, LSTAGE = STAGE + 256;
    const int u0 = cid * NCH64;
    const GAS unsigned char* tb = ws + (MODE == 0 ? WS_TG : (MODE == 1 ? WS_TH : WS_TR)) + (size_t)u0 * STAGE;
    LAS unsigned char* ring = F.lds;
    const GAS float* decp = (const GAS float*)(ws + WS_DEC) + (size_t)(MODE * UNITS + u0) * 64;
    int wv = F.wave; asm volatile("" : "+s"(wv));
    if (wv >= 4) {
        const int lw = wv - 4;
        const int lrow = lane >> 3, lch = lane & 7;
        unsigned voff[LPW], loff[LPW];
#pragma unroll
        for (int j = 0; j < LPW; ++j) { const int p = lw + 4 * j, row = 8 * (p & 7) + lrow; voff[j] = (unsigned)((p >> 3) * 8192 + row * 128 + lch * 16); loff[j] = (unsigned)((p >> 3) * 8192 + row * 128 + ((lch ^ ((row >> 1) & 7)) << 4)); }
        float d0_, d1_, d2_, d3_;
        v4u r0_[LPW], r1_[LPW], r2_[LPW], r3_[LPW];
#define CH_SKIP(j) (((j) >> 1) == TU && ((j) & 1) != half)
#define CH_LOAD(reg, dreg, n_) do { const int nn_ = (n_) < NCH64 ? (n_) : NCH64 - 1; const GAS unsigned char* src = tb + (size_t)nn_ * STAGE; _Pragma("unroll") for (int j = 0; j < LPW; ++j) { if (CH_SKIP(j)) continue; reg[j] = *(const GAS v4u*)(src + voff[j]); } dreg = decp[(size_t)nn_ * 64 + lane]; } while (0)
#define CH_WRITE(reg, dreg, n_) do { LAS unsigned char* dst = ring + ((n_) & 1) * LSTAGE; _Pragma("unroll") for (int j = 0; j < LPW; ++j) { if (CH_SKIP(j)) continue; *(LAS v4u*)(dst + loff[j]) = reg[j]; } *(LAS float*)(dst + STAGE + lane * 4) = dreg; } while (0)
#define CH_SYNC() do { asm volatile("s_waitcnt lgkmcnt(0)" ::: "memory"); __builtin_amdgcn_s_barrier(); asm volatile("" ::: "memory"); } while (0)
        CH_LOAD(r0_, d0_, 0); CH_LOAD(r1_, d1_, 1); CH_LOAD(r2_, d2_, 2); CH_LOAD(r3_, d3_, 3);
        CH_WRITE(r0_, d0_, 0);
#define CH_FENCE() asm volatile("" ::: "memory")
        for (int n = 0; n < NCH64; n += 4) {
            CH_SYNC(); CH_LOAD(r0_, d0_, n + 4); CH_FENCE(); CH_WRITE(r1_, d1_, n + 1);
            CH_SYNC(); CH_LOAD(r1_, d1_, n + 5); CH_FENCE(); CH_WRITE(r2_, d2_, n + 2);
            CH_SYNC(); CH_LOAD(r2_, d2_, n + 6); CH_FENCE(); CH_WRITE(r3_, d3_, n + 3);
            CH_SYNC(); CH_LOAD(r3_, d3_, n + 7); CH_FENCE(); CH_WRITE(r0_, d0_, n + 4);
        }
#undef CH_FENCE
        asm volatile("s_waitcnt vmcnt(0) lgkmcnt(0)" ::: "memory");
#undef CH_SYNC
#undef CH_LOAD
#undef CH_WRITE
#undef CH_SKIP
    } else if (wv >= 2) {
        for (int n = 0; n < NCH64; ++n) __builtin_amdgcn_s_barrier();
    } else {
        const int cb = half * 2 + wv;
        GAS bf16* OB = (obase ? obase : (GAS bf16*)(ws + WS_OB)) + (size_t)(MODE * 2 + dir) * R * 256 + h * 64 + cb * 16 + 4 * q;
        f32x4 S[4]; bf16x8 Sb[2];
#pragma unroll
        for (int m = 0; m < 4; ++m) S[m] = (f32x4){0.f, 0.f, 0.f, 0.f};
        Sb[0] = (bf16x8){0, 0, 0, 0, 0, 0, 0, 0}; Sb[1] = Sb[0];
        auto step = [&](const int n) {
            asm volatile("s_waitcnt lgkmcnt(0)" ::: "memory");
            __builtin_amdgcn_s_barrier();
            asm volatile("" ::: "memory");
            LAS unsigned char* st = ring + (n & 1) * LSTAGE;
            f32x4 vn[4], o[4], dc[4];
            v2u uf[4]; bf16x8 fW[4][2], fQ[4][2], fA[4][2], fK[4][2];
#pragma unroll
            for (int m = 0; m < 4; ++m) { const int row = cb * 16 + r16;
                uf[m] = *(const LAS v2u*)(st + TU * 8192 + row * 128 + (((4 * (m >> 1) + q) ^ ((row >> 1) & 7)) << 4) + 8 * (m & 1)); }
            if (MODE == 0) {
#pragma unroll
                for (int m = 0; m < 4; ++m) { fW[m][0] = ldsfrag_perm(st + TW * 8192, 16 * m + r16, 0, q); fW[m][1] = ldsfrag_perm(st + TW * 8192, 16 * m + r16, 1, q); }
            }
#pragma unroll
            for (int m = 0; m < 4; ++m) { fQ[m][0] = ldsfrag_perm(st + TQG * 8192, 16 * m + r16, 0, q); fQ[m][1] = ldsfrag_perm(st + TQG * 8192, 16 * m + r16, 1, q); }
#pragma unroll
            for (int m = 0; m < 4; ++m) dc[m] = *(const LAS f32x4*)(st + STAGE + (16 * m + 4 * q) * 4);
            __builtin_amdgcn_sched_barrier(0);
#pragma unroll
            for (int m = 0; m < 4; ++m) { fA[m][0] = ldsfrag_perm(st + TATT * 8192, 16 * m + r16, 0, q); fA[m][1] = ldsfrag_perm(st + TATT * 8192, 16 * m + r16, 1, q); }
#pragma unroll
            for (int m = 0; m < 4; ++m) { fK[m][0] = ldsfrag_perm(st + TKD * 8192, 16 * m + r16, 0, q); fK[m][1] = ldsfrag_perm(st + TKD * 8192, 16 * m + r16, 1, q); }
            __builtin_amdgcn_sched_barrier(0);
#pragma unroll
            for (int m = 0; m < 4; ++m) { vn[m] = (f32x4){bflo(uf[m].x), bfhi(uf[m].x), bflo(uf[m].y), bfhi(uf[m].y)}; o[m] = (f32x4){0.f, 0.f, 0.f, 0.f}; }
            if (MODE == 0) {
#pragma unroll
                for (int m = 0; m < 4; ++m) { vn[m] = MFMA16(fW[m][0], Sb[0], vn[m]); vn[m] = MFMA16(fW[m][1], Sb[1], vn[m]); }
            }
#pragma unroll
            for (int m = 0; m < 4; ++m) { o[m] = MFMA16(Sb[0], fQ[m][0], o[m]); o[m] = MFMA16(Sb[1], fQ[m][1], o[m]); }
            bf16x8 vb[2]; vb[0] = pack_acc(vn[0], vn[1]); vb[1] = pack_acc(vn[2], vn[3]);
#pragma unroll
            for (int m = 0; m < 4; ++m) { S[m] = S[m] * dc[m]; S[m] = MFMA16(fK[m][0], vb[0], S[m]); S[m] = MFMA16(fK[m][1], vb[1], S[m]); }
#pragma unroll
            for (int m = 0; m < 4; ++m) { o[m] = MFMA16(vb[0], fA[m][0], o[m]); o[m] = MFMA16(vb[1], fA[m][1], o[m]); }
            Sb[0] = pack_acc(S[0], S[1]); Sb[1] = pack_acc(S[2], S[3]);
            { int r0, step, t0; unit_rows(b, dir, n, r0, step, t0);
#pragma unroll
                for (int m = 0; m < 4; ++m) { const int row = r0 + step * (16 * m + r16); v2u w; w.x = pg8::cvt_pk_bf16(o[m][0], o[m][1]); w.y = pg8::cvt_pk_bf16(o[m][2], o[m][3]);
                    *(GAS v2u*)(OB + (size_t)row * 256) = w; } }
        };
        for (int n = 0; n < NCH64; ++n) step(n);
        asm volatile("s_waitcnt lgkmcnt(0)" ::: "memory");
    }
    __builtin_amdgcn_s_barrier();
}

__device__ __forceinline__ int swz(int rr, int kc) { return rr * 128 + ((kc ^ (rr & 7)) << 4); }
__device__ __forceinline__ v4u pack8(const float (&x)[8]) { v4u w; w.x = pk2(x[0], x[1]); w.y = pk2(x[2], x[3]); w.z = pk2(x[4], x[5]); w.w = pk2(x[6], x[7]); return w; }
__device__ __forceinline__ void unpack8(const v4u w, float (&x)[8]) { x[0] = bflo(w.x); x[1] = bfhi(w.x); x[2] = bflo(w.y); x[3] = bfhi(w.y); x[4] = bflo(w.z); x[5] = bfhi(w.z); x[6] = bflo(w.w); x[7] = bfhi(w.w); }
__device__ __forceinline__ void store_col8(GAS unsigned char* tile, int d0, int i, const float (&x)[8]) {
#pragma unroll
    for (int e = 0; e < 8; ++e) *(GAS bf16*)(tile + (d0 + e) * 128 + i * 2) = (bf16)f2bf(x[e]);
}
template <class Fac>
__device__ __forceinline__ void att_from_lds(LAS unsigned char* Qs, LAS unsigned char* Ks, GAS unsigned char* tATT, int r16, int q, const Fac& fac) {
#pragma unroll
    for (int nt = 0; nt < 4; ++nt) {
        bf16x8 bq[2];
#pragma unroll
        for (int ks = 0; ks < 2; ++ks) bq[ks] = *(const LAS bf16x8*)(Qs + swz(16 * nt + r16, ks * 4 + q));
        const int i = 16 * nt + r16;
#pragma unroll
        for (int mt = 0; mt < 4; ++mt) {
            unsigned zz; asm volatile("v_mov_b32 %0, 0" : "=v"(zz)); v2u w = (v2u){zz, zz};
            if (mt <= nt) {
                f32x4 acc = (f32x4){0.f, 0.f, 0.f, 0.f};
#pragma unroll
                for (int ks = 0; ks < 2; ++ks) { const bf16x8 ka = *(const LAS bf16x8*)(Ks + swz(16 * mt + r16, ks * 4 + q)); acc = MFMA16(ka, bq[ks], acc); }
                float y[4];
#pragma unroll
                for (int r = 0; r < 4; ++r) { const int j = 16 * mt + 4 * q + r; y[r] = (j <= i) ? acc[r] * fac(i, j) : 0.f; }
                w.x = pk2(y[0], y[1]); w.y = pk2(y[2], y[3]);
            }
            *(GAS v2u*)(tATT + i * 128 + (mt >> 1) * 64 + q * 16 + (mt & 1) * 8) = w;
        }
    }
}

__device__ __forceinline__ void tile_g2l(const GAS bf16* base, size_t pitch, int r0, int step, LAS unsigned char* buf, int lane) {
    const int rr = lane >> 3, ch = lane & 7;
    v4u v[8];
#pragma unroll
    for (int i = 0; i < 8; ++i) v[i] = *(const GAS v4u*)(base + (size_t)(r0 + step * (8 * i + rr)) * pitch + ch * 8);
#pragma unroll
    for (int i = 0; i < 8; ++i) *(LAS v4u*)(buf + swz(8 * i + rr, ch)) = v[i];
}
__device__ __forceinline__ void tile_l2g(LAS unsigned char* buf, GAS unsigned char* tile, int lane) {
    const int rr = lane >> 3, ch = lane & 7;
#pragma unroll
    for (int i = 0; i < 8; ++i) { const int row = 8 * i + rr, ks = ch >> 2, q = ch & 3;
        const v2u lo = *(const LAS v2u*)(buf + swz(row, 4 * ks + (q >> 1)) + 8 * (q & 1)), hi = *(const LAS v2u*)(buf + swz(row, 4 * ks + 2 + (q >> 1)) + 8 * (q & 1));
        v4u v; v.x = lo.x; v.y = lo.y; v.z = hi.x; v.w = hi.y; *(GAS v4u*)(tile + row * 128 + ch * 16) = v; }
}
__device__ __forceinline__ void row_rd(LAS unsigned char* buf, int lane, v4u (&w)[8]) {
#pragma unroll
    for (int c = 0; c < 8; ++c) w[c] = *(const LAS v4u*)(buf + swz(lane, c));
}
__device__ __forceinline__ void row_wr(LAS unsigned char* buf, int lane, const v4u (&w)[8]) {
#pragma unroll
    for (int c = 0; c < 8; ++c) *(LAS v4u*)(buf + swz(lane, c)) = w[c];
}
__device__ __forceinline__ void col_wr_raw(LAS unsigned char* buf, int lane, int d0, const v4u w) {
    const unsigned ww[4] = {w.x, w.y, w.z, w.w};
#pragma unroll
    for (int e = 0; e < 8; ++e) { const int d = d0 + e; *(LAS bf16*)(buf + swz(d, lane >> 3) + (lane & 7) * 2) = (bf16)((e & 1) ? (ww[e >> 1] >> 16) : (ww[e >> 1] & 0xffffu)); }
}
__device__ __forceinline__ void col_wr_f(LAS unsigned char* buf, int lane, int d0, const float (&x)[8]) {
#pragma unroll
    for (int e = 0; e < 8; ++e) { const int d = d0 + e; *(LAS bf16*)(buf + swz(d, lane >> 3) + (lane & 7) * 2) = (bf16)f2bf(x[e]); }
}

__device__ __forceinline__ void m1_ret(Frame& F, int l, int uidx, LAS unsigned char* lw) {
    GAS unsigned char* const ws = wsp();
    const int lane = lane_id_opaque(), r16 = lane & 15, q = lane >> 4;
    const int n = uidx % NCH64, t_ = uidx / NCH64, dir = t_ & 1, h = (t_ >> 1) & 3, b = t_ >> 3;
    int r0, step, t0; unit_rows(b, dir, n, r0, step, t0);
    const int tpos = t0 < 0 ? -1 : t0 + step * lane;
    const GAS bf16* pq = (const GAS bf16*)(ws + WS_P) + PC_RQKV + h * 64;
    const GAS float* ROT = (const GAS float*)(ws + WS_ROT);
    GAS unsigned char* tu = ws + WS_TR + (size_t)uidx * 4 * 8192;
    GAS unsigned char* tU = tu, *tKD = tu + 8192, *tQG = tu + 2 * 8192, *tATT = tu + 3 * 8192;
    LAS unsigned char* bufA = lw; LAS unsigned char* bufB = lw + 8192;
    const float lg = -__expf(inp(I_RDEC)[l * 8 + dir * 4 + h]);
    const float gq = __expf(lg * (float)(lane + 1)), gk = 0.125f * __expf(lg * (float)(63 - lane));
    tile_g2l(pq, DPP, r0, step, bufA, lane); tile_g2l(pq + 256, DPP, r0, step, bufB, lane);
    LDS_WAIT();
    v4u qw[8], kw[8]; row_rd(bufA, lane, qw); row_rd(bufB, lane, kw);
#pragma unroll
    for (int c8 = 0; c8 < 4; ++c8) {
        float ql[8], qh[8], kl[8], kh[8];
        unpack8(qw[c8], ql); unpack8(qw[c8 + 4], qh); unpack8(kw[c8], kl); unpack8(kw[c8 + 4], kh);
        if (tpos >= 0) {
            const GAS float* tab = ROT + (size_t)((c8 < 2 ? (tpos >> 6) : 128 + (tpos & 63)) * 16 + (c8 & 1) * 8) * 2;
#pragma unroll
            for (int e = 0; e < 8; ++e) { const float cs = tab[2 * e], sn = tab[2 * e + 1];
                const float a = ql[e] * cs - qh[e] * sn, bq = ql[e] * sn + qh[e] * cs; ql[e] = a; qh[e] = bq;
                const float c = kl[e] * cs - kh[e] * sn, dk = kl[e] * sn + kh[e] * cs; kl[e] = c; kh[e] = dk; }
        }
#pragma unroll
        for (int e = 0; e < 8; ++e) { ql[e] *= gq; qh[e] *= gq; }
        qw[c8] = pack8(ql); qw[c8 + 4] = pack8(qh); kw[c8] = pack8(kl); kw[c8 + 4] = pack8(kh);
    }
    row_wr(bufA, lane, qw); row_wr(bufB, lane, kw);
    LDS_WAIT();
    att_from_lds(bufA, bufB, tATT, r16, q, [&](int, int j) { return 0.125f * __expf(-lg * (float)(j + 1)); });
    LDS_WAIT();
    tile_l2g(bufA, tQG, lane);
#pragma unroll
    for (int c = 0; c < 8; ++c) { float x[8]; unpack8(kw[c], x);
#pragma unroll
        for (int e = 0; e < 8; ++e) x[e] *= gk;
        col_wr_f(bufB, lane, 8 * c, x); }
    LDS_WAIT();
    tile_l2g(bufB, tKD, lane);
    tile_g2l(pq + 512, DPP, r0, step, bufA, lane);
    LDS_WAIT();
    row_rd(bufA, lane, qw);
#pragma unroll
    for (int c = 0; c < 8; ++c) col_wr_raw(bufB, lane, 8 * c, qw[c]);
    LDS_WAIT();
    tile_l2g(bufB, tU, lane);
    ((GAS float*)(ws + WS_DEC))[(size_t)(2 * UNITS + uidx) * 64 + lane] = __expf(lg * 64.f);
    LDS_WAIT();
}

__device__ __forceinline__ void m1_hgrn(Frame& F, int l, int uidx, LAS unsigned char* lw) {
    GAS unsigned char* const ws = wsp();
    const int lane = lane_id_opaque(), r16 = lane & 15, q = lane >> 4;
    const int n = uidx % NCH64, t_ = uidx / NCH64, dir = t_ & 1, h = (t_ >> 1) & 3, b = t_ >> 3;
    int r0, step, t0; unit_rows(b, dir, n, r0, step, t0);
    const GAS bf16* P = (const GAS bf16*)(ws + WS_P);
    const GAS float* LBp = (const GAS float*)(ws + WS_LB) + l * 256 + h * 64;
    GAS unsigned char* tu = ws + WS_TH + (size_t)uidx * 4 * 8192;
    GAS unsigned char* tU = tu, *tKD = tu + 8192, *tQG = tu + 2 * 8192, *tATT = tu + 3 * 8192;
    GAS float* decp = (GAS float*)(ws + WS_DEC) + (size_t)(1 * UNITS + uidx) * 64;
    LAS unsigned char* bufA = lw; LAS unsigned char* bufB = lw + 8192;
    tile_g2l(P + PC_HQ + h * 64, DPP, r0, step, bufA, lane); tile_g2l(P + PC_HF + dir * 256 + h * 64, DPP, r0, step, bufB, lane);
    LDS_WAIT();
    v4u xqp[8], xkp[8];
#pragma unroll
    for (int g8 = 0; g8 < 8; ++g8) {
        float qv[8], fz[8], gc[8], kk[8];
        unpack8(*(const LAS v4u*)(bufA + swz(lane, g8)), qv); unpack8(*(const LAS v4u*)(bufB + swz(lane, g8)), fz);
        const f32x4 lb0 = *(const GAS f32x4*)(LBp + 8 * g8), lb1 = *(const GAS f32x4*)(LBp + 8 * g8 + 4);
#pragma unroll
        for (int e = 0; e < 8; ++e) { const float lb = e < 4 ? lb0[e] : lb1[e - 4]; const float sg = sigmoidf_(fz[e]);
            kk[e] = (1.f - lb) * (1.f - sg); gc[e] = __logf(lb + (1.f - lb) * sg); qv[e] = siluf_(qv[e]); }
#pragma unroll
        for (int o = 1; o < 64; o <<= 1) {
#pragma unroll
            for (int e = 0; e < 8; ++e) { const float t = shfl_idx(gc[e], (lane - o) & 63); if (lane >= o) gc[e] += t; }
        }
        float xq[8], xk[8], xs[8], xt[8];
#pragma unroll
        for (int e = 0; e < 8; ++e) { const float gm = rdlane(gc[e], 31), g63 = rdlane(gc[e], 63);
            xq[e] = qv[e] * __expf(gc[e]); xk[e] = kk[e] * __expf(g63 - gc[e]);
            xs[e] = qv[e] * __expf(fminf(gc[e] - gm, 80.f)); xt[e] = kk[e] * __expf(fminf(gm - gc[e], 80.f));
            if (lane == e) decp[8 * g8 + e] = __expf(g63); }
        xqp[g8] = pack8(xq); xkp[g8] = pack8(xk);
        *(LAS v4u*)(bufA + swz(lane, g8)) = pack8(xs); *(LAS v4u*)(bufB + swz(lane, g8)) = pack8(xt);
    }
    LDS_WAIT();
    att_from_lds(bufA, bufB, tATT, r16, q, [](int, int) { return 1.f; });
    LDS_WAIT();
    row_wr(bufA, lane, xqp);
#pragma unroll
    for (int c = 0; c < 8; ++c) col_wr_raw(bufB, lane, 8 * c, xkp[c]);
    LDS_WAIT();
    tile_l2g(bufA, tQG, lane); tile_l2g(bufB, tKD, lane);
    tile_g2l(P + PC_HI + h * 64, DPP, r0, step, bufA, lane);
    LDS_WAIT();
    row_rd(bufA, lane, xqp);
#pragma unroll
    for (int c = 0; c < 8; ++c) col_wr_raw(bufB, lane, 8 * c, xqp[c]);
    LDS_WAIT();
    tile_l2g(bufB, tU, lane);
    LDS_WAIT();
}

__device__ __forceinline__ void m1_gdn(Frame& F, int uidx, LAS unsigned char* lw) {
    GAS unsigned char* const ws = wsp();
    const int lane = lane_id_opaque(), r16 = lane & 15, q = lane >> 4;
    const int n = uidx % NCH64, t_ = uidx / NCH64, dir = t_ & 1, h = (t_ >> 1) & 3, b = t_ >> 3;
    int r0, step, t0; unit_rows(b, dir, n, r0, step, t0);
    const GAS bf16* GQ = (const GAS bf16*)(ws + WS_GQ) + h * 64; const GAS bf16* GK = (const GAS bf16*)(ws + WS_GK) + h * 64; const GAS bf16* GV = (const GAS bf16*)(ws + WS_GV) + h * 64;
    const GAS float* GSC = (const GAS float*)(ws + WS_GSC);
    GAS unsigned char* tu = ws + WS_TG + (size_t)uidx * 5 * 8192;
    GAS unsigned char* tW = tu, *tU = tu + 8192, *tKD = tu + 2 * 8192, *tQG = tu + 3 * 8192, *tATT = tu + 4 * 8192;
    LAS float* Am = (LAS float*)lw;
    LAS unsigned char* bufA = lw; LAS unsigned char* bufB = lw + 8192;
    const int myrow = r0 + step * lane;
    float gc = GSC[(size_t)myrow * 16 + dir * 4 + h]; const float beta = GSC[(size_t)myrow * 16 + 8 + dir * 4 + h];
#pragma unroll
    for (int o = 1; o < 64; o <<= 1) { const float t = shfl_idx(gc, (lane - o) & 63); if (lane >= o) gc += t; }
    const float g63 = rdlane(gc, 63);
#pragma unroll 1
    for (int nt = 0; nt < 4; ++nt) {
        const int i = 16 * nt + r16; const size_t irow = (size_t)(r0 + step * i) * 256;
        bf16x8 bk[2], bq[2];
#pragma unroll
        for (int ks = 0; ks < 2; ++ks) { bk[ks] = *(const GAS bf16x8*)(GK + irow + 32 * ks + 8 * q); bq[ks] = *(const GAS bf16x8*)(GQ + irow + 32 * ks + 8 * q); }
        const float gci = shfl_idx(gc, i), bti = shfl_idx(beta, i);
#pragma unroll
        for (int mt = 0; mt < 4; ++mt) {
            unsigned zz; asm volatile("v_mov_b32 %0, 0" : "=v"(zz)); v2u w = (v2u){zz, zz};
            if (mt <= nt) {
                f32x4 a1 = (f32x4){0.f, 0.f, 0.f, 0.f}, a2 = a1;
#pragma unroll
                for (int ks = 0; ks < 2; ++ks) { const bf16x8 ka = *(const GAS bf16x8*)(GK + (size_t)(r0 + step * (16 * mt + r16)) * 256 + 32 * ks + 8 * q); a1 = MFMA16(ka, bk[ks], a1); a2 = MFMA16(ka, bq[ks], a2); }
                f32x4 av; float y[4];
#pragma unroll
                for (int r = 0; r < 4; ++r) { const int j = 16 * mt + 4 * q + r; const float gcj = shfl_idx(gc, j); const float dcy = __expf(fminf(gci - gcj, 0.f));
                    av[r] = (j < i) ? bti * a1[r] * dcy : 0.f; y[r] = (j <= i) ? a2[r] * dcy : 0.f; }
                *(LAS f32x4*)(Am + i * 64 + 16 * mt + 4 * q) = av;
                w.x = pk2(y[0], y[1]); w.y = pk2(y[2], y[3]);
            }
            *(GAS v2u*)(tATT + i * 128 + (mt >> 1) * 64 + q * 16 + (mt & 1) * 8) = w;
        }
    }
    ((GAS float*)(ws + WS_DEC))[(size_t)(0 * UNITS + uidx) * 64 + lane] = __expf(g63);
    const float begc = beta * __expf(gc), kdf = __expf(g63 - gc);
    LDS_WAIT();
#define GDN_SOLVE(x) do { _Pragma("unroll") for (int i = 1; i < 64; ++i) { asm volatile("" ::: "memory"); float s0_ = 0.f, s1_ = 0.f, s2_ = 0.f, s3_ = 0.f; \
        _Pragma("unroll") for (int j4 = 0; j4 < (i + 3) / 4; ++j4) { const f32x4 a = *(const LAS f32x4*)(Am + i * 64 + 4 * j4); \
            if (4 * j4 + 0 < i) s0_ += a[0] * x[4 * j4 + 0]; if (4 * j4 + 1 < i) s1_ += a[1] * x[4 * j4 + 1]; if (4 * j4 + 2 < i) s2_ += a[2] * x[4 * j4 + 2]; if (4 * j4 + 3 < i) s3_ += a[3] * x[4 * j4 + 3]; } \
        float su = x[i] - ((s0_ + s1_) + (s2_ + s3_)); asm volatile("" : "+v"(su)); x[i] = su; } } while (0)
    const unsigned ul = (unsigned)lane;
    {   float x[64];
#pragma unroll
        for (int i = 0; i < 64; ++i) { if ((i & 15) == 0) asm volatile("" ::: "memory"); const GAS bf16* rp = GK + (size_t)(r0 + step * i) * 256; x[i] = rdlane(begc, i) * bf2f(rp[ul]); }
        GDN_SOLVE(x);
#pragma unroll
        for (int i = 0; i < 64; ++i) *(GAS bf16*)(tW + i * 128 + (lane >> 5) * 64 + (8 * ((lane & 15) >> 2) + 4 * ((lane >> 4) & 1) + (lane & 3)) * 2) = (bf16)f2bf(-x[i]);
    }
    asm volatile("" ::: "memory");
    {   float x[64];
#pragma unroll
        for (int i = 0; i < 64; ++i) { if ((i & 15) == 0) asm volatile("" ::: "memory"); const GAS bf16* rp = GV + (size_t)(r0 + step * i) * 256; x[i] = rdlane(beta, i) * bf2f(rp[ul]); }
        GDN_SOLVE(x);
        LDS_WAIT(); asm volatile("" ::: "memory");
        const int lane = lane_id_opaque();
#pragma unroll
        for (int c8 = 0; c8 < 8; ++c8) { float y[8];
#pragma unroll
            for (int e = 0; e < 8; ++e) y[e] = x[8 * c8 + e];
            *(LAS v4u*)(bufB + swz(lane, c8)) = pack8(y); }
    }
    { const int lane = lane_id_opaque(); const unsigned ul = (unsigned)lane;
    LDS_WAIT();
    tile_l2g(bufB, tU, lane);
    { v4u kp[8];
#pragma unroll
        for (int c8 = 0; c8 < 8; ++c8) { float y[8];
#pragma unroll
            for (int e = 0; e < 8; ++e) { const int i = 8 * c8 + e; const GAS bf16* rp = GK + (size_t)(r0 + step * i) * 256; y[e] = bf2f(rp[ul]) * rdlane(kdf, i); }
            kp[c8] = pack8(y); }
        row_wr(bufA, lane, kp); }
    tile_g2l(GQ, 256, r0, step, bufB, lane);
    LDS_WAIT();
    tile_l2g(bufA, tKD, lane);
    { v4u qgp[8]; const float eg = __expf(gc); row_rd(bufB, lane, qgp);
#pragma unroll
        for (int c = 0; c < 8; ++c) { float x[8]; unpack8(qgp[c], x);
#pragma unroll
            for (int e = 0; e < 8; ++e) x[e] *= eg;
            qgp[c] = pack8(x); }
        row_wr(bufB, lane, qgp); }
    LDS_WAIT();
    tile_l2g(bufB, tQG, lane);
    }
#undef GDN_SOLVE
    LDS_WAIT();
}
__device__ __forceinline__ void phase_m1(Frame& F, int l, int sel = 7) {
    frame_refresh(F);
    LAS unsigned char* lw = F.lds + F.wave * 16384;
    const int gw = F.bid * 8 + F.wave, NGW = F.G * 8;
    for (int it = gw; it < 3 * UNITS; it += NGW) {
        const int m = it / UNITS, u = it - m * UNITS;
#ifndef M1MASK
#define M1MASK 7
#endif
        if (m == 0) { if (sel & 1) m1_gdn(F, u, lw); }
        else if (m == 1) { if (sel & 2) m1_hgrn(F, l, u, lw); }
        else { if (sel & 4) m1_ret(F, l, u, lw); }
    }
}

__device__ __forceinline__ void scan_s5(Frame& F, int l, int sub, LAS unsigned char* lds) {
    GAS unsigned char* const ws = wsp();
    const int lane = lane_id_opaque(), g = sub & 15, dir = (sub >> 4) & 1, b = sub >> 5;
    const GAS bf16* P = (const GAS bf16*)(ws + WS_P);
    GAS float* O = (GAS float*)(ws + WS_O5) + (size_t)dir * R * 256;
    const int ldg = (l * 2 + dir) * 16 + g;
    const GAS float* LAM = (const GAS float*)(ws + WS_S5LAM) + (size_t)(ldg * 64 + lane) * 2;
    const GAS float* BB = (const GAS float*)(ws + WS_S5B) + (size_t)(ldg * 64 + lane) * 32;
    const float lr = LAM[0], li = LAM[1];
    float br[16], bi[16];
#pragma unroll
    for (int c = 0; c < 16; ++c) { br[c] = BB[2 * c]; bi[c] = BB[2 * c + 1]; }
    LAS float* US = (LAS float*)lds; LAS float* HS = US + 1024; LAS float* CS = HS + 32 * 130; LAS float* YS = CS + 2048;
    { const GAS float* cre = inp(I_S5CRE) + (size_t)ldg * 16 * 64; const GAS float* cim = inp(I_S5CIM) + (size_t)ldg * 16 * 64;
        for (int i = lane; i < 1024; i += 64) { CS[i * 2] = cre[i]; CS[i * 2 + 1] = cim[i]; } }
    float hr = 0.f, hi = 0.f;
    v4u ust;
    auto load = [&](int c) { int r0, step, t0; chunk_rows(b, dir, c, r0, step, t0); const int tt = lane >> 1, half = lane & 1; const int row = r0 + step * tt;
        ust = *(const GAS v4u*)(P + (size_t)row * DPP + PC_S5U + g * 16 + half * 8); };
    auto stage = [&](int buf) { const int tt = lane >> 1, half = lane & 1; LAS float* u = US + buf * 512 + tt * 16 + half * 8; const unsigned w[4] = {ust.x, ust.y, ust.z, ust.w};
        *(LAS f32x4*)u = (f32x4){bflo(w[0]), bfhi(w[0]), bflo(w[1]), bfhi(w[1])}; *(LAS f32x4*)(u + 4) = (f32x4){bflo(w[2]), bfhi(w[2]), bflo(w[3]), bfhi(w[3])}; };
    load(0); stage(0);
    for (int c = 0; c < NCHUNK; ++c) {
        const int buf = c & 1;
        if (c + 1 < NCHUNK) load(c + 1);
        LDS_WAIT();
        const LAS float* U = US + buf * 512;
        for (int tt = 0; tt < TCH; ++tt) {
            f32x4 u[4];
#pragma unroll
            for (int i = 0; i < 4; ++i) u[i] = *(const LAS f32x4*)(U + tt * 16 + 4 * i);
            float ar = 0.f, ai = 0.f;
#pragma unroll
            for (int cc = 0; cc < 16; ++cc) { ar += br[cc] * u[cc >> 2][cc & 3]; ai += bi[cc] * u[cc >> 2][cc & 3]; }
            const float nr = lr * hr - li * hi + ar, ni = lr * hi + li * hr + ai;
            hr = nr; hi = ni;
            *(LAS f32x2*)(HS + tt * 130 + lane * 2) = (f32x2){hr, hi};
        }
        LDS_WAIT();
        { const int cc = lane & 15, tq = lane >> 4;
            float acc[8];
#pragma unroll
            for (int k = 0; k < 8; ++k) acc[k] = 0.f;
            for (int p = 0; p < 64; ++p) {
                const f32x2 cv = *(const LAS f32x2*)(CS + (cc * 64 + p) * 2);
#pragma unroll
                for (int k = 0; k < 8; ++k) { const f32x2 hv = *(const LAS f32x2*)(HS + (tq * 8 + k) * 130 + p * 2); acc[k] += cv[0] * hv[0] - cv[1] * hv[1]; }
            }
#pragma unroll
            for (int k = 0; k < 8; ++k) YS[(tq * 8 + k) * 16 + cc] = acc[k];
        }
        LDS_WAIT();
        { int r0, step, t0; chunk_rows(b, dir, c, r0, step, t0); const int tt = lane >> 1, half = lane & 1; const int row = r0 + step * tt;
            GAS float* op = O + (size_t)row * 256 + g * 16 + half * 8;
            *(GAS f32x4*)op = *(const LAS f32x4*)(YS + tt * 16 + half * 8); *(GAS f32x4*)(op + 4) = *(const LAS f32x4*)(YS + tt * 16 + half * 8 + 4); }
        if (c + 1 < NCHUNK) stage(buf ^ 1);
    }
}

__device__ __forceinline__ int s5_tokrow(int b, int sc) { return sc < 16 ? NLAT + b * CTXL + sc * 16 : b * SEQ + (sc - 16) * 16; }
__device__ __forceinline__ void s5_relayout(Frame& F) {
    GAS unsigned char* const ws = wsp();
    const GAS bf16* P = (const GAS bf16*)(ws + WS_P); GAS bf16* A2 = (GAS bf16*)(ws + WS_S5A2);
    const int gw = F.bid * 8 + F.wave, NGW = F.G * 8, lane = F.lane, g = lane & 15;
    for (int it = gw; it < 2112; it += NGW) {
        const int b = it / 528, sc = it - b * 528, r0 = s5_tokrow(b, sc);
#pragma unroll
        for (int i = 0; i < 4; ++i) { const int t = i * 4 + (lane >> 4);
            const GAS bf16* src = P + (size_t)(r0 + t) * DPP + PC_S5U + g * 16;
            GAS bf16* dst = A2 + ((size_t)(g * 2112 + it) * 512 + t * 16);
            const v4u a = *(const GAS v4u*)src, c = *(const GAS v4u*)(src + 8);
            *(GAS v4u*)dst = a; *(GAS v4u*)(dst + 8) = c; }
    }
}
__device__ __forceinline__ void s5_build(Frame& F, int l) {
    GAS unsigned char* const ws = wsp();
    const GAS float* LAM = (const GAS float*)(ws + WS_S5LAM); const GAS float* BB = (const GAS float*)(ws + WS_S5B);
    const GAS float* cre = inp(I_S5CRE); const GAS float* cim = inp(I_S5CIM);
    GAS bf16* EB = (GAS bf16*)(ws + WS_S5EB); GAS bf16* WY = (GAS bf16*)(ws + WS_S5WY);
    const int gt = F.bid * 512 + F.tid, NT = F.G * 512;
    {   LAS float* kl = (LAS float*)(F.lds + F.wave * 256);
        const int gw = F.bid * 8 + F.wave, NGW = F.G * 8, p = F.lane;
        for (int it = gw; it < 4096; it += NGW) {
            const int g = it >> 8, c = (it >> 4) & 15, c2 = it & 15;
            float Kv[32];
#pragma unroll
            for (int d = 0; d < 2; ++d) { const int i0 = ((l * 2 + d) * 16 + g) * 64 + p;
                const float lr = LAM[i0 * 2], li = LAM[i0 * 2 + 1], br = BB[((size_t)i0 * 16 + c2) * 2], bi = BB[((size_t)i0 * 16 + c2) * 2 + 1];
                const size_t ci_ = (size_t)((l * 2 + d) * 16 + g) * 1024 + c * 64 + p; const float cr = cre[ci_], ci = cim[ci_];
                float wr_ = cr * br - ci * bi, wi_ = cr * bi + ci * br;
#pragma unroll
                for (int j = 0; j < 16; ++j) { Kv[d * 16 + j] = wr_; const float nr = wr_ * lr - wi_ * li; wi_ = wr_ * li + wi_ * lr; wr_ = nr; } }
#pragma unroll
            for (int j = 0; j < 32; ++j) { const float r = wave_sum(Kv[j]); if (p == j) kl[j] = r; }
            LDS_WAIT();
            GAS bf16* wy = WY + (size_t)g * 256 * 512;
#pragma unroll
            for (int e = 0; e < 4; ++e) { const int idx = p * 4 + e, t = idx >> 4, s2 = idx & 15;
                const float v = s2 < t ? kl[t - s2] : (s2 > t ? kl[16 + s2 - t] : kl[0] + kl[16]); wy[(size_t)(t * 16 + c) * 512 + s2 * 16 + c2] = (bf16)f2bf(v); }
            LDS_WAIT();
        }
    }
    for (int it = gt; it < 32768; it += NT) {
        const int p = it & 63, c = (it >> 6) & 15, d = (it >> 10) & 1, g = it >> 11;
        const int i0 = ((l * 2 + d) * 16 + g) * 64 + p;
        const float lr = LAM[i0 * 2], li = LAM[i0 * 2 + 1], br = BB[((size_t)i0 * 16 + c) * 2], bi = BB[((size_t)i0 * 16 + c) * 2 + 1];
        const size_t ci_ = (size_t)((l * 2 + d) * 16 + g) * 1024 + c * 64 + p; const float cr = cre[ci_], ci = cim[ci_];
        float pr[17], pi[17]; pr[0] = 1.f; pi[0] = 0.f;
#pragma unroll
        for (int j = 1; j < 17; ++j) { pr[j] = pr[j - 1] * lr - pi[j - 1] * li; pi[j] = pr[j - 1] * li + pi[j - 1] * lr; }
        GAS bf16* wy = WY + (size_t)g * 256 * 512 + 256 + d * 128 + 2 * p; GAS bf16* eb = EB + (size_t)g * 256 * 256 + (size_t)(d * 128 + 2 * p) * 256;
#pragma unroll
        for (int t = 0; t < 16; ++t) {
            const int jw = d == 0 ? t + 1 : 16 - t, je = d == 0 ? 15 - t : t;
            const float xr = cr * pr[jw] - ci * pi[jw], xi = cr * pi[jw] + ci * pr[jw];
            *(GAS unsigned*)(wy + (size_t)(t * 16 + c) * 512) = pk2(xr, -xi);
            const float er = pr[je] * br - pi[je] * bi, ei = pr[je] * bi + pi[je] * br;
            eb[t * 16 + c] = (bf16)f2bf(er); eb[256 + t * 16 + c] = (bf16)f2bf(ei);
        }
    }
}
__device__ __forceinline__ void s5_scan(Frame& F, int l, int sub) {
    GAS unsigned char* const ws = wsp();
    const int lane = lane_id_opaque(), g = sub & 15, dir = (sub >> 4) & 1, b = sub >> 5;
    const GAS float* LAM = (const GAS float*)(ws + WS_S5LAM) + (size_t)((((l * 2 + dir) * 16 + g) * 64 + lane) * 2);
    float lr = LAM[0], li = LAM[1];
#pragma unroll
    for (int k = 0; k < 4; ++k) { const float nr = lr * lr - li * li; li = 2.f * lr * li; lr = nr; }
    const GAS unsigned* HL = (const GAS unsigned*)(ws + WS_S5HL) + (size_t)(g * 2112 + b * 528) * 128 + dir * 64 + lane;
    GAS unsigned* HI = (GAS unsigned*)(ws + WS_S5A2) + (size_t)(g * 2112 + b * 528) * 256 + 128 + dir * 64 + lane;
    float hr = 0.f, hi = 0.f;
#pragma unroll 1
    for (int k0 = 0; k0 < 528; k0 += 48) {
        unsigned w[48];
#pragma unroll
        for (int j = 0; j < 48; ++j) { const int k = k0 + j; const int sc = dir == 0 ? k : (k < 16 ? 15 - k : 543 - k); w[j] = HL[(size_t)sc * 128]; }
#pragma unroll
        for (int j = 0; j < 48; ++j) { const int k = k0 + j; const int sc = dir == 0 ? k : (k < 16 ? 15 - k : 543 - k);
            HI[(size_t)sc * 256] = pk2(hr, hi);
            const float nr = lr * hr - li * hi + bflo(w[j]), ni = lr * hi + li * hr + bfhi(w[j]); hr = nr; hi = ni; }
    }
}
#ifndef NEWCHAIN
#define NEWCHAIN 7
#endif
__device__ __forceinline__ void phase_scans(Frame& F, int l) {
    frame_refresh(F);
#ifdef CHAINCMP
    if (F.bid < 96) {
        const int m = F.bid >> 5, cid = F.bid & 31;
        if (F.wave < 4) { const int sub = cid * 4 + F.wave; if (m == 0) chain_run<0>(F, sub); else if (m == 1) chain_run<1>(F, sub); else chain_run<2>(F, sub); }
        __syncthreads();
        if (l == 0) { GAS bf16* ob2 = (GAS bf16*)outp(); if (m == 0) { chain_wg<0>(F, cid, 0, ob2); } else if (m == 1) { chain_wg<1>(F, cid, 0, ob2); } else { chain_wg<2>(F, cid, 0, ob2); } }
    } else {
        for (int it = (F.bid - 96) + (F.G - 96) * F.wave; it < 128; it += (F.G - 96) * 8) s5_scan(F, l, it);
    }
#else
    if (F.bid < 192) {
        const int half = (F.bid >> 3) & 1, c_ = (F.bid >> 4) * 8 + (F.bid & 7), m = c_ >> 5, cid = c_ & 31;
        if (m == 0) chain_wg<0>(F, cid, half); else if (m == 1) chain_wg<1>(F, cid, half); else chain_wg<2>(F, cid, half);
    } else {
        for (int it = (F.bid - 192) + (F.G - 192) * F.wave; it < 128; it += (F.G - 192) * 8) s5_scan(F, l, it);
    }
#endif
}

__device__ __forceinline__ void phase_readout(Frame& F, int l) {
    frame_refresh(F); GAS unsigned char* const ws = wsp();
    const GAS bf16* P = (const GAS bf16*)(ws + WS_P);
    GAS bf16* MIX = (GAS bf16*)(ws + WS_MIX); GAS bf16* YA = (GAS bf16*)(ws + WS_GQ);
    GAS float* O5 = (GAS float*)(ws + WS_O5); const GAS bf16* OB = (const GAS bf16*)(ws + WS_OB);
    const int gw = F.bid * 8 + F.wave, NGW = F.G * 8, lane = F.lane;
    const int hsel = lane >> 5, l32 = lane & 31, c8 = 8 * l32, dch = c8 & 63;
    const f32x4 gn0 = *(const GAS f32x4*)(inp(I_GNW) + l * 64 + dch), gn1 = *(const GAS f32x4*)(inp(I_GNW) + l * 64 + dch + 4);
    const f32x4 hn0 = *(const GAS f32x4*)(inp(I_HNW) + l * 64 + dch), hn1 = *(const GAS f32x4*)(inp(I_HNW) + l * 64 + dch + 4);
    const size_t OBS = (size_t)R * 256;
    for (int row0 = gw; row0 < R; row0 += 4 * NGW) {
        int rows[2]; bool ok[2];
#pragma unroll
        for (int u = 0; u < 2; ++u) { const int r_ = row0 + (2 * u + hsel) * NGW; ok[u] = r_ < R; rows[u] = ok[u] ? r_ : row0; }
        v4u of[2][3], ob[2][3], gg[2][3];
#pragma unroll
        for (int u = 0; u < 2; ++u) { if (!ok[u]) continue; const GAS bf16* pr = P + (size_t)rows[u] * DPP; const size_t ro = (size_t)rows[u] * 256 + c8;
#pragma unroll
            for (int m = 0; m < 3; ++m) { of[u][m] = *(const GAS v4u*)(OB + (size_t)(m * 2) * OBS + ro); ob[u][m] = *(const GAS v4u*)(OB + (size_t)(m * 2 + 1) * OBS + ro);
                gg[u][m] = *(const GAS v4u*)(pr + (m == 0 ? PC_GZ : (m == 1 ? PC_HG : PC_RG)) + c8); } }
#pragma unroll
        for (int u = 0; u < 2; ++u) {
#pragma unroll
            for (int m = 0; m < 3; ++m) {
                float o[8], gt[8];
                if (ok[u]) { const v4u f_ = of[u][m], b_ = ob[u][m], g_ = gg[u][m];
                    o[0] = bflo(f_.x) + bflo(b_.x); o[1] = bfhi(f_.x) + bfhi(b_.x); o[2] = bflo(f_.y) + bflo(b_.y); o[3] = bfhi(f_.y) + bfhi(b_.y);
                    o[4] = bflo(f_.z) + bflo(b_.z); o[5] = bfhi(f_.z) + bfhi(b_.z); o[6] = bflo(f_.w) + bflo(b_.w); o[7] = bfhi(f_.w) + bfhi(b_.w);
                    gt[0] = bflo(g_.x); gt[1] = bfhi(g_.x); gt[2] = bflo(g_.y); gt[3] = bfhi(g_.y); gt[4] = bflo(g_.z); gt[5] = bfhi(g_.z); gt[6] = bflo(g_.w); gt[7] = bfhi(g_.w); }
                else {
#pragma unroll
                    for (int i = 0; i < 8; ++i) { o[i] = 0.f; gt[i] = 0.f; } }
                float sq = 0.f;
#pragma unroll
                for (int i = 0; i < 8; ++i) sq += o[i] * o[i];
                const float ss = sum8(sq);
                const float r = __builtin_amdgcn_rsqf(ss * (1.f / 64.f) + RMS_EPS);
                float y[8];
#pragma unroll
                for (int i = 0; i < 8; ++i) { const float nw = m == 0 ? (i < 4 ? gn0[i & 3] : gn1[i & 3]) : (m == 1 ? (i < 4 ? hn0[i & 3] : hn1[i & 3]) : 1.f); y[i] = o[i] * r * nw * siluf_(gt[i]); }
                if (ok[u]) { v4u w; w.x = pk2(y[0], y[1]); w.y = pk2(y[2], y[3]); w.z = pk2(y[4], y[5]); w.w = pk2(y[6], y[7]);
                    *(GAS v4u*)(MIX + (size_t)rows[u] * D + (m == 0 ? 0 : (m == 1 ? 512 : 768)) + c8) = w; }
            } }
    }
}

template <bool ROUTE>
__device__ __forceinline__ void phase_ln(Frame& F, int l, int which) {
    frame_refresh(F); GAS unsigned char* const ws = wsp();
    const GAS bf16* DL = (const GAS bf16*)(ws + WS_Y);
    const bool xin = (l == 0 && which == 0);
    const GAS float* xsl = xin ? inp(I_X) : (const GAS float*)outp(); const GAS float* xsc = xin ? inp(I_CTX) : (const GAS float*)(ws + WS_XC);
    const GAS float* MOD = (const GAS float*)(ws + WS_MOD);
    const GAS float* lg = inp(I_LNG) + (size_t)(l * 2 + which) * D; const GAS float* lb = inp(I_LNB) + (size_t)(l * 2 + which) * D;
    const bool last = (l == DEPTH - 1 && which == 1);
    const int nl = which == 0 ? l : l + 1, shoff = which == 0 ? 3072 : 0, scoff = which == 0 ? 4096 : 1024;
    const int lane = F.lane;
    GAS float* xl = outp(); GAS float* xc = (GAS float*)(ws + WS_XC); GAS bf16* Ab = (GAS bf16*)(ws + WS_A);
    if constexpr (!ROUTE) {
        const int gw = F.bid * 8 + F.wave, NGW = F.G * 8;
        const int nrows = last ? NLAT : R;
        f32x4 lgv[4], lbv[4], shv[4], scv[4]; int cslot = -1;
#pragma unroll
        for (int k = 0; k < 4; ++k) { lgv[k] = *(const GAS f32x4*)(lg + cb8(lane, k)); lbv[k] = *(const GAS f32x4*)(lb + cb8(lane, k)); }
        for (int row = gw; row < nrows; row += 2 * NGW) {
            const int rowb = row + NGW < nrows ? row + NGW : row;
            f32x4 v[4], w[4]; const GAS float* xs = xrow_src(xsl, xsc, row); const GAS float* xsb = xrow_src(xsl, xsc, rowb);
#pragma unroll
            for (int jp = 0; jp < 2; ++jp) { const v4u dw = *(const GAS v4u*)(DL + (size_t)row * D + 8 * lane + 512 * jp), db = *(const GAS v4u*)(DL + (size_t)rowb * D + 8 * lane + 512 * jp);
                v[2 * jp]     = *(const GAS f32x4*)(xs + cb8(lane, 2 * jp)) * ALPHA     + (f32x4){bflo(dw.x), bfhi(dw.x), bflo(dw.y), bfhi(dw.y)};
                v[2 * jp + 1] = *(const GAS f32x4*)(xs + cb8(lane, 2 * jp + 1)) * ALPHA + (f32x4){bflo(dw.z), bfhi(dw.z), bflo(dw.w), bfhi(dw.w)};
                w[2 * jp]     = *(const GAS f32x4*)(xsb + cb8(lane, 2 * jp)) * ALPHA     + (f32x4){bflo(db.x), bfhi(db.x), bflo(db.y), bfhi(db.y)};
                w[2 * jp + 1] = *(const GAS f32x4*)(xsb + cb8(lane, 2 * jp + 1)) * ALPHA + (f32x4){bflo(db.z), bfhi(db.z), bflo(db.w), bfhi(db.w)}; }
            ln_row2h(v, w, lgv, lbv);
            GAS float* xd = xrow_dst(xl, xc, row); GAS float* xdb = xrow_dst(xl, xc, rowb);
#pragma unroll
            for (int k = 0; k < 4; ++k) { *(GAS f32x4*)(xd + cb8(lane, k)) = v[k]; *(GAS f32x4*)(xdb + cb8(lane, k)) = w[k]; }
            if (!last) { const int sl = row_slot(row), slb = row_slot(rowb);
                if (sl != cslot) { const GAS float* mr = MOD + (size_t)(nl * 5 + sl) * 6144;
#pragma unroll
                    for (int k = 0; k < 4; ++k) { shv[k] = *(const GAS f32x4*)(mr + shoff + cb8(lane, k)); scv[k] = *(const GAS f32x4*)(mr + scoff + cb8(lane, k)); }
                    cslot = sl; }
                store_A_rowh8(Ab, lane, row, v, shv, scv);
                if (slb == sl) store_A_rowh8(Ab, lane, rowb, w, shv, scv); else store_A_row8(Ab, lane, rowb, w, MOD + (size_t)(nl * 5 + slb) * 6144, shoff, scoff); }
        }
    } else {
        LAS int* cnt = (LAS int*)F.lds;
        if (F.tid < 8) cnt[F.tid] = 0;
        __syncthreads();
        const GAS float* rw = inp(I_MROUTER) + (size_t)(l >> 1) * D * NEXP;
        f32x4 rwa[4][4][2];
#pragma unroll
        for (int j = 0; j < 4; ++j)
#pragma unroll
            for (int i = 0; i < 4; ++i) { const GAS float* p = rw + (size_t)(4 * lane + 256 * j + i) * 8; rwa[j][i][0] = *(const GAS f32x4*)p; rwa[j][i][1] = *(const GAS f32x4*)(p + 4); }
        GAS int* TOPE = (GAS int*)(ws + WS_TOPE); GAS float* TOPG = (GAS float*)(ws + WS_TOPG);
        const int Rl = (l == DEPTH - 1) ? NLAT : R;
        const int RPW = (Rl + F.G - 1) / F.G, rbeg = F.bid * RPW, rend = min(Rl, rbeg + RPW);
        f32x4 lgv[4], lbv[4];
#pragma unroll
        for (int j = 0; j < 4; ++j) { lgv[j] = *(const GAS f32x4*)(lg + 4 * lane + 256 * j); lbv[j] = *(const GAS f32x4*)(lb + 4 * lane + 256 * j); }
        for (int row0 = rbeg + F.wave; row0 < rend; row0 += 16) {
            const bool two = row0 + 8 < rend; const int rowb = two ? row0 + 8 : row0;
            f32x4 v[4], w[4]; const GAS float* xs = xrow_src(xsl, xsc, row0); const GAS float* xsb = xrow_src(xsl, xsc, rowb);
#pragma unroll
            for (int j = 0; j < 4; ++j) { const v2u dw = *(const GAS v2u*)(DL + (size_t)row0 * D + 4 * lane + 256 * j), db = *(const GAS v2u*)(DL + (size_t)rowb * D + 4 * lane + 256 * j);
                v[j] = *(const GAS f32x4*)(xs + 4 * lane + 256 * j) * ALPHA + (f32x4){bflo(dw.x), bfhi(dw.x), bflo(dw.y), bfhi(dw.y)};
                w[j] = *(const GAS f32x4*)(xsb + 4 * lane + 256 * j) * ALPHA + (f32x4){bflo(db.x), bfhi(db.x), bflo(db.y), bfhi(db.y)}; }
            ln_row2h(v, w, lgv, lbv);
            GAS float* xd = xrow_dst(xl, xc, row0); GAS float* xdb = xrow_dst(xl, xc, rowb);
#pragma unroll
            for (int j = 0; j < 4; ++j) { *(GAS f32x4*)(xd + 4 * lane + 256 * j) = v[j]; *(GAS f32x4*)(xdb + 4 * lane + 256 * j) = w[j]; }
#pragma unroll
            for (int u = 0; u < 2; ++u) {
                if (u == 1 && !two) break;
                const int row = u == 0 ? row0 : rowb; const f32x4 (&vv)[4] = u == 0 ? v : w;
                const GAS float* modrow = MOD + (size_t)(nl * 5 + row_slot(row)) * 6144;
                float lgt[8];
#pragma unroll
                for (int e = 0; e < 8; ++e) lgt[e] = 0.f;
                GAS bf16* ar = Ab + (size_t)row * D;
#pragma unroll
                for (int j = 0; j < 4; ++j) { const int c = 4 * lane + 256 * j; const f32x4 sh = *(const GAS f32x4*)(modrow + shoff + c), sc = *(const GAS f32x4*)(modrow + scoff + c);
                    const f32x4 hv = vv[j] * (sc + 1.f) + sh;
                    { v2u w2; w2.x = pk2(hv[0], hv[1]); w2.y = pk2(hv[2], hv[3]); *(GAS v2u*)(ar + c) = w2; }
#pragma unroll
                    for (int i = 0; i < 4; ++i)
#pragma unroll
                        for (int e = 0; e < 8; ++e) lgt[e] += hv[i] * rwa[j][i][e >> 2][e & 3]; }
#pragma unroll
                for (int e = 0; e < 8; ++e) lgt[e] = wave_sum(lgt[e]);
                int e0 = 0; float v0 = lgt[0];
#pragma unroll
                for (int e = 1; e < 8; ++e) if (lgt[e] > v0) { v0 = lgt[e]; e0 = e; }
                int e1 = -1; float v1 = -3.0e38f;
#pragma unroll
                for (int e = 0; e < 8; ++e) if (e != e0 && lgt[e] > v1) { v1 = lgt[e]; e1 = e; }
                if (lane == 0) { const float ex = __expf(v1 - v0); const float g0 = 1.f / (1.f + ex); TOPE[row] = e0 | (e1 << 8); TOPG[row * 2] = g0; TOPG[row * 2 + 1] = ex * g0;
                    __hip_atomic_fetch_add(&cnt[e0], 1, __ATOMIC_RELAXED, __HIP_MEMORY_SCOPE_WORKGROUP); __hip_atomic_fetch_add(&cnt[e1], 1, __ATOMIC_RELAXED, __HIP_MEMORY_SCOPE_WORKGROUP); }
            }
        }
        __syncthreads();
        if (F.tid < 8) ((GAS int*)(ws + WS_WGCNT))[F.bid * 8 + F.tid] = cnt[F.tid];
    }
}

__device__ __forceinline__ void phase_moe_assign(Frame& F, int l) {
    frame_refresh(F); GAS unsigned char* const ws = wsp();
    LAS int* sm = (LAS int*)F.lds;
    const GAS int* WGCNT = (const GAS int*)(ws + WS_WGCNT);
    if (F.tid < 8) { int tot = 0, pre = 0; for (int w = 0; w < F.G; ++w) { const int c = WGCNT[w * 8 + F.tid]; tot += c; if (w < F.bid) pre += c; } sm[16 + F.tid] = tot; sm[24 + F.tid] = pre; sm[8 + F.tid] = 0; }
    __syncthreads();
    if (F.tid == 0) { int ps = 0; GAS int* info = (GAS int*)(ws + WS_MOEINFO);
        for (int e = 0; e < 8; ++e) { sm[e] = ps + sm[24 + e]; if (F.bid == 0) info[e] = ps >> 8; ps += (sm[16 + e] + 255) & ~255; }
        if (F.bid == 0) { info[8] = ps >> 8; } }
    __syncthreads();
    if (F.bid == 0 && F.tid < 272) { GAS int* info = (GAS int*)(ws + WS_MOEINFO); int ps = 0, e = 0;
        for (int q = 0; q < 8; ++q) { ps += (sm[16 + q] + 255) >> 8; if (F.tid >= ps) e = q + 1; }
        info[16 + F.tid] = e < 8 ? e : 7; }
    __syncthreads();
    const GAS int* TOPE = (const GAS int*)(ws + WS_TOPE); const GAS float* TOPG = (const GAS float*)(ws + WS_TOPG);
    GAS int* TOKPOS = (GAS int*)(ws + WS_TOKPOS); GAS float* ROWG = (GAS float*)(ws + WS_ROWG);
    const GAS bf16* A = (const GAS bf16*)(ws + WS_A); GAS bf16* XG = (GAS bf16*)(ws + WS_XG);
    const int Rl = (l == DEPTH - 1) ? NLAT : R;
    const int RPW = (Rl + F.G - 1) / F.G, rbeg = F.bid * RPW, rend = min(Rl, rbeg + RPW);
    for (int row = rbeg + F.wave; row < rend; row += 8) {
        int p0 = 0, p1 = 0;
        if (F.lane == 0) { const int te = TOPE[row]; const int e0 = te & 255, e1 = te >> 8;
            p0 = sm[e0] + __hip_atomic_fetch_add(&sm[8 + e0], 1, __ATOMIC_RELAXED, __HIP_MEMORY_SCOPE_WORKGROUP); p1 = sm[e1] + __hip_atomic_fetch_add(&sm[8 + e1], 1, __ATOMIC_RELAXED, __HIP_MEMORY_SCOPE_WORKGROUP);
            TOKPOS[row * 2] = p0; TOKPOS[row * 2 + 1] = p1; ROWG[p0] = TOPG[row * 2]; ROWG[p1] = TOPG[row * 2 + 1]; }
        p0 = __builtin_amdgcn_readfirstlane(p0); p1 = __builtin_amdgcn_readfirstlane(p1);
        const v4u a0 = *(const GAS v4u*)(A + (size_t)row * D + 8 * F.lane), a1 = *(const GAS v4u*)(A + (size_t)row * D + 512 + 8 * F.lane);
        *(GAS v4u*)(XG + (size_t)p0 * D + 8 * F.lane) = a0; *(GAS v4u*)(XG + (size_t)p0 * D + 512 + 8 * F.lane) = a1;
        *(GAS v4u*)(XG + (size_t)p1 * D + 8 * F.lane) = a0; *(GAS v4u*)(XG + (size_t)p1 * D + 512 + 8 * F.lane) = a1;
    }
}
__device__ __forceinline__ void phase_moe_combine(Frame& F, int l) {
    frame_refresh(F); GAS unsigned char* const ws = wsp();
    const GAS float* MOD = (const GAS float*)(ws + WS_MOD);
    const GAS float* lg = inp(I_LNG) + (size_t)(l * 2 + 1) * D; const GAS float* lb = inp(I_LNB) + (size_t)(l * 2 + 1) * D;
    const bool last = (l == DEPTH - 1);
    const GAS int* TOKPOS = (const GAS int*)(ws + WS_TOKPOS); const GAS bf16* YB = (const GAS bf16*)(ws + WS_XG);
    const int gw = F.bid * 8 + F.wave, NGW = F.G * 8, lane = F.lane;
    const int nrows = last ? NLAT : R;
    GAS float* xl = outp(); GAS float* xc = (GAS float*)(ws + WS_XC); GAS bf16* Ab = (GAS bf16*)(ws + WS_A);
    f32x4 lgv[4], lbv[4], shv[4], scv[4], gtv[4]; int cslot = -1;
#pragma unroll
    for (int j = 0; j < 4; ++j) { lgv[j] = *(const GAS f32x4*)(lg + 4 * lane + 256 * j); lbv[j] = *(const GAS f32x4*)(lb + 4 * lane + 256 * j); }
    for (int row = gw; row < nrows; row += 2 * NGW) {
        const int rowb = row + NGW < nrows ? row + NGW : row;
        const int p0 = TOKPOS[row * 2], p1 = TOKPOS[row * 2 + 1], q0 = TOKPOS[rowb * 2], q1 = TOKPOS[rowb * 2 + 1];
        const GAS float* xs = xrow_src(xl, xc, row); const GAS float* xsb = xrow_src(xl, xc, rowb);
        const int sl = row_slot(row), slb = row_slot(rowb);
        if (sl != cslot) { const GAS float* mg = MOD + (size_t)(l * 5 + sl) * 6144 + 5120; const GAS float* mr = MOD + (size_t)((last ? l : l + 1) * 5 + sl) * 6144;
#pragma unroll
            for (int j = 0; j < 4; ++j) { gtv[j] = *(const GAS f32x4*)(mg + 4 * lane + 256 * j); shv[j] = *(const GAS f32x4*)(mr + 4 * lane + 256 * j); scv[j] = *(const GAS f32x4*)(mr + 1024 + 4 * lane + 256 * j); }
            cslot = sl; }
        const GAS float* gpb = MOD + (size_t)(l * 5 + slb) * 6144 + 5120;
        f32x4 v[4], w[4];
#pragma unroll
        for (int j = 0; j < 4; ++j) { const int c = 4 * lane + 256 * j;
            const v2u y0 = *(const GAS v2u*)(YB + (size_t)p0 * D + c), y1 = *(const GAS v2u*)(YB + (size_t)p1 * D + c), z0 = *(const GAS v2u*)(YB + (size_t)q0 * D + c), z1 = *(const GAS v2u*)(YB + (size_t)q1 * D + c);
            const f32x4 f = (f32x4){bflo(y0.x) + bflo(y1.x), bfhi(y0.x) + bfhi(y1.x), bflo(y0.y) + bflo(y1.y), bfhi(y0.y) + bfhi(y1.y)};
            const f32x4 h = (f32x4){bflo(z0.x) + bflo(z1.x), bfhi(z0.x) + bfhi(z1.x), bflo(z0.y) + bflo(z1.y), bfhi(z0.y) + bfhi(z1.y)};
            v[j] = *(const GAS f32x4*)(xs + c) * ALPHA + gtv[j] * f;
            const f32x4 gb_ = (slb == sl) ? gtv[j] : *(const GAS f32x4*)(gpb + c);
            w[j] = *(const GAS f32x4*)(xsb + c) * ALPHA + gb_ * h; }
        ln_row2h(v, w, lgv, lbv);
        GAS float* xd = xrow_dst(xl, xc, row); GAS float* xdb = xrow_dst(xl, xc, rowb);
#pragma unroll
        for (int j = 0; j < 4; ++j) { *(GAS f32x4*)(xd + 4 * lane + 256 * j) = v[j]; *(GAS f32x4*)(xdb + 4 * lane + 256 * j) = w[j]; }
        if (!last) { store_A_rowh(Ab, lane, row, v, shv, scv);
            if (slb == sl) store_A_rowh(Ab, lane, rowb, w, shv, scv); else store_A_row(Ab, lane, rowb, w, MOD + (size_t)((l + 1) * 5 + slb) * 6144, 0, 1024); }
    }
}

#ifndef PHMASK
#define PHMASK 0xFFFFFFFFu
#endif
#define PK(k) ((PHMASK >> (k)) & 1u)
constexpr int PPL = 12, NPHASE = 2 + DEPTH * PPL;
__global__ void __launch_bounds__(512, 2) fwd(Args args) {
    extern __shared__ __attribute__((aligned(16))) unsigned char lds_raw[];
    Frame F;
    F.lds = (LAS unsigned char*)lds_raw;
    F.tid = threadIdx.x; F.lane = F.tid & 63; F.wave = __builtin_amdgcn_readfirstlane(F.tid >> 6); F.G = gridDim.x; F.bid = blockIdx.x;
    volatile LAS unsigned* MISC = (volatile LAS unsigned*)(F.lds + LDSCTL_OFF);
    if (F.tid < 64) MISC[F.tid] = 0u;
    __syncthreads();
#if MK_ONE_LAUNCH
    XcdBarrier bar = xcd_barrier_post((GAS unsigned*)(args.ws + WS_CTL) + 4096, MISC + 8, F.wave);
#else
    const int lo = args.ph_lo, hi = args.ph_hi;
    XcdBarrier bar; bar.bar = (GAS unsigned*)(args.ws + WS_CTL) + 4096; bar.x = 0; bar.st = nullptr;
    if (hi - lo > 1) bar = xcd_barrier_post((GAS unsigned*)(args.ws + WS_CTL) + 4096, MISC + 8, F.wave);
#endif
#ifndef DUPMASK
#define DUPMASK 0u
#endif
#define NREP(kind) (((DUPMASK >> (kind)) & 1u) ? 2 : 1)
#define DUPBAR(kind, r) do { if (((DUPMASK >> (kind)) & 1u) && (r) == 0) xcd_barrier(bar, F.wave); } while (0)
#ifndef PROBE_A
#define PROBE_A -1
#endif
#ifndef PROBE_B
#define PROBE_B -1
#endif
#if PROBE_A >= 0
#define PSTAMP(kind) do { if (blockIdx.x == 0 && F.wave == 0) { const unsigned long long t_ = __builtin_amdgcn_s_memrealtime(); MISC[32 + (kind)] += (unsigned)(t_ - ((unsigned long long)MISC[30] | ((unsigned long long)MISC[31] << 32))); MISC[30] = (unsigned)t_; MISC[31] = (unsigned)(t_ >> 32); } } while (0)
#else
#define PSTAMP(kind) do { } while (0)
#endif
#if MK_ONE_LAUNCH
#define IN(k) true
#define PKIND_OF(k) (((k) < 2) ? (k) : (2 + ((k) - 2) % 12 + ((((((k) - 2) / 12) & 1) && ((k) - 2) % 12 >= 8) ? 12 : 0)))
#define SEAM(k) do { xcd_barrier(bar, F.wave); PSTAMP(PKIND_OF(k)); } while (0)
#else
#define IN(k) (lo <= (k) && (k) < hi)
#define SEAM(k) do { if (IN((k) + 1)) xcd_barrier(bar, F.wave); } while (0)
#endif
    LAS unsigned char* ring = F.lds;
    PSTAMP(31);

    if (IN(0)) { if (PK(0)) phase_prologue(F); SEAM(0); }
    if (IN(1)) { if (PK(1)) phase_a0(F); SEAM(1); }
    for (int l = 0; l < DEPTH; ++l) {
        const int pb = 2 + l * PPL;
        const bool moe = (l & 1) != 0;
        if (PK(3) && IN(pb + 0)) for (int r_ = 0; r_ < NREP(2); ++r_) {
            GAS unsigned char* const ws = wsp();
            pg8::Gemm g{(const GAS bf16*)(ws + WS_A), (const GAS bf16*)(ws + WS_WIN) + (size_t)l * DPW * D, D, D};
            pg8::StaticOrder S; S.init(R / 256, DPW / 256, D, F.G, F.bid);
            pg8::EpiBf16 E{(GAS bf16*)(ws + WS_P), DPP, DPROJ};
            pg8::gemm_phase<pg8::EpiBf16, pg8::StaticOrder, true, true>(ring, F.wave, g, S, E);
            DUPBAR(2, r_); if (r_ == NREP(2) - 1) SEAM(pb + 0);
        }
        if (IN(pb + 1)) for (int r_ = 0; r_ < NREP(3); ++r_) { if (PK(4)) { phase_gdn_prep(F, l); s5_relayout(F); s5_build(F, l); } DUPBAR(3, r_); if (r_ == NREP(3) - 1) SEAM(pb + 1); }
        if (IN(pb + 2)) for (int r_ = 0; r_ < NREP(4); ++r_) {
#ifndef M1SEL
#define M1SEL 7
#endif
#ifndef M1DUPSEL
#define M1DUPSEL 7
#endif
            if (PK(19) && r_ == 0) { GAS unsigned char* const ws = wsp();
                pg8::Gemm g{(const GAS bf16*)(ws + WS_S5A2), (const GAS bf16*)(ws + WS_S5EB), 256, 512};
                pg8::S5Order S; S.init(144, 1, 256, F.G, F.bid, 512);
                pg8::EpiS5HL E{(GAS bf16*)(ws + WS_S5HL)};
                pg8::gemm_phase<pg8::EpiS5HL, pg8::S5Order, true, true>(ring, F.wave, g, S, E); }
            if (PK(18)) phase_m1(F, l, r_ == 0 ? M1SEL : M1DUPSEL);
            DUPBAR(4, r_); if (r_ == NREP(4) - 1) SEAM(pb + 2);
        }
#ifndef DUPSCAN
#define DUPSCAN 0
#endif
        if (IN(pb + 3)) { if (PK(5)) phase_scans(F, l);
#if DUPSCAN
            xcd_barrier(bar, F.wave); phase_scans(F, l);
#endif
            SEAM(pb + 3); }
        if (IN(pb + 4)) for (int r_ = 0; r_ < NREP(6); ++r_) {
            if (PK(20)) { GAS unsigned char* const ws = wsp();
                pg8::Gemm g{(const GAS bf16*)(ws + WS_S5A2), (const GAS bf16*)(ws + WS_S5WY), 512, 512};
                pg8::S5Order S; S.init(144, 1, 512, F.G, F.bid, 512);
                pg8::EpiS5Y E{(GAS bf16*)(ws + WS_GQ), (GAS float*)(ws + WS_O5), (const GAS bf16*)(ws + WS_P), inp(I_S5D) + l * 256};
                pg8::gemm_phase<pg8::EpiS5Y, pg8::S5Order, true, true>(ring, F.wave, g, S, E); }
#ifdef CHAINCMP
            if (l == 0) { GAS unsigned char* const ws = wsp(); const GAS unsigned short* a = (const GAS unsigned short*)(ws + WS_OB); const GAS unsigned short* c = (const GAS unsigned short*)outp();
                const int ln_ = lane_id_opaque();
                for (int mm = 0; mm < 3; ++mm) { unsigned bad = 0, big = 0;
                    for (size_t i = (size_t)F.bid * 512 + F.wave * 64 + ln_; i < (size_t)2 * R * 256; i += (size_t)F.G * 512) { const size_t j = (size_t)mm * 2 * R * 256 + i; const float x = bf2f(a[j]), y = bf2f(c[j]); if (a[j] != c[j]) { ++bad; if (fabsf(x - y) > 0.02f * (fabsf(x) + 1e-3f)) ++big; } }
                    if (bad) __hip_atomic_fetch_add((GAS unsigned*)(ws + WS_CTL) + 70010 + mm, bad, __ATOMIC_RELAXED, __HIP_MEMORY_SCOPE_AGENT);
                    if (big) __hip_atomic_fetch_add((GAS unsigned*)(ws + WS_CTL) + 70020 + mm, big, __ATOMIC_RELAXED, __HIP_MEMORY_SCOPE_AGENT); } }
#endif
            if (PK(6)) phase_readout(F, l); if (PK(2) && moe) phase_moe_convert(F, l >> 1); DUPBAR(6, r_); if (r_ == NREP(6) - 1) SEAM(pb + 4);
        }
        if (PK(7) && IN(pb + 5)) for (int r_ = 0; r_ < NREP(7); ++r_) {
            GAS unsigned char* const ws = wsp();
            pg8::Gemm g{(const GAS bf16*)(ws + WS_GQ), (const GAS bf16*)(ws + WS_WGLU) + (size_t)l * 65536, 256, 256};
            pg8::StaticOrder S; S.init(R / 256, 1, 256, F.G, F.bid);
            pg8::EpiGlu E{(GAS bf16*)(ws + WS_MIX), (const GAS float*)(ws + WS_O5), inp(I_S5GLUB) + l * 256};
            pg8::gemm_phase<pg8::EpiGlu, pg8::StaticOrder, true, true>(ring, F.wave, g, S, E);
            DUPBAR(7, r_); if (r_ == NREP(7) - 1) SEAM(pb + 5);
        }
        if (PK(8) && IN(pb + 6)) for (int r_ = 0; r_ < NREP(8); ++r_) {
            GAS unsigned char* const ws = wsp(); const GAS float* modl = (const GAS float*)(ws + WS_MOD) + (size_t)l * 5 * 6144;
            pg8::Gemm g{(const GAS bf16*)(ws + WS_MIX), (const GAS bf16*)(ws + WS_WOUT) + (size_t)l * D * D, D, D};
            pg8::StaticOrder S; S.init((l == DEPTH - 1 ? NLAT : R) / 256, D / 256, D, F.G, F.bid);
            pg8::EpiRes E{(GAS bf16*)(ws + WS_Y), modl, 2048};
            pg8::gemm_phase<pg8::EpiRes, pg8::StaticOrder, true, true>(ring, F.wave, g, S, E);
            DUPBAR(8, r_); if (r_ == NREP(8) - 1) SEAM(pb + 6);
        }
        if (IN(pb + 7)) for (int r_ = 0; r_ < NREP(9); ++r_) { if (moe) { if (PK(9)) phase_ln<true>(F, l, 0); } else { if (PK(10)) phase_ln<false>(F, l, 0); } DUPBAR(9, r_); if (r_ == NREP(9) - 1) SEAM(pb + 7); }
        if (!moe) {
            if (PK(11) && IN(pb + 8)) for (int r_ = 0; r_ < NREP(10); ++r_) {
                GAS unsigned char* const ws = wsp();
                pg8::Gemm g{(const GAS bf16*)(ws + WS_A), (const GAS bf16*)(ws + WS_WF13) + (size_t)(l >> 1) * 2 * FFD * D, D, D};
                pg8::StaticOrder S; S.init(R / 256, 2 * FFD / 256, D, F.G, F.bid);
                pg8::EpiSwiGlu E{(GAS bf16*)(ws + WS_HID), FFD};
                pg8::gemm_phase<pg8::EpiSwiGlu, pg8::StaticOrder, true, true>(ring, F.wave, g, S, E);
                DUPBAR(10, r_); if (r_ == NREP(10) - 1) SEAM(pb + 8);
            }
            if (PK(12) && IN(pb + 9)) for (int r_ = 0; r_ < NREP(11); ++r_) {
                GAS unsigned char* const ws = wsp(); const GAS float* modl = (const GAS float*)(ws + WS_MOD) + (size_t)l * 5 * 6144;
                pg8::Gemm g{(const GAS bf16*)(ws + WS_HID), (const GAS bf16*)(ws + WS_WF2) + (size_t)(l >> 1) * D * FFD, FFD, FFD};
                pg8::StaticOrder S; S.init(R / 256, D / 256, FFD, F.G, F.bid);
                pg8::EpiRes E{(GAS bf16*)(ws + WS_Y), modl, 5120};
                pg8::gemm_phase<pg8::EpiRes, pg8::StaticOrder, true, true>(ring, F.wave, g, S, E);
                DUPBAR(11, r_); if (r_ == NREP(11) - 1) SEAM(pb + 9);
            }
            if (IN(pb + 10)) for (int r_ = 0; r_ < NREP(13); ++r_) { if (PK(13)) phase_ln<false>(F, l, 1); DUPBAR(13, r_); if (r_ == NREP(13) - 1) SEAM(pb + 11); }
        } else {
            if (IN(pb + 8)) for (int r_ = 0; r_ < NREP(22); ++r_) { if (PK(14)) phase_moe_assign(F, l); DUPBAR(22, r_); if (r_ == NREP(22) - 1) SEAM(pb + 8); }
            if (PK(15) && IN(pb + 9)) for (int r_ = 0; r_ < NREP(23); ++r_) {
                GAS unsigned char* const ws = wsp();
                const GAS int* info = (const GAS int*)(ws + WS_MOEINFO);
                pg8::Gemm g{(const GAS bf16*)(ws + WS_XG), (const GAS bf16*)(ws + WS_WM13), D, D};
                pg8::MoeOrder S; S.init(info[8], 2 * FFE / 256, D, F.G, F.bid);
                S.texp = info + 16; S.estride = (size_t)2 * FFE * D * 2;
                pg8::EpiSwiGlu E{(GAS bf16*)(ws + WS_MHID), FFE};
                pg8::gemm_phase<pg8::EpiSwiGlu, pg8::MoeOrder, true, true>(ring, F.wave, g, S, E);
                DUPBAR(23, r_); if (r_ == NREP(23) - 1) SEAM(pb + 9);
            }
            if (PK(16) && IN(pb + 10)) for (int r_ = 0; r_ < NREP(24); ++r_) {
                GAS unsigned char* const ws = wsp();
                const GAS int* info = (const GAS int*)(ws + WS_MOEINFO);
                pg8::Gemm g{(const GAS bf16*)(ws + WS_MHID), (const GAS bf16*)(ws + WS_WM2), FFE, FFE};
                pg8::MoeOrder S; S.init(info[8], D / 256, FFE, F.G, F.bid);
                S.texp = info + 16; S.estride = (size_t)D * FFE * 2;
                pg8::EpiMoeDown E{(GAS bf16*)(ws + WS_XG), (const GAS float*)(ws + WS_ROWG)};
                pg8::gemm_phase<pg8::EpiMoeDown, pg8::MoeOrder, true, true>(ring, F.wave, g, S, E);
                DUPBAR(24, r_); if (r_ == NREP(24) - 1) SEAM(pb + 10);
            }
            if (IN(pb + 11)) for (int r_ = 0; r_ < NREP(25); ++r_) { if (PK(17)) phase_moe_combine(F, l); DUPBAR(25, r_); if (r_ == NREP(25) - 1 && l < DEPTH - 1) SEAM(pb + 11); }
        }
    }
#ifdef CHAINCMP
    {   xcd_barrier(bar, F.wave);
        const GAS unsigned* cw = (const GAS unsigned*)(args.ws + WS_CTL) + 70010;
        const unsigned b0 = cw[0] + cw[1] + cw[2], g0 = cw[10] + cw[11] + cw[12];
        const float va = b0 == 0 ? 0.f : (b0 < 100 ? 10.f : (b0 < 10000 ? 100.f : (b0 < 1000000 ? 1000.f : 10000.f)));
        const float vb = g0 == 0 ? 0.f : (g0 < 100 ? 1.f : (g0 < 10000 ? 2.f : (g0 < 1000000 ? 3.f : 4.f)));
        GAS float* o = outp();
        for (size_t i = (size_t)blockIdx.x * 512 + F.wave * 64 + lane_id_opaque(); i < (size_t)NLAT * D; i += (size_t)gridDim.x * 512) o[i] = (i == 0) ? vb * 1.0e6f + 5.0e5f : va + 3.f;
    }
#endif
#ifdef CHAINCHECK
    {   xcd_barrier(bar, F.wave);
        const GAS unsigned* cw = (const GAS unsigned*)(args.ws + WS_CTL) + 70000;
        const unsigned c0 = cw[0], c1 = cw[1], c2 = cw[2];
        const float va = (c0 ? 100.f : 0.f) + (c1 ? 10.f : 0.f) + (c2 ? 1.f : 0.f);
        const float vb = (float)(c0 + c1 + c2);
        GAS float* o = outp();
        for (size_t i = (size_t)blockIdx.x * 512 + F.wave * 64 + lane_id_opaque(); i < (size_t)NLAT * D; i += (size_t)gridDim.x * 512) o[i] = (i == 0) ? vb * 1000.f + 7777.f : va + 3.f;
    }
#endif
#if PROBE_A >= 0
    {
        PSTAMP(25);
        GAS float* tw = (GAS float*)(args.ws + WS_CTL) + 65536;
        { const int ln_ = lane_id_opaque(); if (blockIdx.x == 0 && F.wave == 0 && ln_ < 32) tw[ln_] = (float)MISC[32 + ln_] * 0.01f; }
        xcd_barrier(bar, F.wave);
        const float va = tw[PROBE_A], vb = tw[PROBE_B] * 1000.f;
        GAS float* o = outp();
        for (size_t i = (size_t)blockIdx.x * 512 + F.wave * 64 + lane_id_opaque(); i < (size_t)NLAT * D; i += (size_t)gridDim.x * 512) o[i] = (i == 0) ? vb : va;
    }
#endif
#undef IN
#undef SEAM
}

extern "C" void kernel_launch(void* const* d_in, const int* in_sizes, int n_in, void* d_out, int out_size, void* d_ws, size_t ws_size, hipStream_t stream) {
    static int grid = 0;
    if (grid == 0) {
        if (n_in != 34 || out_size != NLAT * D || ws_size < WS_END) { fprintf(stderr, "kernel_launch: unexpected shapes (n_in %d out %d ws %zu need %zu)\n", n_in, out_size, ws_size, (size_t)WS_END); grid = -1; return; }
        int dev = 0, cus = 0, per_cu = 0;
        if (hipGetDevice(&dev) != hipSuccess || hipDeviceGetAttribute(&cus, hipDeviceAttributeMultiprocessorCount, dev) != hipSuccess) { grid = -1; return; }
        if (hipFuncSetAttribute((const void*)fwd, hipFuncAttributeMaxDynamicSharedMemorySize, LDS_BYTES) != hipSuccess) { fprintf(stderr, "kernel_launch: hipFuncSetAttribute failed\n"); grid = -1; return; }
        if (hipOccupancyMaxActiveBlocksPerMultiprocessor(&per_cu, (const void*)fwd, 512, LDS_BYTES) != hipSuccess || per_cu < 1) fprintf(stderr, "kernel_launch: occupancy query reports %d\n", per_cu);
        (void)hipGetLastError();
        grid = cus;
    }
    if (grid < 0) return;
    (void)hipMemsetAsync((char*)d_ws + WS_CTL, 0, CTL_ZERO_BYTES, stream);
    Args a{};
    for (int i = 0; i < 34; ++i) a.in[i] = (const float*)d_in[i];
    a.out = (float*)d_out; a.ws = (unsigned char*)d_ws;
#if MK_ONE_LAUNCH
    a.ph_lo = 0; a.ph_hi = NPHASE;
    hipLaunchKernelGGL(fwd, dim3(grid), dim3(512), LDS_BYTES, stream, a);
#else
    for (int p = 0; p < NPHASE; ++p) {
        if (p >= 2) { const int l = (p - 2) / PPL, k = (p - 2) % PPL; const bool moe = (l & 1) != 0; if (k == 11 && !moe) continue; }
        a.ph_lo = p; a.ph_hi = p + 1;
        hipLaunchKernelGGL(fwd, dim3(grid), dim3(512), LDS_BYTES, stream, a);
    }
#endif
}
```
